# Optimizing an MI355X kernel written in HIP

```python
import math
import jax
import jax.numpy as jnp
from jax import lax
import numpy as np


D_MODEL = 1024
BATCH = 4
SEQ = 4096
DEPTH = 4

GRID_W = 64
CTX_LEN = 256
N_EVEN = (DEPTH + 1) // 2
N_ODD = DEPTH // 2
NORM_EPS = 1e-6
N_MOD = 6

DA_HEADS = 4
DA_QK_DIM = 64
DA_V_DIM = 2 * DA_QK_DIM
DA_QK_WIDTH = DA_HEADS * 2 * DA_QK_DIM
DA_WIDTH = DA_HEADS * DA_V_DIM
ROPE_THETA = 10000.0
ROPE_AXIS_DIM = DA_QK_DIM // 2
Q_BLOCK = 128

RG_WIDTH = D_MODEL // 2
RG_BLOCKS = 8
RG_BW = RG_WIDTH // RG_BLOCKS
RG_C = 8.0
CONV_W = 4
CONV_LEFT = CONV_W // 2

EVEN_SPLITS = (DA_QK_WIDTH, 2 * DA_QK_WIDTH, 2 * DA_QK_WIDTH + DA_WIDTH, 2 * DA_QK_WIDTH + DA_WIDTH + RG_WIDTH)
EVEN_IN = 2 * DA_QK_WIDTH + DA_WIDTH + 2 * RG_WIDTH
EVEN_MIX = DA_WIDTH + RG_WIDTH

GDN_HEADS = 8
GDN_DK = 128
GDN_DV = 128
GDN_QK = GDN_HEADS * GDN_DK
GDN_V = GDN_HEADS * GDN_DV
GDN_CONV_CH = 2 * GDN_QK + GDN_V
GDN_CHUNK = 64
ODD_IN = GDN_CONV_CH + GDN_V + 4 * GDN_HEADS

FFN_DENSE = 2816
N_EXPERTS = 8
TOP_K = 2
FFN_EXPERT = 3584
MOE_BLOCK = 512

kernel_name = 'hybrid_diffattn_rglru_gdn_moe_dit'


def rmsnorm(x, g):
    xf = x.astype(jnp.float32)
    y = xf * lax.rsqrt(jnp.mean(xf * xf, axis=-1, keepdims=True) + NORM_EPS)
    return (y * g.astype(jnp.float32)).astype(x.dtype)


def modulate(h, shift, scale):
    return h * (1.0 + scale) + shift


def l2norm(x):
    xf = x.astype(jnp.float32)
    return xf * lax.rsqrt(jnp.sum(xf * xf, axis=-1, keepdims=True) + NORM_EPS)


def flip_time(z):
    return z[:, ::-1]


def identity(z):
    return z


def dwconv(x, w):
    t = x.shape[1]
    xp = jnp.pad(x, ((0, 0), (CONV_LEFT, CONV_W - 1 - CONV_LEFT), (0, 0)))
    return sum(xp[:, j:j + t] * w[j] for j in range(CONV_W))


def swiglu(x, w_in, w_out):
    gate, up = jnp.split(x @ w_in, 2, axis=-1)
    return (jax.nn.silu(gate) * up) @ w_out


def axial_rope_tables(rows):
    pos = jnp.arange(rows * GRID_W)
    row = (pos // GRID_W).astype(jnp.float32)
    col = (pos % GRID_W).astype(jnp.float32)
    inv_freq = ROPE_THETA ** (-jnp.arange(0, ROPE_AXIS_DIM, 2, dtype=jnp.float32) / ROPE_AXIS_DIM)
    ang = jnp.concatenate([row[:, None] * inv_freq, col[:, None] * inv_freq], axis=-1)
    return jnp.cos(ang), jnp.sin(ang)


def apply_rope(x, cos, sin):
    xf = x.astype(jnp.float32).reshape(x.shape[:-1] + (DA_QK_DIM // 2, 2))
    x1, x2 = xf[..., 0], xf[..., 1]
    c = cos[:, None, None, :]
    s = sin[:, None, None, :]
    out = jnp.stack([x1 * c - x2 * s, x1 * s + x2 * c], axis=-1)
    return out.reshape(x.shape).astype(x.dtype)


def diff_attn_block(qb, k, v, lam):
    s = jnp.einsum('bqhmd,bkhmd->bhmqk', qb, k).astype(jnp.float32) * (DA_QK_DIM ** -0.5)
    p = jax.nn.softmax(s, axis=-1)
    w = (p[:, :, 0] - lam * p[:, :, 1]).astype(v.dtype)
    return jnp.einsum('bhqk,bkhe->bqhe', w, v)


def diff_attention(q_lat, k_lat, v_lat, q_ctx, k_ctx, v_ctx, lam, lam_init, g_sub, need_ctx):
    bsz, t = q_lat.shape[:2]
    k_all = jnp.concatenate([k_ctx, k_lat], axis=1)
    v_all = jnp.concatenate([v_ctx, v_lat], axis=1)
    qb = jnp.swapaxes(q_lat.reshape((bsz, t // Q_BLOCK, Q_BLOCK) + q_lat.shape[2:]), 0, 1)
    o = lax.map(lambda q: diff_attn_block(q, k_all, v_all, lam), qb)
    o_lat = jnp.swapaxes(o, 0, 1).reshape(bsz, t, DA_HEADS, DA_V_DIM)

    def post(o_h):
        return (rmsnorm(o_h, g_sub) * (1.0 - lam_init)).reshape(o_h.shape[:2] + (DA_WIDTH,))

    o_ctx = post(diff_attn_block(q_ctx, k_ctx, v_ctx, lam)) if need_ctx else None
    return post(o_lat), o_ctx


def linear_scan(a, b, h0):
    b = b.at[:, 0].add(a[:, 0] * h0)
    _, h = lax.associative_scan(lambda l, r: (l[0] * r[0], r[0] * l[1] + r[1]), (a, b), axis=1)
    return h


def rglru_coeffs(x, w_a, b_a, w_x, b_x, lam):
    bsz, t, _ = x.shape
    xb = x.reshape(bsz, t, RG_BLOCKS, RG_BW)
    r = jax.nn.sigmoid(jnp.einsum('btnc,ncd->btnd', xb, w_a).reshape(bsz, t, RG_WIDTH) + b_a)
    i = jax.nn.sigmoid(jnp.einsum('btnc,ncd->btnd', xb, w_x).reshape(bsz, t, RG_WIDTH) + b_x)
    log_a = -RG_C * r * jax.nn.softplus(-lam)
    a = jnp.exp(log_a)
    return a, jnp.sqrt(-jnp.expm1(2.0 * log_a)) * (i * x)


def rglru_bidir(x_ctx, x_lat, w_a, b_a, w_x, b_x, lam):
    y_ctx, y_lat = 0.0, 0.0
    for d in range(2):
        f = flip_time if d == 1 else identity
        a_c, u_c = rglru_coeffs(f(x_ctx), w_a[d], b_a[d], w_x[d], b_x[d], lam[d])
        a_l, u_l = rglru_coeffs(f(x_lat), w_a[d], b_a[d], w_x[d], b_x[d], lam[d])
        h_c = linear_scan(a_c, u_c, jnp.zeros_like(u_c[:, 0]))
        h_l = linear_scan(a_l, u_l, h_c[:, -1])
        y_ctx = y_ctx + f(h_c)
        y_lat = y_lat + f(h_l)
    return y_ctx, y_lat


def gdn_chunked(q, k, v, g, beta, s0):
    bsz, t, h, dk = q.shape
    dv = v.shape[-1]
    n = t // GDN_CHUNK

    def chunks(z):
        z = z.reshape((bsz, n, GDN_CHUNK, h) + z.shape[3:])
        return jnp.moveaxis(z, (1, 3), (0, 2))

    qc = chunks(q * (dk ** -0.5))
    kc = chunks(k)
    vc = chunks(v)
    gc = jnp.cumsum(chunks(g), axis=-1)
    bc = chunks(beta)[..., None]
    idx = jnp.arange(GDN_CHUNK)
    lower = idx[:, None] >= idx[None, :]
    strict = idx[:, None] > idx[None, :]
    decay = jnp.exp(jnp.where(lower, gc[..., :, None] - gc[..., None, :], -jnp.inf))
    kb = kc * bc
    l_mat = jnp.where(strict, jnp.einsum('nbhid,nbhjd->nbhij', kb, kc) * decay, 0.0)
    a_mat = l_mat + jnp.eye(GDN_CHUNK, dtype=jnp.float32)
    rhs = jnp.concatenate([vc * bc, kb * jnp.exp(gc)[..., None]], axis=-1)
    sol = lax.linalg.triangular_solve(a_mat, rhs, left_side=True, lower=True, unit_diagonal=True)
    u, w = sol[..., :dv], sol[..., dv:]
    qk = jnp.einsum('nbhid,nbhjd->nbhij', qc, kc) * decay
    q_dec = qc * jnp.exp(gc)[..., None]
    k_dec = kc * jnp.exp(gc[..., -1:] - gc)[..., None]
    g_tot = jnp.exp(gc[..., -1])[..., None, None]

    def step(s, inp):
        u_i, w_i, qk_i, qd_i, kd_i, gt_i = inp
        v_new = u_i - jnp.einsum('bhck,bhkv->bhcv', w_i, s)
        o_i = jnp.einsum('bhck,bhkv->bhcv', qd_i, s) + jnp.einsum('bhij,bhjv->bhiv', qk_i, v_new)
        s = s * gt_i + jnp.einsum('bhck,bhcv->bhkv', kd_i, v_new)
        return s, o_i

    s_fin, o = lax.scan(step, s0, (u, w, qk, q_dec, k_dec, g_tot))
    o = jnp.moveaxis(o, (0, 2), (1, 3)).reshape(bsz, t, h, dv)
    return s_fin, o


def moe_swiglu(x, w_router, w_in, w_out):
    n = x.shape[0]
    logits = (x @ w_router).astype(jnp.float32)
    top_logit, top_idx = lax.top_k(logits, TOP_K)
    top_w = jax.nn.softmax(top_logit, axis=-1)
    p = n * TOP_K
    e_flat = top_idx.reshape(p).astype(jnp.int32)
    w_flat = top_w.reshape(p)
    tok_flat = jnp.arange(p, dtype=jnp.int32) // TOP_K
    order = jnp.argsort(e_flat)
    e_sorted = e_flat[order]
    counts = jnp.zeros(N_EXPERTS, jnp.int32).at[e_flat].add(1)
    padded = (counts + MOE_BLOCK - 1) // MOE_BLOCK * MOE_BLOCK
    start = jnp.cumsum(counts) - counts
    pad_end = jnp.cumsum(padded)
    pad_start = pad_end - padded
    dest = pad_start[e_sorted] + jnp.arange(p, dtype=jnp.int32) - start[e_sorted]
    n_blocks = -(-(p + N_EXPERTS * (MOE_BLOCK - 1)) // MOE_BLOCK)
    rows = n_blocks * MOE_BLOCK
    row_tok = jnp.zeros(rows, jnp.int32).at[dest].set(tok_flat[order])
    row_w = jnp.zeros(rows, jnp.float32).at[dest].set(w_flat[order])
    block_start = jnp.arange(n_blocks, dtype=jnp.int32) * MOE_BLOCK
    block_e = jnp.minimum(jnp.sum(block_start[:, None] >= pad_end[None, :], axis=1), N_EXPERTS - 1)
    xs = x[row_tok].reshape(n_blocks, MOE_BLOCK, x.shape[-1])

    def expert_block(args):
        xb, e = args
        return swiglu(xb, w_in[e], w_out[e])

    ys = lax.map(expert_block, (xs, block_e)).reshape(rows, x.shape[-1])
    return jnp.zeros_like(x).at[row_tok].add(ys * row_w[:, None].astype(ys.dtype))


def even_mixer(h_lat, h_ctx, rope_cos, rope_sin, lam_init, need_ctx,
               w_in, w_out, lam_qk, g_sub, conv_w, conv_b, rg_w_a, rg_b_a, rg_w_x, rg_b_x, rg_lam):
    def project(h):
        bsz, t = h.shape[:2]
        q, k, v, xr, gr = jnp.split(h @ w_in, EVEN_SPLITS, axis=-1)
        q = q.reshape(bsz, t, DA_HEADS, 2, DA_QK_DIM)
        k = k.reshape(bsz, t, DA_HEADS, 2, DA_QK_DIM)
        v = v.reshape(bsz, t, DA_HEADS, DA_V_DIM)
        xr = (dwconv(xr, conv_w) + conv_b).astype(jnp.float32)
        return q, k, v, xr, gr

    q_l, k_l, v_l, xr_l, gr_l = project(h_lat)
    q_c, k_c, v_c, xr_c, gr_c = project(h_ctx)
    q_l = apply_rope(q_l, rope_cos, rope_sin)
    k_l = apply_rope(k_l, rope_cos, rope_sin)
    lq = lam_qk.astype(jnp.float32)
    lam = jnp.exp(jnp.sum(lq[0] * lq[1])) - jnp.exp(jnp.sum(lq[2] * lq[3])) + lam_init
    att_l, att_c = diff_attention(q_l, k_l, v_l, q_c, k_c, v_c, lam, lam_init, g_sub, need_ctx)
    rec_c, rec_l = rglru_bidir(xr_c, xr_l, rg_w_a, rg_b_a, rg_w_x, rg_b_x, rg_lam)

    def merge(att, rec, gate):
        rec = (rec * jax.nn.gelu(gate.astype(jnp.float32))).astype(att.dtype)
        return jnp.concatenate([att, rec], axis=-1) @ w_out

    y_lat = merge(att_l, rec_l, gr_l)
    y_ctx = merge(att_c, rec_c, gr_c) if need_ctx else None
    return y_lat, y_ctx


def odd_mixer(h_lat, h_ctx, need_ctx, w_in, conv_w, a_log, dt_bias, g_out, w_out):
    def project(h):
        bsz, t = h.shape[:2]
        p = h @ w_in
        qkv = jax.nn.silu(dwconv(p[..., :GDN_CONV_CH], conv_w))
        q = l2norm(qkv[..., :GDN_QK].reshape(bsz, t, GDN_HEADS, GDN_DK))
        k = l2norm(qkv[..., GDN_QK:2 * GDN_QK].reshape(bsz, t, GDN_HEADS, GDN_DK))
        v = qkv[..., 2 * GDN_QK:].reshape(bsz, t, GDN_HEADS, GDN_DV).astype(jnp.float32)
        z = p[..., GDN_CONV_CH:GDN_CONV_CH + GDN_V]
        ab = p[..., GDN_CONV_CH + GDN_V:].astype(jnp.float32).reshape(bsz, t, 2, 2, GDN_HEADS)
        return q, k, v, z, ab

    lat = project(h_lat)
    ctx = project(h_ctx)
    s0 = jnp.zeros((h_ctx.shape[0], GDN_HEADS, GDN_DK, GDN_DV), jnp.float32)
    o_lat, o_ctx = 0.0, 0.0
    for d in range(2):
        f = flip_time if d == 1 else identity

        def prep(stream):
            q, k, v, _, ab = stream
            g = -jnp.exp(a_log[d].astype(jnp.float32)) * jax.nn.softplus(ab[:, :, d, 0] + dt_bias[d])
            beta = jax.nn.sigmoid(ab[:, :, d, 1])
            return f(q), f(k), f(v), f(g), f(beta)

        s_ctx, oc = gdn_chunked(*prep(ctx), s0)
        _, ol = gdn_chunked(*prep(lat), s_ctx)
        o_lat = o_lat + f(ol)
        if need_ctx:
            o_ctx = o_ctx + f(oc)

    def out(o, z):
        bsz, t = z.shape[:2]
        o = rmsnorm(o, g_out) * jax.nn.silu(z.astype(jnp.float32)).reshape(bsz, t, GDN_HEADS, GDN_DV)
        return o.reshape(bsz, t, GDN_V).astype(z.dtype) @ w_out

    y_ctx = out(o_ctx, ctx[3]) if need_ctx else None
    return out(o_lat, lat[3]), y_ctx


def setup_inputs(seed: int = 0) -> dict:
    key = jax.random.key(seed)
    ks = iter(jax.random.split(key, 64))
    f32 = jnp.float32
    d = D_MODEL

    def nrm(shape, scale):
        return jax.random.normal(next(ks), shape, f32) * scale

    def gain(shape):
        return 1.0 + nrm(shape, 0.02)

    a_base = jax.random.uniform(next(ks), (N_EVEN, 2, RG_WIDTH), f32, 0.9, 0.999) ** (1.0 / RG_C)
    rg_lam = jnp.log(a_base) - jnp.log1p(-a_base)
    a_log = jnp.log(jax.random.uniform(next(ks), (N_ODD, 2, GDN_HEADS), f32, 1.0, 16.0))
    dt = jnp.exp(jax.random.uniform(next(ks), (N_ODD, 2, GDN_HEADS), f32, math.log(1e-3), math.log(0.1)))
    dt_bias = dt + jnp.log(-jnp.expm1(-dt))
    return {
        'x': nrm((BATCH, SEQ, d), 1.0),
        'c': nrm((BATCH, d), 1.0),
        'ctx': nrm((BATCH, CTX_LEN, d), 1.0),
        'c_ctx': nrm((d,), 1.0),
        'w_ada': nrm((DEPTH, d, N_MOD * d), 0.5 * d ** -0.5),
        'b_ada': nrm((DEPTH, N_MOD * d), 0.01),
        'g_norm1': gain((DEPTH, d)),
        'g_norm2': gain((DEPTH, d)),
        'g_final': gain((d,)),
        'e_w_in': nrm((N_EVEN, d, EVEN_IN), d ** -0.5),
        'e_w_out': nrm((N_EVEN, EVEN_MIX, d), EVEN_MIX ** -0.5),
        'e_lam_qk': nrm((N_EVEN, 4, DA_QK_DIM), 0.1),
        'e_g_sub': gain((N_EVEN, DA_V_DIM)),
        'e_conv_w': nrm((N_EVEN, CONV_W, RG_WIDTH), CONV_W ** -0.5),
        'e_conv_b': nrm((N_EVEN, RG_WIDTH), 0.01),
        'e_rg_w_a': nrm((N_EVEN, 2, RG_BLOCKS, RG_BW, RG_BW), RG_BW ** -0.5),
        'e_rg_b_a': nrm((N_EVEN, 2, RG_WIDTH), 0.01),
        'e_rg_w_x': nrm((N_EVEN, 2, RG_BLOCKS, RG_BW, RG_BW), RG_BW ** -0.5),
        'e_rg_b_x': nrm((N_EVEN, 2, RG_WIDTH), 0.01),
        'e_rg_lam': rg_lam,
        'e_ffn_in': nrm((N_EVEN, d, 2 * FFN_DENSE), d ** -0.5),
        'e_ffn_out': nrm((N_EVEN, FFN_DENSE, d), FFN_DENSE ** -0.5),
        'o_w_in': nrm((N_ODD, d, ODD_IN), d ** -0.5),
        'o_conv_w': nrm((N_ODD, CONV_W, GDN_CONV_CH), CONV_W ** -0.5),
        'o_a_log': a_log,
        'o_dt_bias': dt_bias,
        'o_g_norm': gain((N_ODD, GDN_DV)),
        'o_w_out': nrm((N_ODD, GDN_V, d), GDN_V ** -0.5),
        'o_router': nrm((N_ODD, d, N_EXPERTS), d ** -0.5),
        'o_exp_in': nrm((N_ODD, N_EXPERTS, d, 2 * FFN_EXPERT), d ** -0.5),
        'o_exp_out': nrm((N_ODD, N_EXPERTS, FFN_EXPERT, d), FFN_EXPERT ** -0.5),
    }


def reference(x, c, ctx, c_ctx, w_ada, b_ada, g_norm1, g_norm2, g_final,
              e_w_in, e_w_out, e_lam_qk, e_g_sub, e_conv_w, e_conv_b, e_rg_w_a, e_rg_b_a,
              e_rg_w_x, e_rg_b_x, e_rg_lam, e_ffn_in, e_ffn_out,
              o_w_in, o_conv_w, o_a_log, o_dt_bias, o_g_norm, o_w_out, o_router, o_exp_in, o_exp_out):
    bsz, n_lat, d = x.shape
    rows = n_lat // GRID_W
    rope_cos, rope_sin = axial_rope_tables(rows)
    silu_c = jax.nn.silu(c)
    silu_cc = jax.nn.silu(c_ctx)
    xc = ctx
    for layer in range(DEPTH):
        i = layer // 2
        need_ctx = layer < DEPTH - 1
        sh1, sc1, ga1, sh2, sc2, ga2 = jnp.split((silu_c @ w_ada[layer] + b_ada[layer])[:, None, :], N_MOD, axis=-1)
        csh1, csc1, cga1, csh2, csc2, cga2 = jnp.split(silu_cc @ w_ada[layer] + b_ada[layer], N_MOD, axis=-1)
        h_lat = modulate(rmsnorm(x, g_norm1[layer]), sh1, sc1)
        h_ctx = modulate(rmsnorm(xc, g_norm1[layer]), csh1, csc1)
        if layer % 2 == 0:
            lam_init = 0.8 - 0.6 * math.exp(-0.3 * layer)
            y_lat, y_ctx = even_mixer(h_lat, h_ctx, rope_cos, rope_sin, lam_init, need_ctx,
                                      e_w_in[i], e_w_out[i], e_lam_qk[i], e_g_sub[i], e_conv_w[i], e_conv_b[i],
                                      e_rg_w_a[i], e_rg_b_a[i], e_rg_w_x[i], e_rg_b_x[i], e_rg_lam[i])
        else:
            y_lat, y_ctx = odd_mixer(h_lat, h_ctx, need_ctx, o_w_in[i], o_conv_w[i], o_a_log[i],
                                     o_dt_bias[i], o_g_norm[i], o_w_out[i])
        x = x + ga1 * y_lat
        f_lat_in = modulate(rmsnorm(x, g_norm2[layer]), sh2, sc2)
        if need_ctx:
            xc = xc + cga1 * y_ctx
            f_ctx_in = modulate(rmsnorm(xc, g_norm2[layer]), csh2, csc2)
        if layer % 2 == 0:
            f_lat = swiglu(f_lat_in, e_ffn_in[i], e_ffn_out[i])
            if need_ctx:
                f_ctx = swiglu(f_ctx_in, e_ffn_in[i], e_ffn_out[i])
        else:
            tokens = f_lat_in.reshape(-1, d)
            if need_ctx:
                tokens = jnp.concatenate([tokens, f_ctx_in.reshape(-1, d)], axis=0)
            f_all = moe_swiglu(tokens, o_router[i], o_exp_in[i], o_exp_out[i])
            n_tok = bsz * n_lat
            f_lat = f_all[:n_tok].reshape(x.shape)
            if need_ctx:
                f_ctx = f_all[n_tok:].reshape(xc.shape)
        x = x + ga2 * f_lat
        if need_ctx:
            xc = xc + cga2 * f_ctx
    return rmsnorm(x, g_final)
```

```cpp
#include <hip/hip_runtime.h>
#include <cstdio>
#include <cstdint>
#include <cmath>
namespace cfg {
constexpr int D = 1024, B = 4, SEQ = 4096, CTX = 256, DEPTH = 4;
constexpr int NLAT = B * SEQ, NCTX = B * CTX, NTOK = NLAT + NCTX;
constexpr int NMOD = 6, MODW = NMOD * D;
constexpr int EVEN_IN = 2560, ODD_IN = 4128, FFN = 2816, FFE = 3584, NEXP = 8;
}
namespace nv {
using namespace cfg;

__device__ __forceinline__ float sigmoidf_(float x) { return 1.f / (1.f + expf(-x)); }
__device__ __forceinline__ float siluf_(float x) { return x / (1.f + expf(-x)); }
__device__ __forceinline__ float softplusf_(float x) { return fmaxf(x, 0.f) + log1pf(expf(-fabsf(x))); }
__device__ __forceinline__ float gelu_tanhf_(float x) { return 0.5f * x * (1.f + tanhf(0.7978845608028654f * (x + 0.044715f * x * x * x))); }
__device__ __forceinline__ int row_modidx(int r) { return r < NLAT ? (r >> 12) : 4; }

__global__ void n_mod(const float* __restrict__ c, const float* __restrict__ c_ctx, const float* __restrict__ w_ada, const float* __restrict__ b_ada, float* __restrict__ MOD) {
    __shared__ float s[5][1024];
    for (int i = threadIdx.x; i < 5 * 1024; i += 256) { int v = i >> 10, k = i & 1023; float x = v < 4 ? c[v * 1024 + k] : c_ctx[k]; s[v][k] = siluf_(x); }
    __syncthreads();
    const int l = blockIdx.y, n = blockIdx.x * 256 + threadIdx.x;
    const float* w = w_ada + (size_t)l * 1024 * MODW + n;
    float acc[5] = {0.f, 0.f, 0.f, 0.f, 0.f};
    for (int k = 0; k < 1024; ++k) { const float wv = w[(size_t)k * MODW];
#pragma unroll
        for (int v = 0; v < 5; ++v) acc[v] += s[v][k] * wv; }
#pragma unroll
    for (int v = 0; v < 5; ++v) MOD[(size_t)(l * 5 + v) * MODW + n] = acc[v] + b_ada[l * MODW + n];
}

__global__ void n_init_x(const float* __restrict__ x, const float* __restrict__ ctx, float* __restrict__ X) {
    const size_t i = (size_t)blockIdx.x * 256 + threadIdx.x;
    const size_t nl4 = (size_t)NLAT * D / 4, nt4 = (size_t)NTOK * D / 4;
    if (i < nl4) ((float4*)X)[i] = ((const float4*)x)[i]; else if (i < nt4) ((float4*)X)[i] = ((const float4*)ctx)[i - nl4];
}

__global__ void n_normmod(const float* __restrict__ X, const float* __restrict__ g, const float* __restrict__ MODl, int shift_idx, int scale_idx, float* __restrict__ H) {
    const int r = blockIdx.x, t = threadIdx.x;
    const float4 v = ((const float4*)(X + (size_t)r * D))[t];
    float ss = v.x * v.x + v.y * v.y + v.z * v.z + v.w * v.w;
    for (int o = 32; o >= 1; o >>= 1) ss += __shfl_xor(ss, o);
    __shared__ float red[4];
    if ((t & 63) == 0) red[t >> 6] = ss;
    __syncthreads();
    ss = red[0] + red[1] + red[2] + red[3];
    const float rs = rsqrtf(ss * (1.f / D) + 1e-6f);
    const float* mv = MODl + (size_t)row_modidx(r) * MODW;
    const float4 gg = ((const float4*)g)[t], sh = ((const float4*)(mv + shift_idx * D))[t], sc = ((const float4*)(mv + scale_idx * D))[t];
    float4 o; o.x = v.x * rs * gg.x * (1.f + sc.x) + sh.x; o.y = v.y * rs * gg.y * (1.f + sc.y) + sh.y; o.z = v.z * rs * gg.z * (1.f + sc.z) + sh.z; o.w = v.w * rs * gg.w * (1.f + sc.w) + sh.w;
    ((float4*)(H + (size_t)r * D))[t] = o;
}
__global__ void n_final_norm(const float* __restrict__ X, const float* __restrict__ g, float* __restrict__ out) {
    const int r = blockIdx.x, t = threadIdx.x;
    const float4 v = ((const float4*)(X + (size_t)r * D))[t];
    float ss = v.x * v.x + v.y * v.y + v.z * v.z + v.w * v.w;
    for (int o = 32; o >= 1; o >>= 1) ss += __shfl_xor(ss, o);
    __shared__ float red[4];
    if ((t & 63) == 0) red[t >> 6] = ss;
    __syncthreads();
    ss = red[0] + red[1] + red[2] + red[3];
    const float rs = rsqrtf(ss * (1.f / D) + 1e-6f);
    const float4 gg = ((const float4*)g)[t];
    float4 o; o.x = v.x * rs * gg.x; o.y = v.y * rs * gg.y; o.z = v.z * rs * gg.z; o.w = v.w * rs * gg.w;
    ((float4*)(out + (size_t)r * D))[t] = o;
}

enum { EPI_STORE = 0, EPI_SWIGLU = 1, EPI_RESID = 2, EPI_MOE_OUT = 3 };
struct GArgs {
    const float* A; int lda; const int* gather;
    const float* W; int ldw;
    int M; const int* Mdev;
    int N, K;
    float* C; int ldc;
    int up_off;
    const float* gate; int gate_off;
    const int* tok; const float* wgt;
    int pad;
};
template <int EPI> __global__ __launch_bounds__(256) void n_gemm(GArgs g) {
    const int M = g.Mdev ? *g.Mdev : g.M;
    const int m0 = blockIdx.y * 64, n0 = blockIdx.x * 64;
    if (m0 >= M) return;
    __shared__ float As[16][68];
    __shared__ float Ws[16][68];
    __shared__ float Ws2[EPI == EPI_SWIGLU ? 16 : 1][68];
    const int tid = threadIdx.x, tx = tid & 15, ty = tid >> 4;
    float acc[4][4] = {}, acc2[4][4] = {};
    const int ar = tid >> 2, ak = (tid & 3) * 4;
    const int am = m0 + ar;
    const float* arow = nullptr;
    if (am < M) { const int src = g.gather ? g.gather[am] : am; arow = g.A + (size_t)src * g.lda; }
    const int wk = tid >> 4, wn = (tid & 15) * 4;
    for (int k0 = 0; k0 < g.K; k0 += 16) {
        float4 av = make_float4(0.f, 0.f, 0.f, 0.f);
        if (arow) av = *(const float4*)(arow + k0 + ak);
        As[ak + 0][ar] = av.x; As[ak + 1][ar] = av.y; As[ak + 2][ar] = av.z; As[ak + 3][ar] = av.w;
        {
            const float* wp = g.W + (size_t)(k0 + wk) * g.ldw + n0 + wn;
            float4 wv;
            if (n0 + wn + 3 < g.N) wv = *(const float4*)wp;
            else { wv.x = n0 + wn + 0 < g.N ? wp[0] : 0.f; wv.y = n0 + wn + 1 < g.N ? wp[1] : 0.f; wv.z = n0 + wn + 2 < g.N ? wp[2] : 0.f; wv.w = n0 + wn + 3 < g.N ? wp[3] : 0.f; }
            *(float4*)&Ws[wk][wn] = wv;
            if (EPI == EPI_SWIGLU) { *(float4*)&Ws2[wk][wn] = *(const float4*)(wp + g.up_off); }
        }
        __syncthreads();
#pragma unroll
        for (int kk = 0; kk < 16; ++kk) {
            const float4 a4 = *(const float4*)&As[kk][ty * 4];
            const float4 w4 = *(const float4*)&Ws[kk][tx * 4];
            const float a[4] = {a4.x, a4.y, a4.z, a4.w}, w[4] = {w4.x, w4.y, w4.z, w4.w};
#pragma unroll
            for (int i = 0; i < 4; ++i)
#pragma unroll
                for (int j = 0; j < 4; ++j) acc[i][j] += a[i] * w[j];
            if (EPI == EPI_SWIGLU) {
                const float4 u4 = *(const float4*)&Ws2[kk][tx * 4];
                const float u[4] = {u4.x, u4.y, u4.z, u4.w};
#pragma unroll
                for (int i = 0; i < 4; ++i)
#pragma unroll
                    for (int j = 0; j < 4; ++j) acc2[i][j] += a[i] * u[j];
            }
        }
        __syncthreads();
    }
#pragma unroll
    for (int i = 0; i < 4; ++i) {
        const int m = m0 + ty * 4 + i;
        if (m >= M) continue;
#pragma unroll
        for (int j = 0; j < 4; ++j) {
            const int n = n0 + tx * 4 + j;
            if (n >= g.N) continue;
            const float v = acc[i][j];
            if (EPI == EPI_STORE) g.C[(size_t)m * g.ldc + n] = v;
            else if (EPI == EPI_SWIGLU) g.C[(size_t)m * g.ldc + n] = siluf_(v) * acc2[i][j];
            else if (EPI == EPI_RESID) { const float gt = g.gate[(size_t)row_modidx(m) * MODW + g.gate_off + n]; g.C[(size_t)m * g.ldc + n] += gt * v; }
            else if (EPI == EPI_MOE_OUT) atomicAdd(&g.C[(size_t)g.tok[m] * g.ldc + n], g.wgt[m] * v);
        }
    }
}

__global__ void n_rope(float* __restrict__ P) {
    const int idx = blockIdx.x * 256 + threadIdx.x;
    const int r = idx >> 9, p = idx & 511;
    if (r >= NLAT) return;
    const int col = 2 * p;
    const int d = col & 63, i = d >> 1;
    const int t = r & 4095, rowpos = t >> 6, colpos = t & 63;
    const float invf = powf(10000.f, -(float)(i & 15) / 16.f);
    const float ang = (i < 16 ? (float)rowpos : (float)colpos) * invf;
    const float cs = cosf(ang), sn = sinf(ang);
    float* pp = P + (size_t)r * EVEN_IN + col;
    const float x1 = pp[0], x2 = pp[1];
    pp[0] = x1 * cs - x2 * sn; pp[1] = x1 * sn + x2 * cs;
}
__global__ void n_lam(const float* __restrict__ lam_qk, float lam_init, float* __restrict__ out) {
    float s01 = 0.f, s23 = 0.f;
    for (int i = 0; i < 64; ++i) { s01 += lam_qk[i] * lam_qk[64 + i]; s23 += lam_qk[128 + i] * lam_qk[192 + i]; }
    if (threadIdx.x == 0) out[0] = expf(s01) - expf(s23) + lam_init;
}
__global__ __launch_bounds__(256) void n_attn(const float* __restrict__ P, float* __restrict__ ATT, const float* __restrict__ lamp, int ctx_q) {
    __shared__ float Ks[32][128];
    __shared__ float Vs[32][128];
    const int tid = threadIdx.x, ql = tid >> 3, sl = tid & 7;
    const int h = blockIdx.y, b = blockIdx.z;
    const int qrow = ctx_q ? (NLAT + b * CTX + blockIdx.x * 32 + ql) : (b * SEQ + blockIdx.x * 32 + ql);
    const int nk = ctx_q ? CTX : (CTX + SEQ);
    float q0[8], q1[8];
#pragma unroll
    for (int i = 0; i < 8; ++i) { q0[i] = P[(size_t)qrow * EVEN_IN + h * 128 + sl * 8 + i] * 0.125f; q1[i] = P[(size_t)qrow * EVEN_IN + h * 128 + 64 + sl * 8 + i] * 0.125f; }
    float m0 = -INFINITY, m1 = -INFINITY, l0 = 0.f, l1 = 0.f, O0[16], O1[16];
#pragma unroll
    for (int j = 0; j < 16; ++j) { O0[j] = 0.f; O1[j] = 0.f; }
    for (int kt = 0; kt < nk; kt += 32) {
        __syncthreads();
        for (int i = tid; i < 32 * 32; i += 256) {
            const int kk = i >> 5, c4 = (i & 31) * 4, kidx = kt + kk;
            const int krow = kidx < CTX ? (NLAT + b * CTX + kidx) : (b * SEQ + kidx - CTX);
            *(float4*)&Ks[kk][c4] = *(const float4*)(P + (size_t)krow * EVEN_IN + 512 + h * 128 + c4);
            *(float4*)&Vs[kk][c4] = *(const float4*)(P + (size_t)krow * EVEN_IN + 1024 + h * 128 + c4);
        }
        __syncthreads();
        for (int kk = 0; kk < 32; ++kk) {
            float s0 = 0.f, s1 = 0.f;
#pragma unroll
            for (int i = 0; i < 8; ++i) { s0 += q0[i] * Ks[kk][sl * 8 + i]; s1 += q1[i] * Ks[kk][64 + sl * 8 + i]; }
            s0 += __shfl_xor(s0, 1); s0 += __shfl_xor(s0, 2); s0 += __shfl_xor(s0, 4);
            s1 += __shfl_xor(s1, 1); s1 += __shfl_xor(s1, 2); s1 += __shfl_xor(s1, 4);
            const float mn0 = fmaxf(m0, s0), mn1 = fmaxf(m1, s1);
            const float c0 = expf(m0 - mn0), c1 = expf(m1 - mn1), e0 = expf(s0 - mn0), e1 = expf(s1 - mn1);
            m0 = mn0; m1 = mn1; l0 = l0 * c0 + e0; l1 = l1 * c1 + e1;
#pragma unroll
            for (int j = 0; j < 16; ++j) { const float vv = Vs[kk][sl * 16 + j]; O0[j] = O0[j] * c0 + e0 * vv; O1[j] = O1[j] * c1 + e1 * vv; }
        }
    }
    const float lam = lamp[0], i0 = 1.f / l0, i1 = lam / l1;
#pragma unroll
    for (int j = 0; j < 16; ++j) ATT[(size_t)qrow * 512 + h * 128 + sl * 16 + j] = O0[j] * i0 - O1[j] * i1;
}
__global__ void n_attn_post(const float* __restrict__ ATT, const float* __restrict__ g_sub, float mul, float* __restrict__ MIX) {
    const int r = blockIdx.x, h = blockIdx.y, e = threadIdx.x;
    const float v = ATT[(size_t)r * 512 + h * 128 + e];
    float ss = v * v;
    for (int o = 32; o >= 1; o >>= 1) ss += __shfl_xor(ss, o);
    __shared__ float red[2];
    if ((e & 63) == 0) red[e >> 6] = ss;
    __syncthreads();
    ss = red[0] + red[1];
    MIX[(size_t)r * D + h * 128 + e] = v * rsqrtf(ss * (1.f / 128.f) + 1e-6f) * g_sub[e] * mul;
}
__device__ __forceinline__ void seq_bounds(int r, int& s0, int& s1) { if (r < NLAT) { s0 = r & ~4095; s1 = s0 + 4096; } else { s0 = NLAT + ((r - NLAT) & ~255); s1 = s0 + 256; } }
__global__ void n_rg_conv(const float* __restrict__ P, const float* __restrict__ cw, const float* __restrict__ cb, float* __restrict__ XC) {
    const int r = blockIdx.x, ch = threadIdx.x + blockIdx.y * 256;
    int s0, s1; seq_bounds(r, s0, s1);
    float a = cb[ch];
#pragma unroll
    for (int j = 0; j < 4; ++j) { const int rr = r + j - 2; if (rr >= s0 && rr < s1) a += cw[j * 512 + ch] * P[(size_t)rr * EVEN_IN + 1536 + ch]; }
    XC[(size_t)r * 512 + ch] = a;
}
__global__ void n_rg_gates(const float* __restrict__ XC, const float* __restrict__ w_a, const float* __restrict__ b_a, const float* __restrict__ w_x, const float* __restrict__ b_x, const float* __restrict__ lam,
                           float* __restrict__ Aa, float* __restrict__ Uu) {
    const int r = blockIdx.x, ch = threadIdx.x + blockIdx.y * 256, n = ch >> 6, dch = ch & 63;
    __shared__ float xs[512];
    for (int i = threadIdx.x; i < 512; i += 256) xs[i] = XC[(size_t)r * 512 + i];
    __syncthreads();
    for (int d = 0; d < 2; ++d) {
        float sa = b_a[d * 512 + ch], sx = b_x[d * 512 + ch];
        const float* wa = w_a + ((size_t)(d * 8 + n) * 64) * 64 + dch; const float* wx = w_x + ((size_t)(d * 8 + n) * 64) * 64 + dch;
        for (int c = 0; c < 64; ++c) { const float xv = xs[n * 64 + c]; sa += xv * wa[c * 64]; sx += xv * wx[c * 64]; }
        const float rr = sigmoidf_(sa), ii = sigmoidf_(sx);
        const float log_a = -8.f * rr * softplusf_(-lam[d * 512 + ch]);
        const float a = expf(log_a), u = sqrtf(-expm1f(2.f * log_a)) * (ii * xs[ch]);
        Aa[((size_t)d * NTOK + r) * 512 + ch] = a; Uu[((size_t)d * NTOK + r) * 512 + ch] = u;
    }
}
__global__ void n_rg_scan(const float* __restrict__ Aa, const float* __restrict__ Uu, float* __restrict__ HS) {
    const int idx = blockIdx.x * 64 + threadIdx.x, ch = idx & 511, d = (idx >> 9) & 1, b = idx >> 10;
    float h = 0.f;
    for (int s = 0; s < CTX; ++s) { const int j = d ? CTX - 1 - s : s; const size_t o = ((size_t)d * NTOK + NLAT + b * CTX + j) * 512 + ch; h = Aa[o] * h + Uu[o]; HS[o] = h; }
    for (int s = 0; s < SEQ; ++s) { const int t = d ? SEQ - 1 - s : s; const size_t o = ((size_t)d * NTOK + b * SEQ + t) * 512 + ch; h = Aa[o] * h + Uu[o]; HS[o] = h; }
}
__global__ void n_rg_merge(const float* __restrict__ HS, const float* __restrict__ P, float* __restrict__ MIX) {
    const int r = blockIdx.x, ch = threadIdx.x + blockIdx.y * 256;
    const float y = HS[(size_t)r * 512 + ch] + HS[((size_t)NTOK + r) * 512 + ch];
    MIX[(size_t)r * D + 512 + ch] = y * gelu_tanhf_(P[(size_t)r * EVEN_IN + 2048 + ch]);
}

__global__ void n_gdn_prep(const float* __restrict__ P, const float* __restrict__ cw, const float* __restrict__ a_log, const float* __restrict__ dt_bias,
                           float* __restrict__ QKV, float* __restrict__ G, float* __restrict__ BETA) {
    const int r = blockIdx.x, t = threadIdx.x;
    int s0, s1; seq_bounds(r, s0, s1);
    __shared__ float buf[3072];
    __shared__ float nrm[16];
    for (int c = t; c < 3072; c += 256) {
        float a = 0.f;
#pragma unroll
        for (int j = 0; j < 4; ++j) { const int rr = r + j - 2; if (rr >= s0 && rr < s1) a += cw[j * 3072 + c] * P[(size_t)rr * ODD_IN + c]; }
        buf[c] = siluf_(a);
    }
    __syncthreads();
    {
        const int w = t >> 6, lane = t & 63;
        for (int gi = 0; gi < 4; ++gi) { const int gidx = w * 4 + gi; const float a = buf[gidx * 128 + lane], b2 = buf[gidx * 128 + 64 + lane]; float ss = a * a + b2 * b2;
            for (int o = 32; o >= 1; o >>= 1) ss += __shfl_xor(ss, o);
            if (lane == 0) nrm[gidx] = rsqrtf(ss + 1e-6f); }
    }
    __syncthreads();
    for (int c = t; c < 3072; c += 256) QKV[(size_t)r * 3072 + c] = c < 2048 ? buf[c] * nrm[c >> 7] : buf[c];
    if (t < 16) { const int d = t >> 3, h = t & 7;
        const float x0 = P[(size_t)r * ODD_IN + 4096 + d * 16 + h], x1 = P[(size_t)r * ODD_IN + 4096 + d * 16 + 8 + h];
        G[((size_t)d * NTOK + r) * 8 + h] = -expf(a_log[d * 8 + h]) * softplusf_(x0 + dt_bias[d * 8 + h]);
        BETA[((size_t)d * NTOK + r) * 8 + h] = sigmoidf_(x1); }
}
__global__ __launch_bounds__(128) void n_gdn_rec(const float* __restrict__ QKV, const float* __restrict__ G, const float* __restrict__ BETA, float* __restrict__ O) {
    const int v = threadIdx.x, h = blockIdx.x, d = blockIdx.y, b = blockIdx.z;
    __shared__ float ks[2][128], qs[2][128];
    float S[128];
#pragma unroll
    for (int k = 0; k < 128; ++k) S[k] = 0.f;
    const float qscale = 0.08838834764831845f;
    for (int s = 0; s < CTX + SEQ; ++s) {
        int r;
        if (s < CTX) r = NLAT + b * CTX + (d ? CTX - 1 - s : s); else { const int t = s - CTX; r = b * SEQ + (d ? SEQ - 1 - t : t); }
        const int pb = s & 1;
        ks[pb][v] = QKV[(size_t)r * 3072 + 1024 + h * 128 + v];
        qs[pb][v] = QKV[(size_t)r * 3072 + h * 128 + v];
        const float vt = QKV[(size_t)r * 3072 + 2048 + h * 128 + v];
        const float eg = expf(G[((size_t)d * NTOK + r) * 8 + h]), beta = BETA[((size_t)d * NTOK + r) * 8 + h];
        __syncthreads();
        float kS = 0.f;
#pragma unroll
        for (int k = 0; k < 128; ++k) kS += ks[pb][k] * S[k];
        const float vnew = beta * (vt - eg * kS);
        float o = 0.f;
#pragma unroll
        for (int k = 0; k < 128; ++k) { S[k] = eg * S[k] + ks[pb][k] * vnew; o += qs[pb][k] * S[k]; }
        O[((size_t)d * NTOK + r) * D + h * 128 + v] = o * qscale;
    }
}
__global__ void n_gdn_out(const float* __restrict__ O, const float* __restrict__ P, const float* __restrict__ g_out, float* __restrict__ MIX) {
    const int r = blockIdx.x, h = blockIdx.y, e = threadIdx.x;
    const float v = O[(size_t)r * D + h * 128 + e] + O[((size_t)NTOK + r) * D + h * 128 + e];
    float ss = v * v;
    for (int o = 32; o >= 1; o >>= 1) ss += __shfl_xor(ss, o);
    __shared__ float red[2];
    if ((e & 63) == 0) red[e >> 6] = ss;
    __syncthreads();
    ss = red[0] + red[1];
    const float z = P[(size_t)r * ODD_IN + 3072 + h * 128 + e];
    MIX[(size_t)r * D + h * 128 + e] = v * rsqrtf(ss * (1.f / 128.f) + 1e-6f) * g_out[e] * siluf_(z);
}

__global__ void n_router(const float* __restrict__ H, const float* __restrict__ wr, int ntok, int* __restrict__ cnt, int* __restrict__ list_tok, float* __restrict__ list_w) {
    const int tok = blockIdx.x * 4 + (threadIdx.x >> 6), lane = threadIdx.x & 63;
    if (tok >= ntok) return;
    float lg[8] = {0.f, 0.f, 0.f, 0.f, 0.f, 0.f, 0.f, 0.f};
    for (int k = lane; k < D; k += 64) { const float x = H[(size_t)tok * D + k];
#pragma unroll
        for (int e = 0; e < 8; ++e) lg[e] += x * wr[k * 8 + e]; }
#pragma unroll
    for (int e = 0; e < 8; ++e) for (int o = 32; o >= 1; o >>= 1) lg[e] += __shfl_xor(lg[e], o);
    if (lane == 0) {
        int e0 = 0; for (int e = 1; e < 8; ++e) if (lg[e] > lg[e0]) e0 = e;
        int e1 = -1; for (int e = 0; e < 8; ++e) if (e != e0 && (e1 < 0 || lg[e] > lg[e1])) e1 = e;
        const float w1 = 1.f / (1.f + expf(lg[e0] - lg[e1])), w0 = 1.f - w1;
        int p0 = atomicAdd(&cnt[e0], 1); list_tok[e0 * NTOK + p0] = tok; list_w[e0 * NTOK + p0] = w0;
        int p1 = atomicAdd(&cnt[e1], 1); list_tok[e1 * NTOK + p1] = tok; list_w[e1 * NTOK + p1] = w1;
    }
}
__global__ void n_resid_ff(float* __restrict__ X, const float* __restrict__ F, const float* __restrict__ MODl, int gate_off, int nrows) {
    const int r = blockIdx.x, t = threadIdx.x;
    if (r >= nrows) return;
    const float* mv = MODl + (size_t)row_modidx(r) * MODW + gate_off;
    float4 x = ((float4*)(X + (size_t)r * D))[t]; const float4 f = ((const float4*)(F + (size_t)r * D))[t], g = ((const float4*)mv)[t];
    x.x += g.x * f.x; x.y += g.y * f.y; x.z += g.z * f.z; x.w += g.w * f.w;
    ((float4*)(X + (size_t)r * D))[t] = x;
}

struct Inputs { const float* p[31]; };
struct NaiveWs {
    float *MOD, *X, *H, *P, *MIX, *T0, *T1, *T2, *FOUT, *HID, *lam; int* cnt; int* list_tok; float* list_w;
};

template <int EPI> static void launch_gemm(const GArgs& g, int Mmax, hipStream_t s) {
    dim3 grid((g.N + 63) / 64, (Mmax + 63) / 64);
    hipLaunchKernelGGL(n_gemm<EPI>, grid, dim3(256), 0, s, g);
}

static void run_naive(const Inputs& in, const NaiveWs& w, float* d_out, float* snaps, hipStream_t s) {
    const float *x = in.p[0], *c = in.p[1], *ctx = in.p[2], *c_ctx = in.p[3], *w_ada = in.p[4], *b_ada = in.p[5], *g1 = in.p[6], *g2 = in.p[7], *gf = in.p[8];
    hipLaunchKernelGGL(n_mod, dim3(MODW / 256, DEPTH), dim3(256), 0, s, c, c_ctx, w_ada, b_ada, w.MOD);
    hipLaunchKernelGGL(n_init_x, dim3((NTOK * D / 4 + 255) / 256), dim3(256), 0, s, x, ctx, w.X);
    int snap_i = 0;
    for (int layer = 0; layer < DEPTH; ++layer) {
        const int i = layer / 2;
        const float* MODl = w.MOD + (size_t)layer * 5 * MODW;
        hipLaunchKernelGGL(n_normmod, dim3(NTOK), dim3(256), 0, s, w.X, g1 + layer * D, MODl, 0, 1, w.H);
        if (layer % 2 == 0) {
            const float lam_init = 0.8f - 0.6f * expf(-0.3f * (float)layer);
            GArgs g{}; g.A = w.H; g.lda = D; g.W = in.p[9] + (size_t)i * D * EVEN_IN; g.ldw = EVEN_IN; g.M = NTOK; g.N = EVEN_IN; g.K = D; g.C = w.P; g.ldc = EVEN_IN;
            launch_gemm<EPI_STORE>(g, NTOK, s);
            hipLaunchKernelGGL(n_rope, dim3(NLAT * 512 / 256), dim3(256), 0, s, w.P);
            hipLaunchKernelGGL(n_lam, dim3(1), dim3(64), 0, s, in.p[11] + i * 256, lam_init, w.lam);
            hipLaunchKernelGGL(n_attn, dim3(SEQ / 32, 4, B), dim3(256), 0, s, w.P, w.T0, w.lam, 0);
            hipLaunchKernelGGL(n_attn, dim3(CTX / 32, 4, B), dim3(256), 0, s, w.P, w.T0, w.lam, 1);
            hipLaunchKernelGGL(n_attn_post, dim3(NTOK, 4), dim3(128), 0, s, w.T0, in.p[12] + i * 128, 1.f - lam_init, w.MIX);
            hipLaunchKernelGGL(n_rg_conv, dim3(NTOK, 2), dim3(256), 0, s, w.P, in.p[13] + i * 4 * 512, in.p[14] + i * 512, w.T0);
            float* Aa = w.T1; float* Uu = w.T1 + (size_t)2 * NTOK * 512; float* HS = w.T2;
            hipLaunchKernelGGL(n_rg_gates, dim3(NTOK, 2), dim3(256), 0, s, w.T0, in.p[15] + (size_t)i * 2 * 8 * 64 * 64, in.p[16] + i * 1024, in.p[17] + (size_t)i * 2 * 8 * 64 * 64, in.p[18] + i * 1024, in.p[19] + i * 1024, Aa, Uu);
            hipLaunchKernelGGL(n_rg_scan, dim3(B * 2 * 512 / 64), dim3(64), 0, s, Aa, Uu, HS);
            hipLaunchKernelGGL(n_rg_merge, dim3(NTOK, 2), dim3(256), 0, s, HS, w.P, w.MIX);
            GArgs go{}; go.A = w.MIX; go.lda = D; go.W = in.p[10] + (size_t)i * D * D; go.ldw = D; go.M = NTOK; go.N = D; go.K = D; go.C = w.X; go.ldc = D; go.gate = MODl; go.gate_off = 2 * D;
            launch_gemm<EPI_RESID>(go, NTOK, s);
        } else {
            GArgs g{}; g.A = w.H; g.lda = D; g.W = in.p[22] + (size_t)i * D * ODD_IN; g.ldw = ODD_IN; g.M = NTOK; g.N = ODD_IN; g.K = D; g.C = w.P; g.ldc = ODD_IN;
            launch_gemm<EPI_STORE>(g, NTOK, s);
            float* QKV = w.T1; float* G = w.T0; float* BETA = w.T0 + (size_t)2 * NTOK * 8; float* O = w.T2;
            hipLaunchKernelGGL(n_gdn_prep, dim3(NTOK), dim3(256), 0, s, w.P, in.p[23] + (size_t)i * 4 * 3072, in.p[24] + i * 16, in.p[25] + i * 16, QKV, G, BETA);
            hipLaunchKernelGGL(n_gdn_rec, dim3(8, 2, B), dim3(128), 0, s, QKV, G, BETA, O);
            hipLaunchKernelGGL(n_gdn_out, dim3(NTOK, 8), dim3(128), 0, s, O, w.P, in.p[26] + i * 128, w.MIX);
            GArgs go{}; go.A = w.MIX; go.lda = D; go.W = in.p[27] + (size_t)i * D * D; go.ldw = D; go.M = NTOK; go.N = D; go.K = D; go.C = w.X; go.ldc = D; go.gate = MODl; go.gate_off = 2 * D;
            launch_gemm<EPI_RESID>(go, NTOK, s);
        }
        if (snaps) hipMemcpyAsync(snaps + (size_t)(snap_i++) * NTOK * D, w.X, (size_t)NTOK * D * 4, hipMemcpyDeviceToDevice, s);
        hipLaunchKernelGGL(n_normmod, dim3(NTOK), dim3(256), 0, s, w.X, g2 + layer * D, MODl, 3, 4, w.H);
        if (layer % 2 == 0) {
            GArgs g{}; g.A = w.H; g.lda = D; g.W = in.p[20] + (size_t)i * D * 2 * FFN; g.ldw = 2 * FFN; g.M = NTOK; g.N = FFN; g.K = D; g.C = w.HID; g.ldc = FFN; g.up_off = FFN;
            launch_gemm<EPI_SWIGLU>(g, NTOK, s);
            GArgs go{}; go.A = w.HID; go.lda = FFN; go.W = in.p[21] + (size_t)i * FFN * D; go.ldw = D; go.M = NTOK; go.N = D; go.K = FFN; go.C = w.X; go.ldc = D; go.gate = MODl; go.gate_off = 5 * D;
            launch_gemm<EPI_RESID>(go, NTOK, s);
        } else {
            const int ntok = (layer < DEPTH - 1) ? NTOK : NLAT;
            hipMemsetAsync(w.cnt, 0, 64, s);
            hipMemsetAsync(w.FOUT, 0, (size_t)NTOK * D * 4, s);
            hipLaunchKernelGGL(n_router, dim3((ntok + 3) / 4), dim3(256), 0, s, w.H, in.p[28] + (size_t)i * D * 8, ntok, w.cnt, w.list_tok, w.list_w);
            for (int e = 0; e < NEXP; ++e) {
                GArgs g{}; g.A = w.H; g.lda = D; g.gather = w.list_tok + e * NTOK; g.W = in.p[29] + ((size_t)i * NEXP + e) * D * 2 * FFE; g.ldw = 2 * FFE; g.M = 0; g.Mdev = w.cnt + e; g.N = FFE; g.K = D; g.C = w.HID; g.ldc = FFE; g.up_off = FFE;
                launch_gemm<EPI_SWIGLU>(g, ntok, s);
                GArgs go{}; go.A = w.HID; go.lda = FFE; go.W = in.p[30] + ((size_t)i * NEXP + e) * FFE * D; go.ldw = D; go.M = 0; go.Mdev = w.cnt + e; go.N = D; go.K = FFE; go.C = w.FOUT; go.ldc = D; go.tok = w.list_tok + e * NTOK; go.wgt = w.list_w + e * NTOK;
                launch_gemm<EPI_MOE_OUT>(go, ntok, s);
            }
            hipLaunchKernelGGL(n_resid_ff, dim3(NTOK), dim3(256), 0, s, w.X, w.FOUT, MODl, 5 * D, ntok);
        }
        if (snaps) hipMemcpyAsync(snaps + (size_t)(snap_i++) * NTOK * D, w.X, (size_t)NTOK * D * 4, hipMemcpyDeviceToDevice, s);
    }
    hipLaunchKernelGGL(n_final_norm, dim3(NLAT), dim3(256), 0, s, w.X, gf, d_out);
}
}
static nv::NaiveWs carve_naive(char* base, size_t& off) {
    using namespace cfg;
    nv::NaiveWs w{};
    auto take = [&](size_t nfloats) { float* p = (float*)(base + off); off += ((nfloats * 4 + 255) / 256) * 256; return p; };
    w.MOD = take((size_t)DEPTH * 5 * MODW);
    w.X = take((size_t)NTOK * D); w.H = take((size_t)NTOK * D); w.P = take((size_t)NTOK * ODD_IN); w.MIX = take((size_t)NTOK * D);
    w.T0 = take((size_t)NTOK * 512); w.T1 = take((size_t)NTOK * 3072); w.T2 = take((size_t)NTOK * 2048);
    w.FOUT = take((size_t)NTOK * D); w.HID = take((size_t)NTOK * FFE);
    w.lam = take(64); w.cnt = (int*)take(64); w.list_tok = (int*)take((size_t)NEXP * NTOK); w.list_w = take((size_t)NEXP * NTOK);
    return w;
}
extern "C" void kernel_launch(void* const* d_in, const int* in_sizes, int n_in, void* d_out, int out_size, void* d_ws, size_t ws_size, hipStream_t stream) {
    using namespace cfg;
    if (n_in != 31 || out_size != NLAT * D) { fprintf(stderr, "kernel_launch: unexpected n_in %d / out_size %d\n", n_in, out_size); return; }
    nv::Inputs in{}; for (int i = 0; i < 31; ++i) in.p[i] = (const float*)d_in[i];
    size_t off = 0; nv::NaiveWs w = carve_naive((char*)d_ws, off);
    if (off > ws_size) { fprintf(stderr, "kernel_launch: workspace too small: need %zu have %zu\n", off, ws_size); return; }
    nv::run_naive(in, w, (float*)d_out, nullptr, stream);
}
```

```cpp
#include <hip/hip_runtime.h>
#include <cstdio>
#include <cstdint>
#include <cmath>
namespace cfg {
constexpr int D = 1024, B = 4, SEQ = 4096, CTX = 256, DEPTH = 4;
constexpr int NLAT = B * SEQ, NCTX = B * CTX, NTOK = NLAT + NCTX;
constexpr int NMOD = 6, MODW = NMOD * D;
constexpr int EVEN_IN = 2560, ODD_IN = 4128, FFN = 2816, FFE = 3584, NEXP = 8;
}
namespace nv {
using namespace cfg;
struct NaiveWs { float *MOD, *X, *H, *P, *MIX, *T0, *T1, *T2, *FOUT, *HID, *lam; int* cnt; int* list_tok; float* list_w; };
}
namespace pg8 {
#define PG8_LAS __attribute__((address_space(3)))
typedef unsigned short bf16_t;
typedef short bf16x8 __attribute__((ext_vector_type(8)));
typedef float f32x4 __attribute__((ext_vector_type(4)));
typedef unsigned u32x4 __attribute__((ext_vector_type(4)));
constexpr int BM = 256, BK = 64, HALF = 128, HTB = HALF * BK * 2  , STAGE_BYTES = 8 * HTB, NXCD = 8, WGM = 8;

__host__ __device__ __forceinline__ int lds_byte(int r, int c) { const int st = (r >> 4) * 2 + (c >> 5), rr = r & 15, cc = c & 31, ob = rr * 64 + cc * 2; return st * 1024 + (ob ^ (((ob >> 9) & 1) << 5)); }
__host__ __device__ __forceinline__ void stage_rc(int b, int& R, int& C) { const int st = b / 1024, sb = b % 1024, swz = sb ^ (((sb >> 9) & 1) << 5); R = (st >> 1) * 16 + swz / 64; C = (st & 1) * 32 + (swz % 64) / 2; }
__host__ __device__ __forceinline__ int perm32(int rho) { const int n = rho >> 4, i = rho & 15; return 8 * (i >> 2) + 4 * n + (i & 3); }

struct Unit { int pm, pn; };
struct Gemm { const bf16_t* A; const bf16_t* Bt; int M, N, K; };

struct StaticOrder {
    int nM, nN, nwg, G, c;
    __host__ __device__ void init(int M, int N, int G_, int c_) { nM = M / BM; nN = N / BM; nwg = nM * nN; G = G_; c = c_; }
    __host__ __device__ bool next(int i, Unit& u) const {
        const long L = (long)i * G + c; if (L >= nwg) return false;
        int wgid = (int)L; { const int q = nwg / NXCD, r = nwg % NXCD, xcd = wgid % NXCD, off = wgid / NXCD; wgid = (xcd < r ? xcd * (q + 1) : r * (q + 1) + (xcd - r) * q) + off; }
        const int nig = WGM * nN, gid = wgid / nig, fm = gid * WGM, gsz = (nM - fm) < WGM ? (nM - fm) : WGM;
        u.pm = fm + ((wgid % nig) % gsz); u.pn = (wgid % nig) / gsz; return true;
    }
    __device__ __forceinline__ void a_ready(const Unit&) const {}
    __device__ __forceinline__ void done(const Unit&) const {}
};
template <class Epi, class Sched>
__device__ __forceinline__ void gemm_phase(PG8_LAS unsigned char* lds, const Gemm g, const Sched& S, const Epi& E, const int tid) {
    const int wid = __builtin_amdgcn_readfirstlane(tid >> 6), lane = tid & 63, wr = wid >> 2, wc = wid & 3, fr = lane & 15, fq = lane >> 4;
    const int K = g.K, nt = K / BK;
    unsigned voffA[2], voffB[2];
#pragma unroll
    for (int i = 0; i < 2; ++i) { int R, C; stage_rc(tid * 16 + i * 8192, R, C); const int Rb = Epi::PERM ? ((R & ~31) + perm32(R & 31)) : R;
        voffA[i] = (unsigned)(R * K + C) * 2u; voffB[i] = (unsigned)(Rb * K + C) * 2u; }
    const size_t kstep = (size_t)(BK * 2);
    const size_t hstep = (size_t)HALF * K * 2;
    const size_t tstep = 2 * hstep;
    const unsigned ldsw = (unsigned)wid * 1024u;
    const int aoff = lds_byte(wr * 64 + fr, fq * 8), boff = lds_byte(wc * 32 + fr, fq * 8);
#define PG8_SA(b, h) (((b) * 2 + (h)) * HTB)
#define PG8_SB(b, h) ((4 + (b) * 2 + (h)) * HTB)
#define PG8_STAGE(bufoff, gbase, voff) do { _Pragma("unroll") for (int _i = 0; _i < 2; ++_i) \
        __builtin_amdgcn_global_load_lds((const unsigned*)((const char*)(gbase) + (voff)[_i]), (PG8_LAS unsigned*)(lds + (bufoff) + ldsw + _i * 8192), 16, 0, 0); } while (0)
#define PG8_LDA(dst, b, h) do { _Pragma("unroll") for (int m = 0; m < 4; ++m) _Pragma("unroll") for (int k = 0; k < 2; ++k) dst[m][k] = *(const PG8_LAS bf16x8*)(lds + PG8_SA(b, h) + aoff + m * 2048 + k * 1024); } while (0)
#define PG8_LDB(dst, b, h) do { _Pragma("unroll") for (int n = 0; n < 2; ++n) _Pragma("unroll") for (int k = 0; k < 2; ++k) dst[n][k] = *(const PG8_LAS bf16x8*)(lds + PG8_SB(b, h) + boff + n * 2048 + k * 1024); } while (0)
#define PG8_MMA(ai, bj, At, Bt) do { __builtin_amdgcn_s_setprio(1); _Pragma("unroll") for (int m = 0; m < 4; ++m) _Pragma("unroll") for (int n = 0; n < 2; ++n) _Pragma("unroll") for (int k = 0; k < 2; ++k) \
        acc[ai][bj][m][n] = __builtin_amdgcn_mfma_f32_16x16x32_bf16(Bt[n][k], At[m][k], acc[ai][bj][m][n], 0, 0, 0); __builtin_amdgcn_s_setprio(0); } while (0)
#define PG8_WAIT_V(n) asm volatile("s_waitcnt vmcnt(" #n ")" ::: "memory")
#define PG8_WAIT_L(n) asm volatile("s_waitcnt lgkmcnt(" #n ")" ::: "memory")
#define PG8_BAR __builtin_amdgcn_s_barrier()
#define PG8_SCHED __builtin_amdgcn_sched_barrier(0)
    Unit cur, nxt; int ui = 0;
    if (!S.next(0, cur)) return;
    f32x4 acc[2][2][4][2];
#pragma unroll
    for (int a = 0; a < 2; ++a)
#pragma unroll
        for (int b = 0; b < 2; ++b)
#pragma unroll
            for (int m = 0; m < 4; ++m)
#pragma unroll
                for (int n = 0; n < 2; ++n) acc[a][b][m][n] = (f32x4){0.f, 0.f, 0.f, 0.f};
    bf16x8 At[4][2], B0[2][2], B1[2][2];
    const char* cA = (const char*)g.A + (size_t)cur.pm * tstep; const char* cB = (const char*)g.Bt + (size_t)cur.pn * tstep;
    S.a_ready(cur);
    PG8_STAGE(PG8_SB(0, 0), cB, voffB); PG8_STAGE(PG8_SA(0, 0), cA, voffA); PG8_STAGE(PG8_SB(0, 1), cB + hstep, voffB); PG8_STAGE(PG8_SA(0, 1), cA + hstep, voffA);
    if (wr == 1) PG8_BAR;
    PG8_WAIT_V(4); PG8_BAR;
    PG8_STAGE(PG8_SB(1, 0), cB + kstep, voffB); PG8_STAGE(PG8_SA(1, 0), cA + kstep, voffA); PG8_STAGE(PG8_SB(1, 1), cB + hstep + kstep, voffB);
    PG8_WAIT_V(6); PG8_BAR;
    for (;;) {
        const bool has_next = S.next(ui + 1, nxt);
        const char* nA = has_next ? (const char*)g.A + (size_t)nxt.pm * tstep : cA; const char* nB = has_next ? (const char*)g.Bt + (size_t)nxt.pn * tstep : cB;
        for (int t = 0; t < nt; t += 2) {
            const bool last = (t == nt - 2);
            const char* a1 = cA + (size_t)(t + 1) * kstep;
            const char* a2 = last ? nA : cA + (size_t)(t + 2) * kstep; const char* b2 = last ? nB : cB + (size_t)(t + 2) * kstep;
            const char* a3 = a2 + kstep; const char* b3 = b2 + kstep;
            if (last && has_next) S.a_ready(nxt);
            PG8_LDB(B0, 0, 0); PG8_SCHED; PG8_LDA(At, 0, 0); PG8_STAGE(PG8_SA(1, 1), a1 + hstep, voffA);
            PG8_WAIT_L(8); PG8_BAR; PG8_WAIT_L(0); PG8_MMA(0, 0, At, B0); PG8_BAR; PG8_SCHED;
            PG8_LDB(B1, 0, 1); PG8_STAGE(PG8_SB(0, 0), b2, voffB);
            PG8_BAR; PG8_WAIT_L(0); PG8_MMA(0, 1, At, B1); PG8_BAR;
            PG8_LDA(At, 0, 1); PG8_STAGE(PG8_SA(0, 0), a2, voffA);
            PG8_BAR; PG8_WAIT_L(0); PG8_MMA(1, 0, At, B0); PG8_BAR; PG8_SCHED;
            PG8_STAGE(PG8_SB(0, 1), b2 + hstep, voffB);
            PG8_WAIT_V(6); PG8_BAR; PG8_MMA(1, 1, At, B1); PG8_BAR;
            PG8_LDB(B0, 1, 0); PG8_SCHED; PG8_LDA(At, 1, 0); PG8_STAGE(PG8_SA(0, 1), a2 + hstep, voffA);
            PG8_WAIT_L(8); PG8_BAR; PG8_WAIT_L(0); PG8_MMA(0, 0, At, B0); PG8_BAR; PG8_SCHED;
            PG8_LDB(B1, 1, 1); PG8_STAGE(PG8_SB(1, 0), b3, voffB);
            PG8_BAR; PG8_WAIT_L(0); PG8_MMA(0, 1, At, B1); PG8_BAR;
            PG8_LDA(At, 1, 1); PG8_STAGE(PG8_SA(1, 0), a3, voffA);
            PG8_BAR; PG8_WAIT_L(0); PG8_MMA(1, 0, At, B0); PG8_BAR; PG8_SCHED;
            PG8_STAGE(PG8_SB(1, 1), b3 + hstep, voffB);
            PG8_WAIT_V(6); PG8_BAR; PG8_MMA(1, 1, At, B1); PG8_BAR;
        }
        if constexpr (!Epi::AFTER_DRAIN) { E(acc, cur, wr, wc, fr, fq); S.done(cur); }
        if (!has_next) break;
#pragma unroll
        for (int a = 0; a < 2; ++a)
#pragma unroll
            for (int b = 0; b < 2; ++b)
#pragma unroll
                for (int m = 0; m < 4; ++m)
#pragma unroll
                    for (int n = 0; n < 2; ++n) acc[a][b][m][n] = (f32x4){0.f, 0.f, 0.f, 0.f};
        cur = nxt; cA = nA; cB = nB; ++ui;
    }
    PG8_WAIT_V(0);
    if (wr == 0) PG8_BAR;
    PG8_BAR;
    if constexpr (Epi::AFTER_DRAIN) { E.fused(acc, cur, wr, wc, fr, fq, lds, wid, lane); S.done(cur); }
#undef PG8_SA
#undef PG8_SB
#undef PG8_STAGE
#undef PG8_LDA
#undef PG8_LDB
#undef PG8_MMA
#undef PG8_WAIT_V
#undef PG8_WAIT_L
#undef PG8_BAR
#undef PG8_SCHED
}
}
namespace fk {
using namespace cfg;
#define LAS __attribute__((address_space(3)))
typedef unsigned short bf16;
typedef short bf16x8 __attribute__((ext_vector_type(8)));
typedef short s16x4 __attribute__((ext_vector_type(4)));
typedef float f32x4 __attribute__((ext_vector_type(4)));
typedef float f32x2 __attribute__((ext_vector_type(2)));
typedef float f32x16 __attribute__((ext_vector_type(16)));
typedef unsigned u32x4 __attribute__((ext_vector_type(4)));
typedef unsigned u32x2 __attribute__((ext_vector_type(2)));
typedef __bf16 bf16x2_t __attribute__((ext_vector_type(2)));
#define DI __device__ __forceinline__
#define MFMA32(a, b, c) __builtin_amdgcn_mfma_f32_32x32x16_bf16((a), (b), (c), 0, 0, 0)

DI unsigned pk2(float a, float b) { f32x2 f = {a, b}; bf16x2_t r = __builtin_convertvector(f, bf16x2_t); return __builtin_bit_cast(unsigned, r); }
DI bf16 f2bf(float a) { return (bf16)(pk2(a, 0.f) & 0xffffu); }
DI float bf2f(bf16 v) { return __builtin_bit_cast(float, (unsigned)v << 16); }
DI float bflo(unsigned w) { return __builtin_bit_cast(float, w << 16); }
DI float bfhi(unsigned w) { return __builtin_bit_cast(float, w & 0xffff0000u); }
DI float sigmoid_(float x) { return 1.f / (1.f + __expf(-x)); }
DI float silu_(float x) { return x / (1.f + __expf(-x)); }
DI float softplus_(float x) { return fmaxf(x, 0.f) + log1pf(expf(-fabsf(x))); }
DI float gelu_tanh_(float x) { const float u = 0.7978845608028654f * (x + 0.044715f * x * x * x); const float e = __expf(2.f * u); return x * (1.f - 1.f / (e + 1.f)); }
DI int crow(int reg, int h) { return (reg & 3) + 8 * (reg >> 2) + 4 * h; }
DI f32x16 zero16() { f32x16 z; for (int i = 0; i < 16; ++i) z[i] = 0.f; return z; }
DI bf16x8 pack_step(const f32x16& x, int s) {
    u32x4 p; p[0] = pk2(x[8 * s], x[8 * s + 1]); p[1] = pk2(x[8 * s + 2], x[8 * s + 3]); p[2] = pk2(x[8 * s + 4], x[8 * s + 5]); p[3] = pk2(x[8 * s + 6], x[8 * s + 7]);
    return __builtin_bit_cast(bf16x8, p);
}
DI bf16x8 ld_perm_frag(const LAS bf16* rowp, int kbase, int s, int h) {
    const s16x4 lo = *(const LAS s16x4*)(rowp + kbase + 16 * s + 4 * h);
    const s16x4 hi = *(const LAS s16x4*)(rowp + kbase + 16 * s + 8 + 4 * h);
    return __builtin_shufflevector(lo, hi, 0, 1, 2, 3, 4, 5, 6, 7);
}
DI float shx(float v, int o, int lane) { return __builtin_bit_cast(float, __builtin_amdgcn_ds_bpermute((lane ^ o) << 2, __builtin_bit_cast(int, v))); }
DI float wave_sum(float v, int lane) {
#pragma unroll
    for (int o = 1; o < 64; o <<= 1) v += shx(v, o, lane);
    return v;
}

constexpr size_t al256(size_t x) { return (x + 255) / 256 * 256; }
constexpr int RMAX = 36864;
constexpr int NCH = NTOK / 64;
constexpr int NCHD = NCH * 8 * 2;
constexpr size_t WS_CTL = 0, CTL_BYTES = 1u << 20;
constexpr size_t WS_MOD = CTL_BYTES;
constexpr size_t WS_COS = WS_MOD + al256((size_t)DEPTH * 5 * MODW * 4);
constexpr size_t WS_SIN = WS_COS + (size_t)SEQ * 32 * 4;
constexpr size_t WS_WEIN = WS_SIN + (size_t)SEQ * 32 * 4;
constexpr size_t WS_WEOUT = WS_WEIN + (size_t)2 * 2560 * 1024 * 2;
constexpr size_t WS_WEF1 = WS_WEOUT + (size_t)2 * 1024 * 1024 * 2;
constexpr size_t WS_WEF2 = WS_WEF1 + (size_t)2 * 5632 * 1024 * 2;
constexpr size_t WS_WOIN = WS_WEF2 + (size_t)2 * 1024 * 2816 * 2;
constexpr size_t WS_WOOUT = WS_WOIN + (size_t)2 * 4352 * 1024 * 2;
constexpr size_t WS_WXIN = WS_WOOUT + (size_t)2 * 1024 * 1024 * 2;
constexpr size_t WS_WXOUT = WS_WXIN + (size_t)2 * 8 * 7168 * 1024 * 2;
constexpr size_t WS_X = WS_WXOUT + (size_t)2 * 8 * 1024 * 3584 * 2;
constexpr size_t WS_H = WS_X + (size_t)NTOK * D * 4;
constexpr size_t WS_MIX = WS_H + (size_t)NTOK * D * 2;
constexpr size_t WS_P = WS_MIX + (size_t)NTOK * D * 2;
constexpr size_t WS_HS1 = WS_P + (size_t)NTOK * 4352 * 2;
constexpr size_t WS_U = WS_HS1 + (size_t)NTOK * 512 * 4;
constexpr size_t WS_QKVN = WS_U;
constexpr size_t WS_WG = WS_QKVN + (size_t)NTOK * 3072 * 2;
constexpr size_t WS_UG = WS_WG + (size_t)NCHD * 64 * 128 * 2;
constexpr size_t WS_QKD = WS_UG + (size_t)NCHD * 64 * 128 * 4;
constexpr size_t WS_SC = WS_QKD + (size_t)NCHD * 64 * 64 * 2;
constexpr size_t WS_OG = WS_SC + (size_t)NCHD * 192 * 4;
constexpr size_t WS_U_END1 = WS_OG + (size_t)2 * NTOK * D * 4;
constexpr size_t WS_XS = WS_U;
constexpr size_t WS_HIDM = WS_XS + (size_t)RMAX * D * 2;
constexpr size_t WS_Y = WS_HIDM + (size_t)RMAX * FFE * 2;
constexpr size_t WS_U_END2 = WS_Y + (size_t)RMAX * D * 4;
constexpr size_t WS_TOK = (WS_U_END1 > WS_U_END2 ? WS_U_END1 : WS_U_END2);
constexpr size_t WS_END = WS_TOK + (size_t)NTOK * 32;
constexpr size_t WS_AB = WS_HS1;
constexpr size_t WS_GB = WS_AB + (size_t)NTOK * 32 * 4;

constexpr int CW_BAR = 4096;
constexpr int CW_CNT = 8192;
constexpr int CW_Q = 8448;

constexpr int LDS_BYTES = 152 * 1024;
constexpr int LDS_MISC = LDS_BYTES - 256;

struct Params { const float* in[31]; float* out; unsigned char* ws; int ph_lo, ph_hi; int dbg0, dbg1; };

struct Ctx {
    LAS unsigned char* lds;
    unsigned char* ws;
    int tid, lane, wave, nblk, blk;
};
#define XB_TMO      128
#define XB_XCNT(j)  (256  + 64 * (j))
#define XB_XSUB(j)  (1280 + 64 * (j))
#define XB_XGEN(j)  (2304 + 64 * (j))
#define XB_TOP      3328
#define XB_TOPGEN   3392
#define XCD_BAR_WORDS 3456
#define XB_SPIN_CAP (1u << 27)

__device__ __forceinline__ unsigned xb_ld(unsigned* p)              { return __hip_atomic_load(p, __ATOMIC_RELAXED, __HIP_MEMORY_SCOPE_AGENT); }
__device__ __forceinline__ unsigned xb_add(unsigned* p, unsigned v) { return __hip_atomic_fetch_add(p, v, __ATOMIC_RELAXED, __HIP_MEMORY_SCOPE_AGENT); }
__device__ __forceinline__ unsigned xb_xcc_id() { return (unsigned)__builtin_amdgcn_s_getreg((3 << 11) | 20) & 0xFu; }
#define XB_SPIN(cond, bar) do { unsigned _sp = 0; while (cond) { __builtin_amdgcn_s_sleep(1); \
    if ((++_sp & 255u) == 0u) { if (xb_ld(&(bar)[XB_TMO])) break; if (_sp > XB_SPIN_CAP) { atomicAdd(&(bar)[XB_TMO], 1u); break; } } } } while (0)

struct XcdBarrier {
    unsigned* bar; unsigned x;
    volatile LAS unsigned* st;
};

__device__ __forceinline__ XcdBarrier xcd_barrier_post(unsigned* bar, volatile LAS unsigned* st) {
    XcdBarrier b; b.bar = bar; b.x = xb_xcc_id(); b.st = st;
    if (threadIdx.x == 0) (void)xb_add(&bar[XB_XCNT(b.x)], 1u);
    return b;
}
__device__ __forceinline__ void xcd_barrier_complete(unsigned* bar, unsigned x, unsigned& nloc, unsigned& nx) {
    const unsigned G = gridDim.x * gridDim.y * gridDim.z;
    unsigned sum, cnt, mine, sp = 0u;
    for (;;) {
        sum = 0u; cnt = 0u; mine = 0u;
#pragma unroll
        for (unsigned j = 0; j < 16; ++j) { const unsigned c = xb_ld(&bar[XB_XCNT(j)]); sum += c; cnt += (c > 0u) ? 1u : 0u; mine = (j == x) ? c : mine; }
        if (sum == G) break;
        __builtin_amdgcn_s_sleep(1);
        if ((++sp & 255u) == 0u) { if (xb_ld(&bar[XB_TMO])) break; if (sp > XB_SPIN_CAP) { atomicAdd(&bar[XB_TMO], 1u); break; } }
    }
    nloc = mine > 0u ? mine : 1u; nx = cnt > 0u ? cnt : 1u;
}

__device__ __forceinline__ void xcd_barrier(const XcdBarrier& b) {
    asm volatile("s_waitcnt vmcnt(0)" ::: "memory");
    __syncthreads();
    if (threadIdx.x == 0) {
        unsigned* bar = b.bar;
        __builtin_amdgcn_s_waitcnt(0);
        unsigned nloc = b.st[0], nx = b.st[1];
        if (nloc == 0u) { xcd_barrier_complete(bar, b.x, nloc, nx); b.st[0] = nloc; b.st[1] = nx; }
        const unsigned old = xb_add(&bar[XB_XSUB(b.x)], 1u);
        const unsigned gen = old / nloc;
        if (old + 1u == (gen + 1u) * nloc) {
            __builtin_amdgcn_fence(__ATOMIC_RELEASE, "agent");
            asm volatile("s_waitcnt vmcnt(0)" ::: "memory");
            const unsigned og = xb_add(&bar[XB_TOP], 1u);
            const unsigned tg = og / nx;
            if (og + 1u == (tg + 1u) * nx) xb_add(&bar[XB_TOPGEN], 1u);
            else XB_SPIN(xb_ld(&bar[XB_TOPGEN]) == tg, bar);
            __builtin_amdgcn_fence(__ATOMIC_ACQUIRE, "agent");
            xb_add(&bar[XB_XGEN(b.x)], 1u);
            asm volatile("s_waitcnt vmcnt(0)" ::: "memory");
        } else {
            XB_SPIN(xb_ld(&bar[XB_XGEN(b.x)]) == gen, bar);
            __builtin_amdgcn_fence(__ATOMIC_ACQUIRE, "agent");
            asm volatile("s_waitcnt vmcnt(0)" ::: "memory");
        }
    }
    __syncthreads();
}

using pg8::Unit;
typedef pg8::f32x4 af4;

struct EpiEvenIn {
    static constexpr bool PERM = true, AFTER_DRAIN = false;
    bf16* P; const float* cosT; const float* sinT;
    DI void operator()(const af4 (&acc)[2][2][4][2], const Unit& u, int wr, int wc, int fr, int fq) const {
        const int row0 = u.pm * 256 + wr * 64 + fr, col0 = u.pn * 256 + wc * 32 + 8 * fq;
        const bool rope = (u.pn < 4) && (u.pm < 64);
        const float qs = (u.pn < 2) ? 0.125f : 1.f;
#pragma unroll
        for (int ai = 0; ai < 2; ++ai)
#pragma unroll
            for (int m = 0; m < 4; ++m) {
                const int row = row0 + ai * 128 + m * 16;
                bf16* rowp = P + (size_t)row * EVEN_IN + col0;
#pragma unroll
                for (int bj = 0; bj < 2; ++bj) {
                    af4 v0 = acc[ai][bj][m][0], v1 = acc[ai][bj][m][1];
                    if (rope) {
                        const int t = row & 4095, i0 = ((col0 + bj * 128) & 63) >> 1;
                        const af4 cs = *(const af4*)(cosT + t * 32 + i0), sn = *(const af4*)(sinT + t * 32 + i0);
                        af4 o0, o1;
                        o0[0] = v0[0] * cs[0] - v0[1] * sn[0]; o0[1] = v0[0] * sn[0] + v0[1] * cs[0];
                        o0[2] = v0[2] * cs[1] - v0[3] * sn[1]; o0[3] = v0[2] * sn[1] + v0[3] * cs[1];
                        o1[0] = v1[0] * cs[2] - v1[1] * sn[2]; o1[1] = v1[0] * sn[2] + v1[1] * cs[2];
                        o1[2] = v1[2] * cs[3] - v1[3] * sn[3]; o1[3] = v1[2] * sn[3] + v1[3] * cs[3];
                        v0 = o0; v1 = o1;
                    }
                    v0 = v0 * qs; v1 = v1 * qs;
                    u32x4 w; w[0] = pk2(v0[0], v0[1]); w[1] = pk2(v0[2], v0[3]); w[2] = pk2(v1[0], v1[1]); w[3] = pk2(v1[2], v1[3]);
                    *(u32x4*)(rowp + bj * 128) = w;
                }
            }
    }
};
struct EpiBf16Ab {
    static constexpr bool PERM = true, AFTER_DRAIN = false;
    bf16* O; int ldc; float* AB; int ab_pn;
    DI void operator()(const af4 (&acc)[2][2][4][2], const Unit& u, int wr, int wc, int fr, int fq) const {
        const int row0 = u.pm * 256 + wr * 64 + fr, col0 = u.pn * 256 + wc * 32 + 8 * fq;
        if (u.pn == ab_pn) {
            if (wc == 0) {
#pragma unroll
                for (int ai = 0; ai < 2; ++ai)
#pragma unroll
                    for (int m = 0; m < 4; ++m) { float* ap = AB + (size_t)(row0 + ai * 128 + m * 16) * 32 + 8 * fq; *(af4*)ap = acc[ai][0][m][0]; *(af4*)(ap + 4) = acc[ai][0][m][1]; }
            }
            return;
        }
#pragma unroll
        for (int ai = 0; ai < 2; ++ai)
#pragma unroll
            for (int m = 0; m < 4; ++m) {
                bf16* rowp = O + (size_t)(row0 + ai * 128 + m * 16) * ldc + col0;
#pragma unroll
                for (int bj = 0; bj < 2; ++bj) { const af4 v0 = acc[ai][bj][m][0], v1 = acc[ai][bj][m][1];
                    u32x4 w; w[0] = pk2(v0[0], v0[1]); w[1] = pk2(v0[2], v0[3]); w[2] = pk2(v1[0], v1[1]); w[3] = pk2(v1[2], v1[3]);
                    *(u32x4*)(rowp + bj * 128) = w; }
            }
    }
};
struct EpiSwiglu {
    static constexpr bool PERM = true, AFTER_DRAIN = false;
    bf16* O; int ldc; int nN;
    DI void operator()(const af4 (&acc)[2][2][4][2], const Unit& u, int wr, int wc, int fr, int fq) const {
        const int row0 = u.pm * 256 + wr * 64 + fr, col0 = (u.pn % nN) * 128 + wc * 32 + 8 * fq;
#pragma unroll
        for (int ai = 0; ai < 2; ++ai)
#pragma unroll
            for (int m = 0; m < 4; ++m) {
                const af4 g0 = acc[ai][0][m][0], g1 = acc[ai][0][m][1], u0 = acc[ai][1][m][0], u1 = acc[ai][1][m][1];
                float r[8];
#pragma unroll
                for (int j = 0; j < 4; ++j) { r[j] = silu_(g0[j]) * u0[j]; r[4 + j] = silu_(g1[j]) * u1[j]; }
                u32x4 w; w[0] = pk2(r[0], r[1]); w[1] = pk2(r[2], r[3]); w[2] = pk2(r[4], r[5]); w[3] = pk2(r[6], r[7]);
                *(u32x4*)(O + (size_t)(row0 + ai * 128 + m * 16) * ldc + col0) = w;
            }
    }
};
struct EpiResid {
    static constexpr bool PERM = false, AFTER_DRAIN = false;
    float* X; const float* gate;
    DI void operator()(const af4 (&acc)[2][2][4][2], const Unit& u, int wr, int wc, int fr, int fq) const {
        const int row0 = u.pm * 256 + wr * 64 + fr, col0 = u.pn * 256 + wc * 32 + 4 * fq;
        const float* gv = gate + (size_t)(u.pm < 64 ? (u.pm >> 4) : 4) * MODW + col0;
        af4 g[2][2];
#pragma unroll
        for (int bj = 0; bj < 2; ++bj)
#pragma unroll
            for (int n = 0; n < 2; ++n) g[bj][n] = *(const af4*)(gv + bj * 128 + n * 16);
#pragma unroll
        for (int ai = 0; ai < 2; ++ai)
#pragma unroll
            for (int m = 0; m < 4; ++m) { float* rowp = X + (size_t)(row0 + ai * 128 + m * 16) * D + col0;
#pragma unroll
                for (int bj = 0; bj < 2; ++bj)
#pragma unroll
                    for (int n = 0; n < 2; ++n) { af4* p = (af4*)(rowp + bj * 128 + n * 16); *p = *p + g[bj][n] * acc[ai][bj][m][n]; } }
    }
};
struct EpiF32 {
    static constexpr bool PERM = false, AFTER_DRAIN = false;
    float* C; int ldc; int nN;
    DI void operator()(const af4 (&acc)[2][2][4][2], const Unit& u, int wr, int wc, int fr, int fq) const {
        const int row0 = u.pm * 256 + wr * 64 + fr, col0 = (u.pn % nN) * 256 + wc * 32 + 4 * fq;
#pragma unroll
        for (int ai = 0; ai < 2; ++ai)
#pragma unroll
            for (int m = 0; m < 4; ++m) { float* rowp = C + (size_t)(row0 + ai * 128 + m * 16) * ldc + col0;
#pragma unroll
                for (int bj = 0; bj < 2; ++bj)
#pragma unroll
                    for (int n = 0; n < 2; ++n) *(af4*)(rowp + bj * 128 + n * 16) = acc[ai][bj][m][n]; }
    }
};
struct MoeOrder : pg8::StaticOrder {
    int tend[8];
    __device__ void initm(const unsigned* cnt, int nN_, int G_, int c_) {
        int acc = 0;
#pragma unroll
        for (int e = 0; e < 8; ++e) { acc += ((int)cnt[e] + 255) >> 8; tend[e] = acc; }
        nM = acc; nN = nN_; nwg = nM * nN; G = G_; c = c_;
    }
    __device__ bool next(int i, Unit& u) const {
        if (!pg8::StaticOrder::next(i, u)) return false;
        int e = 0;
#pragma unroll
        for (int k = 0; k < 7; ++k) e += (u.pm >= tend[k]) ? 1 : 0;
        u.pn += e * nN; return true;
    }
};
DI void transpose_item(const float* W, int ldw, int K, bf16* WT, int k0, int n0, int drow0, LAS float* scr, int lane) {
#pragma unroll 8
    for (int i = 0; i < 32; ++i) { const int kk = 2 * i + (lane >> 5); scr[kk * 33 + (lane & 31)] = W[(size_t)(k0 + kk) * ldw + n0 + (lane & 31)]; }
    asm volatile("s_waitcnt lgkmcnt(0)" ::: "memory");
    const int c = lane & 7;
#pragma unroll
    for (int j = 0; j < 4; ++j) { const int n = (lane >> 3) + 8 * j; const LAS float* s = scr + (8 * c) * 33 + n;
        u32x4 o; o[0] = pk2(s[0 * 33], s[1 * 33]); o[1] = pk2(s[2 * 33], s[3 * 33]); o[2] = pk2(s[4 * 33], s[5 * 33]); o[3] = pk2(s[6 * 33], s[7 * 33]);
        *(u32x4*)(WT + (size_t)(drow0 + n) * K + k0 + 8 * c) = o; }
    asm volatile("s_waitcnt lgkmcnt(0)" ::: "memory");
}
struct TJob { const float* W; bf16* WT; int ldw, K, N, F; };
DI int tjob_items(const TJob& j) { return (j.K / 64) * (j.N / 32); }
DI TJob get_tjob(const Params& p, int j) {
    const int i = j / 22, r = j % 22; unsigned char* ws = p.ws; TJob t;
    if (r == 0) t = TJob{p.in[9] + (size_t)i * D * EVEN_IN, (bf16*)(ws + WS_WEIN) + (size_t)i * 2560 * 1024, EVEN_IN, D, EVEN_IN, 0};
    else if (r == 1) t = TJob{p.in[10] + (size_t)i * D * D, (bf16*)(ws + WS_WEOUT) + (size_t)i * 1024 * 1024, D, D, D, 0};
    else if (r == 2) t = TJob{p.in[20] + (size_t)i * D * 2 * FFN, (bf16*)(ws + WS_WEF1) + (size_t)i * 5632 * 1024, 2 * FFN, D, 2 * FFN, FFN};
    else if (r == 3) t = TJob{p.in[21] + (size_t)i * FFN * D, (bf16*)(ws + WS_WEF2) + (size_t)i * 1024 * 2816, D, FFN, D, 0};
    else if (r == 4) t = TJob{p.in[22] + (size_t)i * D * ODD_IN, (bf16*)(ws + WS_WOIN) + (size_t)i * 4352 * 1024, ODD_IN, D, ODD_IN, 0};
    else if (r == 5) t = TJob{p.in[27] + (size_t)i * D * D, (bf16*)(ws + WS_WOOUT) + (size_t)i * 1024 * 1024, D, D, D, 0};
    else if (r < 14) { const int e = r - 6; t = TJob{p.in[29] + ((size_t)i * 8 + e) * D * 2 * FFE, (bf16*)(ws + WS_WXIN) + ((size_t)i * 8 + e) * 7168 * 1024, 2 * FFE, D, 2 * FFE, FFE}; }
    else { const int e = r - 14; t = TJob{p.in[30] + ((size_t)i * 8 + e) * FFE * D, (bf16*)(ws + WS_WXOUT) + ((size_t)i * 8 + e) * 1024 * 3584, D, FFE, D, 0}; }
    return t;
}
DI void ph_prologue(const Ctx& C, const Params& p) {
    LAS float* sil = (LAS float*)(C.lds);
    LAS float* scr = (LAS float*)(C.lds + 32768 + C.wave * 8704);
    for (int i = C.tid; i < 5 * 1024; i += 512) { const int v = i >> 10, k = i & 1023; const float x = v < 4 ? p.in[1][v * 1024 + k] : p.in[3][k]; sil[i] = x / (1.f + expf(-x)); }
    __syncthreads();
    const int gw = C.blk * 8 + C.wave, NGW = C.nblk * 8;
    float* MOD = (float*)(C.ws + WS_MOD);
    for (int it = gw; it < DEPTH * (MODW / 64); it += NGW) {
        const int l = it / (MODW / 64), n = (it % (MODW / 64)) * 64 + C.lane;
        const float* w = p.in[4] + (size_t)l * 1024 * MODW + n;
        float a0 = 0.f, a1 = 0.f, a2 = 0.f, a3 = 0.f, a4 = 0.f;
#pragma unroll 8
        for (int k = 0; k < 1024; ++k) { const float wv = w[(size_t)k * MODW]; a0 += sil[k] * wv; a1 += sil[1024 + k] * wv; a2 += sil[2048 + k] * wv; a3 += sil[3072 + k] * wv; a4 += sil[4096 + k] * wv; }
        const float bb = p.in[5][l * MODW + n];
        MOD[(size_t)(l * 5 + 0) * MODW + n] = a0 + bb; MOD[(size_t)(l * 5 + 1) * MODW + n] = a1 + bb; MOD[(size_t)(l * 5 + 2) * MODW + n] = a2 + bb;
        MOD[(size_t)(l * 5 + 3) * MODW + n] = a3 + bb; MOD[(size_t)(l * 5 + 4) * MODW + n] = a4 + bb;
    }
    { float* cosT = (float*)(C.ws + WS_COS); float* sinT = (float*)(C.ws + WS_SIN);
      for (int idx = C.blk * 512 + C.tid; idx < SEQ * 32; idx += C.nblk * 512) { const int t = idx >> 5, i = idx & 31;
          const float invf = powf(10000.f, -(float)(i & 15) / 16.f); const float ang = (i < 16 ? (float)(t >> 6) : (float)(t & 63)) * invf;
          cosT[idx] = cosf(ang); sinT[idx] = sinf(ang); } }
    { for (int i = 0; i < 2; ++i) { u32x4* z = (u32x4*)((bf16*)(C.ws + WS_WOIN) + (size_t)i * 4352 * 1024 + (size_t)4128 * 1024);
          for (int idx = C.blk * 512 + C.tid; idx < 224 * 1024 / 8; idx += C.nblk * 512) z[idx] = (u32x4){0u, 0u, 0u, 0u}; } }
    int jstart = 0;
    for (int j = 0; j < 44; ++j) {
        const TJob t = get_tjob(p, j); const int ni = tjob_items(t), nblkN = t.N / 32;
        int first = (gw - jstart % NGW + NGW) % NGW;
        for (int it = first; it < ni; it += NGW) {
            const int kb = it / nblkN, nb = it % nblkN, n0 = nb * 32;
            int drow0 = n0;
            if (t.F > 0) drow0 = (n0 < t.F) ? ((n0 / 128) * 256 + (n0 % 128)) : (((n0 - t.F) / 128) * 256 + 128 + ((n0 - t.F) % 128));
            transpose_item(t.W, t.ldw, t.K, t.WT, kb * 64, n0, drow0, scr, C.lane);
        }
        jstart += ni;
    }
}

DI void normmod_regs(f32x4 (&v)[4], const float* g, const float* shift, const float* scale, int lane) {
    float ss = 0.f;
#pragma unroll
    for (int j = 0; j < 4; ++j) ss += (v[j][0] * v[j][0] + v[j][1] * v[j][1]) + (v[j][2] * v[j][2] + v[j][3] * v[j][3]);
    const float rs = rsqrtf(wave_sum(ss, lane) * (1.f / D) + 1e-6f);
#pragma unroll
    for (int j = 0; j < 4; ++j) { const f32x4 gg = ((const f32x4*)g)[lane + 64 * j], sh = ((const f32x4*)shift)[lane + 64 * j], sc = ((const f32x4*)scale)[lane + 64 * j];
        v[j] = v[j] * rs * gg * (sc + 1.f) + sh; }
}
DI void store_row_bf16(bf16* orow, const f32x4 (&v)[4], int lane) {
#pragma unroll
    for (int j = 0; j < 4; ++j) { u32x2 w; w[0] = pk2(v[j][0], v[j][1]); w[1] = pk2(v[j][2], v[j][3]); ((u32x2*)orow)[lane + 64 * j] = w; }
}
DI void ph_normmod(const Ctx& C, const Params& p, int layer, bool second, bool from_input) {
    const int gw = C.blk * 8 + C.wave, NGW = C.nblk * 8;
    float* X = (float*)(C.ws + WS_X); bf16* H = (bf16*)(C.ws + WS_H);
    const float* MODl = (const float*)(C.ws + WS_MOD) + (size_t)layer * 5 * MODW;
    const float* g = (second ? p.in[7] : p.in[6]) + layer * D;
    for (int r = gw; r < NTOK; r += NGW) {
        const float* src = from_input ? (r < NLAT ? p.in[0] + (size_t)r * D : p.in[2] + (size_t)(r - NLAT) * D) : X + (size_t)r * D;
        f32x4 v[4];
#pragma unroll
        for (int j = 0; j < 4; ++j) v[j] = ((const f32x4*)src)[C.lane + 64 * j];
        if (from_input) {
#pragma unroll
            for (int j = 0; j < 4; ++j) ((f32x4*)(X + (size_t)r * D))[C.lane + 64 * j] = v[j]; }
        const float* mv = MODl + (size_t)(r < NLAT ? (r >> 12) : 4) * MODW + (second ? 3 * D : 0);
        normmod_regs(v, g, mv, mv + D, C.lane);
        store_row_bf16(H + (size_t)r * D, v, C.lane);
    }
}

DI void seq_bounds(int r, int& s0, int& s1) { if (r < NLAT) { s0 = r & ~4095; s1 = s0 + 4096; } else { s0 = NLAT + ((r - NLAT) & ~255); s1 = s0 + 256; } }

DI void ph_odd_conv(const Ctx& C, const Params& p, int i) {
    const int gw = C.blk * 8 + C.wave, NGW = C.nblk * 8;
    const bf16* PO = (const bf16*)(C.ws + WS_P); bf16* QKVN = (bf16*)(C.ws + WS_QKVN);
    const float* AB = (const float*)(C.ws + WS_AB); float* Gd = (float*)(C.ws + WS_GB); float* Bd = Gd + (size_t)2 * NTOK * 8;
    const float* cw = p.in[23] + (size_t)i * 4 * 3072;
    for (int r = gw; r < NTOK; r += NGW) {
        int s0, s1; seq_bounds(r, s0, s1);
#pragma unroll
        for (int j = 0; j < 6; ++j) {
            const int c = 8 * (C.lane + 64 * j);
            float a[8] = {0.f, 0.f, 0.f, 0.f, 0.f, 0.f, 0.f, 0.f};
#pragma unroll
            for (int tp = 0; tp < 4; ++tp) { const int rr = r + tp - 2;
                if (rr >= s0 && rr < s1) { const u32x4 x = *(const u32x4*)(PO + (size_t)rr * 4352 + c); const f32x4 w0 = *(const f32x4*)(cw + tp * 3072 + c), w1 = *(const f32x4*)(cw + tp * 3072 + c + 4);
                    a[0] += w0[0] * bflo(x[0]); a[1] += w0[1] * bfhi(x[0]); a[2] += w0[2] * bflo(x[1]); a[3] += w0[3] * bfhi(x[1]);
                    a[4] += w1[0] * bflo(x[2]); a[5] += w1[1] * bfhi(x[2]); a[6] += w1[2] * bflo(x[3]); a[7] += w1[3] * bfhi(x[3]); } }
            float ss = 0.f;
#pragma unroll
            for (int e = 0; e < 8; ++e) { a[e] = silu_(a[e]); ss += a[e] * a[e]; }
            if (j < 4) {
                ss += shx(ss, 1, C.lane); ss += shx(ss, 2, C.lane); ss += shx(ss, 4, C.lane); ss += shx(ss, 8, C.lane);
                const float rn = rsqrtf(ss + 1e-6f);
#pragma unroll
                for (int e = 0; e < 8; ++e) a[e] *= rn;
            }
            u32x4 w; w[0] = pk2(a[0], a[1]); w[1] = pk2(a[2], a[3]); w[2] = pk2(a[4], a[5]); w[3] = pk2(a[6], a[7]);
            *(u32x4*)(QKVN + (size_t)r * 3072 + c) = w;
        }
        if (C.lane < 16) { const int d = C.lane >> 3, h = C.lane & 7;
            const float x0 = AB[(size_t)r * 32 + d * 16 + h], x1 = AB[(size_t)r * 32 + d * 16 + 8 + h];
            Gd[((size_t)d * NTOK + r) * 8 + h] = -expf(p.in[24][i * 16 + d * 8 + h]) * softplus_(x0 + p.in[25][i * 16 + d * 8 + h]);
            Bd[((size_t)d * NTOK + r) * 8 + h] = 1.f / (1.f + expf(-x1)); }
    }
}
DI void ph_gdn_out(const Ctx& C, const Params& p, int i) {
    const int gw = C.blk * 8 + C.wave, NGW = C.nblk * 8;
    const float* OG = (const float*)(C.ws + WS_OG); const bf16* PO = (const bf16*)(C.ws + WS_P); bf16* MIX = (bf16*)(C.ws + WS_MIX);
    const f32x4 go = ((const f32x4*)(p.in[26] + i * 128))[C.lane & 31];
    for (int r = gw; r < NTOK; r += NGW) {
#pragma unroll
        for (int j = 0; j < 4; ++j) {
            const f32x4 a = ((const f32x4*)(OG + (size_t)r * D))[C.lane + 64 * j], b = ((const f32x4*)(OG + ((size_t)NTOK + r) * D))[C.lane + 64 * j];
            f32x4 o = a + b;
            float ss = (o[0] * o[0] + o[1] * o[1]) + (o[2] * o[2] + o[3] * o[3]);
            ss += shx(ss, 1, C.lane); ss += shx(ss, 2, C.lane); ss += shx(ss, 4, C.lane); ss += shx(ss, 8, C.lane); ss += shx(ss, 16, C.lane);
            const float rs = rsqrtf(ss * (1.f / 128.f) + 1e-6f);
            const u32x2 z = *(const u32x2*)(PO + (size_t)r * 4352 + 3072 + 4 * C.lane + 256 * j);
            o[0] *= rs * go[0] * silu_(bflo(z[0])); o[1] *= rs * go[1] * silu_(bfhi(z[0])); o[2] *= rs * go[2] * silu_(bflo(z[1])); o[3] *= rs * go[3] * silu_(bfhi(z[1]));
            u32x2 w; w[0] = pk2(o[0], o[1]); w[1] = pk2(o[2], o[3]);
            ((u32x2*)(MIX + (size_t)r * D))[C.lane + 64 * j] = w;
        }
    }
}
struct TokInfo { int e0, p0, e1, p1; float w0, w1; int r0, r1; };
DI void ph_router(const Ctx& C, const Params& p, int layer, int ntok) {
    const int gw = C.blk * 8 + C.wave, NGW = C.nblk * 8, i = layer >> 1;
    const float* X = (const float*)(C.ws + WS_X); bf16* H = (bf16*)(C.ws + WS_H);
    const float* MODl = (const float*)(C.ws + WS_MOD) + (size_t)layer * 5 * MODW;
    const float* g = p.in[7] + layer * D; const float* wr = p.in[28] + (size_t)i * D * 8;
    unsigned* cnt = (unsigned*)(C.ws + WS_CTL) + CW_CNT + i * 64; TokInfo* TI = (TokInfo*)(C.ws + WS_TOK);
    for (int r = gw; r < NTOK; r += NGW) {
        f32x4 v[4];
#pragma unroll
        for (int j = 0; j < 4; ++j) v[j] = ((const f32x4*)(X + (size_t)r * D))[C.lane + 64 * j];
        const float* mv = MODl + (size_t)(r < NLAT ? (r >> 12) : 4) * MODW + 3 * D;
        normmod_regs(v, g, mv, mv + D, C.lane);
        store_row_bf16(H + (size_t)r * D, v, C.lane);
        if (r >= ntok) continue;
        float lg[8] = {0.f, 0.f, 0.f, 0.f, 0.f, 0.f, 0.f, 0.f};
#pragma unroll
        for (int j = 0; j < 4; ++j)
#pragma unroll
            for (int q = 0; q < 4; ++q) { const int k = 4 * C.lane + 256 * j + q; const f32x4 w0 = *(const f32x4*)(wr + k * 8), w1 = *(const f32x4*)(wr + k * 8 + 4); const float x = v[j][q];
                lg[0] += x * w0[0]; lg[1] += x * w0[1]; lg[2] += x * w0[2]; lg[3] += x * w0[3]; lg[4] += x * w1[0]; lg[5] += x * w1[1]; lg[6] += x * w1[2]; lg[7] += x * w1[3]; }
#pragma unroll
        for (int e = 0; e < 8; ++e) lg[e] = wave_sum(lg[e], C.lane);
        if (C.lane == 0) {
            int e0 = 0; float b0 = lg[0];
#pragma unroll
            for (int e = 1; e < 8; ++e) if (lg[e] > b0) { e0 = e; b0 = lg[e]; }
            int e1 = -1; float b1 = -INFINITY;
#pragma unroll
            for (int e = 0; e < 8; ++e) if (e != e0 && lg[e] > b1) { e1 = e; b1 = lg[e]; }
            const float w1 = 1.f / (1.f + expf(b0 - b1)), w0 = 1.f - w1;
            TokInfo t; t.e0 = e0; t.e1 = e1; t.w0 = w0; t.w1 = w1;
            t.p0 = (int)__hip_atomic_fetch_add(cnt + e0, 1u, __ATOMIC_RELAXED, __HIP_MEMORY_SCOPE_AGENT);
            t.p1 = (int)__hip_atomic_fetch_add(cnt + e1, 1u, __ATOMIC_RELAXED, __HIP_MEMORY_SCOPE_AGENT);
            t.r0 = 0; t.r1 = 0;
            TI[r] = t;
        }
    }
}
DI void ph_gather(const Ctx& C, int layer, int ntok) {
    const int gw = C.blk * 8 + C.wave, NGW = C.nblk * 8, i = layer >> 1;
    const unsigned* cnt = (const unsigned*)(C.ws + WS_CTL) + CW_CNT + i * 64; TokInfo* TI = (TokInfo*)(C.ws + WS_TOK);
    const bf16* H = (const bf16*)(C.ws + WS_H); bf16* XS = (bf16*)(C.ws + WS_XS);
    int base[8], cn[8]; { int acc = 0;
#pragma unroll
        for (int e = 0; e < 8; ++e) { cn[e] = (int)cnt[e]; base[e] = acc * 256; acc += (cn[e] + 255) >> 8; } }
    for (int r = gw; r < ntok; r += NGW) {
        const TokInfo t = TI[r];
        int b0 = 0, b1 = 0;
#pragma unroll
        for (int e = 0; e < 8; ++e) { b0 = (t.e0 == e) ? base[e] : b0; b1 = (t.e1 == e) ? base[e] : b1; }
        const int r0 = b0 + t.p0, r1 = b1 + t.p1;
        const u32x4 a = ((const u32x4*)(H + (size_t)r * D))[C.lane], b = ((const u32x4*)(H + (size_t)r * D))[C.lane + 64];
        ((u32x4*)(XS + (size_t)r0 * D))[C.lane] = a; ((u32x4*)(XS + (size_t)r0 * D))[C.lane + 64] = b;
        ((u32x4*)(XS + (size_t)r1 * D))[C.lane] = a; ((u32x4*)(XS + (size_t)r1 * D))[C.lane + 64] = b;
        if (C.lane == 0) { TI[r].r0 = r0; TI[r].r1 = r1; }
    }
    for (int pr = gw; pr < 8 * 256; pr += NGW) {
        const int e = pr >> 8, j = pr & 255; int be = 0, ce = 0;
#pragma unroll
        for (int k = 0; k < 8; ++k) { be = (e == k) ? base[k] : be; ce = (e == k) ? cn[k] : ce; }
        const int lim = ((ce + 255) >> 8) << 8;
        if (ce + j < lim) { u32x4* z = (u32x4*)(XS + (size_t)(be + ce + j) * D); z[C.lane] = (u32x4){0u, 0u, 0u, 0u}; z[C.lane + 64] = (u32x4){0u, 0u, 0u, 0u}; }
    }
}
DI void ph_combine(const Ctx& C, const Params& p, int layer, int ntok) {
    const int gw = C.blk * 8 + C.wave, NGW = C.nblk * 8;
    float* X = (float*)(C.ws + WS_X); bf16* H = (bf16*)(C.ws + WS_H); const float* Y = (const float*)(C.ws + WS_Y); const TokInfo* TI = (const TokInfo*)(C.ws + WS_TOK);
    const float* MODl = (const float*)(C.ws + WS_MOD) + (size_t)layer * 5 * MODW;
    const bool last = (layer == DEPTH - 1);
    const int nrows = last ? NLAT : NTOK;
    for (int r = gw; r < nrows; r += NGW) {
        f32x4 v[4];
#pragma unroll
        for (int j = 0; j < 4; ++j) v[j] = ((const f32x4*)(X + (size_t)r * D))[C.lane + 64 * j];
        if (r < ntok) {
            const TokInfo t = TI[r];
            const float* ga = MODl + (size_t)(r < NLAT ? (r >> 12) : 4) * MODW + 5 * D;
#pragma unroll
            for (int j = 0; j < 4; ++j) { const f32x4 y0 = ((const f32x4*)(Y + (size_t)t.r0 * D))[C.lane + 64 * j], y1 = ((const f32x4*)(Y + (size_t)t.r1 * D))[C.lane + 64 * j], gg = ((const f32x4*)ga)[C.lane + 64 * j];
                v[j] = v[j] + gg * (y0 * t.w0 + y1 * t.w1); }
        }
        if (!last) {
#pragma unroll
            for (int j = 0; j < 4; ++j) ((f32x4*)(X + (size_t)r * D))[C.lane + 64 * j] = v[j];
            const float* MODn = (const float*)(C.ws + WS_MOD) + (size_t)(layer + 1) * 5 * MODW;
            const float* mv = MODn + (size_t)(r < NLAT ? (r >> 12) : 4) * MODW;
            normmod_regs(v, p.in[6] + (layer + 1) * D, mv, mv + D, C.lane);
            store_row_bf16(H + (size_t)r * D, v, C.lane);
        } else {
            float ss = 0.f;
#pragma unroll
            for (int j = 0; j < 4; ++j) ss += (v[j][0] * v[j][0] + v[j][1] * v[j][1]) + (v[j][2] * v[j][2] + v[j][3] * v[j][3]);
            const float rs = rsqrtf(wave_sum(ss, C.lane) * (1.f / D) + 1e-6f);
#pragma unroll
            for (int j = 0; j < 4; ++j) { const f32x4 gg = ((const f32x4*)p.in[8])[C.lane + 64 * j]; ((f32x4*)(p.out + (size_t)r * D))[C.lane + 64 * j] = v[j] * rs * gg; }
        }
    }
}
constexpr int AT_KB = 0, AT_KB_SZ = 64 * 136 * 2, AT_VT = 2 * AT_KB_SZ, AT_VT_SZ = 128 * 72 * 2, AT_XCH = AT_VT + 2 * AT_VT_SZ;
static_assert(AT_XCH + 65536 <= LDS_MISC, "attention LDS");
DI void attn_unit(const Ctx& C, const bf16* PE, bf16* MIX, const float* gsub, float lam, float mul, int b, int h, int qb, bool ctxq) {
    LAS unsigned char* ldsb = C.lds; asm volatile("" : "+v"(ldsb));
    int tid = C.tid; asm volatile("" : "+v"(tid));
    const int lane = tid & 63, wave = __builtin_amdgcn_readfirstlane(tid >> 6);
    const int map = wave >> 2, qsub = wave & 3, r = lane & 31, hh = lane >> 5;
    const int qrow = (ctxq ? NLAT + b * CTX : b * SEQ) + qb * 128 + qsub * 32 + r;
    const int ntile = ctxq ? CTX / 64 : (CTX + SEQ) / 64;
    LAS float* XCH = (LAS float*)(ldsb + AT_XCH);
    bf16x8 qf[4];
#pragma unroll
    for (int ks = 0; ks < 4; ++ks) qf[ks] = *(const bf16x8*)(PE + (size_t)qrow * EVEN_IN + h * 128 + map * 64 + 16 * ks + 8 * hh);
    f32x16 O[4];
#pragma unroll
    for (int k = 0; k < 4; ++k) O[k] = zero16();
    float m = -1e30f, l = 0.f;
    u32x4 kreg[2], vreg[2];
    const int skey = tid >> 4, spart = tid & 15;
#define AT_LOAD(t) do { _Pragma("unroll") for (int i_ = 0; i_ < 2; ++i_) { const int kidx_ = (t) * 64 + skey + 32 * i_; const int krow_ = kidx_ < CTX ? NLAT + b * CTX + kidx_ : b * SEQ + kidx_ - CTX; \
        const bf16* src_ = PE + (size_t)krow_ * EVEN_IN + h * 128 + spart * 8; kreg[i_] = *(const u32x4*)(src_ + 512); vreg[i_] = *(const u32x4*)(src_ + 1024); } } while (0)
#define AT_STORE(buf) do { LAS bf16* kb_ = (LAS bf16*)(ldsb + AT_KB + (buf) * AT_KB_SZ); LAS bf16* vt_ = (LAS bf16*)(ldsb + AT_VT + (buf) * AT_VT_SZ); \
        _Pragma("unroll") for (int i_ = 0; i_ < 2; ++i_) { const int key_ = skey + 32 * i_; *(LAS u32x4*)(kb_ + key_ * 136 + spart * 8) = kreg[i_]; \
            _Pragma("unroll") for (int e_ = 0; e_ < 4; ++e_) { vt_[(spart * 8 + 2 * e_) * 72 + key_] = (bf16)(vreg[i_][e_] & 0xffffu); vt_[(spart * 8 + 2 * e_ + 1) * 72 + key_] = (bf16)(vreg[i_][e_] >> 16); } } } while (0)
    AT_LOAD(0); AT_STORE(0);
    __syncthreads();
    for (int t = 0; t < ntile; ++t) {
        const int buf = t & 1;
        if (t + 1 < ntile) AT_LOAD(t + 1);
        const LAS bf16* kb = (const LAS bf16*)(ldsb + AT_KB + buf * AT_KB_SZ); const LAS bf16* vt = (const LAS bf16*)(ldsb + AT_VT + buf * AT_VT_SZ);
        f32x16 S[2];
#pragma unroll
        for (int ks2 = 0; ks2 < 2; ++ks2) { S[ks2] = zero16();
#pragma unroll
            for (int ks = 0; ks < 4; ++ks) { const bf16x8 a = *(const LAS bf16x8*)(kb + (ks2 * 32 + r) * 136 + map * 64 + 16 * ks + 8 * hh); S[ks2] = MFMA32(a, qf[ks], S[ks2]); } }
        float mx = S[0][0];
#pragma unroll
        for (int i = 0; i < 16; ++i) { mx = fmaxf(mx, S[0][i]); mx = fmaxf(mx, S[1][i]); }
        mx = fmaxf(mx, shx(mx, 32, lane));
        const float mnew = fmaxf(m, mx), corr = __expf(m - mnew); m = mnew;
        float ls = 0.f;
#pragma unroll
        for (int i = 0; i < 16; ++i) { S[0][i] = __expf(S[0][i] - mnew); S[1][i] = __expf(S[1][i] - mnew); ls += S[0][i] + S[1][i]; }
        l = l * corr + ls;
#pragma unroll
        for (int k = 0; k < 4; ++k) O[k] = O[k] * corr;
#pragma unroll
        for (int ks2 = 0; ks2 < 2; ++ks2)
#pragma unroll
            for (int s = 0; s < 2; ++s) { const bf16x8 pf = pack_step(S[ks2], s);
#pragma unroll
                for (int k = 0; k < 4; ++k) { const bf16x8 a = ld_perm_frag(vt + (k * 32 + r) * 72, ks2 * 32, s, hh); O[k] = MFMA32(a, pf, O[k]); } }
        if (t + 1 < ntile) AT_STORE(buf ^ 1);
        __syncthreads();
    }
#undef AT_LOAD
#undef AT_STORE
    const float ltot = l + shx(l, 32, lane), inv = 1.f / ltot;
    if (map == 1) { const float sc = lam * inv;
#pragma unroll
        for (int k = 0; k < 4; ++k)
#pragma unroll
            for (int i = 0; i < 16; ++i) XCH[((qsub * 4 + k) * 16 + i) * 64 + lane] = O[k][i] * sc; }
    __syncthreads();
    if (map == 0) {
        float ss = 0.f;
#pragma unroll
        for (int k = 0; k < 4; ++k)
#pragma unroll
            for (int i = 0; i < 16; ++i) { const float o = O[k][i] * inv - XCH[((qsub * 4 + k) * 16 + i) * 64 + lane]; O[k][i] = o; ss += o * o; }
        ss += shx(ss, 32, lane);
        const float rs = rsqrtf(ss * (1.f / 128.f) + 1e-6f) * mul;
#pragma unroll
        for (int k = 0; k < 4; ++k)
#pragma unroll
            for (int g4 = 0; g4 < 4; ++g4) { const int dv0 = k * 32 + 8 * g4 + 4 * hh; const f32x4 gg = *(const f32x4*)(gsub + dv0);
                u32x2 w; w[0] = pk2(O[k][4 * g4] * rs * gg[0], O[k][4 * g4 + 1] * rs * gg[1]); w[1] = pk2(O[k][4 * g4 + 2] * rs * gg[2], O[k][4 * g4 + 3] * rs * gg[3]);
                *(u32x2*)(MIX + (size_t)qrow * D + h * 128 + dv0) = w; }
    }
    __syncthreads();
}

constexpr int RG_XRAW = 0, RG_XC = 34368, RG_WGT = RG_XC + 256 * 65 * 4, RG_AU = RG_WGT + 8192, RG_SB = RG_AU + 16384, RG_CIN = RG_SB + 4096, RG_CARRY = RG_CIN + 2048, RG_HB = RG_CARRY + 64;
static_assert(RG_HB + 8192 <= LDS_MISC && 260 * 66 * 2 <= RG_XC, "rg-lru LDS");
DI void rglru_unit(const Ctx& C, const Params& p, int i, int b, int n, int cg) {
    LAS unsigned char* ldsb = C.lds; asm volatile("" : "+v"(ldsb));
    const bf16* PE = (const bf16*)(C.ws + WS_P); float* HS1 = (float*)(C.ws + WS_HS1); bf16* MIX = (bf16*)(C.ws + WS_MIX);
    LAS bf16* xraw = (LAS bf16*)(ldsb + RG_XRAW); LAS float* xc = (LAS float*)(ldsb + RG_XC); LAS float* wgt = (LAS float*)(ldsb + RG_WGT); LAS float* au = (LAS float*)(ldsb + RG_AU);
    LAS float* sb = (LAS float*)(ldsb + RG_SB); LAS float* cin = (LAS float*)(ldsb + RG_CIN); LAS float* carry = (LAS float*)(ldsb + RG_CARRY); LAS float* hb = (LAS float*)(ldsb + RG_HB);
    const float* w_a = p.in[15] + (size_t)i * 2 * 8 * 64 * 64; const float* w_x = p.in[17] + (size_t)i * 2 * 8 * 64 * 64;
    const float* b_a = p.in[16] + i * 1024; const float* b_x = p.in[18] + i * 1024; const float* lamv = p.in[19] + i * 1024;
    const float* cw = p.in[13] + i * 4 * 512; const float* cb = p.in[14] + i * 512;
    int tid = C.tid; asm volatile("" : "+v"(tid));
    for (int idx = tid; idx < 2048; idx += 512) { const int c8 = idx & 7, ci = (idx >> 3) & 63, gate = (idx >> 9) & 1, d = idx >> 10;
        const float* src = gate ? w_x : w_a; wgt[idx] = src[((size_t)(d * 8 + n) * 64 + ci) * 64 + cg * 8 + c8]; }
    const int cc = tid & 63; float tap[4];
#pragma unroll
    for (int tp = 0; tp < 4; ++tp) tap[tp] = cw[tp * 512 + n * 64 + cc];
    const float cbias = cb[n * 64 + cc];
    const int gtok = tid & 255, ghalf = tid >> 8;
    const int sch = tid & 7, ssub = tid >> 3;
    for (int pass = 0; pass < 2; ++pass) {
        const int d = 1 - pass;
        float gba[4], gbx[4], gsp[4];
#pragma unroll
        for (int c4 = 0; c4 < 4; ++c4) { const int ch = n * 64 + cg * 8 + ghalf * 4 + c4; gba[c4] = b_a[d * 512 + ch]; gbx[c4] = b_x[d * 512 + ch]; gsp[c4] = softplus_(-lamv[d * 512 + ch]); }
        if (tid < 8) carry[tid] = 0.f;
        __syncthreads();
        for (int sidx = 0; sidx < 17; ++sidx) {
            int seg_r0;
            if (sidx == 0) seg_r0 = NLAT + b * CTX; else seg_r0 = b * SEQ + (d ? (16 - sidx) : (sidx - 1)) * 256;
            int s0, s1; seq_bounds(seg_r0, s0, s1);
            for (int idx = tid; idx < 259 * 8; idx += 512) { const int ri = idx >> 3, part = idx & 7, row = seg_r0 - 2 + ri;
                u32x4 v = (u32x4){0u, 0u, 0u, 0u};
                if (row >= s0 && row < s1) v = *(const u32x4*)(PE + (size_t)row * EVEN_IN + 1536 + n * 64 + part * 8);
                LAS unsigned* dst = (LAS unsigned*)(xraw + ri * 66 + part * 8); dst[0] = v[0]; dst[1] = v[1]; dst[2] = v[2]; dst[3] = v[3]; }
            __syncthreads();
#pragma unroll 4
            for (int it = 0; it < 32; ++it) { const int tok = (tid >> 6) + 8 * it; float a = cbias;
#pragma unroll
                for (int tp = 0; tp < 4; ++tp) a += tap[tp] * bf2f(xraw[(tok + tp) * 66 + cc]);
                xc[tok * 65 + cc] = a; }
            __syncthreads();
            {
                float sa[4], sx[4];
#pragma unroll
                for (int c4 = 0; c4 < 4; ++c4) { sa[c4] = gba[c4]; sx[c4] = gbx[c4]; }
                const LAS float* wa = wgt + (d * 2 + 0) * 512 + ghalf * 4; const LAS float* wx = wgt + (d * 2 + 1) * 512 + ghalf * 4;
#pragma unroll 8
                for (int ci = 0; ci < 64; ++ci) { const float x = xc[gtok * 65 + ci]; const f32x4 a4 = *(const LAS f32x4*)(wa + ci * 8), x4 = *(const LAS f32x4*)(wx + ci * 8);
#pragma unroll
                    for (int c4 = 0; c4 < 4; ++c4) { sa[c4] += x * a4[c4]; sx[c4] += x * x4[c4]; } }
#pragma unroll
                for (int c4 = 0; c4 < 4; ++c4) { const float rr = 1.f / (1.f + expf(-sa[c4])), ii = 1.f / (1.f + expf(-sx[c4]));
                    const float log_a = -8.f * rr * gsp[c4]; const float a = expf(log_a), u = sqrtf(-expm1f(2.f * log_a)) * (ii * xc[gtok * 65 + cg * 8 + ghalf * 4 + c4]);
                    au[(gtok * 8 + ghalf * 4 + c4) * 2] = a; au[(gtok * 8 + ghalf * 4 + c4) * 2 + 1] = u; }
            }
            __syncthreads();
            float hl[4], al[4];
            { float A = 1.f, Hh = 0.f;
#pragma unroll
              for (int e = 0; e < 4; ++e) { const int q = ssub * 4 + e, tok = d ? 255 - q : q; const float a = au[(tok * 8 + sch) * 2], u = au[(tok * 8 + sch) * 2 + 1]; Hh = a * Hh + u; A *= a; hl[e] = Hh; al[e] = A; }
              sb[(ssub * 8 + sch) * 2] = A; sb[(ssub * 8 + sch) * 2 + 1] = Hh; }
            __syncthreads();
            if (tid < 8) { float c = carry[tid];
                for (int s = 0; s < 64; ++s) { cin[s * 8 + tid] = c; c = sb[(s * 8 + tid) * 2] * c + sb[(s * 8 + tid) * 2 + 1]; }
                carry[tid] = c; }
            __syncthreads();
            { const float c = cin[ssub * 8 + sch];
#pragma unroll
              for (int e = 0; e < 4; ++e) { const int q = ssub * 4 + e, tok = d ? 255 - q : q; hb[tok * 8 + sch] = hl[e] + al[e] * c; } }
            __syncthreads();
            if (tid < 256) { const int row = seg_r0 + tid; const f32x4 h0 = *(const LAS f32x4*)(hb + tid * 8), h1 = *(const LAS f32x4*)(hb + tid * 8 + 4);
                float* hs = HS1 + (size_t)row * 512 + n * 64 + cg * 8;
                if (pass == 0) { *(f32x4*)hs = h0; *(f32x4*)(hs + 4) = h1; }
                else { const f32x4 y0 = h0 + *(const f32x4*)hs, y1 = h1 + *(const f32x4*)(hs + 4);
                    const u32x4 g = *(const u32x4*)(PE + (size_t)row * EVEN_IN + 2048 + n * 64 + cg * 8);
                    u32x4 w; w[0] = pk2(y0[0] * gelu_tanh_(bflo(g[0])), y0[1] * gelu_tanh_(bfhi(g[0]))); w[1] = pk2(y0[2] * gelu_tanh_(bflo(g[1])), y0[3] * gelu_tanh_(bfhi(g[1])));
                    w[2] = pk2(y1[0] * gelu_tanh_(bflo(g[2])), y1[1] * gelu_tanh_(bfhi(g[2]))); w[3] = pk2(y1[2] * gelu_tanh_(bflo(g[3])), y1[3] * gelu_tanh_(bfhi(g[3])));
                    *(u32x4*)(MIX + (size_t)row * D + 512 + n * 64 + cg * 8) = w; }
            }
        }
        __syncthreads();
    }
}
DI void ph_even_mix(const Ctx& C, const Params& p, int layer) {
    const int i = layer >> 1;
    volatile LAS unsigned* misc = (volatile LAS unsigned*)(C.lds + LDS_MISC);
    unsigned* q = (unsigned*)(C.ws + WS_CTL) + CW_Q + i * 64;
    const float lam_init = 0.8f - 0.6f * expf(-0.3f * (float)layer);
    if (C.wave == 0) { const float* lq = p.in[11] + i * 256; const float a = wave_sum(lq[C.lane] * lq[64 + C.lane], C.lane), b2 = wave_sum(lq[128 + C.lane] * lq[192 + C.lane], C.lane);
        if (C.lane == 0) ((volatile LAS float*)misc)[4] = expf(a) - expf(b2) + lam_init; }
    __syncthreads();
    const float lam = ((volatile LAS float*)misc)[4];
    const bf16* PE = (const bf16*)(C.ws + WS_P); bf16* MIX = (bf16*)(C.ws + WS_MIX);
    for (;;) {
        if (C.tid == 0) misc[8] = __hip_atomic_fetch_add(q, 1u, __ATOMIC_RELAXED, __HIP_MEMORY_SCOPE_AGENT);
        __syncthreads();
        const int u = (int)misc[8];
        __syncthreads();
        if (u >= 800) break;
        if (u < 256) rglru_unit(C, p, i, u >> 6, (u >> 3) & 7, u & 7);
        else if (u < 768) { const int x = u - 256; attn_unit(C, PE, MIX, p.in[12] + i * 128, lam, 1.f - lam_init, x >> 7, (x >> 5) & 3, x & 31, false); }
        else { const int x = u - 768; attn_unit(C, PE, MIX, p.in[12] + i * 128, lam, 1.f - lam_init, x >> 3, (x >> 1) & 3, x & 1, true); }
    }
}
DI int chunk_row0(int cidx) { return cidx < 256 ? (cidx >> 6) * SEQ + (cidx & 63) * 64 : NLAT + (cidx - 256) * 64; }
constexpr int GA_KC = 0, GA_QC = GA_KC + 64 * 136 * 2, GA_KT = GA_QC + 64 * 136 * 2, GA_VT = GA_KT + 128 * 72 * 2, GA_LM = GA_VT + 128 * 72 * 2, GA_QM = GA_LM + 64 * 65 * 4,
              GA_T1 = GA_QM + 64 * 65 * 4, GA_T2 = GA_T1 + 64 * 72 * 2, GA_GC = GA_T2 + 64 * 72 * 2, GA_BE = GA_GC + 256, GA_END = GA_BE + 256;
static_assert(GA_END <= LDS_MISC, "GA LDS");
DI void gdn_ga_unit(const Ctx& C, int unit) {
    LAS unsigned char* ldsb = C.lds; asm volatile("" : "+v"(ldsb));
    const int d = unit & 1, h = (unit >> 1) & 7, cidx = unit >> 4;
    const int row0 = chunk_row0(cidx);
    const bf16* QKVN = (const bf16*)(C.ws + WS_QKVN); const float* Gd = (const float*)(C.ws + WS_GB); const float* Bd = Gd + (size_t)2 * NTOK * 8;
    bf16* WG = (bf16*)(C.ws + WS_WG) + (size_t)unit * 64 * 128; float* UG = (float*)(C.ws + WS_UG) + (size_t)unit * 64 * 128; bf16* QKD = (bf16*)(C.ws + WS_QKD) + (size_t)unit * 64 * 64; float* SC = (float*)(C.ws + WS_SC) + (size_t)unit * 192;
    LAS bf16* Kc = (LAS bf16*)(ldsb + GA_KC); LAS bf16* Qc = (LAS bf16*)(ldsb + GA_QC); LAS bf16* Kt = (LAS bf16*)(ldsb + GA_KT); LAS bf16* Vt = (LAS bf16*)(ldsb + GA_VT);
    LAS float* Lm = (LAS float*)(ldsb + GA_LM); LAS float* Qm = (LAS float*)(ldsb + GA_QM); LAS bf16* T1 = (LAS bf16*)(ldsb + GA_T1); LAS bf16* T2 = (LAS bf16*)(ldsb + GA_T2);
    LAS float* gc = (LAS float*)(ldsb + GA_GC); LAS float* be = (LAS float*)(ldsb + GA_BE);
    int tid = C.tid; asm volatile("" : "+v"(tid));
    const int lane = tid & 63, wave = __builtin_amdgcn_readfirstlane(tid >> 6), r = lane & 31, hh = lane >> 5;
#pragma unroll
    for (int i2 = 0; i2 < 2; ++i2) { const int c = tid + 512 * i2, pos = c >> 4, part = c & 15, row = row0 + (d ? 63 - pos : pos);
        const bf16* src = QKVN + (size_t)row * 3072 + h * 128 + part * 8;
        const u32x4 q = *(const u32x4*)src, k = *(const u32x4*)(src + 1024), v = *(const u32x4*)(src + 2048);
        *(LAS u32x4*)(Qc + pos * 136 + part * 8) = q; *(LAS u32x4*)(Kc + pos * 136 + part * 8) = k;
#pragma unroll
        for (int e = 0; e < 4; ++e) { Kt[(part * 8 + 2 * e) * 72 + pos] = (bf16)(k[e] & 0xffffu); Kt[(part * 8 + 2 * e + 1) * 72 + pos] = (bf16)(k[e] >> 16);
            Vt[(part * 8 + 2 * e) * 72 + pos] = (bf16)(v[e] & 0xffffu); Vt[(part * 8 + 2 * e + 1) * 72 + pos] = (bf16)(v[e] >> 16); } }
    if (wave == 0) {
        const int row = row0 + (d ? 63 - lane : lane);
        float g = Gd[((size_t)d * NTOK + row) * 8 + h];
#pragma unroll
        for (int o = 1; o < 64; o <<= 1) { const float t = __builtin_bit_cast(float, __builtin_amdgcn_ds_bpermute((lane - o) << 2, __builtin_bit_cast(int, g))); if (lane >= o) g += t; }
        gc[lane] = g; be[lane] = Bd[((size_t)d * NTOK + row) * 8 + h];
    }
    __syncthreads();
    { const int ti = (wave & 3) >> 1, tj = wave & 1; const LAS bf16* Arows = (wave < 4 ? Kc : Qc);
      f32x16 acc = zero16();
#pragma unroll
      for (int ks = 0; ks < 8; ++ks) { const bf16x8 a = *(const LAS bf16x8*)(Arows + (ti * 32 + r) * 136 + 16 * ks + 8 * hh), bb = *(const LAS bf16x8*)(Kc + (tj * 32 + r) * 136 + 16 * ks + 8 * hh); acc = MFMA32(a, bb, acc); }
      LAS float* dst = (wave < 4 ? Lm : Qm);
#pragma unroll
      for (int i = 0; i < 16; ++i) dst[(ti * 32 + crow(i, hh)) * 65 + tj * 32 + r] = acc[i]; }
    __syncthreads();
    const float qscale = 0.08838834764831845f;
#pragma unroll
    for (int e = 0; e < 8; ++e) { const int idx = tid + 512 * e, i = idx >> 6, j = idx & 63;
        const float dec = (j <= i) ? expf(gc[i] - gc[j]) : 0.f;
        Lm[i * 65 + j] = (j < i) ? Lm[i * 65 + j] * be[i] * dec : 0.f;
        QKD[idx] = f2bf(Qm[i * 65 + j] * qscale * dec); }
    if (tid < 64) { SC[tid] = qscale * expf(gc[tid]); SC[64 + tid] = expf(gc[63] - gc[tid]); if (tid == 0) SC[128] = expf(gc[63]); }
    __syncthreads();
    if (wave == 0) {
        const int c = lane; float T[64];
#pragma unroll
        for (int i = 0; i < 64; ++i) { float a = (i == c) ? 1.f : 0.f;
#pragma unroll
            for (int j = 0; j < i; ++j) a -= Lm[i * 65 + j] * T[j];
            T[i] = a; asm volatile("" ::: "memory"); }
        const float s1 = be[c] * expf(gc[c]), s2 = be[c];
#pragma unroll
        for (int i = 0; i < 64; ++i) { T1[i * 72 + c] = f2bf(T[i] * s1); T2[i * 72 + c] = f2bf(T[i] * s2); }
    }
    __syncthreads();
    { const int ti = wave >> 2, tn = wave & 3; f32x16 aw = zero16(), au = zero16();
#pragma unroll
      for (int ks = 0; ks < 4; ++ks) { const bf16x8 a1 = *(const LAS bf16x8*)(T1 + (ti * 32 + r) * 72 + 16 * ks + 8 * hh), a2 = *(const LAS bf16x8*)(T2 + (ti * 32 + r) * 72 + 16 * ks + 8 * hh);
          const bf16x8 bk = *(const LAS bf16x8*)(Kt + (tn * 32 + r) * 72 + 16 * ks + 8 * hh), bv = *(const LAS bf16x8*)(Vt + (tn * 32 + r) * 72 + 16 * ks + 8 * hh);
          aw = MFMA32(a1, bk, aw); au = MFMA32(a2, bv, au); }
#pragma unroll
      for (int i = 0; i < 16; ++i) { const int pos = ti * 32 + crow(i, hh); WG[pos * 128 + tn * 32 + r] = f2bf(aw[i]); UG[pos * 128 + tn * 32 + r] = au[i]; } }
    __syncthreads();
}
DI void ph_gdn_ga(const Ctx& C) { for (int u = C.blk; u < NCHD; u += C.nblk) gdn_ga_unit(C, u); }

constexpr int GB_NSL = 2;
constexpr int GB_W = 0, GB_Q = GB_W + 64 * 136 * 2, GB_KT = GB_Q + 64 * 136 * 2, GB_QK = GB_KT + 128 * 72 * 2, GB_SC = GB_QK + 64 * 72 * 2, GB_BUF = GB_SC + 1024;
static_assert(2 * GB_BUF <= LDS_MISC, "GB LDS");
DI void gdn_gb_unit(const Ctx& C, int unit) {
    LAS unsigned char* ldsb = C.lds; asm volatile("" : "+v"(ldsb));
    constexpr int NGRP = 4 / GB_NSL;
    const int grp = unit % NGRP, bhd = unit / NGRP, d = bhd & 1, h = (bhd >> 1) & 7, b = bhd >> 4;
    const bf16* QKVN = (const bf16*)(C.ws + WS_QKVN);
    const bf16* WGb = (const bf16*)(C.ws + WS_WG); const float* UGb = (const float*)(C.ws + WS_UG); const bf16* QKDb = (const bf16*)(C.ws + WS_QKD); const float* SCb = (const float*)(C.ws + WS_SC);
    float* OG = (float*)(C.ws + WS_OG) + (size_t)d * NTOK * D;
    int tid = C.tid; asm volatile("" : "+v"(tid));
    const int lane = tid & 63, wave = __builtin_amdgcn_readfirstlane(tid >> 6), r = lane & 31, hh = lane >> 5;
    const bool comp = wave < GB_NSL; const int dv0 = (grp * GB_NSL + wave) * 32;
    f32x16 S[4];
#pragma unroll
    for (int k = 0; k < 4; ++k) S[k] = zero16();
    constexpr int NST = 512 - GB_NSL * 64, NCK = 3584, NIT = (NCK + NST - 1) / NST;
    const int st = tid - GB_NSL * 64;
    u32x4 sreg[NIT]; float rsc = 0.f;
    auto chunk_of = [&](int step) { return step < 4 ? 256 + b * 4 + (d ? 3 - step : step) : b * 64 + (d ? 63 - (step - 4) : (step - 4)); };
#define GB_LOAD(step) do { if (!comp) { int st_ = st; asm volatile("" : "+v"(st_)); const int cidx_ = chunk_of(step), un_ = (cidx_ * 8 + h) * 2 + d, row0_ = chunk_row0(cidx_); \
        _Pragma("unroll") for (int i_ = 0; i_ < NIT; ++i_) { const int q_ = st_ + NST * i_; if (q_ < NCK) { const int reg_ = q_ >> 10, c_ = q_ & 1023, pos_ = c_ >> 4, part_ = c_ & 15, row_ = row0_ + (d ? 63 - pos_ : pos_); \
            const bf16* src_ = reg_ == 0 ? WGb + (size_t)un_ * 8192 + c_ * 8 : reg_ == 1 ? QKVN + (size_t)row_ * 3072 + h * 128 + part_ * 8 : reg_ == 2 ? QKVN + (size_t)row_ * 3072 + 1024 + h * 128 + part_ * 8 : QKDb + (size_t)un_ * 4096 + c_ * 8; \
            sreg[i_] = *(const u32x4*)src_; } } \
        if (st_ < 192) rsc = SCb[(size_t)un_ * 192 + st_]; } } while (0)
#define GB_STORE(buf) do { if (!comp) { int st_ = st; asm volatile("" : "+v"(st_)); LAS unsigned char* B_ = ldsb + (buf) * GB_BUF; \
        _Pragma("unroll") for (int i_ = 0; i_ < NIT; ++i_) { const int q_ = st_ + NST * i_; if (q_ < NCK) { const int reg_ = q_ >> 10, c_ = q_ & 1023, pos_ = c_ >> 4, part_ = c_ & 15; \
            if (reg_ == 0) *(LAS u32x4*)((LAS bf16*)(B_ + GB_W) + pos_ * 136 + part_ * 8) = sreg[i_]; \
            else if (reg_ == 1) *(LAS u32x4*)((LAS bf16*)(B_ + GB_Q) + pos_ * 136 + part_ * 8) = sreg[i_]; \
            else if (reg_ == 2) { LAS bf16* KT_ = (LAS bf16*)(B_ + GB_KT); _Pragma("unroll") for (int e_ = 0; e_ < 4; ++e_) { KT_[(part_ * 8 + 2 * e_) * 72 + pos_] = (bf16)(sreg[i_][e_] & 0xffffu); KT_[(part_ * 8 + 2 * e_ + 1) * 72 + pos_] = (bf16)(sreg[i_][e_] >> 16); } } \
            else *(LAS u32x4*)((LAS bf16*)(B_ + GB_QK) + (c_ >> 3) * 72 + (c_ & 7) * 8) = sreg[i_]; } } \
        if (st_ < 192) ((LAS float*)(B_ + GB_SC))[st_] = rsc; } } while (0)
    GB_LOAD(0); GB_STORE(0);
    __syncthreads();
    for (int step = 0; step < 68; ++step) {
        const int buf = step & 1;
        if (step + 1 < 68) GB_LOAD(step + 1);
        if (comp) {
            int ln_ = lane; asm volatile("" : "+v"(ln_)); const int r = ln_ & 31, hh = ln_ >> 5;
            const int cidx = chunk_of(step), un = (cidx * 8 + h) * 2 + d, row0 = chunk_row0(cidx);
            const LAS unsigned char* Bp = ldsb + buf * GB_BUF; const LAS bf16* Wl = (const LAS bf16*)(Bp + GB_W); const LAS bf16* Ql = (const LAS bf16*)(Bp + GB_Q);
            const LAS bf16* KTl = (const LAS bf16*)(Bp + GB_KT); const LAS bf16* QKl = (const LAS bf16*)(Bp + GB_QK); const LAS float* scl = (const LAS float*)(Bp + GB_SC);
            const float* Uu = UGb + (size_t)un * 8192 + dv0 + r;
            f32x16 Vn[2];
#pragma unroll
            for (int tt = 0; tt < 2; ++tt) {
                f32x16 aw = zero16();
#pragma unroll
                for (int kb = 0; kb < 4; ++kb)
#pragma unroll
                    for (int s = 0; s < 2; ++s) aw = MFMA32(ld_perm_frag(Wl + (tt * 32 + r) * 136, kb * 32, s, hh), pack_step(S[kb], s), aw);
#pragma unroll
                for (int i = 0; i < 16; ++i) { const int pos = tt * 32 + crow(i, hh); Vn[tt][i] = Uu[pos * 128] - aw[i]; }
                asm volatile("" ::: "memory");
            }
            bf16x8 vp[2][2];
#pragma unroll
            for (int jt = 0; jt < 2; ++jt) { vp[jt][0] = pack_step(Vn[jt], 0); vp[jt][1] = pack_step(Vn[jt], 1); }
#pragma unroll
            for (int tt = 0; tt < 2; ++tt) {
                f32x16 aq = zero16();
#pragma unroll
                for (int kb = 0; kb < 4; ++kb)
#pragma unroll
                    for (int s = 0; s < 2; ++s) aq = MFMA32(ld_perm_frag(Ql + (tt * 32 + r) * 136, kb * 32, s, hh), pack_step(S[kb], s), aq);
#pragma unroll
                for (int i = 0; i < 16; ++i) aq[i] *= scl[tt * 32 + crow(i, hh)];
#pragma unroll
                for (int jt = 0; jt < 2; ++jt)
#pragma unroll
                    for (int s = 0; s < 2; ++s) aq = MFMA32(ld_perm_frag(QKl + (tt * 32 + r) * 72, jt * 32, s, hh), vp[jt][s], aq);
#pragma unroll
                for (int i = 0; i < 16; ++i) { const int pos = tt * 32 + crow(i, hh), row = row0 + (d ? 63 - pos : pos); OG[(size_t)row * D + h * 128 + dv0 + r] = aq[i]; }
                asm volatile("" ::: "memory");
            }
#pragma unroll
            for (int jt = 0; jt < 2; ++jt) {
#pragma unroll
                for (int i = 0; i < 16; ++i) Vn[jt][i] *= scl[64 + jt * 32 + crow(i, hh)];
                vp[jt][0] = pack_step(Vn[jt], 0); vp[jt][1] = pack_step(Vn[jt], 1); }
            const float gtot = scl[128];
#pragma unroll
            for (int kb = 0; kb < 4; ++kb) { S[kb] = S[kb] * gtot;
#pragma unroll
                for (int jt = 0; jt < 2; ++jt)
#pragma unroll
                    for (int s = 0; s < 2; ++s) S[kb] = MFMA32(ld_perm_frag(KTl + (kb * 32 + r) * 72, jt * 32, s, hh), vp[jt][s], S[kb]);
                asm volatile("" ::: "memory"); }
        }
        if (step + 1 < 68) GB_STORE(buf ^ 1);
        __syncthreads();
    }
#undef GB_LOAD
#undef GB_STORE
}
DI void ph_gdn_gb(const Ctx& C) { for (int u = C.blk; u < 64 * (4 / GB_NSL); u += C.nblk) gdn_gb_unit(C, u); }
constexpr int NPH_PAIR = 19, NPHASE = 1 + 2 * NPH_PAIR;
DI void fresh(Ctx& C) { int t = threadIdx.x; asm volatile("" : "+v"(t)); int b = blockIdx.x; asm volatile("" : "+s"(b)); C.tid = t; C.lane = t & 63; C.wave = __builtin_amdgcn_readfirstlane(t >> 6); C.blk = b; }
__global__ void __launch_bounds__(512, 2) fused_fwd(Params p) {
    extern __shared__ __attribute__((aligned(16))) unsigned char lds_raw[];
    Ctx C; C.lds = (LAS unsigned char*)lds_raw; C.ws = p.ws; C.tid = threadIdx.x; C.lane = C.tid & 63; C.wave = __builtin_amdgcn_readfirstlane(C.tid >> 6); C.nblk = gridDim.x; C.blk = blockIdx.x;
    volatile LAS unsigned* misc = (volatile LAS unsigned*)(C.lds + LDS_MISC);
    if (C.tid < 16) misc[C.tid] = 0u;
    __syncthreads();
    unsigned* ctl = (unsigned*)(p.ws + WS_CTL);
    const bool single = (p.ph_lo == 0 && p.ph_hi == NPHASE);
    XcdBarrier bar; bar.bar = ctl + CW_BAR; bar.x = 0; bar.st = misc;
    if (single) bar = xcd_barrier_post(ctl + CW_BAR, misc);
    const int lo = p.ph_lo, hi = p.ph_hi;
#ifndef PH_MASK
#define PH_MASK 0xFFFFFu
#endif
#define PHEN(k) (((PH_MASK) >> (k)) & 1u)
#define IN(k) (fresh(C), lo <= (k) && (k) < hi)
#define SEAM(k) do { if (single) { unsigned* bp_ = ctl + CW_BAR; asm volatile("" : "+s"(bp_)); bar.bar = bp_; xcd_barrier(bar); } } while (0)
    bf16* H = (bf16*)(p.ws + WS_H); bf16* MIX = (bf16*)(p.ws + WS_MIX); bf16* P = (bf16*)(p.ws + WS_P); float* X = (float*)(p.ws + WS_X);
    const float* MOD = (const float*)(p.ws + WS_MOD);
    if (PHEN(0) && IN(0)) ph_prologue(C, p);
    SEAM(0);
    for (int lp = 0; lp < 2; ++lp) {
        const int pb = 1 + lp * NPH_PAIR, le = 2 * lp, lod = 2 * lp + 1;
        if (PHEN(1) && IN(pb + 0)) { if (lp == 0) ph_normmod(C, p, 0, false, true); }
        SEAM(pb + 0);
        if (PHEN(2) && IN(pb + 1)) { pg8::Gemm g{H, (const bf16*)(p.ws + WS_WEIN) + (size_t)lp * 2560 * 1024, NTOK, EVEN_IN, D}; pg8::StaticOrder S; S.init(NTOK, EVEN_IN, C.nblk, C.blk);
            EpiEvenIn E{P, (const float*)(p.ws + WS_COS), (const float*)(p.ws + WS_SIN)}; pg8::gemm_phase<EpiEvenIn, pg8::StaticOrder>(C.lds, g, S, E, C.tid); }
        SEAM(pb + 1);
        if (PHEN(3) && IN(pb + 2)) ph_even_mix(C, p, le);
        SEAM(pb + 2);
        if (PHEN(4) && IN(pb + 3)) { pg8::Gemm g{MIX, (const bf16*)(p.ws + WS_WEOUT) + (size_t)lp * 1024 * 1024, NTOK, D, D}; pg8::StaticOrder S; S.init(NTOK, D, C.nblk, C.blk);
            EpiResid E{X, MOD + (size_t)le * 5 * MODW + 2 * D}; pg8::gemm_phase<EpiResid, pg8::StaticOrder>(C.lds, g, S, E, C.tid); }
        SEAM(pb + 3);
        if (PHEN(5) && IN(pb + 4)) ph_normmod(C, p, le, true, false);
        SEAM(pb + 4);
        if (PHEN(6) && IN(pb + 5)) { pg8::Gemm g{H, (const bf16*)(p.ws + WS_WEF1) + (size_t)lp * 5632 * 1024, NTOK, 2 * FFN, D}; pg8::StaticOrder S; S.init(NTOK, 2 * FFN, C.nblk, C.blk);
            EpiSwiglu E{P, FFN, 2 * FFN / 256}; pg8::gemm_phase<EpiSwiglu, pg8::StaticOrder>(C.lds, g, S, E, C.tid); }
        SEAM(pb + 5);
        if (PHEN(7) && IN(pb + 6)) { pg8::Gemm g{P, (const bf16*)(p.ws + WS_WEF2) + (size_t)lp * 1024 * 2816, NTOK, D, FFN}; pg8::StaticOrder S; S.init(NTOK, D, C.nblk, C.blk);
            EpiResid E{X, MOD + (size_t)le * 5 * MODW + 5 * D}; pg8::gemm_phase<EpiResid, pg8::StaticOrder>(C.lds, g, S, E, C.tid); }
        SEAM(pb + 6);
        const int ntok = (lod < DEPTH - 1) ? NTOK : NLAT;
        if (PHEN(8) && IN(pb + 7)) ph_normmod(C, p, lod, false, false);
        SEAM(pb + 7);
        if (PHEN(9) && IN(pb + 8)) { pg8::Gemm g{H, (const bf16*)(p.ws + WS_WOIN) + (size_t)lp * 4352 * 1024, NTOK, 4352, D}; pg8::StaticOrder S; S.init(NTOK, 4352, C.nblk, C.blk);
            EpiBf16Ab E{P, 4352, (float*)(p.ws + WS_AB), 16}; pg8::gemm_phase<EpiBf16Ab, pg8::StaticOrder>(C.lds, g, S, E, C.tid); }
        SEAM(pb + 8);
        if (PHEN(10) && IN(pb + 9)) ph_odd_conv(C, p, lp);
        SEAM(pb + 9);
        if (PHEN(11) && IN(pb + 10)) ph_gdn_ga(C);
        SEAM(pb + 10);
        if (PHEN(12) && IN(pb + 11)) ph_gdn_gb(C);
        SEAM(pb + 11);
        if (PHEN(13) && IN(pb + 12)) ph_gdn_out(C, p, lp);
        SEAM(pb + 12);
        if (PHEN(14) && IN(pb + 13)) { pg8::Gemm g{MIX, (const bf16*)(p.ws + WS_WOOUT) + (size_t)lp * 1024 * 1024, NTOK, D, D}; pg8::StaticOrder S; S.init(NTOK, D, C.nblk, C.blk);
            EpiResid E{X, MOD + (size_t)lod * 5 * MODW + 2 * D}; pg8::gemm_phase<EpiResid, pg8::StaticOrder>(C.lds, g, S, E, C.tid); }
        SEAM(pb + 13);
        if (PHEN(15) && IN(pb + 14)) ph_router(C, p, lod, ntok);
        SEAM(pb + 14);
        if (PHEN(16) && IN(pb + 15)) ph_gather(C, lod, ntok);
        SEAM(pb + 15);
        if (PHEN(17) && IN(pb + 16)) { pg8::Gemm g{(const bf16*)(p.ws + WS_XS), (const bf16*)(p.ws + WS_WXIN) + (size_t)lp * 8 * 7168 * 1024, RMAX, 8 * 7168, D}; MoeOrder S; S.initm(ctl + CW_CNT + lp * 64, 28, C.nblk, C.blk);
            EpiSwiglu E{(bf16*)(p.ws + WS_HIDM), FFE, 28}; pg8::gemm_phase<EpiSwiglu, MoeOrder>(C.lds, g, S, E, C.tid); }
        SEAM(pb + 16);
        if (PHEN(18) && IN(pb + 17)) { pg8::Gemm g{(const bf16*)(p.ws + WS_HIDM), (const bf16*)(p.ws + WS_WXOUT) + (size_t)lp * 8 * 1024 * 3584, RMAX, 8 * 1024, FFE}; MoeOrder S; S.initm(ctl + CW_CNT + lp * 64, 4, C.nblk, C.blk);
            EpiF32 E{(float*)(p.ws + WS_Y), D, 4}; pg8::gemm_phase<EpiF32, MoeOrder>(C.lds, g, S, E, C.tid); }
        SEAM(pb + 17);
        if (PHEN(19) && IN(pb + 18)) ph_combine(C, p, lod, ntok);
        SEAM(pb + 18);
    }
#undef IN
#undef SEAM
}

static int fused_setup() {
    static int grid = 0;
    if (grid == 0) {
        int dev = 0, cus = 0, per_cu = 0;
        if (hipGetDevice(&dev) != hipSuccess || hipDeviceGetAttribute(&cus, hipDeviceAttributeMultiprocessorCount, dev) != hipSuccess) { fprintf(stderr, "fused_setup: device query failed\n"); grid = -1; return grid; }
        if (hipFuncSetAttribute((const void*)fused_fwd, hipFuncAttributeMaxDynamicSharedMemorySize, LDS_BYTES) != hipSuccess) { fprintf(stderr, "fused_setup: hipFuncSetAttribute failed\n"); grid = -1; return grid; }
        if (hipOccupancyMaxActiveBlocksPerMultiprocessor(&per_cu, (const void*)fused_fwd, 512, LDS_BYTES) != hipSuccess || per_cu < 1) { fprintf(stderr, "fused_setup: occupancy query says %d blocks per CU\n", per_cu); (void)hipGetLastError(); }
        grid = cus;
    }
    return grid;
}
static void launch_fused(const Params& p0, int lo, int hi, hipStream_t s) {
    const int grid = fused_setup(); if (grid <= 0) return;
    Params p = p0; p.ph_lo = lo; p.ph_hi = hi;
    hipLaunchKernelGGL(fused_fwd, dim3(grid), dim3(512), LDS_BYTES, s, p);
}
}
#ifdef DEBUG_MODE
namespace dbg {
using namespace cfg;
__global__ void k_cmp_f32_bf16(const float* __restrict__ A, const unsigned short* __restrict__ R, size_t n, float* __restrict__ res) {
    float d2 = 0.f, r2 = 0.f;
    for (size_t i = (size_t)blockIdx.x * 256 + threadIdx.x; i < n; i += (size_t)gridDim.x * 256) { const float r = __uint_as_float((unsigned)R[i] << 16), a = A[i]; d2 += (a - r) * (a - r); r2 += r * r; }
    for (int o = 32; o >= 1; o >>= 1) { d2 += __shfl_xor(d2, o); r2 += __shfl_xor(r2, o); }
    if ((threadIdx.x & 63) == 0) { atomicAdd(res, d2); atomicAdd(res + 1, r2); }
}
__global__ void k_cmp_bf16_f32(const unsigned short* __restrict__ A, int fp, int fo, const float* __restrict__ R, int rp, int ro, int nrows, int ncols, float rscale, float* __restrict__ res) {
    float d2 = 0.f, r2 = 0.f;
    for (size_t i = (size_t)blockIdx.x * 256 + threadIdx.x; i < (size_t)nrows * ncols; i += (size_t)gridDim.x * 256) { const int row = (int)(i / ncols), c = (int)(i % ncols);
        const float a = __uint_as_float((unsigned)A[(size_t)row * fp + fo + c] << 16), r = R[(size_t)row * rp + ro + c] * rscale; d2 += (a - r) * (a - r); r2 += r * r; }
    for (int o = 32; o >= 1; o >>= 1) { d2 += __shfl_xor(d2, o); r2 += __shfl_xor(r2, o); }
    if ((threadIdx.x & 63) == 0) { atomicAdd(res, d2); atomicAdd(res + 1, r2); }
}
__global__ void k_cmp_f32_f32(const float* __restrict__ A, int fp, int fo, const float* __restrict__ R, int rp, int ro, int nrows, int ncols, float* __restrict__ res) {
    float d2 = 0.f, r2 = 0.f;
    for (size_t i = (size_t)blockIdx.x * 256 + threadIdx.x; i < (size_t)nrows * ncols; i += (size_t)gridDim.x * 256) { const int row = (int)(i / ncols), c = (int)(i % ncols);
        const float a = A[(size_t)row * fp + fo + c], r = R[(size_t)row * rp + ro + c]; d2 += (a - r) * (a - r); r2 += r * r; }
    for (int o = 32; o >= 1; o >>= 1) { d2 += __shfl_xor(d2, o); r2 += __shfl_xor(r2, o); }
    if ((threadIdx.x & 63) == 0) { atomicAdd(res, d2); atomicAdd(res + 1, r2); }
}
__global__ void k_decide(const float* __restrict__ res, int nchk, float tol, float* __restrict__ out, size_t nout) {
    int code = 0; float frac = 0.f;
    for (int k = 0; k < nchk; ++k) { const float err = res[2 * k] / res[2 * k + 1]; if (!(err <= tol)) { code = k + 1; float l = (err == err && err > 0.f) ? log10f(err) : 0.f; frac = fminf(fmaxf((l + 4.f) / 4.f * 0.9f, 0.f), 0.9f); break; } }
    if (code == 0) return;
    const float c = sqrtf((float)code + frac);
    for (size_t i = (size_t)blockIdx.x * 256 + threadIdx.x; i < nout; i += (size_t)gridDim.x * 256) out[i] = c;
}
}
#endif

static nv::NaiveWs carve_naive(char* base, size_t& off) {
    using namespace cfg;
    nv::NaiveWs w{};
    auto take = [&](size_t nfloats) { float* p = (float*)(base + off); off += ((nfloats * 4 + 255) / 256) * 256; return p; };
    w.MOD = take((size_t)DEPTH * 5 * MODW);
    w.X = take((size_t)NTOK * D); w.H = take((size_t)NTOK * D); w.P = take((size_t)NTOK * ODD_IN); w.MIX = take((size_t)NTOK * D);
    w.T0 = take((size_t)NTOK * 512); w.T1 = take((size_t)NTOK * 3072); w.T2 = take((size_t)NTOK * 2048);
    w.FOUT = take((size_t)NTOK * D); w.HID = take((size_t)NTOK * FFE);
    w.lam = take(64); w.cnt = (int*)take(64); w.list_tok = (int*)take((size_t)NEXP * NTOK); w.list_w = take((size_t)NEXP * NTOK);
    return w;
}
extern "C" void kernel_launch(void* const* d_in, const int* in_sizes, int n_in, void* d_out, int out_size, void* d_ws, size_t ws_size, hipStream_t stream) {
    using namespace cfg;
    if (n_in != 31 || out_size != NLAT * D) { fprintf(stderr, "kernel_launch: unexpected n_in %d / out_size %d\n", n_in, out_size); return; }
    fk::Params p{}; for (int i = 0; i < 31; ++i) p.in[i] = (const float*)d_in[i];
    p.out = (float*)d_out; p.ws = (unsigned char*)d_ws;
#ifdef DEBUG_MODE
    const size_t snap_bytes = (size_t)NTOK * D * 2, CK_BYTES = 8 * snap_bytes + (size_t)NLAT * D * 4 + 4096;
    if (ws_size < fk::WS_END + CK_BYTES) { fprintf(stderr, "kernel_launch(debug): workspace too small\n"); return; }
    char* ckb = (char*)d_ws + ws_size - CK_BYTES; ckb -= ((size_t)ckb & 255);
    unsigned short* snaps = (unsigned short*)ckb; float* nout = (float*)(ckb + 8 * snap_bytes); float* res = (float*)(ckb + 8 * snap_bytes + (size_t)NLAT * D * 4);
    {
        nv::Inputs in{}; for (int i = 0; i < 31; ++i) in.p[i] = (const float*)d_in[i];
        size_t off = 0; nv::NaiveWs w = carve_naive((char*)d_ws, off);
        if ((char*)d_ws + off > ckb) { fprintf(stderr, "kernel_launch(debug): oracle scratch overlaps snapshots\n"); return; }
        nv::run_naive(in, w, nout, snaps, stream);
    }
    (void)hipMemsetAsync(res, 0, 4096, stream);
    (void)hipMemsetAsync((char*)d_ws + fk::WS_CTL, 0, fk::CTL_BYTES, stream);
    int chk = 0;
    for (int ph = 0; ph < fk::NPHASE; ++ph) {
        fk::launch_fused(p, ph, ph + 1, stream);
        if (ph == 0) continue;
        const int lp = (ph - 1) / fk::NPH_PAIR, k = (ph - 1) % fk::NPH_PAIR;
        int snap = -1;
        if (k == 3) snap = 4 * lp + 0; else if (k == 6) snap = 4 * lp + 1; else if (k == 13) snap = 4 * lp + 2; else if (k == 18 && lp == 0) snap = 3;
        if (snap >= 0) { hipLaunchKernelGGL(dbg::k_cmp_f32_bf16, dim3(2048), dim3(256), 0, stream, (const float*)((char*)d_ws + fk::WS_X), snaps + (size_t)snap * NTOK * D, (size_t)NTOK * D, res + 2 * chk); ++chk; }
    }
    hipLaunchKernelGGL(dbg::k_cmp_f32_f32, dim3(2048), dim3(256), 0, stream, (const float*)d_out, D, 0, (const float*)nout, D, 0, NLAT, D, res + 2 * chk); ++chk;
    hipLaunchKernelGGL(dbg::k_decide, dim3(1024), dim3(256), 0, stream, (const float*)res, chk, DEBUG_TOL, (float*)d_out, (size_t)NLAT * D);
#else
    if (ws_size < fk::WS_END) { fprintf(stderr, "kernel_launch: workspace too small: need %zu have %zu\n", (size_t)fk::WS_END, ws_size); return; }
    (void)hipMemsetAsync((char*)d_ws + fk::WS_CTL, 0, fk::CTL_BYTES, stream);
    fk::launch_fused(p, 0, fk::NPHASE, stream);
#endif
}
```

```cpp
#include <hip/hip_runtime.h>
#include <cstdio>
#include <cstdint>
#include <cmath>
namespace cfg {
constexpr int D = 1024, B = 4, SEQ = 4096, CTX = 256, DEPTH = 4;
constexpr int NLAT = B * SEQ, NCTX = B * CTX, NTOK = NLAT + NCTX;
constexpr int NMOD = 6, MODW = NMOD * D;
constexpr int EVEN_IN = 2560, ODD_IN = 4128, FFN = 2816, FFE = 3584, NEXP = 8;
}
namespace nv {
using namespace cfg;
struct NaiveWs { float *MOD, *X, *H, *P, *MIX, *T0, *T1, *T2, *FOUT, *HID, *lam; int* cnt; int* list_tok; float* list_w; };
}
namespace pg8 {
#define PG8_LAS __attribute__((address_space(3)))
typedef unsigned short bf16_t;
typedef short bf16x8 __attribute__((ext_vector_type(8)));
typedef float f32x4 __attribute__((ext_vector_type(4)));
typedef unsigned u32x4 __attribute__((ext_vector_type(4)));
constexpr int BM = 256, BK = 64, HALF = 128, HTB = HALF * BK * 2  , STAGE_BYTES = 8 * HTB, NXCD = 8, WGM = 8;

__host__ __device__ __forceinline__ int lds_byte(int r, int c) { const int st = (r >> 4) * 2 + (c >> 5), rr = r & 15, cc = c & 31, ob = rr * 64 + cc * 2; return st * 1024 + (ob ^ (((ob >> 9) & 1) << 5)); }
__host__ __device__ __forceinline__ void stage_rc(int b, int& R, int& C) { const int st = b / 1024, sb = b % 1024, swz = sb ^ (((sb >> 9) & 1) << 5); R = (st >> 1) * 16 + swz / 64; C = (st & 1) * 32 + (swz % 64) / 2; }
__host__ __device__ __forceinline__ int perm32(int rho) { const int n = rho >> 4, i = rho & 15; return 8 * (i >> 2) + 4 * n + (i & 3); }

struct Unit { int pm, pn; };
struct Gemm { const bf16_t* A; const bf16_t* Bt; int M, N, K; };

struct StaticOrder {
    int nM, nN, nwg, G, c;
    __host__ __device__ void init(int M, int N, int G_, int c_) { nM = M / BM; nN = N / BM; nwg = nM * nN; G = G_; c = c_; }
    __host__ __device__ bool next(int i, Unit& u) const {
        const long L = (long)i * G + c; if (L >= nwg) return false;
        int wgid = (int)L; { const int q = nwg / NXCD, r = nwg % NXCD, xcd = wgid % NXCD, off = wgid / NXCD; wgid = (xcd < r ? xcd * (q + 1) : r * (q + 1) + (xcd - r) * q) + off; }
        const int nig = WGM * nN, gid = wgid / nig, fm = gid * WGM, gsz = (nM - fm) < WGM ? (nM - fm) : WGM;
        u.pm = fm + ((wgid % nig) % gsz); u.pn = (wgid % nig) / gsz; return true;
    }
    __device__ __forceinline__ void a_ready(const Unit&) const {}
    __device__ __forceinline__ void done(const Unit&) const {}
};
template <class Epi, class Sched>
__device__ __forceinline__ void gemm_phase(PG8_LAS unsigned char* lds, const Gemm g, const Sched& S, const Epi& E, const int tid) {
    const int wid = __builtin_amdgcn_readfirstlane(tid >> 6), lane = tid & 63, wr = wid >> 2, wc = wid & 3, fr = lane & 15, fq = lane >> 4;
    const int K = g.K, nt = K / BK;
    unsigned voffA[2], voffB[2];
#pragma unroll
    for (int i = 0; i < 2; ++i) { int R, C; stage_rc(tid * 16 + i * 8192, R, C); const int Rb = Epi::PERM ? ((R & ~31) + perm32(R & 31)) : R;
        voffA[i] = (unsigned)(R * K + C) * 2u; voffB[i] = (unsigned)(Rb * K + C) * 2u; }
    const size_t kstep = (size_t)(BK * 2);
    const size_t hstep = (size_t)HALF * K * 2;
    const size_t tstep = 2 * hstep;
    const unsigned ldsw = (unsigned)wid * 1024u;
    const int aoff = lds_byte(wr * 64 + fr, fq * 8), boff = lds_byte(wc * 32 + fr, fq * 8);
#define PG8_SA(b, h) (((b) * 2 + (h)) * HTB)
#define PG8_SB(b, h) ((4 + (b) * 2 + (h)) * HTB)
#define PG8_STAGE(bufoff, gbase, voff) do { _Pragma("unroll") for (int _i = 0; _i < 2; ++_i) \
        __builtin_amdgcn_global_load_lds((const unsigned*)((const char*)(gbase) + (voff)[_i]), (PG8_LAS unsigned*)(lds + (bufoff) + ldsw + _i * 8192), 16, 0, 0); } while (0)
#define PG8_LDA(dst, b, h) do { _Pragma("unroll") for (int m = 0; m < 4; ++m) _Pragma("unroll") for (int k = 0; k < 2; ++k) dst[m][k] = *(const PG8_LAS bf16x8*)(lds + PG8_SA(b, h) + aoff + m * 2048 + k * 1024); } while (0)
#define PG8_LDB(dst, b, h) do { _Pragma("unroll") for (int n = 0; n < 2; ++n) _Pragma("unroll") for (int k = 0; k < 2; ++k) dst[n][k] = *(const PG8_LAS bf16x8*)(lds + PG8_SB(b, h) + boff + n * 2048 + k * 1024); } while (0)
#define PG8_MMA(ai, bj, At, Bt) do { __builtin_amdgcn_s_setprio(1); _Pragma("unroll") for (int m = 0; m < 4; ++m) _Pragma("unroll") for (int n = 0; n < 2; ++n) _Pragma("unroll") for (int k = 0; k < 2; ++k) \
        acc[ai][bj][m][n] = __builtin_amdgcn_mfma_f32_16x16x32_bf16(Bt[n][k], At[m][k], acc[ai][bj][m][n], 0, 0, 0); __builtin_amdgcn_s_setprio(0); } while (0)
#define PG8_WAIT_V(n) asm volatile("s_waitcnt vmcnt(" #n ")" ::: "memory")
#define PG8_WAIT_L(n) asm volatile("s_waitcnt lgkmcnt(" #n ")" ::: "memory")
#define PG8_BAR __builtin_amdgcn_s_barrier()
#define PG8_SCHED __builtin_amdgcn_sched_barrier(0)
    Unit cur, nxt; int ui = 0;
    if (!S.next(0, cur)) return;
    f32x4 acc[2][2][4][2];
#pragma unroll
    for (int a = 0; a < 2; ++a)
#pragma unroll
        for (int b = 0; b < 2; ++b)
#pragma unroll
            for (int m = 0; m < 4; ++m)
#pragma unroll
                for (int n = 0; n < 2; ++n) acc[a][b][m][n] = (f32x4){0.f, 0.f, 0.f, 0.f};
    bf16x8 At[4][2], B0[2][2], B1[2][2];
    const char* cA = (const char*)g.A + (size_t)cur.pm * tstep; const char* cB = (const char*)g.Bt + (size_t)cur.pn * tstep;
    S.a_ready(cur);
    PG8_STAGE(PG8_SB(0, 0), cB, voffB); PG8_STAGE(PG8_SA(0, 0), cA, voffA); PG8_STAGE(PG8_SB(0, 1), cB + hstep, voffB); PG8_STAGE(PG8_SA(0, 1), cA + hstep, voffA);
    if (wr == 1) PG8_BAR;
    PG8_WAIT_V(4); PG8_BAR;
    PG8_STAGE(PG8_SB(1, 0), cB + kstep, voffB); PG8_STAGE(PG8_SA(1, 0), cA + kstep, voffA); PG8_STAGE(PG8_SB(1, 1), cB + hstep + kstep, voffB);
    PG8_WAIT_V(6); PG8_BAR;
    for (;;) {
        const bool has_next = S.next(ui + 1, nxt);
        const char* nA = has_next ? (const char*)g.A + (size_t)nxt.pm * tstep : cA; const char* nB = has_next ? (const char*)g.Bt + (size_t)nxt.pn * tstep : cB;
        for (int t = 0; t < nt; t += 2) {
            const bool last = (t == nt - 2);
            const char* a1 = cA + (size_t)(t + 1) * kstep;
            const char* a2 = last ? nA : cA + (size_t)(t + 2) * kstep; const char* b2 = last ? nB : cB + (size_t)(t + 2) * kstep;
            const char* a3 = a2 + kstep; const char* b3 = b2 + kstep;
            if (last && has_next) S.a_ready(nxt);
            PG8_LDB(B0, 0, 0); PG8_SCHED; PG8_LDA(At, 0, 0); PG8_STAGE(PG8_SA(1, 1), a1 + hstep, voffA);
            PG8_WAIT_L(8); PG8_BAR; PG8_WAIT_L(0); PG8_MMA(0, 0, At, B0); PG8_BAR; PG8_SCHED;
            PG8_LDB(B1, 0, 1); PG8_STAGE(PG8_SB(0, 0), b2, voffB);
            PG8_BAR; PG8_WAIT_L(0); PG8_MMA(0, 1, At, B1); PG8_BAR;
            PG8_LDA(At, 0, 1); PG8_STAGE(PG8_SA(0, 0), a2, voffA);
            PG8_BAR; PG8_WAIT_L(0); PG8_MMA(1, 0, At, B0); PG8_BAR; PG8_SCHED;
            PG8_STAGE(PG8_SB(0, 1), b2 + hstep, voffB);
            PG8_WAIT_V(6); PG8_BAR; PG8_MMA(1, 1, At, B1); PG8_BAR;
            PG8_LDB(B0, 1, 0); PG8_SCHED; PG8_LDA(At, 1, 0); PG8_STAGE(PG8_SA(0, 1), a2 + hstep, voffA);
            PG8_WAIT_L(8); PG8_BAR; PG8_WAIT_L(0); PG8_MMA(0, 0, At, B0); PG8_BAR; PG8_SCHED;
            PG8_LDB(B1, 1, 1); PG8_STAGE(PG8_SB(1, 0), b3, voffB);
            PG8_BAR; PG8_WAIT_L(0); PG8_MMA(0, 1, At, B1); PG8_BAR;
            PG8_LDA(At, 1, 1); PG8_STAGE(PG8_SA(1, 0), a3, voffA);
            PG8_BAR; PG8_WAIT_L(0); PG8_MMA(1, 0, At, B0); PG8_BAR; PG8_SCHED;
            PG8_STAGE(PG8_SB(1, 1), b3 + hstep, voffB);
            PG8_WAIT_V(6); PG8_BAR; PG8_MMA(1, 1, At, B1); PG8_BAR;
        }
        if constexpr (!Epi::AFTER_DRAIN) { E(acc, cur, wr, wc, fr, fq); S.done(cur); }
        if (!has_next) break;
#pragma unroll
        for (int a = 0; a < 2; ++a)
#pragma unroll
            for (int b = 0; b < 2; ++b)
#pragma unroll
                for (int m = 0; m < 4; ++m)
#pragma unroll
                    for (int n = 0; n < 2; ++n) acc[a][b][m][n] = (f32x4){0.f, 0.f, 0.f, 0.f};
        cur = nxt; cA = nA; cB = nB; ++ui;
    }
    PG8_WAIT_V(0);
    if (wr == 0) PG8_BAR;
    PG8_BAR;
    if constexpr (Epi::AFTER_DRAIN) { E.fused(acc, cur, wr, wc, fr, fq, lds, wid, lane); S.done(cur); }
#undef PG8_SA
#undef PG8_SB
#undef PG8_STAGE
#undef PG8_LDA
#undef PG8_LDB
#undef PG8_MMA
#undef PG8_WAIT_V
#undef PG8_WAIT_L
#undef PG8_BAR
#undef PG8_SCHED
}
}
namespace fk {
using namespace cfg;
#define LAS __attribute__((address_space(3)))
typedef unsigned short bf16;
typedef short bf16x8 __attribute__((ext_vector_type(8)));
typedef short s16x4 __attribute__((ext_vector_type(4)));
typedef float f32x4 __attribute__((ext_vector_type(4)));
typedef float f32x2 __attribute__((ext_vector_type(2)));
typedef float f32x16 __attribute__((ext_vector_type(16)));
typedef unsigned u32x4 __attribute__((ext_vector_type(4)));
typedef unsigned u32x2 __attribute__((ext_vector_type(2)));
typedef __bf16 bf16x2_t __attribute__((ext_vector_type(2)));
#define DI __device__ __forceinline__
#define MFMA32(a, b, c) __builtin_amdgcn_mfma_f32_32x32x16_bf16((a), (b), (c), 0, 0, 0)

DI unsigned pk2(float a, float b) { f32x2 f = {a, b}; bf16x2_t r = __builtin_convertvector(f, bf16x2_t); return __builtin_bit_cast(unsigned, r); }
DI bf16 f2bf(float a) { return (bf16)(pk2(a, 0.f) & 0xffffu); }
DI float bf2f(bf16 v) { return __builtin_bit_cast(float, (unsigned)v << 16); }
DI float bflo(unsigned w) { return __builtin_bit_cast(float, w << 16); }
DI float bfhi(unsigned w) { return __builtin_bit_cast(float, w & 0xffff0000u); }
DI float sigmoid_(float x) { return 1.f / (1.f + __expf(-x)); }
DI float silu_(float x) { return x / (1.f + __expf(-x)); }
DI float softplus_(float x) { return fmaxf(x, 0.f) + log1pf(expf(-fabsf(x))); }
DI float gelu_tanh_(float x) { const float u = 0.7978845608028654f * (x + 0.044715f * x * x * x); const float e = __expf(2.f * u); return x * (1.f - 1.f / (e + 1.f)); }
DI int crow(int reg, int h) { return (reg & 3) + 8 * (reg >> 2) + 4 * h; }
DI f32x16 zero16() { f32x16 z; for (int i = 0; i < 16; ++i) z[i] = 0.f; return z; }
DI bf16x8 pack_step(const f32x16& x, int s) {
    u32x4 p; p[0] = pk2(x[8 * s], x[8 * s + 1]); p[1] = pk2(x[8 * s + 2], x[8 * s + 3]); p[2] = pk2(x[8 * s + 4], x[8 * s + 5]); p[3] = pk2(x[8 * s + 6], x[8 * s + 7]);
    return __builtin_bit_cast(bf16x8, p);
}
DI bf16x8 ld_perm_frag(const LAS bf16* rowp, int kbase, int s, int h) {
    const s16x4 lo = *(const LAS s16x4*)(rowp + kbase + 16 * s + 4 * h);
    const s16x4 hi = *(const LAS s16x4*)(rowp + kbase + 16 * s + 8 + 4 * h);
    return __builtin_shufflevector(lo, hi, 0, 1, 2, 3, 4, 5, 6, 7);
}
DI float shx(float v, int o, int lane) { return __builtin_bit_cast(float, __builtin_amdgcn_ds_bpermute((lane ^ o) << 2, __builtin_bit_cast(int, v))); }
DI float wave_sum(float v, int lane) {
#pragma unroll
    for (int o = 1; o < 64; o <<= 1) v += shx(v, o, lane);
    return v;
}

constexpr size_t al256(size_t x) { return (x + 255) / 256 * 256; }
constexpr int RMAX = 36864;
constexpr int NCH = NTOK / 64;
constexpr int NCHD = NCH * 8 * 2;
constexpr size_t WS_CTL = 0, CTL_BYTES = 1u << 20;
constexpr size_t WS_MOD = CTL_BYTES;
constexpr size_t WS_COS = WS_MOD + al256((size_t)DEPTH * 5 * MODW * 4);
constexpr size_t WS_SIN = WS_COS + (size_t)SEQ * 32 * 4;
constexpr size_t WS_WEIN = WS_SIN + (size_t)SEQ * 32 * 4;
constexpr size_t WS_WEOUT = WS_WEIN + (size_t)2 * 2560 * 1024 * 2;
constexpr size_t WS_WEF1 = WS_WEOUT + (size_t)2 * 1024 * 1024 * 2;
constexpr size_t WS_WEF2 = WS_WEF1 + (size_t)2 * 5632 * 1024 * 2;
constexpr size_t WS_WOIN = WS_WEF2 + (size_t)2 * 1024 * 2816 * 2;
constexpr size_t WS_WOOUT = WS_WOIN + (size_t)2 * 4352 * 1024 * 2;
constexpr size_t WS_WXIN = WS_WOOUT + (size_t)2 * 1024 * 1024 * 2;
constexpr size_t WS_WXOUT = WS_WXIN + (size_t)2 * 8 * 7168 * 1024 * 2;
constexpr size_t WS_X = WS_WXOUT + (size_t)2 * 8 * 1024 * 3584 * 2;
constexpr size_t WS_H = WS_X + (size_t)NTOK * D * 4;
constexpr size_t WS_MIX = WS_H + (size_t)NTOK * D * 2;
constexpr size_t WS_P = WS_MIX + (size_t)NTOK * D * 2;
constexpr size_t WS_HS1 = WS_P + (size_t)NTOK * 4352 * 2;
constexpr size_t WS_U = WS_HS1 + (size_t)NTOK * 512 * 4;
constexpr size_t WS_RGA = WS_U;
constexpr size_t WS_RGU = WS_RGA + (size_t)2 * NTOK * 512 * 4;
constexpr size_t WS_QKVN = WS_U;
constexpr size_t WS_WG = WS_QKVN + (size_t)NTOK * 3072 * 2;
constexpr size_t WS_UG = WS_WG + (size_t)NCHD * 64 * 128 * 2;
constexpr size_t WS_QKD = WS_UG + (size_t)NCHD * 64 * 128 * 4;
constexpr size_t WS_SC = WS_QKD + (size_t)NCHD * 64 * 64 * 2;
constexpr size_t WS_KTG = WS_SC + (size_t)NCHD * 192 * 4;
constexpr size_t WS_OG = WS_KTG + (size_t)NCHD * 128 * 64 * 2;
constexpr size_t WS_U_END1 = WS_OG + (size_t)2 * NTOK * D * 4;
constexpr size_t WS_XS = WS_U;
constexpr size_t WS_HIDM = WS_XS + (size_t)RMAX * D * 2;
constexpr size_t WS_Y = WS_HIDM + (size_t)RMAX * FFE * 2;
constexpr size_t WS_U_END2 = WS_Y + (size_t)RMAX * D * 4;
constexpr size_t WS_TOK = (WS_U_END1 > WS_U_END2 ? WS_U_END1 : WS_U_END2);
constexpr size_t WS_END = WS_TOK + (size_t)NTOK * 32;
constexpr size_t WS_AB = WS_HS1;
constexpr size_t WS_GB = WS_AB + (size_t)NTOK * 32 * 4;

constexpr int CW_BAR = 4096;
constexpr int CW_CNT = 8192;
constexpr int CW_Q = 8448;

constexpr int LDS_BYTES = 152 * 1024;
constexpr int LDS_MISC = LDS_BYTES - 256;

struct Params { const float* in[31]; float* out; unsigned char* ws; int ph_lo, ph_hi; int dbg0, dbg1; };

struct Ctx {
    LAS unsigned char* lds;
    unsigned char* ws; unsigned char* ws0;
    int tid, lane, wave, nblk, blk, wave0;
};
#define XB_TMO      128
#define XB_XCNT(j)  (256  + 64 * (j))
#define XB_XSUB(j)  (1280 + 64 * (j))
#define XB_XGEN(j)  (2304 + 64 * (j))
#define XB_TOP      3328
#define XB_TOPGEN   3392
#define XCD_BAR_WORDS 3456
#define XB_SPIN_CAP (1u << 27)

__device__ __forceinline__ unsigned xb_ld(unsigned* p)              { return __hip_atomic_load(p, __ATOMIC_RELAXED, __HIP_MEMORY_SCOPE_AGENT); }
__device__ __forceinline__ unsigned xb_add(unsigned* p, unsigned v) { return __hip_atomic_fetch_add(p, v, __ATOMIC_RELAXED, __HIP_MEMORY_SCOPE_AGENT); }
__device__ __forceinline__ unsigned xb_xcc_id() { return (unsigned)__builtin_amdgcn_s_getreg((3 << 11) | 20) & 0xFu; }
#define XB_SPIN(cond, bar) do { unsigned _sp = 0; while (cond) { __builtin_amdgcn_s_sleep(1); \
    if ((++_sp & 255u) == 0u) { if (xb_ld(&(bar)[XB_TMO])) break; if (_sp > XB_SPIN_CAP) { atomicAdd(&(bar)[XB_TMO], 1u); break; } } } } while (0)

struct XcdBarrier {
    unsigned* bar; unsigned x;
    volatile LAS unsigned* st;
};

__device__ __forceinline__ XcdBarrier xcd_barrier_post(unsigned* bar, volatile LAS unsigned* st) {
    XcdBarrier b; b.bar = bar; b.x = xb_xcc_id(); b.st = st;
    if (threadIdx.x == 0) (void)xb_add(&bar[XB_XCNT(b.x)], 1u);
    return b;
}
__device__ __forceinline__ void xcd_barrier_complete(unsigned* bar, unsigned x, unsigned& nloc, unsigned& nx) {
    const unsigned G = gridDim.x * gridDim.y * gridDim.z;
    unsigned sum, cnt, mine, sp = 0u;
    for (;;) {
        sum = 0u; cnt = 0u; mine = 0u;
#pragma unroll
        for (unsigned j = 0; j < 16; ++j) { const unsigned c = xb_ld(&bar[XB_XCNT(j)]); sum += c; cnt += (c > 0u) ? 1u : 0u; mine = (j == x) ? c : mine; }
        if (sum == G) break;
        __builtin_amdgcn_s_sleep(1);
        if ((++sp & 255u) == 0u) { if (xb_ld(&bar[XB_TMO])) break; if (sp > XB_SPIN_CAP) { atomicAdd(&bar[XB_TMO], 1u); break; } }
    }
    nloc = mine > 0u ? mine : 1u; nx = cnt > 0u ? cnt : 1u;
}

__device__ __forceinline__ void xcd_barrier(const XcdBarrier& b) {
    asm volatile("s_waitcnt vmcnt(0)" ::: "memory");
    __syncthreads();
    if (threadIdx.x == 0) {
        unsigned* bar = b.bar;
        __builtin_amdgcn_s_waitcnt(0);
        unsigned nloc = b.st[0], nx = b.st[1];
        if (nloc == 0u) { xcd_barrier_complete(bar, b.x, nloc, nx); b.st[0] = nloc; b.st[1] = nx; }
        const unsigned old = xb_add(&bar[XB_XSUB(b.x)], 1u);
        const unsigned gen = old / nloc;
        if (old + 1u == (gen + 1u) * nloc) {
            __builtin_amdgcn_fence(__ATOMIC_RELEASE, "agent");
            asm volatile("s_waitcnt vmcnt(0)" ::: "memory");
            const unsigned og = xb_add(&bar[XB_TOP], 1u);
            const unsigned tg = og / nx;
            if (og + 1u == (tg + 1u) * nx) xb_add(&bar[XB_TOPGEN], 1u);
            else XB_SPIN(xb_ld(&bar[XB_TOPGEN]) == tg, bar);
            __builtin_amdgcn_fence(__ATOMIC_ACQUIRE, "agent");
            xb_add(&bar[XB_XGEN(b.x)], 1u);
            asm volatile("s_waitcnt vmcnt(0)" ::: "memory");
        } else {
            XB_SPIN(xb_ld(&bar[XB_XGEN(b.x)]) == gen, bar);
            __builtin_amdgcn_fence(__ATOMIC_ACQUIRE, "agent");
            asm volatile("s_waitcnt vmcnt(0)" ::: "memory");
        }
    }
    __syncthreads();
}

using pg8::Unit;
typedef pg8::f32x4 af4;

struct EpiEvenIn {
    static constexpr bool PERM = true, AFTER_DRAIN = false;
    bf16* P; const float* cosT; const float* sinT;
    DI void operator()(const af4 (&acc)[2][2][4][2], const Unit& u, int wr, int wc, int fr, int fq) const {
        const int row0 = u.pm * 256 + wr * 64 + fr, col0 = u.pn * 256 + wc * 32 + 8 * fq;
        const bool rope = (u.pn < 4) && (u.pm < 64);
        const float qs = (u.pn < 2) ? 0.18033688011112042f : 1.f;
#pragma unroll
        for (int ai = 0; ai < 2; ++ai)
#pragma unroll
            for (int m = 0; m < 4; ++m) {
                const int row = row0 + ai * 128 + m * 16;
                bf16* rowp = P + (size_t)row * EVEN_IN + col0;
#pragma unroll
                for (int bj = 0; bj < 2; ++bj) {
                    af4 v0 = acc[ai][bj][m][0], v1 = acc[ai][bj][m][1];
                    if (rope) {
                        const int t = row & 4095, i0 = ((col0 + bj * 128) & 63) >> 1;
                        const af4 cs = *(const af4*)(cosT + t * 32 + i0), sn = *(const af4*)(sinT + t * 32 + i0);
                        af4 o0, o1;
                        o0[0] = v0[0] * cs[0] - v0[1] * sn[0]; o0[1] = v0[0] * sn[0] + v0[1] * cs[0];
                        o0[2] = v0[2] * cs[1] - v0[3] * sn[1]; o0[3] = v0[2] * sn[1] + v0[3] * cs[1];
                        o1[0] = v1[0] * cs[2] - v1[1] * sn[2]; o1[1] = v1[0] * sn[2] + v1[1] * cs[2];
                        o1[2] = v1[2] * cs[3] - v1[3] * sn[3]; o1[3] = v1[2] * sn[3] + v1[3] * cs[3];
                        v0 = o0; v1 = o1;
                    }
                    v0 = v0 * qs; v1 = v1 * qs;
                    u32x4 w; w[0] = pk2(v0[0], v0[1]); w[1] = pk2(v0[2], v0[3]); w[2] = pk2(v1[0], v1[1]); w[3] = pk2(v1[2], v1[3]);
                    *(u32x4*)(rowp + bj * 128) = w;
                }
            }
    }
};
struct EpiBf16Ab {
    static constexpr bool PERM = true, AFTER_DRAIN = false;
    bf16* O; int ldc; float* AB; int ab_pn;
    DI void operator()(const af4 (&acc)[2][2][4][2], const Unit& u, int wr, int wc, int fr, int fq) const {
        const int row0 = u.pm * 256 + wr * 64 + fr, col0 = u.pn * 256 + wc * 32 + 8 * fq;
        if (u.pn == ab_pn) {
            if (wc == 0) {
#pragma unroll
                for (int ai = 0; ai < 2; ++ai)
#pragma unroll
                    for (int m = 0; m < 4; ++m) { float* ap = AB + (size_t)(row0 + ai * 128 + m * 16) * 32 + 8 * fq; *(af4*)ap = acc[ai][0][m][0]; *(af4*)(ap + 4) = acc[ai][0][m][1]; }
            }
            return;
        }
#pragma unroll
        for (int ai = 0; ai < 2; ++ai)
#pragma unroll
            for (int m = 0; m < 4; ++m) {
                bf16* rowp = O + (size_t)(row0 + ai * 128 + m * 16) * ldc + col0;
#pragma unroll
                for (int bj = 0; bj < 2; ++bj) { const af4 v0 = acc[ai][bj][m][0], v1 = acc[ai][bj][m][1];
                    u32x4 w; w[0] = pk2(v0[0], v0[1]); w[1] = pk2(v0[2], v0[3]); w[2] = pk2(v1[0], v1[1]); w[3] = pk2(v1[2], v1[3]);
                    *(u32x4*)(rowp + bj * 128) = w; }
            }
    }
};
struct EpiSwiglu {
    static constexpr bool PERM = true, AFTER_DRAIN = false;
    bf16* O; int ldc; int nN;
    DI void operator()(const af4 (&acc)[2][2][4][2], const Unit& u, int wr, int wc, int fr, int fq) const {
        const int row0 = u.pm * 256 + wr * 64 + fr, col0 = (u.pn % nN) * 128 + wc * 32 + 8 * fq;
#pragma unroll
        for (int ai = 0; ai < 2; ++ai)
#pragma unroll
            for (int m = 0; m < 4; ++m) {
                const af4 g0 = acc[ai][0][m][0], g1 = acc[ai][0][m][1], u0 = acc[ai][1][m][0], u1 = acc[ai][1][m][1];
                float r[8];
#pragma unroll
                for (int j = 0; j < 4; ++j) { r[j] = silu_(g0[j]) * u0[j]; r[4 + j] = silu_(g1[j]) * u1[j]; }
                u32x4 w; w[0] = pk2(r[0], r[1]); w[1] = pk2(r[2], r[3]); w[2] = pk2(r[4], r[5]); w[3] = pk2(r[6], r[7]);
                *(u32x4*)(O + (size_t)(row0 + ai * 128 + m * 16) * ldc + col0) = w;
            }
    }
};
struct EpiResid {
    static constexpr bool PERM = false, AFTER_DRAIN = false;
    float* X; const float* gate;
    DI void operator()(const af4 (&acc)[2][2][4][2], const Unit& u, int wr, int wc, int fr, int fq) const {
        const int row0 = u.pm * 256 + wr * 64 + fr, col0 = u.pn * 256 + wc * 32 + 4 * fq;
        const float* gv = gate + (size_t)(u.pm < 64 ? (u.pm >> 4) : 4) * MODW + col0;
        af4 g[2][2];
#pragma unroll
        for (int bj = 0; bj < 2; ++bj)
#pragma unroll
            for (int n = 0; n < 2; ++n) g[bj][n] = *(const af4*)(gv + bj * 128 + n * 16);
#pragma unroll
        for (int ai = 0; ai < 2; ++ai)
#pragma unroll
            for (int m = 0; m < 4; ++m) { float* rowp = X + (size_t)(row0 + ai * 128 + m * 16) * D + col0;
#pragma unroll
                for (int bj = 0; bj < 2; ++bj)
#pragma unroll
                    for (int n = 0; n < 2; ++n) { af4* p = (af4*)(rowp + bj * 128 + n * 16); *p = *p + g[bj][n] * acc[ai][bj][m][n]; } }
    }
};
struct EpiF32 {
    static constexpr bool PERM = false, AFTER_DRAIN = false;
    float* C; int ldc; int nN;
    DI void operator()(const af4 (&acc)[2][2][4][2], const Unit& u, int wr, int wc, int fr, int fq) const {
        const int row0 = u.pm * 256 + wr * 64 + fr, col0 = (u.pn % nN) * 256 + wc * 32 + 4 * fq;
#pragma unroll
        for (int ai = 0; ai < 2; ++ai)
#pragma unroll
            for (int m = 0; m < 4; ++m) { float* rowp = C + (size_t)(row0 + ai * 128 + m * 16) * ldc + col0;
#pragma unroll
                for (int bj = 0; bj < 2; ++bj)
#pragma unroll
                    for (int n = 0; n < 2; ++n) *(af4*)(rowp + bj * 128 + n * 16) = acc[ai][bj][m][n]; }
    }
};
struct MoeOrder : pg8::StaticOrder {
    int tend[8];
    __device__ void initm(const unsigned* cnt, int nN_, int G_, int c_) {
        int acc = 0;
#pragma unroll
        for (int e = 0; e < 8; ++e) { acc += ((int)cnt[e] + 255) >> 8; tend[e] = acc; }
        nM = acc; nN = nN_; nwg = nM * nN; G = G_; c = c_;
    }
    __device__ bool next(int i, Unit& u) const {
        if (!pg8::StaticOrder::next(i, u)) return false;
        int e = 0;
#pragma unroll
        for (int k = 0; k < 7; ++k) e += (u.pm >= tend[k]) ? 1 : 0;
        u.pn += e * nN; return true;
    }
};
DI void transpose_item(const float* W, int ldw, int K, bf16* WT, int k0, int n0, int drow0, LAS float* scr, int lane) {
#pragma unroll 8
    for (int i = 0; i < 32; ++i) { const int kk = 2 * i + (lane >> 5); scr[kk * 33 + (lane & 31)] = W[(size_t)(k0 + kk) * ldw + n0 + (lane & 31)]; }
    asm volatile("s_waitcnt lgkmcnt(0)" ::: "memory");
    const int c = lane & 7;
#pragma unroll
    for (int j = 0; j < 4; ++j) { const int n = (lane >> 3) + 8 * j; const LAS float* s = scr + (8 * c) * 33 + n;
        u32x4 o; o[0] = pk2(s[0 * 33], s[1 * 33]); o[1] = pk2(s[2 * 33], s[3 * 33]); o[2] = pk2(s[4 * 33], s[5 * 33]); o[3] = pk2(s[6 * 33], s[7 * 33]);
        *(u32x4*)(WT + (size_t)(drow0 + n) * K + k0 + 8 * c) = o; }
    asm volatile("s_waitcnt lgkmcnt(0)" ::: "memory");
}
struct TJob { const float* W; bf16* WT; int ldw, K, N, F; };
DI int tjob_items(const TJob& j) { return (j.K / 64) * (j.N / 32); }
DI TJob get_tjob(const Params& p, int j) {
    const int i = j / 22, r = j % 22; unsigned char* ws = p.ws; TJob t;
    if (r == 0) t = TJob{p.in[9] + (size_t)i * D * EVEN_IN, (bf16*)(ws + WS_WEIN) + (size_t)i * 2560 * 1024, EVEN_IN, D, EVEN_IN, 0};
    else if (r == 1) t = TJob{p.in[10] + (size_t)i * D * D, (bf16*)(ws + WS_WEOUT) + (size_t)i * 1024 * 1024, D, D, D, 0};
    else if (r == 2) t = TJob{p.in[20] + (size_t)i * D * 2 * FFN, (bf16*)(ws + WS_WEF1) + (size_t)i * 5632 * 1024, 2 * FFN, D, 2 * FFN, FFN};
    else if (r == 3) t = TJob{p.in[21] + (size_t)i * FFN * D, (bf16*)(ws + WS_WEF2) + (size_t)i * 1024 * 2816, D, FFN, D, 0};
    else if (r == 4) t = TJob{p.in[22] + (size_t)i * D * ODD_IN, (bf16*)(ws + WS_WOIN) + (size_t)i * 4352 * 1024, ODD_IN, D, ODD_IN, 0};
    else if (r == 5) t = TJob{p.in[27] + (size_t)i * D * D, (bf16*)(ws + WS_WOOUT) + (size_t)i * 1024 * 1024, D, D, D, 0};
    else if (r < 14) { const int e = r - 6; t = TJob{p.in[29] + ((size_t)i * 8 + e) * D * 2 * FFE, (bf16*)(ws + WS_WXIN) + ((size_t)i * 8 + e) * 7168 * 1024, 2 * FFE, D, 2 * FFE, FFE}; }
    else { const int e = r - 14; t = TJob{p.in[30] + ((size_t)i * 8 + e) * FFE * D, (bf16*)(ws + WS_WXOUT) + ((size_t)i * 8 + e) * 1024 * 3584, D, FFE, D, 0}; }
    return t;
}
DI void ph_prologue(const Ctx& C, const Params& p) {
    LAS float* sil = (LAS float*)(C.lds);
    LAS float* scr = (LAS float*)(C.lds + 32768 + C.wave * 8704);
    for (int i = C.tid; i < 5 * 1024; i += 512) { const int v = i >> 10, k = i & 1023; const float x = v < 4 ? p.in[1][v * 1024 + k] : p.in[3][k]; sil[i] = x / (1.f + expf(-x)); }
    __syncthreads();
    const int gw = C.blk * 8 + C.wave, NGW = C.nblk * 8;
    float* MOD = (float*)(C.ws + WS_MOD);
    for (int it = gw; it < DEPTH * (MODW / 64); it += NGW) {
        const int l = it / (MODW / 64), n = (it % (MODW / 64)) * 64 + C.lane;
        const float* w = p.in[4] + (size_t)l * 1024 * MODW + n;
        float a0 = 0.f, a1 = 0.f, a2 = 0.f, a3 = 0.f, a4 = 0.f;
#pragma unroll 8
        for (int k = 0; k < 1024; ++k) { const float wv = w[(size_t)k * MODW]; a0 += sil[k] * wv; a1 += sil[1024 + k] * wv; a2 += sil[2048 + k] * wv; a3 += sil[3072 + k] * wv; a4 += sil[4096 + k] * wv; }
        const float bb = p.in[5][l * MODW + n];
        MOD[(size_t)(l * 5 + 0) * MODW + n] = a0 + bb; MOD[(size_t)(l * 5 + 1) * MODW + n] = a1 + bb; MOD[(size_t)(l * 5 + 2) * MODW + n] = a2 + bb;
        MOD[(size_t)(l * 5 + 3) * MODW + n] = a3 + bb; MOD[(size_t)(l * 5 + 4) * MODW + n] = a4 + bb;
    }
    { float* cosT = (float*)(C.ws + WS_COS); float* sinT = (float*)(C.ws + WS_SIN);
      for (int idx = C.blk * 512 + C.tid; idx < SEQ * 32; idx += C.nblk * 512) { const int t = idx >> 5, i = idx & 31;
          const float invf = powf(10000.f, -(float)(i & 15) / 16.f); const float ang = (i < 16 ? (float)(t >> 6) : (float)(t & 63)) * invf;
          cosT[idx] = cosf(ang); sinT[idx] = sinf(ang); } }
    { for (int i = 0; i < 2; ++i) { u32x4* z = (u32x4*)((bf16*)(C.ws + WS_WOIN) + (size_t)i * 4352 * 1024 + (size_t)4128 * 1024);
          for (int idx = C.blk * 512 + C.tid; idx < 224 * 1024 / 8; idx += C.nblk * 512) z[idx] = (u32x4){0u, 0u, 0u, 0u}; } }
    int jstart = 0;
    for (int j = 0; j < 44; ++j) {
        const TJob t = get_tjob(p, j); const int ni = tjob_items(t), nblkN = t.N / 32;
        int first = (gw - jstart % NGW + NGW) % NGW;
        for (int it = first; it < ni; it += NGW) {
            const int kb = it / nblkN, nb = it % nblkN, n0 = nb * 32;
            int drow0 = n0;
            if (t.F > 0) drow0 = (n0 < t.F) ? ((n0 / 128) * 256 + (n0 % 128)) : (((n0 - t.F) / 128) * 256 + 128 + ((n0 - t.F) % 128));
            transpose_item(t.W, t.ldw, t.K, t.WT, kb * 64, n0, drow0, scr, C.lane);
        }
        jstart += ni;
    }
}

DI void normmod_regs(f32x4 (&v)[4], const float* g, const float* shift, const float* scale, int lane) {
    float ss = 0.f;
#pragma unroll
    for (int j = 0; j < 4; ++j) ss += (v[j][0] * v[j][0] + v[j][1] * v[j][1]) + (v[j][2] * v[j][2] + v[j][3] * v[j][3]);
    const float rs = rsqrtf(wave_sum(ss, lane) * (1.f / D) + 1e-6f);
#pragma unroll
    for (int j = 0; j < 4; ++j) { const f32x4 gg = ((const f32x4*)g)[lane + 64 * j], sh = ((const f32x4*)shift)[lane + 64 * j], sc = ((const f32x4*)scale)[lane + 64 * j];
        v[j] = v[j] * rs * gg * (sc + 1.f) + sh; }
}
DI void store_row_bf16(bf16* orow, const f32x4 (&v)[4], int lane) {
#pragma unroll
    for (int j = 0; j < 4; ++j) { u32x2 w; w[0] = pk2(v[j][0], v[j][1]); w[1] = pk2(v[j][2], v[j][3]); ((u32x2*)orow)[lane + 64 * j] = w; }
}
DI void ph_normmod(const Ctx& C, const Params& p, int layer, bool second, bool from_input) {
    const int gw = C.blk * 8 + C.wave, NGW = C.nblk * 8;
    float* X = (float*)(C.ws + WS_X); bf16* H = (bf16*)(C.ws + WS_H);
    const float* MODl = (const float*)(C.ws + WS_MOD) + (size_t)layer * 5 * MODW;
    const float* g = (second ? p.in[7] : p.in[6]) + layer * D;
    for (int r = gw; r < NTOK; r += NGW) {
        const float* src = from_input ? (r < NLAT ? p.in[0] + (size_t)r * D : p.in[2] + (size_t)(r - NLAT) * D) : X + (size_t)r * D;
        f32x4 v[4];
#pragma unroll
        for (int j = 0; j < 4; ++j) v[j] = ((const f32x4*)src)[C.lane + 64 * j];
        if (from_input) {
#pragma unroll
            for (int j = 0; j < 4; ++j) ((f32x4*)(X + (size_t)r * D))[C.lane + 64 * j] = v[j]; }
        const float* mv = MODl + (size_t)(r < NLAT ? (r >> 12) : 4) * MODW + (second ? 3 * D : 0);
        normmod_regs(v, g, mv, mv + D, C.lane);
        store_row_bf16(H + (size_t)r * D, v, C.lane);
    }
}

DI void seq_bounds(int r, int& s0, int& s1) { if (r < NLAT) { s0 = r & ~4095; s1 = s0 + 4096; } else { s0 = NLAT + ((r - NLAT) & ~255); s1 = s0 + 256; } }

DI void ph_odd_conv(const Ctx& C, const Params& p, int i) {
    const int gw = C.blk * 8 + C.wave, NGW = C.nblk * 8;
    const bf16* PO = (const bf16*)(C.ws + WS_P); bf16* QKVN = (bf16*)(C.ws + WS_QKVN);
    const float* AB = (const float*)(C.ws + WS_AB); float* Gd = (float*)(C.ws + WS_GB); float* Bd = Gd + (size_t)2 * NTOK * 8;
    const float* cw = p.in[23] + (size_t)i * 4 * 3072;
    for (int r = gw; r < NTOK; r += NGW) {
        int s0, s1; seq_bounds(r, s0, s1);
#pragma unroll
        for (int j = 0; j < 6; ++j) {
            const int c = 8 * (C.lane + 64 * j);
            float a[8] = {0.f, 0.f, 0.f, 0.f, 0.f, 0.f, 0.f, 0.f};
#pragma unroll
            for (int tp = 0; tp < 4; ++tp) { const int rr = r + tp - 2;
                if (rr >= s0 && rr < s1) { const u32x4 x = *(const u32x4*)(PO + (size_t)rr * 4352 + c); const f32x4 w0 = *(const f32x4*)(cw + tp * 3072 + c), w1 = *(const f32x4*)(cw + tp * 3072 + c + 4);
                    a[0] += w0[0] * bflo(x[0]); a[1] += w0[1] * bfhi(x[0]); a[2] += w0[2] * bflo(x[1]); a[3] += w0[3] * bfhi(x[1]);
                    a[4] += w1[0] * bflo(x[2]); a[5] += w1[1] * bfhi(x[2]); a[6] += w1[2] * bflo(x[3]); a[7] += w1[3] * bfhi(x[3]); } }
            float ss = 0.f;
#pragma unroll
            for (int e = 0; e < 8; ++e) { a[e] = silu_(a[e]); ss += a[e] * a[e]; }
            if (j < 4) {
                ss += shx(ss, 1, C.lane); ss += shx(ss, 2, C.lane); ss += shx(ss, 4, C.lane); ss += shx(ss, 8, C.lane);
                const float rn = rsqrtf(ss + 1e-6f);
#pragma unroll
                for (int e = 0; e < 8; ++e) a[e] *= rn;
            }
            u32x4 w; w[0] = pk2(a[0], a[1]); w[1] = pk2(a[2], a[3]); w[2] = pk2(a[4], a[5]); w[3] = pk2(a[6], a[7]);
            *(u32x4*)(QKVN + (size_t)r * 3072 + c) = w;
        }
        if (C.lane < 16) { const int d = C.lane >> 3, h = C.lane & 7;
            const float x0 = AB[(size_t)r * 32 + d * 16 + h], x1 = AB[(size_t)r * 32 + d * 16 + 8 + h];
            Gd[((size_t)d * NTOK + r) * 8 + h] = -expf(p.in[24][i * 16 + d * 8 + h]) * softplus_(x0 + p.in[25][i * 16 + d * 8 + h]);
            Bd[((size_t)d * NTOK + r) * 8 + h] = 1.f / (1.f + expf(-x1)); }
    }
}
DI void ph_gdn_out(const Ctx& C, const Params& p, int i) {
    const int gw = C.blk * 8 + C.wave, NGW = C.nblk * 8;
    const float* OG = (const float*)(C.ws + WS_OG); const bf16* PO = (const bf16*)(C.ws + WS_P); bf16* MIX = (bf16*)(C.ws + WS_MIX);
    const f32x4 go = ((const f32x4*)(p.in[26] + i * 128))[C.lane & 31];
    for (int r = gw; r < NTOK; r += NGW) {
#pragma unroll
        for (int j = 0; j < 4; ++j) {
            const f32x4 a = ((const f32x4*)(OG + (size_t)r * D))[C.lane + 64 * j], b = ((const f32x4*)(OG + ((size_t)NTOK + r) * D))[C.lane + 64 * j];
            f32x4 o = a + b;
            float ss = (o[0] * o[0] + o[1] * o[1]) + (o[2] * o[2] + o[3] * o[3]);
            ss += shx(ss, 1, C.lane); ss += shx(ss, 2, C.lane); ss += shx(ss, 4, C.lane); ss += shx(ss, 8, C.lane); ss += shx(ss, 16, C.lane);
            const float rs = rsqrtf(ss * (1.f / 128.f) + 1e-6f);
            const u32x2 z = *(const u32x2*)(PO + (size_t)r * 4352 + 3072 + 4 * C.lane + 256 * j);
            o[0] *= rs * go[0] * silu_(bflo(z[0])); o[1] *= rs * go[1] * silu_(bfhi(z[0])); o[2] *= rs * go[2] * silu_(bflo(z[1])); o[3] *= rs * go[3] * silu_(bfhi(z[1]));
            u32x2 w; w[0] = pk2(o[0], o[1]); w[1] = pk2(o[2], o[3]);
            ((u32x2*)(MIX + (size_t)r * D))[C.lane + 64 * j] = w;
        }
    }
}
struct TokInfo { int e0, p0, e1, p1; float w0, w1; int r0, r1; };
DI void ph_router(const Ctx& C, const Params& p, int layer, int ntok) {
    const int gw = C.blk * 8 + C.wave, NGW = C.nblk * 8, i = layer >> 1;
    const float* X = (const float*)(C.ws + WS_X); bf16* H = (bf16*)(C.ws + WS_H);
    const float* MODl = (const float*)(C.ws + WS_MOD) + (size_t)layer * 5 * MODW;
    const float* g = p.in[7] + layer * D; const float* wr = p.in[28] + (size_t)i * D * 8;
    unsigned* cnt = (unsigned*)(C.ws + WS_CTL) + CW_CNT + i * 64; TokInfo* TI = (TokInfo*)(C.ws + WS_TOK);
    LAS unsigned* cl = (LAS unsigned*)(C.lds);
    LAS int* sl = (LAS int*)(C.lds + 64);
    if (C.tid < 16) cl[C.tid] = 0u;
    __syncthreads();
    int k = 0;
    for (int r = gw; r < NTOK; r += NGW, ++k) {
        f32x4 v[4];
#pragma unroll
        for (int j = 0; j < 4; ++j) v[j] = ((const f32x4*)(X + (size_t)r * D))[C.lane + 64 * j];
        const float* mv = MODl + (size_t)(r < NLAT ? (r >> 12) : 4) * MODW + 3 * D;
        normmod_regs(v, g, mv, mv + D, C.lane);
        store_row_bf16(H + (size_t)r * D, v, C.lane);
        if (r >= ntok) continue;
        float lg[8] = {0.f, 0.f, 0.f, 0.f, 0.f, 0.f, 0.f, 0.f};
#pragma unroll
        for (int j = 0; j < 4; ++j)
#pragma unroll
            for (int q = 0; q < 4; ++q) { const int kk = 4 * C.lane + 256 * j + q; const f32x4 w0 = *(const f32x4*)(wr + kk * 8), w1 = *(const f32x4*)(wr + kk * 8 + 4); const float x = v[j][q];
                lg[0] += x * w0[0]; lg[1] += x * w0[1]; lg[2] += x * w0[2]; lg[3] += x * w0[3]; lg[4] += x * w1[0]; lg[5] += x * w1[1]; lg[6] += x * w1[2]; lg[7] += x * w1[3]; }
#pragma unroll
        for (int e = 0; e < 8; ++e) lg[e] = wave_sum(lg[e], C.lane);
        if (C.lane == 0) {
            int e0 = 0; float b0 = lg[0];
#pragma unroll
            for (int e = 1; e < 8; ++e) if (lg[e] > b0) { e0 = e; b0 = lg[e]; }
            int e1 = -1; float b1 = -INFINITY;
#pragma unroll
            for (int e = 0; e < 8; ++e) if (e != e0 && lg[e] > b1) { e1 = e; b1 = lg[e]; }
            const float w1 = 1.f / (1.f + expf(b0 - b1)), w0 = 1.f - w1;
            LAS int* s = sl + (k * 8 + C.wave) * 6;
            s[0] = e0; s[1] = e1; s[2] = (int)__hip_atomic_fetch_add(cl + e0, 1u, __ATOMIC_RELAXED, __HIP_MEMORY_SCOPE_WORKGROUP); s[3] = (int)__hip_atomic_fetch_add(cl + e1, 1u, __ATOMIC_RELAXED, __HIP_MEMORY_SCOPE_WORKGROUP);
            s[4] = __float_as_int(w0); s[5] = __float_as_int(w1);
        }
    }
    __syncthreads();
    if (C.tid < 8) cl[8 + C.tid] = __hip_atomic_fetch_add(cnt + C.tid, cl[C.tid], __ATOMIC_RELAXED, __HIP_MEMORY_SCOPE_AGENT);
    __syncthreads();
    if (C.lane == 0) { k = 0;
        for (int r = gw; r < ntok; r += NGW, ++k) { const LAS int* s = sl + (k * 8 + C.wave) * 6;
            TokInfo t; t.e0 = s[0]; t.e1 = s[1]; t.p0 = (int)cl[8 + s[0]] + s[2]; t.p1 = (int)cl[8 + s[1]] + s[3]; t.w0 = __int_as_float(s[4]); t.w1 = __int_as_float(s[5]); t.r0 = 0; t.r1 = 0;
            TI[r] = t; } }
    __syncthreads();
}
DI void ph_gather(const Ctx& C, int layer, int ntok) {
    const int gw = C.blk * 8 + C.wave, NGW = C.nblk * 8, i = layer >> 1;
    const unsigned* cnt = (const unsigned*)(C.ws + WS_CTL) + CW_CNT + i * 64; TokInfo* TI = (TokInfo*)(C.ws + WS_TOK);
    const bf16* H = (const bf16*)(C.ws + WS_H); bf16* XS = (bf16*)(C.ws + WS_XS);
    int base[8], cn[8]; { int acc = 0;
#pragma unroll
        for (int e = 0; e < 8; ++e) { cn[e] = (int)cnt[e]; base[e] = acc * 256; acc += (cn[e] + 255) >> 8; } }
    for (int r = gw; r < ntok; r += NGW) {
        const TokInfo t = TI[r];
        int b0 = 0, b1 = 0;
#pragma unroll
        for (int e = 0; e < 8; ++e) { b0 = (t.e0 == e) ? base[e] : b0; b1 = (t.e1 == e) ? base[e] : b1; }
        const int r0 = b0 + t.p0, r1 = b1 + t.p1;
        const u32x4 a = ((const u32x4*)(H + (size_t)r * D))[C.lane], b = ((const u32x4*)(H + (size_t)r * D))[C.lane + 64];
        ((u32x4*)(XS + (size_t)r0 * D))[C.lane] = a; ((u32x4*)(XS + (size_t)r0 * D))[C.lane + 64] = b;
        ((u32x4*)(XS + (size_t)r1 * D))[C.lane] = a; ((u32x4*)(XS + (size_t)r1 * D))[C.lane + 64] = b;
        if (C.lane == 0) { TI[r].r0 = r0; TI[r].r1 = r1; }
    }
    for (int pr = gw; pr < 8 * 256; pr += NGW) {
        const int e = pr >> 8, j = pr & 255; int be = 0, ce = 0;
#pragma unroll
        for (int k = 0; k < 8; ++k) { be = (e == k) ? base[k] : be; ce = (e == k) ? cn[k] : ce; }
        const int lim = ((ce + 255) >> 8) << 8;
        if (ce + j < lim) { u32x4* z = (u32x4*)(XS + (size_t)(be + ce + j) * D); z[C.lane] = (u32x4){0u, 0u, 0u, 0u}; z[C.lane + 64] = (u32x4){0u, 0u, 0u, 0u}; }
    }
}
DI void ph_combine(const Ctx& C, const Params& p, int layer, int ntok) {
    const int gw = C.blk * 8 + C.wave, NGW = C.nblk * 8;
    float* X = (float*)(C.ws + WS_X); bf16* H = (bf16*)(C.ws + WS_H); const float* Y = (const float*)(C.ws + WS_Y); const TokInfo* TI = (const TokInfo*)(C.ws + WS_TOK);
    const float* MODl = (const float*)(C.ws + WS_MOD) + (size_t)layer * 5 * MODW;
    const bool last = (layer == DEPTH - 1);
    const int nrows = last ? NLAT : NTOK;
    for (int r = gw; r < nrows; r += NGW) {
        f32x4 v[4];
#pragma unroll
        for (int j = 0; j < 4; ++j) v[j] = ((const f32x4*)(X + (size_t)r * D))[C.lane + 64 * j];
        if (r < ntok) {
            const TokInfo t = TI[r];
            const float* ga = MODl + (size_t)(r < NLAT ? (r >> 12) : 4) * MODW + 5 * D;
#pragma unroll
            for (int j = 0; j < 4; ++j) { const f32x4 y0 = ((const f32x4*)(Y + (size_t)t.r0 * D))[C.lane + 64 * j], y1 = ((const f32x4*)(Y + (size_t)t.r1 * D))[C.lane + 64 * j], gg = ((const f32x4*)ga)[C.lane + 64 * j];
                v[j] = v[j] + gg * (y0 * t.w0 + y1 * t.w1); }
        }
        if (!last) {
#pragma unroll
            for (int j = 0; j < 4; ++j) ((f32x4*)(X + (size_t)r * D))[C.lane + 64 * j] = v[j];
            const float* MODn = (const float*)(C.ws + WS_MOD) + (size_t)(layer + 1) * 5 * MODW;
            const float* mv = MODn + (size_t)(r < NLAT ? (r >> 12) : 4) * MODW;
            normmod_regs(v, p.in[6] + (layer + 1) * D, mv, mv + D, C.lane);
            store_row_bf16(H + (size_t)r * D, v, C.lane);
        } else {
            float ss = 0.f;
#pragma unroll
            for (int j = 0; j < 4; ++j) ss += (v[j][0] * v[j][0] + v[j][1] * v[j][1]) + (v[j][2] * v[j][2] + v[j][3] * v[j][3]);
            const float rs = rsqrtf(wave_sum(ss, C.lane) * (1.f / D) + 1e-6f);
#pragma unroll
            for (int j = 0; j < 4; ++j) { const f32x4 gg = ((const f32x4*)p.in[8])[C.lane + 64 * j]; ((f32x4*)(p.out + (size_t)r * D))[C.lane + 64 * j] = v[j] * rs * gg; }
        }
    }
}
constexpr int AT_KB = 0, AT_KB_SZ = 64 * 136 * 2, AT_VT = 2 * AT_KB_SZ, AT_VT_SZ = 128 * 68 * 2, AT_QL = AT_VT + 2 * AT_VT_SZ, AT_END = AT_QL + 256 * 136 * 2;
static_assert(AT_END <= LDS_MISC, "attention LDS");
DI void attn_unit(const Ctx& C, const bf16* PE, bf16* MIX, const float* gsub, float lam, float mul, int b, int h, int qb, bool ctxq) {
    LAS unsigned char* ldsb = C.lds; asm volatile("" : "+v"(ldsb));
    int tid = C.tid; asm volatile("" : "+v"(tid));
    const int lane = tid & 63, wave = __builtin_amdgcn_readfirstlane(tid >> 6), r = lane & 31, hh = lane >> 5;
    const int qrow0 = (ctxq ? NLAT + b * CTX : b * SEQ) + qb * 256;
    const int ntile = ctxq ? CTX / 64 : (CTX + SEQ) / 64;
    LAS bf16* QL = (LAS bf16*)(ldsb + AT_QL);
#pragma unroll
    for (int i = 0; i < 8; ++i) { const int c = tid + 512 * i, row = c >> 4, part = c & 15; *(LAS u32x4*)(QL + row * 136 + part * 8) = *(const u32x4*)(PE + (size_t)(qrow0 + row) * EVEN_IN + h * 128 + part * 8); }
    f32x16 O[2][4];
#pragma unroll
    for (int mp = 0; mp < 2; ++mp)
#pragma unroll
        for (int k = 0; k < 4; ++k) O[mp][k] = zero16();
    float m[2] = {-1e30f, -1e30f}, l[2] = {0.f, 0.f};
    u32x4 kA[2], vA[2];
    const int skey = tid & 63, spart = tid >> 6;
#define AT_LOAD(t, kr, vr) do { const int kidx_ = (t) * 64 + skey; const int krow_ = kidx_ < CTX ? NLAT + b * CTX + kidx_ : b * SEQ + kidx_ - CTX; \
        _Pragma("unroll") for (int i_ = 0; i_ < 2; ++i_) { const bf16* src_ = PE + (size_t)krow_ * EVEN_IN + h * 128 + (spart + 8 * i_) * 8; kr[i_] = *(const u32x4*)(src_ + 512); vr[i_] = *(const u32x4*)(src_ + 1024); } } while (0)
#define AT_STORE(buf, kr, vr) do { LAS bf16* kb_ = (LAS bf16*)(ldsb + AT_KB + (buf) * AT_KB_SZ); LAS bf16* vt_ = (LAS bf16*)(ldsb + AT_VT + (buf) * AT_VT_SZ); \
        _Pragma("unroll") for (int i_ = 0; i_ < 2; ++i_) { const int part_ = spart + 8 * i_; *(LAS u32x4*)(kb_ + skey * 136 + part_ * 8) = kr[i_]; \
            _Pragma("unroll") for (int e_ = 0; e_ < 4; ++e_) { vt_[(part_ * 8 + 2 * e_) * 68 + skey] = (bf16)(vr[i_][e_] & 0xffffu); vt_[(part_ * 8 + 2 * e_ + 1) * 68 + skey] = (bf16)(vr[i_][e_] >> 16); } } } while (0)
#define AT_TILE(t) do { const int buf = (t) & 1; \
        int tl_ = tid; asm volatile("" : "+v"(tl_)); const int lane = tl_ & 63, r = lane & 31, hh = lane >> 5, skey = lane, spart = tl_ >> 6;     \
        if ((t) + 1 < ntile) AT_LOAD((t) + 1, kA, vA); \
        const LAS bf16* kb = (const LAS bf16*)(ldsb + AT_KB + buf * AT_KB_SZ); const LAS bf16* vt = (const LAS bf16*)(ldsb + AT_VT + buf * AT_VT_SZ); \
        _Pragma("unroll") for (int ks2 = 0; ks2 < 2; ++ks2) {             \
            bf16x8 pf[2][2]; \
            _Pragma("unroll") for (int mp = 0; mp < 2; ++mp) { \
                f32x16 S = zero16(); \
                _Pragma("unroll") for (int ks = 0; ks < 4; ++ks) { const bf16x8 qf = *(const LAS bf16x8*)(QL + (wave * 32 + r) * 136 + mp * 64 + 16 * ks + 8 * hh); \
                    const bf16x8 a = *(const LAS bf16x8*)(kb + (ks2 * 32 + r) * 136 + mp * 64 + 16 * ks + 8 * hh); S = MFMA32(a, qf, S); } \
                float mx = S[0]; \
                _Pragma("unroll") for (int i = 1; i < 16; ++i) mx = fmaxf(mx, S[i]); \
                mx = fmaxf(mx, shx(mx, 32, lane)); \
                if (__any(mx > m[mp] + 8.f)) { const float mnew = fmaxf(m[mp], mx), corr = __builtin_amdgcn_exp2f(m[mp] - mnew); m[mp] = mnew; l[mp] *= corr; \
                    _Pragma("unroll") for (int k = 0; k < 4; ++k) O[mp][k] = O[mp][k] * corr; } \
                float ls = 0.f; const float mu = m[mp]; \
                _Pragma("unroll") for (int i = 0; i < 16; ++i) { S[i] = __builtin_amdgcn_exp2f(S[i] - mu); ls += S[i]; } \
                l[mp] += ls; \
                pf[mp][0] = pack_step(S, 0); pf[mp][1] = pack_step(S, 1); } \
            _Pragma("unroll") for (int s = 0; s < 2; ++s) \
                _Pragma("unroll") for (int k = 0; k < 4; ++k) { const bf16x8 a = ld_perm_frag(vt + (k * 32 + r) * 68, ks2 * 32, s, hh); O[0][k] = MFMA32(a, pf[0][s], O[0][k]); O[1][k] = MFMA32(a, pf[1][s], O[1][k]); } } \
        if ((t) + 1 < ntile) AT_STORE(buf ^ 1, kA, vA); \
        __syncthreads(); } while (0)
    AT_LOAD(0, kA, vA); AT_STORE(0, kA, vA);
    __syncthreads();
    for (int t = 0; t < ntile; ++t) AT_TILE(t);
#undef AT_TILE
#undef AT_LOAD
#undef AT_STORE
    {
        const float i0 = 1.f / (l[0] + shx(l[0], 32, lane)), i1 = lam / (l[1] + shx(l[1], 32, lane));
        float ss = 0.f;
#pragma unroll
        for (int k = 0; k < 4; ++k)
#pragma unroll
            for (int i = 0; i < 16; ++i) { const float o = O[0][k][i] * i0 - O[1][k][i] * i1; O[0][k][i] = o; ss += o * o; }
        ss += shx(ss, 32, lane);
        const float rs = rsqrtf(ss * (1.f / 128.f) + 1e-6f) * mul;
        const int qrow = qrow0 + wave * 32 + r;
#pragma unroll
        for (int k = 0; k < 4; ++k)
#pragma unroll
            for (int g4 = 0; g4 < 4; ++g4) { const int dv0 = k * 32 + 8 * g4 + 4 * hh; const f32x4 gg = *(const f32x4*)(gsub + dv0);
                u32x2 w; w[0] = pk2(O[0][k][4 * g4] * rs * gg[0], O[0][k][4 * g4 + 1] * rs * gg[1]); w[1] = pk2(O[0][k][4 * g4 + 2] * rs * gg[2], O[0][k][4 * g4 + 3] * rs * gg[3]);
                *(u32x2*)(MIX + (size_t)qrow * D + h * 128 + dv0) = w; }
    }
    __syncthreads();
}

constexpr int RGG_WT = 0, RGG_XR = 36864, RGG_XB = RGG_XR + 17408, RGG_XF = RGG_XB + 18432, RGG_END = RGG_XF + 128 * 65 * 4;
static_assert(RGG_END <= LDS_MISC && 131 * 66 * 2 <= 17408, "rg gates LDS");
DI void ph_rg_gates(const Ctx& C, const Params& p, int i) {
    const bf16* PE = (const bf16*)(C.ws + WS_P); float* RGA = (float*)(C.ws + WS_RGA); float* RGU = (float*)(C.ws + WS_RGU);
    const float* w_a = p.in[15] + (size_t)i * 2 * 8 * 64 * 64; const float* w_x = p.in[17] + (size_t)i * 2 * 8 * 64 * 64;
    const float* b_a = p.in[16] + i * 1024; const float* b_x = p.in[18] + i * 1024; const float* lamv = p.in[19] + i * 1024;
    const float* cw = p.in[13] + i * 4 * 512; const float* cb = p.in[14] + i * 512;
    int ncur = -1;
    for (int unit = C.blk; unit < (NTOK / 128) * 8; unit += C.nblk) {
        LAS unsigned char* ldsb = C.lds; asm volatile("" : "+v"(ldsb));
        int tid = C.tid; asm volatile("" : "+v"(tid));
        const int lane = tid & 63, wave = __builtin_amdgcn_readfirstlane(tid >> 6), r = lane & 31, hh = lane >> 5;
        const int n = unit & 7, tile = unit >> 3, r0 = tile * 128;
        LAS bf16* WT = (LAS bf16*)(ldsb + RGG_WT); LAS bf16* xraw = (LAS bf16*)(ldsb + RGG_XR); LAS bf16* XB = (LAS bf16*)(ldsb + RGG_XB); LAS float* XF = (LAS float*)(ldsb + RGG_XF);
        if (n != ncur) {
            __syncthreads();
            for (int idx = tid; idx < 16384; idx += 512) { const int ch = idx & 63, ci = (idx >> 6) & 63, g = (idx >> 12) & 1, d = idx >> 13;
                const float v = (g ? w_x : w_a)[((size_t)(d * 8 + n) * 64 + ci) * 64 + ch];
                WT[(((d * 2 + g) * 2 + (ch >> 5)) * 32 + (ch & 31)) * 72 + ci] = f2bf(v); }
            ncur = n;
        }
        int s0, s1; seq_bounds(r0, s0, s1);
        for (int idx = tid; idx < 131 * 8; idx += 512) { const int ri = idx >> 3, part = idx & 7, row = r0 - 2 + ri;
            u32x4 v = (u32x4){0u, 0u, 0u, 0u};
            if (row >= s0 && row < s1) v = *(const u32x4*)(PE + (size_t)row * EVEN_IN + 1536 + n * 64 + part * 8);
            LAS unsigned* dst = (LAS unsigned*)(xraw + ri * 66 + part * 8); dst[0] = v[0]; dst[1] = v[1]; dst[2] = v[2]; dst[3] = v[3]; }
        __syncthreads();
        { const int cc = tid & 63; float tap[4];
#pragma unroll
          for (int tp = 0; tp < 4; ++tp) tap[tp] = cw[tp * 512 + n * 64 + cc];
          const float cbias = cb[n * 64 + cc];
#pragma unroll 4
          for (int it = 0; it < 16; ++it) { const int tok = (tid >> 6) + 8 * it; float a = cbias;
#pragma unroll
              for (int tp = 0; tp < 4; ++tp) a += tap[tp] * bf2f(xraw[(tok + tp) * 66 + cc]);
              XF[tok * 65 + cc] = a; XB[tok * 72 + cc] = f2bf(a); } }
        __syncthreads();
        { const int ti = wave & 3, d = wave >> 2;
#pragma unroll
          for (int chblk = 0; chblk < 2; ++chblk) {
              f32x16 aa = zero16(), ax = zero16();
#pragma unroll
              for (int ks = 0; ks < 4; ++ks) { const bf16x8 xa = *(const LAS bf16x8*)(XB + (ti * 32 + r) * 72 + 16 * ks + 8 * hh);
                  const bf16x8 ba = *(const LAS bf16x8*)(WT + (((d * 2 + 0) * 2 + chblk) * 32 + r) * 72 + 16 * ks + 8 * hh), bx = *(const LAS bf16x8*)(WT + (((d * 2 + 1) * 2 + chblk) * 32 + r) * 72 + 16 * ks + 8 * hh);
                  aa = MFMA32(xa, ba, aa); ax = MFMA32(xa, bx, ax); }
              const int ch = n * 64 + chblk * 32 + r;
              const float ba_ = b_a[d * 512 + ch], bx_ = b_x[d * 512 + ch], sp = softplus_(-lamv[d * 512 + ch]);
#pragma unroll
              for (int q = 0; q < 16; ++q) { const int tok = ti * 32 + crow(q, hh);
                  const float rr = 1.f / (1.f + __expf(-(aa[q] + ba_))), ii = 1.f / (1.f + __expf(-(ax[q] + bx_)));
                  const float log_a = -8.f * rr * sp; const float a = __expf(log_a), u = sqrtf(fmaxf(1.f - a * a, 0.f)) * (ii * XF[tok * 65 + chblk * 32 + r]);
                  const size_t o = ((size_t)d * NTOK + r0 + tok) * 512 + ch; RGA[o] = a; RGU[o] = u; }
          } }
        __syncthreads();
    }
}
DI int rg_row(int b, int d, int pp) { return pp < CTX ? NLAT + b * CTX + (d ? CTX - 1 - pp : pp) : b * SEQ + (d ? SEQ - 1 - (pp - CTX) : (pp - CTX)); }
DI void rgscan_unit(const Ctx& C, int b, int cg) {
    LAS unsigned char* ldsb = C.lds; asm volatile("" : "+v"(ldsb));
    int tid = C.tid; asm volatile("" : "+v"(tid));
    const float* RGA = (const float*)(C.ws + WS_RGA); const float* RGU = (const float*)(C.ws + WS_RGU); float* HS1 = (float*)(C.ws + WS_HS1);
    const bf16* PE = (const bf16*)(C.ws + WS_P); bf16* MIX = (bf16*)(C.ws + WS_MIX);
    LAS float* sb = (LAS float*)ldsb;
    const int ch = cg * 16 + (tid & 15), chunk = tid >> 4, p0 = chunk * 136;
    for (int pass = 0; pass < 2; ++pass) {
        const int d = 1 - pass;
        const float* Ad = RGA + (size_t)d * NTOK * 512 + ch; const float* Ud = RGU + (size_t)d * NTOK * 512 + ch;
        float av[17], uv[17], an[17], un[17];
        float A = 1.f, H = 0.f;
#pragma unroll
        for (int k = 0; k < 17; ++k) { const size_t o = (size_t)rg_row(b, d, p0 + k) * 512; av[k] = Ad[o]; uv[k] = Ud[o]; }
        for (int g8 = 0; g8 < 8; ++g8) {
            if (g8 < 7) {
#pragma unroll
                for (int k = 0; k < 17; ++k) { const size_t o = (size_t)rg_row(b, d, p0 + (g8 + 1) * 17 + k) * 512; an[k] = Ad[o]; un[k] = Ud[o]; } }
#pragma unroll
            for (int k = 0; k < 17; ++k) { H = av[k] * H + uv[k]; A *= av[k]; }
#pragma unroll
            for (int k = 0; k < 17; ++k) { av[k] = an[k]; uv[k] = un[k]; }
        }
        sb[(chunk * 16 + (tid & 15)) * 2] = A; sb[(chunk * 16 + (tid & 15)) * 2 + 1] = H;
        __syncthreads();
        float h = 0.f;
        for (int k = 0; k < chunk; ++k) h = sb[(k * 16 + (tid & 15)) * 2] * h + sb[(k * 16 + (tid & 15)) * 2 + 1];
#pragma unroll
        for (int k = 0; k < 17; ++k) { const size_t o = (size_t)rg_row(b, d, p0 + k) * 512; av[k] = Ad[o]; uv[k] = Ud[o]; }
        for (int g8 = 0; g8 < 8; ++g8) {
            if (g8 < 7) {
#pragma unroll
                for (int k = 0; k < 17; ++k) { const size_t o = (size_t)rg_row(b, d, p0 + (g8 + 1) * 17 + k) * 512; an[k] = Ad[o]; un[k] = Ud[o]; } }
#pragma unroll
            for (int k = 0; k < 17; ++k) { h = av[k] * h + uv[k]; const int row = rg_row(b, d, p0 + g8 * 17 + k);
                if (pass == 0) HS1[(size_t)row * 512 + ch] = h;
                else { const float y = h + HS1[(size_t)row * 512 + ch]; MIX[(size_t)row * D + 512 + ch] = f2bf(y * gelu_tanh_(bf2f(PE[(size_t)row * EVEN_IN + 2048 + ch]))); } }
#pragma unroll
            for (int k = 0; k < 17; ++k) { av[k] = an[k]; uv[k] = un[k]; }
        }
        __syncthreads();
    }
}
DI void ph_even_mix(const Ctx& C, const Params& p, int layer, int rep) {
    const int i = layer >> 1;
    volatile LAS unsigned* misc = (volatile LAS unsigned*)(C.lds + LDS_MISC);
    unsigned* q = (unsigned*)(C.ws + WS_CTL) + CW_Q + (i + 2 * rep) * 64;
    const float lam_init = 0.8f - 0.6f * expf(-0.3f * (float)layer);
    if (C.wave == 0) { const float* lq = p.in[11] + i * 256; const float a = wave_sum(lq[C.lane] * lq[64 + C.lane], C.lane), b2 = wave_sum(lq[128 + C.lane] * lq[192 + C.lane], C.lane);
        if (C.lane == 0) ((volatile LAS float*)misc)[4] = expf(a) - expf(b2) + lam_init; }
    __syncthreads();
    const float lam = ((volatile LAS float*)misc)[4];
    const bf16* PE = (const bf16*)(C.ws + WS_P); bf16* MIX = (bf16*)(C.ws + WS_MIX);
    for (;;) {
        if (C.tid == 0) misc[8] = __hip_atomic_fetch_add(q, 1u, __ATOMIC_RELAXED, __HIP_MEMORY_SCOPE_AGENT);
        __syncthreads();
        const int u = (int)misc[8];
        __syncthreads();
#ifndef MIX_RG_REP
#define MIX_RG_REP 1
#endif
#ifndef MIX_AT_REP
#define MIX_AT_REP 1
#endif
        if (u >= 128 * MIX_RG_REP + 272 * MIX_AT_REP) break;
        if (u < 128 * MIX_RG_REP) { const int x = u & 127; rgscan_unit(C, x >> 5, x & 31); }
        else { const int y = (u - 128 * MIX_RG_REP) % 272;
            if (y < 256) attn_unit(C, PE, MIX, p.in[12] + i * 128, lam, 1.f - lam_init, y >> 6, (y >> 4) & 3, y & 15, false);
            else { const int x = y - 256; attn_unit(C, PE, MIX, p.in[12] + i * 128, lam, 1.f - lam_init, x >> 2, x & 3, 0, true); } }
    }
}
DI int chunk_row0(int cidx) { return cidx < 256 ? (cidx >> 6) * SEQ + (cidx & 63) * 64 : NLAT + (cidx - 256) * 64; }
constexpr int GA_RA = 0, GA_RB = 18432, GA_KT0 = 2 * 18432, GA_KT1 = 3 * 18432, GA_VT0 = 4 * 18432, GA_VT1 = 5 * 18432, GA_KK = 6 * 18432, GA_QK = GA_KK + 16640, GA_GC = GA_QK + 16640, GA_END = GA_GC + 1024;
static_assert(GA_END <= LDS_MISC, "GA LDS");
DI void gdn_ga_unit(const Ctx& C, int unit) {
    LAS unsigned char* ldsb = C.lds; asm volatile("" : "+v"(ldsb));
    const int h = unit & 7, cidx = unit >> 3;
    const int row0 = chunk_row0(cidx);
    const bf16* QKVN = (const bf16*)(C.ws + WS_QKVN); const float* Gd = (const float*)(C.ws + WS_GB); const float* Bd = Gd + (size_t)2 * NTOK * 8;
    const size_t ud0 = (size_t)(cidx * 8 + h) * 2;
    bf16* WG = (bf16*)(C.ws + WS_WG) + ud0 * 8192; float* UG = (float*)(C.ws + WS_UG) + ud0 * 8192; bf16* QKD = (bf16*)(C.ws + WS_QKD) + ud0 * 4096; float* SC = (float*)(C.ws + WS_SC) + ud0 * 192;
    bf16* KTG = (bf16*)(C.ws + WS_KTG) + ud0 * 8192;
    LAS bf16* Kc = (LAS bf16*)(ldsb + GA_RA); LAS bf16* Qc = (LAS bf16*)(ldsb + GA_RB);
    LAS float* KKm = (LAS float*)(ldsb + GA_KK); LAS float* QKm = (LAS float*)(ldsb + GA_QK);
    LAS float* gc = (LAS float*)(ldsb + GA_GC); LAS float* be = gc + 128;
    int tid = C.tid; asm volatile("" : "+v"(tid));
    const int lane = tid & 63, wave = __builtin_amdgcn_readfirstlane(tid >> 6), r = lane & 31, hh = lane >> 5;
#pragma unroll
    for (int i2 = 0; i2 < 2; ++i2) { const int c = tid + 512 * i2, pos = c & 63, part = c >> 6;
        const bf16* src = QKVN + (size_t)(row0 + pos) * 3072 + h * 128 + part * 8;
        const u32x4 q = *(const u32x4*)src, k = *(const u32x4*)(src + 1024), v = *(const u32x4*)(src + 2048);
        *(LAS u32x4*)(Qc + pos * 136 + part * 8) = q; *(LAS u32x4*)(Kc + pos * 136 + part * 8) = k;
        LAS bf16* kt0 = (LAS bf16*)(ldsb + GA_KT0) + (part * 8) * 72; LAS bf16* kt1 = (LAS bf16*)(ldsb + GA_KT1) + (part * 8) * 72;
        LAS bf16* vt0 = (LAS bf16*)(ldsb + GA_VT0) + (part * 8) * 72; LAS bf16* vt1 = (LAS bf16*)(ldsb + GA_VT1) + (part * 8) * 72;
#pragma unroll
        for (int e = 0; e < 4; ++e) { const bf16 k0 = (bf16)(k[e] & 0xffffu), k1 = (bf16)(k[e] >> 16), v0 = (bf16)(v[e] & 0xffffu), v1 = (bf16)(v[e] >> 16);
            kt0[(2 * e) * 72 + pos] = k0; kt0[(2 * e + 1) * 72 + pos] = k1; kt1[(2 * e) * 72 + 63 - pos] = k0; kt1[(2 * e + 1) * 72 + 63 - pos] = k1;
            vt0[(2 * e) * 72 + pos] = v0; vt0[(2 * e + 1) * 72 + pos] = v1; vt1[(2 * e) * 72 + 63 - pos] = v0; vt1[(2 * e + 1) * 72 + 63 - pos] = v1; } }
    if (wave < 2) {
        const int d = wave, row = row0 + (d ? 63 - lane : lane);
        float g = Gd[((size_t)d * NTOK + row) * 8 + h];
#pragma unroll
        for (int o = 1; o < 64; o <<= 1) { const float t = __builtin_bit_cast(float, __builtin_amdgcn_ds_bpermute((lane - o) << 2, __builtin_bit_cast(int, g))); if (lane >= o) g += t; }
        gc[d * 64 + lane] = g; be[d * 64 + lane] = Bd[((size_t)d * NTOK + row) * 8 + h];
    }
    __syncthreads();
    { const int ti = (wave & 3) >> 1, tj = wave & 1; const LAS bf16* Arows = (wave < 4 ? Kc : Qc);
      f32x16 acc = zero16();
#pragma unroll
      for (int ks = 0; ks < 8; ++ks) { const bf16x8 a = *(const LAS bf16x8*)(Arows + (ti * 32 + r) * 136 + 16 * ks + 8 * hh), bb = *(const LAS bf16x8*)(Kc + (tj * 32 + r) * 136 + 16 * ks + 8 * hh); acc = MFMA32(a, bb, acc); }
      LAS float* dst = (wave < 4 ? KKm : QKm);
#pragma unroll
      for (int i = 0; i < 16; ++i) dst[(ti * 32 + crow(i, hh)) * 65 + tj * 32 + r] = acc[i]; }
    __syncthreads();
    const float qscale = 0.08838834764831845f;
#pragma unroll
    for (int e = 0; e < 16; ++e) { const int idx = tid + 512 * e, d = idx >> 12, i = (idx >> 6) & 63, j = idx & 63, ti = d ? 63 - i : i, tj = d ? 63 - j : j;
        const float dec = (j <= i) ? __expf(gc[d * 64 + i] - gc[d * 64 + j]) : 0.f;
        ((LAS float*)(ldsb + (d ? GA_RB : GA_RA)))[i * 68 + j] = (j < i) ? KKm[ti * 65 + tj] * be[d * 64 + i] * dec : 0.f;
        QKD[idx] = f2bf(QKm[ti * 65 + tj] * qscale * dec); }
    if (tid < 128) { const int d = tid >> 6, i = tid & 63; SC[d * 192 + i] = qscale * __expf(gc[d * 64 + i]); SC[d * 192 + 64 + i] = __expf(gc[d * 64 + 63] - gc[d * 64 + i]); if (i == 0) SC[d * 192 + 128] = __expf(gc[d * 64 + 63]); }
    __syncthreads();
    if (wave < 2) {
        const int d = wave, c = lane; LAS float* Lm = (LAS float*)(ldsb + (d ? GA_RB : GA_RA)); float T[64];
#pragma unroll
        for (int i = 0; i < 64; ++i) { float a0 = (i == c) ? 1.f : 0.f, a1 = 0.f, a2 = 0.f, a3 = 0.f;
#pragma unroll
            for (int j4 = 0; j4 < (i + 3) / 4; ++j4) { const f32x4 l4 = *(const LAS f32x4*)(Lm + i * 68 + 4 * j4);
                a0 -= l4[0] * T[4 * j4]; if (4 * j4 + 1 < i) a1 -= l4[1] * T[4 * j4 + 1]; if (4 * j4 + 2 < i) a2 -= l4[2] * T[4 * j4 + 2]; if (4 * j4 + 3 < i) a3 -= l4[3] * T[4 * j4 + 3]; }
            T[i] = (a0 + a1) + (a2 + a3); asm volatile("" ::: "memory"); }
        const float s2 = be[d * 64 + c], s1 = s2 * __expf(gc[d * 64 + c]);
        LAS bf16* T1 = (LAS bf16*)Lm; LAS bf16* T2 = T1 + 64 * 72;
#pragma unroll
        for (int i = 0; i < 64; ++i) { T1[i * 72 + c] = f2bf(T[i] * s1); T2[i * 72 + c] = f2bf(T[i] * s2); }
    }
    __syncthreads();
#pragma unroll
    for (int d = 0; d < 2; ++d) {
        const LAS bf16* T1 = (const LAS bf16*)(ldsb + (d ? GA_RB : GA_RA)); const LAS bf16* T2 = T1 + 64 * 72;
        const LAS bf16* Kt = (const LAS bf16*)(ldsb + (d ? GA_KT1 : GA_KT0)); const LAS bf16* Vt = (const LAS bf16*)(ldsb + (d ? GA_VT1 : GA_VT0));
        const int ti = wave >> 2, tn = wave & 3; f32x16 aw = zero16(), au = zero16();
#pragma unroll
        for (int ks = 0; ks < 4; ++ks) { const bf16x8 a1 = *(const LAS bf16x8*)(T1 + (ti * 32 + r) * 72 + 16 * ks + 8 * hh), a2 = *(const LAS bf16x8*)(T2 + (ti * 32 + r) * 72 + 16 * ks + 8 * hh);
            const bf16x8 bk = *(const LAS bf16x8*)(Kt + (tn * 32 + r) * 72 + 16 * ks + 8 * hh), bv = *(const LAS bf16x8*)(Vt + (tn * 32 + r) * 72 + 16 * ks + 8 * hh);
            aw = MFMA32(a1, bk, aw); au = MFMA32(a2, bv, au); }
#pragma unroll
        for (int i = 0; i < 16; ++i) { const int pos = ti * 32 + crow(i, hh); WG[d * 8192 + pos * 128 + tn * 32 + r] = f2bf(aw[i]); UG[d * 8192 + pos * 128 + tn * 32 + r] = au[i]; }
#pragma unroll
        for (int i2 = 0; i2 < 2; ++i2) { const int c = tid + 512 * i2, row = c >> 3, part = c & 7; *(u32x4*)(KTG + d * 8192 + row * 64 + part * 8) = *(const LAS u32x4*)(Kt + row * 72 + part * 8); }
    }
    __syncthreads();
}
DI void ph_gdn_ga(const Ctx& C) { for (int u = C.blk; u < NCH * 8; u += C.nblk) gdn_ga_unit(C, u); }

constexpr int GB_NSL = 2;
constexpr int GB_W = 0, GB_Q = GB_W + 64 * 136 * 2, GB_KT = GB_Q + 64 * 136 * 2, GB_QK = GB_KT + 128 * 72 * 2, GB_SC = GB_QK + 64 * 72 * 2, GB_BUF = GB_SC + 1024;
static_assert(2 * GB_BUF <= LDS_MISC, "GB LDS");
DI void gdn_gb_unit(const Ctx& C, int unit) {
    LAS unsigned char* ldsb = C.lds; asm volatile("" : "+v"(ldsb));
    constexpr int NGRP = 4 / GB_NSL;
    const int grp = unit % NGRP, bhd = unit / NGRP, d = bhd & 1, h = (bhd >> 1) & 7, b = bhd >> 4;
    const bf16* QKVN = (const bf16*)(C.ws + WS_QKVN);
    const bf16* WGb = (const bf16*)(C.ws + WS_WG); const float* UGb = (const float*)(C.ws + WS_UG); const bf16* QKDb = (const bf16*)(C.ws + WS_QKD); const bf16* KTGb = (const bf16*)(C.ws + WS_KTG); const float* SCb = (const float*)(C.ws + WS_SC);
    float* OG = (float*)(C.ws + WS_OG) + (size_t)d * NTOK * D;
    int tid = C.tid; asm volatile("" : "+v"(tid));
    const int lane = tid & 63, wave = __builtin_amdgcn_readfirstlane(tid >> 6), r = lane & 31, hh = lane >> 5;
    const bool comp = wave < GB_NSL; const int dv0 = (grp * GB_NSL + wave) * 32;
    f32x16 S[4];
#pragma unroll
    for (int k = 0; k < 4; ++k) S[k] = zero16();
    constexpr int NST = 512 - GB_NSL * 64, NCK = 3584, NIT = (NCK + NST - 1) / NST;
    const int st = tid - GB_NSL * 64;
    u32x4 sreg[NIT]; float rsc = 0.f;
    auto chunk_of = [&](int step) { return step < 4 ? 256 + b * 4 + (d ? 3 - step : step) : b * 64 + (d ? 63 - (step - 4) : (step - 4)); };
#define GB_LOAD(step) do { if (!comp) { int st_ = st; asm volatile("" : "+v"(st_)); const int cidx_ = chunk_of(step), un_ = (cidx_ * 8 + h) * 2 + d, row0_ = chunk_row0(cidx_); \
        _Pragma("unroll") for (int i_ = 0; i_ < NIT; ++i_) { const int q_ = st_ + NST * i_; if (q_ < NCK) { const int reg_ = q_ >> 10, c_ = q_ & 1023, pos_ = c_ >> 4, part_ = c_ & 15, row_ = row0_ + (d ? 63 - pos_ : pos_); \
            const bf16* src_ = reg_ == 0 ? WGb + (size_t)un_ * 8192 + c_ * 8 : reg_ == 1 ? QKVN + (size_t)row_ * 3072 + h * 128 + part_ * 8 : reg_ == 2 ? KTGb + (size_t)un_ * 8192 + c_ * 8 : QKDb + (size_t)un_ * 4096 + c_ * 8; \
            sreg[i_] = *(const u32x4*)src_; } } \
        if (st_ < 192) rsc = SCb[(size_t)un_ * 192 + st_]; } } while (0)
#define GB_STORE(buf) do { if (!comp) { int st_ = st; asm volatile("" : "+v"(st_)); LAS unsigned char* B_ = ldsb + (buf) * GB_BUF; \
        _Pragma("unroll") for (int i_ = 0; i_ < NIT; ++i_) { const int q_ = st_ + NST * i_; if (q_ < NCK) { const int reg_ = q_ >> 10, c_ = q_ & 1023, pos_ = c_ >> 4, part_ = c_ & 15; \
            if (reg_ == 0) *(LAS u32x4*)((LAS bf16*)(B_ + GB_W) + pos_ * 136 + part_ * 8) = sreg[i_]; \
            else if (reg_ == 1) *(LAS u32x4*)((LAS bf16*)(B_ + GB_Q) + pos_ * 136 + part_ * 8) = sreg[i_]; \
            else if (reg_ == 2) *(LAS u32x4*)((LAS bf16*)(B_ + GB_KT) + (c_ >> 3) * 72 + (c_ & 7) * 8) = sreg[i_]; \
            else *(LAS u32x4*)((LAS bf16*)(B_ + GB_QK) + (c_ >> 3) * 72 + (c_ & 7) * 8) = sreg[i_]; } } \
        if (st_ < 192) ((LAS float*)(B_ + GB_SC))[st_] = rsc; } } while (0)
    GB_LOAD(0); GB_STORE(0);
    f32x16 Un[2];
    Un[0] = zero16(); Un[1] = zero16();
    if (comp) { const int cidx = chunk_of(0), un = (cidx * 8 + h) * 2 + d; const float* Uu = UGb + (size_t)un * 8192 + dv0 + r;
#pragma unroll
        for (int tt = 0; tt < 2; ++tt)
#pragma unroll
            for (int i = 0; i < 16; ++i) Un[tt][i] = Uu[(tt * 32 + crow(i, hh)) * 128]; }
    __syncthreads();
    for (int step = 0; step < 68; ++step) {
        const int buf = step & 1;
        if (!comp) { if (step + 1 < 68) { GB_LOAD(step + 1); GB_STORE(buf ^ 1); } }
        else {
            int ln_ = lane; asm volatile("" : "+v"(ln_)); const int r = ln_ & 31, hh = ln_ >> 5;
            const int cidx = chunk_of(step), un = (cidx * 8 + h) * 2 + d, row0 = chunk_row0(cidx);
            const LAS unsigned char* Bp = ldsb + buf * GB_BUF; const LAS bf16* Wl = (const LAS bf16*)(Bp + GB_W); const LAS bf16* Ql = (const LAS bf16*)(Bp + GB_Q);
            const LAS bf16* KTl = (const LAS bf16*)(Bp + GB_KT); const LAS bf16* QKl = (const LAS bf16*)(Bp + GB_QK); const LAS float* scl = (const LAS float*)(Bp + GB_SC);
#pragma unroll
            for (int tt = 0; tt < 2; ++tt) {
                f32x16 aw = zero16();
#pragma unroll
                for (int kb = 0; kb < 4; ++kb)
#pragma unroll
                    for (int s = 0; s < 2; ++s) aw = MFMA32(ld_perm_frag(Wl + (tt * 32 + r) * 136, kb * 32, s, hh), pack_step(S[kb], s), aw);
#pragma unroll
                for (int i = 0; i < 16; ++i) Un[tt][i] -= aw[i];
                asm volatile("" ::: "memory");
            }
            bf16x8 vp[2][2];
#pragma unroll
            for (int jt = 0; jt < 2; ++jt) { vp[jt][0] = pack_step(Un[jt], 0); vp[jt][1] = pack_step(Un[jt], 1); }
#pragma unroll
            for (int tt = 0; tt < 2; ++tt) {
                f32x16 aq = zero16();
#pragma unroll
                for (int kb = 0; kb < 4; ++kb)
#pragma unroll
                    for (int s = 0; s < 2; ++s) aq = MFMA32(ld_perm_frag(Ql + (tt * 32 + r) * 136, kb * 32, s, hh), pack_step(S[kb], s), aq);
#pragma unroll
                for (int i = 0; i < 16; ++i) aq[i] *= scl[tt * 32 + crow(i, hh)];
#pragma unroll
                for (int jt = 0; jt < 2; ++jt)
#pragma unroll
                    for (int s = 0; s < 2; ++s) aq = MFMA32(ld_perm_frag(QKl + (tt * 32 + r) * 72, jt * 32, s, hh), vp[jt][s], aq);
#pragma unroll
                for (int i = 0; i < 16; ++i) { const int pos = tt * 32 + crow(i, hh), row = row0 + (d ? 63 - pos : pos); OG[(size_t)row * D + h * 128 + dv0 + r] = aq[i]; }
                asm volatile("" ::: "memory");
            }
#pragma unroll
            for (int jt = 0; jt < 2; ++jt) {
#pragma unroll
                for (int i = 0; i < 16; ++i) Un[jt][i] *= scl[64 + jt * 32 + crow(i, hh)];
                vp[jt][0] = pack_step(Un[jt], 0); vp[jt][1] = pack_step(Un[jt], 1); }
            if (step + 1 < 68) { const int cn = chunk_of(step + 1), unn = (cn * 8 + h) * 2 + d; const float* Uu = UGb + (size_t)unn * 8192 + dv0 + r;
#pragma unroll
                for (int tt = 0; tt < 2; ++tt)
#pragma unroll
                    for (int i = 0; i < 16; ++i) Un[tt][i] = Uu[(tt * 32 + crow(i, hh)) * 128]; }
            const float gtot = scl[128];
#pragma unroll
            for (int kb = 0; kb < 4; ++kb) { S[kb] = S[kb] * gtot;
#pragma unroll
                for (int jt = 0; jt < 2; ++jt)
#pragma unroll
                    for (int s = 0; s < 2; ++s) S[kb] = MFMA32(ld_perm_frag(KTl + (kb * 32 + r) * 72, jt * 32, s, hh), vp[jt][s], S[kb]);
                asm volatile("" ::: "memory"); }
        }
        __syncthreads();
    }
#undef GB_LOAD
#undef GB_STORE
}
DI void ph_gdn_gb(const Ctx& C) { for (int u = C.blk; u < 64 * (4 / GB_NSL); u += C.nblk) gdn_gb_unit(C, u); }
constexpr int NPH_PAIR = 20, NPHASE = 1 + 2 * NPH_PAIR;
DI void fresh(Ctx& C) { int t = C.wave0 * 64 + (int)__builtin_amdgcn_mbcnt_hi(~0u, __builtin_amdgcn_mbcnt_lo(~0u, 0u)); asm volatile("" : "+v"(t));     int b = blockIdx.x; asm volatile("" : "+s"(b)); unsigned char* w_ = C.ws0; asm volatile("" : "+s"(w_)); C.ws = w_; C.tid = t; C.lane = t & 63; C.wave = __builtin_amdgcn_readfirstlane(t >> 6); C.blk = b; }
__global__ void __launch_bounds__(512, 2) fused_fwd(Params p) {
    extern __shared__ __attribute__((aligned(16))) unsigned char lds_raw[];
    Ctx C; C.lds = (LAS unsigned char*)lds_raw; C.ws = p.ws; C.ws0 = p.ws; C.tid = threadIdx.x; C.lane = C.tid & 63; C.wave = __builtin_amdgcn_readfirstlane(C.tid >> 6); C.wave0 = C.wave; C.nblk = gridDim.x; C.blk = blockIdx.x;
    volatile LAS unsigned* misc = (volatile LAS unsigned*)(C.lds + LDS_MISC);
    if (C.tid < 16) misc[C.tid] = 0u;
    __syncthreads();
    unsigned* ctl = (unsigned*)(p.ws + WS_CTL);
    const bool single = (p.ph_lo == 0 && p.ph_hi == NPHASE);
    XcdBarrier bar; bar.bar = ctl + CW_BAR; bar.x = 0; bar.st = misc;
    if (single) bar = xcd_barrier_post(ctl + CW_BAR, misc);
    const int lo = p.ph_lo, hi = p.ph_hi;
#ifndef PH_MASK
#define PH_MASK 0x1FFFFFu
#endif
#define PHEN(k) (((PH_MASK) >> (k)) & 1u)
#ifndef XTRA_BAR
#define XTRA_BAR 0
#endif
#ifndef REP_MASK
#define REP_MASK 0u
#endif
#define NREP(k) (1 + (int)(((REP_MASK) >> (k)) & 1u))
#define IN(k) (fresh(C), lo <= (k) && (k) < hi)
#define SEAM(k) do { if (single) { unsigned* bp_ = ctl + CW_BAR; asm volatile("" : "+s"(bp_)); bar.bar = bp_; xcd_barrier(bar); for (int xb_ = 0; xb_ < XTRA_BAR; ++xb_) xcd_barrier(bar); } } while (0)
#define H ((bf16*)(C.ws + WS_H))
#define MIX ((bf16*)(C.ws + WS_MIX))
#define P ((bf16*)(C.ws + WS_P))
#define X ((float*)(C.ws + WS_X))
#define MOD ((const float*)(C.ws + WS_MOD))
    for (int rep_ = 0; rep_ < NREP(0); ++rep_) { if (rep_) { SEAM(0); } if (PHEN(0) && IN(0)) ph_prologue(C, p); }
    SEAM(0);
    for (int lp = 0; lp < 2; ++lp) {
        const int pb = 1 + lp * NPH_PAIR, le = 2 * lp, lod = 2 * lp + 1;
        for (int rep_ = 0; rep_ < NREP(1); ++rep_) { if (rep_) { SEAM(0); } if (PHEN(1) && IN(pb + 0)) { if (lp == 0) ph_normmod(C, p, 0, false, true); } }
        SEAM(pb + 0);
        for (int rep_ = 0; rep_ < NREP(2); ++rep_) { if (rep_) { SEAM(0); } if (PHEN(2) && IN(pb + 1)) { pg8::Gemm g{H, (const bf16*)(C.ws + WS_WEIN) + (size_t)lp * 2560 * 1024, NTOK, EVEN_IN, D}; pg8::StaticOrder S; S.init(NTOK, EVEN_IN, C.nblk, C.blk);
            EpiEvenIn E{P, (const float*)(C.ws + WS_COS), (const float*)(C.ws + WS_SIN)}; pg8::gemm_phase<EpiEvenIn, pg8::StaticOrder>(C.lds, g, S, E, C.tid); } }
        SEAM(pb + 1);
        for (int rep_ = 0; rep_ < NREP(20); ++rep_) { if (rep_) { SEAM(0); } if (PHEN(20) && IN(pb + 2)) ph_rg_gates(C, p, lp); }
        SEAM(pb + 2);
        for (int rep_ = 0; rep_ < NREP(3); ++rep_) { if (rep_) { SEAM(0); } if (PHEN(3) && IN(pb + 3)) ph_even_mix(C, p, le, rep_); }
        SEAM(pb + 3);
        for (int rep_ = NREP(4) - 1; rep_ >= 0; --rep_) { if (PHEN(4) && IN(pb + 4)) { pg8::Gemm g{MIX, (const bf16*)(C.ws + WS_WEOUT) + (size_t)lp * 1024 * 1024, NTOK, D, D}; pg8::StaticOrder S; S.init(NTOK, D, C.nblk, C.blk);
            EpiResid E{rep_ ? (float*)(C.ws + WS_U) : X, MOD + (size_t)le * 5 * MODW + 2 * D}; pg8::gemm_phase<EpiResid, pg8::StaticOrder>(C.lds, g, S, E, C.tid); } if (rep_) { SEAM(0); } }
        SEAM(pb + 4);
        for (int rep_ = 0; rep_ < NREP(5); ++rep_) { if (rep_) { SEAM(0); } if (PHEN(5) && IN(pb + 5)) ph_normmod(C, p, le, true, false); }
        SEAM(pb + 5);
        for (int rep_ = 0; rep_ < NREP(6); ++rep_) { if (rep_) { SEAM(0); } if (PHEN(6) && IN(pb + 6)) { pg8::Gemm g{H, (const bf16*)(C.ws + WS_WEF1) + (size_t)lp * 5632 * 1024, NTOK, 2 * FFN, D}; pg8::StaticOrder S; S.init(NTOK, 2 * FFN, C.nblk, C.blk);
            EpiSwiglu E{P, FFN, 2 * FFN / 256}; pg8::gemm_phase<EpiSwiglu, pg8::StaticOrder>(C.lds, g, S, E, C.tid); } }
        SEAM(pb + 6);
        for (int rep_ = NREP(7) - 1; rep_ >= 0; --rep_) { if (PHEN(7) && IN(pb + 7)) { pg8::Gemm g{P, (const bf16*)(C.ws + WS_WEF2) + (size_t)lp * 1024 * 2816, NTOK, D, FFN}; pg8::StaticOrder S; S.init(NTOK, D, C.nblk, C.blk);
            EpiResid E{rep_ ? (float*)(C.ws + WS_U) : X, MOD + (size_t)le * 5 * MODW + 5 * D}; pg8::gemm_phase<EpiResid, pg8::StaticOrder>(C.lds, g, S, E, C.tid); } if (rep_) { SEAM(0); } }
        SEAM(pb + 7);
        const int ntok = (lod < DEPTH - 1) ? NTOK : NLAT;
        for (int rep_ = 0; rep_ < NREP(8); ++rep_) { if (rep_) { SEAM(0); } if (PHEN(8) && IN(pb + 8)) ph_normmod(C, p, lod, false, false); }
        SEAM(pb + 8);
        for (int rep_ = 0; rep_ < NREP(9); ++rep_) { if (rep_) { SEAM(0); } if (PHEN(9) && IN(pb + 9)) { pg8::Gemm g{H, (const bf16*)(C.ws + WS_WOIN) + (size_t)lp * 4352 * 1024, NTOK, 4352, D}; pg8::StaticOrder S; S.init(NTOK, 4352, C.nblk, C.blk);
            EpiBf16Ab E{P, 4352, (float*)(C.ws + WS_AB), 16}; pg8::gemm_phase<EpiBf16Ab, pg8::StaticOrder>(C.lds, g, S, E, C.tid); } }
        SEAM(pb + 9);
        for (int rep_ = 0; rep_ < NREP(10); ++rep_) { if (rep_) { SEAM(0); } if (PHEN(10) && IN(pb + 10)) ph_odd_conv(C, p, lp); }
        SEAM(pb + 10);
        for (int rep_ = 0; rep_ < NREP(11); ++rep_) { if (rep_) { SEAM(0); } if (PHEN(11) && IN(pb + 11)) ph_gdn_ga(C); }
        SEAM(pb + 11);
        for (int rep_ = 0; rep_ < NREP(12); ++rep_) { if (rep_) { SEAM(0); } if (PHEN(12) && IN(pb + 12)) ph_gdn_gb(C); }
        SEAM(pb + 12);
        for (int rep_ = 0; rep_ < NREP(13); ++rep_) { if (rep_) { SEAM(0); } if (PHEN(13) && IN(pb + 13)) ph_gdn_out(C, p, lp); }
        SEAM(pb + 13);
        for (int rep_ = NREP(14) - 1; rep_ >= 0; --rep_) { if (PHEN(14) && IN(pb + 14)) { pg8::Gemm g{MIX, (const bf16*)(C.ws + WS_WOOUT) + (size_t)lp * 1024 * 1024, NTOK, D, D}; pg8::StaticOrder S; S.init(NTOK, D, C.nblk, C.blk);
            EpiResid E{rep_ ? (float*)(C.ws + WS_U) : X, MOD + (size_t)lod * 5 * MODW + 2 * D}; pg8::gemm_phase<EpiResid, pg8::StaticOrder>(C.lds, g, S, E, C.tid); } if (rep_) { SEAM(0); } }
        SEAM(pb + 14);
        if (PHEN(15) && IN(pb + 15)) ph_router(C, p, lod, ntok);
        SEAM(pb + 15);
        for (int rep_ = 0; rep_ < NREP(16); ++rep_) { if (rep_) { SEAM(0); } if (PHEN(16) && IN(pb + 16)) ph_gather(C, lod, ntok); }
        SEAM(pb + 16);
        for (int rep_ = 0; rep_ < NREP(17); ++rep_) { if (rep_) { SEAM(0); } if (PHEN(17) && IN(pb + 17)) { pg8::Gemm g{(const bf16*)(C.ws + WS_XS), (const bf16*)(C.ws + WS_WXIN) + (size_t)lp * 8 * 7168 * 1024, RMAX, 8 * 7168, D}; MoeOrder S; S.initm(ctl + CW_CNT + lp * 64, 28, C.nblk, C.blk);
            EpiSwiglu E{(bf16*)(C.ws + WS_HIDM), FFE, 28}; pg8::gemm_phase<EpiSwiglu, MoeOrder>(C.lds, g, S, E, C.tid); } }
        SEAM(pb + 17);
        for (int rep_ = 0; rep_ < NREP(18); ++rep_) { if (rep_) { SEAM(0); } if (PHEN(18) && IN(pb + 18)) { pg8::Gemm g{(const bf16*)(C.ws + WS_HIDM), (const bf16*)(C.ws + WS_WXOUT) + (size_t)lp * 8 * 1024 * 3584, RMAX, 8 * 1024, FFE}; MoeOrder S; S.initm(ctl + CW_CNT + lp * 64, 4, C.nblk, C.blk);
            EpiF32 E{(float*)(C.ws + WS_Y), D, 4}; pg8::gemm_phase<EpiF32, MoeOrder>(C.lds, g, S, E, C.tid); } }
        SEAM(pb + 18);
        if (PHEN(19) && IN(pb + 19)) ph_combine(C, p, lod, ntok);
        SEAM(pb + 19);
    }
#undef IN
#undef SEAM
#undef H
#undef MIX
#undef P
#undef X
#undef MOD
}

static int fused_setup() {
    static int grid = 0;
    if (grid == 0) {
        int dev = 0, cus = 0, per_cu = 0;
        if (hipGetDevice(&dev) != hipSuccess || hipDeviceGetAttribute(&cus, hipDeviceAttributeMultiprocessorCount, dev) != hipSuccess) { fprintf(stderr, "fused_setup: device query failed\n"); grid = -1; return grid; }
        if (hipFuncSetAttribute((const void*)fused_fwd, hipFuncAttributeMaxDynamicSharedMemorySize, LDS_BYTES) != hipSuccess) { fprintf(stderr, "fused_setup: hipFuncSetAttribute failed\n"); grid = -1; return grid; }
        if (hipOccupancyMaxActiveBlocksPerMultiprocessor(&per_cu, (const void*)fused_fwd, 512, LDS_BYTES) != hipSuccess || per_cu < 1) { fprintf(stderr, "fused_setup: occupancy query says %d blocks per CU\n", per_cu); (void)hipGetLastError(); }
        grid = cus;
    }
    return grid;
}
static void launch_fused(const Params& p0, int lo, int hi, hipStream_t s) {
    const int grid = fused_setup(); if (grid <= 0) return;
    Params p = p0; p.ph_lo = lo; p.ph_hi = hi;
    hipLaunchKernelGGL(fused_fwd, dim3(grid), dim3(512), LDS_BYTES, s, p);
}
}
#ifdef DEBUG_MODE
namespace dbg {
using namespace cfg;
__global__ void k_cmp_f32_bf16(const float* __restrict__ A, const unsigned short* __restrict__ R, size_t n, float* __restrict__ res) {
    float d2 = 0.f, r2 = 0.f;
    for (size_t i = (size_t)blockIdx.x * 256 + threadIdx.x; i < n; i += (size_t)gridDim.x * 256) { const float r = __uint_as_float((unsigned)R[i] << 16), a = A[i]; d2 += (a - r) * (a - r); r2 += r * r; }
    for (int o = 32; o >= 1; o >>= 1) { d2 += __shfl_xor(d2, o); r2 += __shfl_xor(r2, o); }
    if ((threadIdx.x & 63) == 0) { atomicAdd(res, d2); atomicAdd(res + 1, r2); }
}
__global__ void k_cmp_bf16_f32(const unsigned short* __restrict__ A, int fp, int fo, const float* __restrict__ R, int rp, int ro, int nrows, int ncols, float rscale, float* __restrict__ res) {
    float d2 = 0.f, r2 = 0.f;
    for (size_t i = (size_t)blockIdx.x * 256 + threadIdx.x; i < (size_t)nrows * ncols; i += (size_t)gridDim.x * 256) { const int row = (int)(i / ncols), c = (int)(i % ncols);
        const float a = __uint_as_float((unsigned)A[(size_t)row * fp + fo + c] << 16), r = R[(size_t)row * rp + ro + c] * rscale; d2 += (a - r) * (a - r); r2 += r * r; }
    for (int o = 32; o >= 1; o >>= 1) { d2 += __shfl_xor(d2, o); r2 += __shfl_xor(r2, o); }
    if ((threadIdx.x & 63) == 0) { atomicAdd(res, d2); atomicAdd(res + 1, r2); }
}
__global__ void k_cmp_f32_f32(const float* __restrict__ A, int fp, int fo, const float* __restrict__ R, int rp, int ro, int nrows, int ncols, float* __restrict__ res) {
    float d2 = 0.f, r2 = 0.f;
    for (size_t i = (size_t)blockIdx.x * 256 + threadIdx.x; i < (size_t)nrows * ncols; i += (size_t)gridDim.x * 256) { const int row = (int)(i / ncols), c = (int)(i % ncols);
        const float a = A[(size_t)row * fp + fo + c], r = R[(size_t)row * rp + ro + c]; d2 += (a - r) * (a - r); r2 += r * r; }
    for (int o = 32; o >= 1; o >>= 1) { d2 += __shfl_xor(d2, o); r2 += __shfl_xor(r2, o); }
    if ((threadIdx.x & 63) == 0) { atomicAdd(res, d2); atomicAdd(res + 1, r2); }
}
__global__ void k_decide(const float* __restrict__ res, int nchk, float tol, float* __restrict__ out, size_t nout) {
    int code = 0; float frac = 0.f;
    for (int k = 0; k < nchk; ++k) { const float err = res[2 * k] / res[2 * k + 1]; if (!(err <= tol)) { code = k + 1; float l = (err == err && err > 0.f) ? log10f(err) : 0.f; frac = fminf(fmaxf((l + 4.f) / 4.f * 0.9f, 0.f), 0.9f); break; } }
    if (code == 0) return;
    const float c = sqrtf((float)code + frac);
    for (size_t i = (size_t)blockIdx.x * 256 + threadIdx.x; i < nout; i += (size_t)gridDim.x * 256) out[i] = c;
}
}
#endif

static nv::NaiveWs carve_naive(char* base, size_t& off) {
    using namespace cfg;
    nv::NaiveWs w{};
    auto take = [&](size_t nfloats) { float* p = (float*)(base + off); off += ((nfloats * 4 + 255) / 256) * 256; return p; };
    w.MOD = take((size_t)DEPTH * 5 * MODW);
    w.X = take((size_t)NTOK * D); w.H = take((size_t)NTOK * D); w.P = take((size_t)NTOK * ODD_IN); w.MIX = take((size_t)NTOK * D);
    w.T0 = take((size_t)NTOK * 512); w.T1 = take((size_t)NTOK * 3072); w.T2 = take((size_t)NTOK * 2048);
    w.FOUT = take((size_t)NTOK * D); w.HID = take((size_t)NTOK * FFE);
    w.lam = take(64); w.cnt = (int*)take(64); w.list_tok = (int*)take((size_t)NEXP * NTOK); w.list_w = take((size_t)NEXP * NTOK);
    return w;
}
extern "C" void kernel_launch(void* const* d_in, const int* in_sizes, int n_in, void* d_out, int out_size, void* d_ws, size_t ws_size, hipStream_t stream) {
    using namespace cfg;
    if (n_in != 31 || out_size != NLAT * D) { fprintf(stderr, "kernel_launch: unexpected n_in %d / out_size %d\n", n_in, out_size); return; }
    fk::Params p{}; for (int i = 0; i < 31; ++i) p.in[i] = (const float*)d_in[i];
    p.out = (float*)d_out; p.ws = (unsigned char*)d_ws;
#ifdef DEBUG_MODE
    const size_t snap_bytes = (size_t)NTOK * D * 2, CK_BYTES = 8 * snap_bytes + (size_t)NLAT * D * 4 + 4096;
    if (ws_size < fk::WS_END + CK_BYTES) { fprintf(stderr, "kernel_launch(debug): workspace too small\n"); return; }
    char* ckb = (char*)d_ws + ws_size - CK_BYTES; ckb -= ((size_t)ckb & 255);
    unsigned short* snaps = (unsigned short*)ckb; float* nout = (float*)(ckb + 8 * snap_bytes); float* res = (float*)(ckb + 8 * snap_bytes + (size_t)NLAT * D * 4);
    {
        nv::Inputs in{}; for (int i = 0; i < 31; ++i) in.p[i] = (const float*)d_in[i];
        size_t off = 0; nv::NaiveWs w = carve_naive((char*)d_ws, off);
        if ((char*)d_ws + off > ckb) { fprintf(stderr, "kernel_launch(debug): oracle scratch overlaps snapshots\n"); return; }
        nv::run_naive(in, w, nout, snaps, stream);
    }
    (void)hipMemsetAsync(res, 0, 4096, stream);
    (void)hipMemsetAsync((char*)d_ws + fk::WS_CTL, 0, fk::CTL_BYTES, stream);
    int chk = 0;
    for (int ph = 0; ph < fk::NPHASE; ++ph) {
        fk::launch_fused(p, ph, ph + 1, stream);
        if (ph == 0) continue;
        const int lp = (ph - 1) / fk::NPH_PAIR, k = (ph - 1) % fk::NPH_PAIR;
        int snap = -1;
        if (k == 4) snap = 4 * lp + 0; else if (k == 7) snap = 4 * lp + 1; else if (k == 14) snap = 4 * lp + 2; else if (k == 19 && lp == 0) snap = 3;
        if (snap >= 0) { hipLaunchKernelGGL(dbg::k_cmp_f32_bf16, dim3(2048), dim3(256), 0, stream, (const float*)((char*)d_ws + fk::WS_X), snaps + (size_t)snap * NTOK * D, (size_t)NTOK * D, res + 2 * chk); ++chk; }
    }
    hipLaunchKernelGGL(dbg::k_cmp_f32_f32, dim3(2048), dim3(256), 0, stream, (const float*)d_out, D, 0, (const float*)nout, D, 0, NLAT, D, res + 2 * chk); ++chk;
    hipLaunchKernelGGL(dbg::k_decide, dim3(1024), dim3(256), 0, stream, (const float*)res, chk, DEBUG_TOL, (float*)d_out, (size_t)NLAT * D);
#else
    if (ws_size < fk::WS_END) { fprintf(stderr, "kernel_launch: workspace too small: need %zu have %zu\n", (size_t)fk::WS_END, ws_size); return; }
    (void)hipMemsetAsync((char*)d_ws + fk::WS_CTL, 0, fk::CTL_BYTES, stream);
    fk::launch_fused(p, 0, fk::NPHASE, stream);
#endif
}
```

```cpp
#include <hip/hip_runtime.h>
#include <cstdio>
#include <cstdint>
#include <cmath>
namespace cfg {
constexpr int D = 1024, B = 4, SEQ = 4096, CTX = 256, DEPTH = 4;
constexpr int NLAT = B * SEQ, NCTX = B * CTX, NTOK = NLAT + NCTX;
constexpr int NMOD = 6, MODW = NMOD * D;
constexpr int EVEN_IN = 2560, ODD_IN = 4128, FFN = 2816, FFE = 3584, NEXP = 8;
}
namespace nv {
using namespace cfg;
struct NaiveWs { float *MOD, *X, *H, *P, *MIX, *T0, *T1, *T2, *FOUT, *HID, *lam; int* cnt; int* list_tok; float* list_w; };
}
namespace pg8 {
#define PG8_LAS __attribute__((address_space(3)))
typedef unsigned short bf16_t;
typedef short bf16x8 __attribute__((ext_vector_type(8)));
typedef float f32x4 __attribute__((ext_vector_type(4)));
typedef unsigned u32x4 __attribute__((ext_vector_type(4)));
constexpr int BM = 256, BK = 64, HALF = 128, HTB = HALF * BK * 2  , STAGE_BYTES = 8 * HTB, NXCD = 8, WGM = 8;

__host__ __device__ __forceinline__ int lds_byte(int r, int c) { const int st = (r >> 4) * 2 + (c >> 5), rr = r & 15, cc = c & 31, ob = rr * 64 + cc * 2; return st * 1024 + (ob ^ (((ob >> 9) & 1) << 5)); }
__host__ __device__ __forceinline__ void stage_rc(int b, int& R, int& C) { const int st = b / 1024, sb = b % 1024, swz = sb ^ (((sb >> 9) & 1) << 5); R = (st >> 1) * 16 + swz / 64; C = (st & 1) * 32 + (swz % 64) / 2; }
__host__ __device__ __forceinline__ int perm32(int rho) { const int n = rho >> 4, i = rho & 15; return 8 * (i >> 2) + 4 * n + (i & 3); }

struct Unit { int pm, pn, pk; };
struct Gemm { const bf16_t* A; const bf16_t* Bt; int M, N, K, Kh; };

struct StaticOrder {
    int nM, nN, nwg, G, c;
    int lim, L0, s;
    __host__ __device__ void init(int M, int N, int G_, int c_) { nM = M / BM; nN = N / BM; nwg = nM * nN; G = G_; c = c_; lim = nwg; L0 = 0; s = 1; }
    __host__ __device__ void decode(int wgid, Unit& u) const {
        { const int q = nwg / NXCD, r = nwg % NXCD, xcd = wgid % NXCD, off = wgid / NXCD; wgid = (xcd < r ? xcd * (q + 1) : r * (q + 1) + (xcd - r) * q) + off; }
        const int nig = WGM * nN, gid = wgid / nig, fm = gid * WGM, gsz = (nM - fm) < WGM ? (nM - fm) : WGM;
        u.pm = fm + ((wgid % nig) % gsz); u.pn = (wgid % nig) / gsz;
    }
    __host__ __device__ bool next(int i, Unit& u) const {
        const long j = (long)i * G + c; if (j >= lim) return false;
        u.pk = (int)(j % s); decode(L0 + (int)(j / s), u); return true;
    }
    __host__ __device__ void main_part() { lim = (nwg / G) * G; L0 = 0; s = 1; }
    __host__ __device__ void tail_part(int s_) { L0 = (nwg / G) * G; s = s_; lim = (nwg - L0) * s_; }
    __host__ __device__ int tail_tiles() const { return nwg - (nwg / G) * G; }
    __device__ __forceinline__ void a_ready(const Unit&) const {}
    __device__ __forceinline__ void done(const Unit&) const {}
};
template <class Epi, class Sched>
__device__ __forceinline__ void gemm_phase(PG8_LAS unsigned char* lds, const Gemm g, const Sched& S, const Epi& E, const int tid) {
    const int wid = __builtin_amdgcn_readfirstlane(tid >> 6), lane = tid & 63, wr = wid >> 2, wc = wid & 3, fr = lane & 15, fq = lane >> 4;
    const int K = g.K, Kh = g.Kh ? g.Kh : g.K, nt = Kh / BK;
    unsigned voffA[2], voffB[2];
#pragma unroll
    for (int i = 0; i < 2; ++i) { int R, C; stage_rc(tid * 16 + i * 8192, R, C); const int Rb = Epi::PERM ? ((R & ~31) + perm32(R & 31)) : R;
        voffA[i] = (unsigned)(R * K + C) * 2u; voffB[i] = (unsigned)(Rb * K + C) * 2u; }
    const size_t kstep = (size_t)(BK * 2);
    const size_t hstep = (size_t)HALF * K * 2;
    const size_t tstep = 2 * hstep;
    const unsigned ldsw = (unsigned)wid * 1024u;
    const int aoff = lds_byte(wr * 64 + fr, fq * 8), boff = lds_byte(wc * 32 + fr, fq * 8);
#define PG8_SA(b, h) (((b) * 2 + (h)) * HTB)
#define PG8_SB(b, h) ((4 + (b) * 2 + (h)) * HTB)
#define PG8_STAGE(bufoff, gbase, voff) do { _Pragma("unroll") for (int _i = 0; _i < 2; ++_i) \
        __builtin_amdgcn_global_load_lds((const unsigned*)((const char*)(gbase) + (voff)[_i]), (PG8_LAS unsigned*)(lds + (bufoff) + ldsw + _i * 8192), 16, 0, 0); } while (0)
#define PG8_LDA(dst, b, h) do { _Pragma("unroll") for (int m = 0; m < 4; ++m) _Pragma("unroll") for (int k = 0; k < 2; ++k) dst[m][k] = *(const PG8_LAS bf16x8*)(lds + PG8_SA(b, h) + aoff + m * 2048 + k * 1024); } while (0)
#define PG8_LDB(dst, b, h) do { _Pragma("unroll") for (int n = 0; n < 2; ++n) _Pragma("unroll") for (int k = 0; k < 2; ++k) dst[n][k] = *(const PG8_LAS bf16x8*)(lds + PG8_SB(b, h) + boff + n * 2048 + k * 1024); } while (0)
#define PG8_MMA(ai, bj, At, Bt) do { __builtin_amdgcn_s_setprio(1); _Pragma("unroll") for (int m = 0; m < 4; ++m) _Pragma("unroll") for (int n = 0; n < 2; ++n) _Pragma("unroll") for (int k = 0; k < 2; ++k) \
        acc[ai][bj][m][n] = __builtin_amdgcn_mfma_f32_16x16x32_bf16(Bt[n][k], At[m][k], acc[ai][bj][m][n], 0, 0, 0); __builtin_amdgcn_s_setprio(0); } while (0)
#define PG8_WAIT_V(n) asm volatile("s_waitcnt vmcnt(" #n ")" ::: "memory")
#define PG8_WAIT_L(n) asm volatile("s_waitcnt lgkmcnt(" #n ")" ::: "memory")
#define PG8_BAR __builtin_amdgcn_s_barrier()
#define PG8_SCHED __builtin_amdgcn_sched_barrier(0)
    Unit cur, nxt; int ui = 0;
    if (!S.next(0, cur)) return;
    f32x4 acc[2][2][4][2];
#pragma unroll
    for (int a = 0; a < 2; ++a)
#pragma unroll
        for (int b = 0; b < 2; ++b)
#pragma unroll
            for (int m = 0; m < 4; ++m)
#pragma unroll
                for (int n = 0; n < 2; ++n) acc[a][b][m][n] = (f32x4){0.f, 0.f, 0.f, 0.f};
    bf16x8 At[4][2], B0[2][2], B1[2][2];
    const char* cA = (const char*)g.A + (size_t)cur.pm * tstep + (size_t)cur.pk * Kh * 2; const char* cB = (const char*)g.Bt + (size_t)cur.pn * tstep + (size_t)cur.pk * Kh * 2;
    S.a_ready(cur);
    PG8_STAGE(PG8_SB(0, 0), cB, voffB); PG8_STAGE(PG8_SA(0, 0), cA, voffA); PG8_STAGE(PG8_SB(0, 1), cB + hstep, voffB); PG8_STAGE(PG8_SA(0, 1), cA + hstep, voffA);
    if (wr == 1) PG8_BAR;
    PG8_WAIT_V(4); PG8_BAR;
    PG8_STAGE(PG8_SB(1, 0), cB + kstep, voffB); PG8_STAGE(PG8_SA(1, 0), cA + kstep, voffA); PG8_STAGE(PG8_SB(1, 1), cB + hstep + kstep, voffB);
    PG8_WAIT_V(6); PG8_BAR;
    for (;;) {
        const bool has_next = S.next(ui + 1, nxt);
        const char* nA = has_next ? (const char*)g.A + (size_t)nxt.pm * tstep + (size_t)nxt.pk * Kh * 2 : cA; const char* nB = has_next ? (const char*)g.Bt + (size_t)nxt.pn * tstep + (size_t)nxt.pk * Kh * 2 : cB;
        for (int t = 0; t < nt; t += 2) {
            const bool last = (t == nt - 2);
            const char* a1 = cA + (size_t)(t + 1) * kstep;
            const char* a2 = last ? nA : cA + (size_t)(t + 2) * kstep; const char* b2 = last ? nB : cB + (size_t)(t + 2) * kstep;
            const char* a3 = a2 + kstep; const char* b3 = b2 + kstep;
            if (last && has_next) S.a_ready(nxt);
            PG8_LDB(B0, 0, 0); PG8_SCHED; PG8_LDA(At, 0, 0); PG8_STAGE(PG8_SA(1, 1), a1 + hstep, voffA);
            PG8_WAIT_L(8); PG8_BAR; PG8_WAIT_L(0); PG8_MMA(0, 0, At, B0); PG8_BAR; PG8_SCHED;
            PG8_LDB(B1, 0, 1); PG8_STAGE(PG8_SB(0, 0), b2, voffB);
            PG8_BAR; PG8_WAIT_L(0); PG8_MMA(0, 1, At, B1); PG8_BAR;
            PG8_LDA(At, 0, 1); PG8_STAGE(PG8_SA(0, 0), a2, voffA);
            PG8_BAR; PG8_WAIT_L(0); PG8_MMA(1, 0, At, B0); PG8_BAR; PG8_SCHED;
            PG8_STAGE(PG8_SB(0, 1), b2 + hstep, voffB);
            PG8_WAIT_V(6); PG8_BAR; PG8_MMA(1, 1, At, B1); PG8_BAR;
            PG8_LDB(B0, 1, 0); PG8_SCHED; PG8_LDA(At, 1, 0); PG8_STAGE(PG8_SA(0, 1), a2 + hstep, voffA);
            PG8_WAIT_L(8); PG8_BAR; PG8_WAIT_L(0); PG8_MMA(0, 0, At, B0); PG8_BAR; PG8_SCHED;
            PG8_LDB(B1, 1, 1); PG8_STAGE(PG8_SB(1, 0), b3, voffB);
            PG8_BAR; PG8_WAIT_L(0); PG8_MMA(0, 1, At, B1); PG8_BAR;
            PG8_LDA(At, 1, 1); PG8_STAGE(PG8_SA(1, 0), a3, voffA);
            PG8_BAR; PG8_WAIT_L(0); PG8_MMA(1, 0, At, B0); PG8_BAR; PG8_SCHED;
            PG8_STAGE(PG8_SB(1, 1), b3 + hstep, voffB);
            PG8_WAIT_V(6); PG8_BAR; PG8_MMA(1, 1, At, B1); PG8_BAR;
        }
        if constexpr (!Epi::AFTER_DRAIN) { E(acc, cur, wr, wc, fr, fq); S.done(cur); }
        if (!has_next) break;
#pragma unroll
        for (int a = 0; a < 2; ++a)
#pragma unroll
            for (int b = 0; b < 2; ++b)
#pragma unroll
                for (int m = 0; m < 4; ++m)
#pragma unroll
                    for (int n = 0; n < 2; ++n) acc[a][b][m][n] = (f32x4){0.f, 0.f, 0.f, 0.f};
        cur = nxt; cA = nA; cB = nB; ++ui;
    }
    PG8_WAIT_V(0);
    if (wr == 0) PG8_BAR;
    PG8_BAR;
    if constexpr (Epi::AFTER_DRAIN) { E.fused(acc, cur, wr, wc, fr, fq, lds, wid, lane); S.done(cur); }
#undef PG8_SA
#undef PG8_SB
#undef PG8_STAGE
#undef PG8_LDA
#undef PG8_LDB
#undef PG8_MMA
#undef PG8_WAIT_V
#undef PG8_WAIT_L
#undef PG8_BAR
#undef PG8_SCHED
}
}
namespace fk {
using namespace cfg;
#define LAS __attribute__((address_space(3)))
typedef unsigned short bf16;
typedef short bf16x8 __attribute__((ext_vector_type(8)));
typedef short s16x4 __attribute__((ext_vector_type(4)));
typedef float f32x4 __attribute__((ext_vector_type(4)));
typedef float f32x2 __attribute__((ext_vector_type(2)));
typedef float f32x16 __attribute__((ext_vector_type(16)));
typedef unsigned u32x4 __attribute__((ext_vector_type(4)));
typedef unsigned u32x2 __attribute__((ext_vector_type(2)));
typedef __bf16 bf16x2_t __attribute__((ext_vector_type(2)));
#define DI __device__ __forceinline__
#define MFMA32(a, b, c) __builtin_amdgcn_mfma_f32_32x32x16_bf16((a), (b), (c), 0, 0, 0)

DI unsigned pk2(float a, float b) { f32x2 f = {a, b}; bf16x2_t r = __builtin_convertvector(f, bf16x2_t); return __builtin_bit_cast(unsigned, r); }
DI bf16 f2bf(float a) { return (bf16)(pk2(a, 0.f) & 0xffffu); }
DI float bf2f(bf16 v) { return __builtin_bit_cast(float, (unsigned)v << 16); }
DI float bflo(unsigned w) { return __builtin_bit_cast(float, w << 16); }
DI float bfhi(unsigned w) { return __builtin_bit_cast(float, w & 0xffff0000u); }
DI float sigmoid_(float x) { return 1.f / (1.f + __expf(-x)); }
DI float silu_(float x) { return x / (1.f + __expf(-x)); }
DI float softplus_(float x) { return fmaxf(x, 0.f) + log1pf(expf(-fabsf(x))); }
DI float gelu_tanh_(float x) { const float u = 0.7978845608028654f * (x + 0.044715f * x * x * x); const float e = __expf(2.f * u); return x * (1.f - 1.f / (e + 1.f)); }
DI int crow(int reg, int h) { return (reg & 3) + 8 * (reg >> 2) + 4 * h; }
DI f32x16 zero16() { f32x16 z; for (int i = 0; i < 16; ++i) z[i] = 0.f; return z; }
DI bf16x8 pack_step(const f32x16& x, int s) {
    u32x4 p; p[0] = pk2(x[8 * s], x[8 * s + 1]); p[1] = pk2(x[8 * s + 2], x[8 * s + 3]); p[2] = pk2(x[8 * s + 4], x[8 * s + 5]); p[3] = pk2(x[8 * s + 6], x[8 * s + 7]);
    return __builtin_bit_cast(bf16x8, p);
}
DI bf16x8 ld_perm_frag(const LAS bf16* rowp, int kbase, int s, int h) {
    const s16x4 lo = *(const LAS s16x4*)(rowp + kbase + 16 * s + 4 * h);
    const s16x4 hi = *(const LAS s16x4*)(rowp + kbase + 16 * s + 8 + 4 * h);
    return __builtin_shufflevector(lo, hi, 0, 1, 2, 3, 4, 5, 6, 7);
}
DI float shx(float v, int o, int lane) { return __builtin_bit_cast(float, __builtin_amdgcn_ds_bpermute((lane ^ o) << 2, __builtin_bit_cast(int, v))); }
DI float wave_sum(float v, int lane) {
#pragma unroll
    for (int o = 1; o < 64; o <<= 1) v += shx(v, o, lane);
    return v;
}

constexpr size_t al256(size_t x) { return (x + 255) / 256 * 256; }
constexpr int RMAX = 36864;
constexpr int NCH = NTOK / 64;
constexpr int NCHD = NCH * 8 * 2;
constexpr size_t WS_CTL = 0, CTL_BYTES = 1u << 20;
constexpr size_t WS_MOD = CTL_BYTES;
constexpr size_t WS_COS = WS_MOD + al256((size_t)DEPTH * 5 * MODW * 4);
constexpr size_t WS_SIN = WS_COS + (size_t)SEQ * 32 * 4;
constexpr size_t WS_WEIN = WS_SIN + (size_t)SEQ * 32 * 4;
constexpr size_t WS_WEOUT = WS_WEIN + (size_t)2 * 2560 * 1024 * 2;
constexpr size_t WS_WEF1 = WS_WEOUT + (size_t)2 * 1024 * 1024 * 2;
constexpr size_t WS_WEF2 = WS_WEF1 + (size_t)2 * 5632 * 1024 * 2;
constexpr size_t WS_WOIN = WS_WEF2 + (size_t)2 * 1024 * 2816 * 2;
constexpr size_t WS_WOOUT = WS_WOIN + (size_t)2 * 4352 * 1024 * 2;
constexpr size_t WS_WXIN = WS_WOOUT + (size_t)2 * 1024 * 1024 * 2;
constexpr size_t WS_WXOUT = WS_WXIN + (size_t)2 * 8 * 7168 * 1024 * 2;
constexpr size_t WS_X = WS_WXOUT + (size_t)2 * 8 * 1024 * 3584 * 2;
constexpr size_t WS_H = WS_X + (size_t)NTOK * D * 4;
constexpr size_t WS_MIX = WS_H + (size_t)NTOK * D * 2;
constexpr size_t WS_P = WS_MIX + (size_t)NTOK * D * 2;
constexpr size_t WS_HS1 = WS_P + (size_t)NTOK * 4352 * 2;
constexpr size_t WS_U = WS_HS1 + (size_t)NTOK * 512 * 4;
constexpr size_t WS_PART = WS_U + (size_t)400 * 1024 * 1024;
constexpr size_t WS_RGA = WS_U;
constexpr size_t WS_RGU = WS_RGA + (size_t)2 * NTOK * 512 * 4;
constexpr size_t WS_QKVN = WS_U;
constexpr size_t WS_WG = WS_QKVN + (size_t)NTOK * 3072 * 2;
constexpr size_t WS_UG = WS_WG + (size_t)NCHD * 64 * 128 * 2;
constexpr size_t WS_QKD = WS_UG + (size_t)NCHD * 64 * 128 * 4;
constexpr size_t WS_SC = WS_QKD + (size_t)NCHD * 64 * 64 * 2;
constexpr size_t WS_KTG = WS_SC + (size_t)NCHD * 192 * 4;
constexpr size_t WS_OG = WS_KTG + (size_t)NCHD * 128 * 64 * 2;
constexpr size_t WS_U_END1 = WS_OG + (size_t)2 * NTOK * D * 4;
constexpr size_t WS_XS = WS_U;
constexpr size_t WS_HIDM = WS_XS + (size_t)RMAX * D * 2;
constexpr size_t WS_Y = WS_HIDM + (size_t)RMAX * FFE * 2;
constexpr size_t WS_YP = WS_Y + (size_t)RMAX * D * 4;
constexpr size_t WS_U_END2 = WS_YP + (size_t)64 * 256 * D * 4;
constexpr size_t WS_TOK = (WS_U_END1 > WS_U_END2 ? WS_U_END1 : WS_U_END2);
constexpr size_t WS_END = WS_TOK + (size_t)NTOK * 32;
constexpr size_t WS_AB = WS_HS1;
constexpr size_t WS_GB = WS_AB + (size_t)NTOK * 32 * 4;

constexpr int CW_BAR = 4096;
constexpr int CW_CNT = 8192;
constexpr int CW_Q = 8448;

constexpr int LDS_BYTES = 152 * 1024;
constexpr int LDS_MISC = LDS_BYTES - 256;

struct Params { const float* in[31]; float* out; unsigned char* ws; int ph_lo, ph_hi; int dbg0, dbg1; };

struct Ctx {
    LAS unsigned char* lds;
    unsigned char* ws; unsigned char* ws0;
    int tid, lane, wave, nblk, blk, wave0;
};
#define XB_TMO      128
#define XB_XCNT(j)  (256  + 64 * (j))
#define XB_XSUB(j)  (1280 + 64 * (j))
#define XB_XGEN(j)  (2304 + 64 * (j))
#define XB_TOP      3328
#define XB_TOPGEN   3392
#define XCD_BAR_WORDS 3456
#define XB_SPIN_CAP (1u << 27)

__device__ __forceinline__ unsigned xb_ld(unsigned* p)              { return __hip_atomic_load(p, __ATOMIC_RELAXED, __HIP_MEMORY_SCOPE_AGENT); }
__device__ __forceinline__ unsigned xb_add(unsigned* p, unsigned v) { return __hip_atomic_fetch_add(p, v, __ATOMIC_RELAXED, __HIP_MEMORY_SCOPE_AGENT); }
__device__ __forceinline__ unsigned xb_xcc_id() { return (unsigned)__builtin_amdgcn_s_getreg((3 << 11) | 20) & 0xFu; }
#define XB_SPIN(cond, bar) do { unsigned _sp = 0; while (cond) { __builtin_amdgcn_s_sleep(1); \
    if ((++_sp & 255u) == 0u) { if (xb_ld(&(bar)[XB_TMO])) break; if (_sp > XB_SPIN_CAP) { atomicAdd(&(bar)[XB_TMO], 1u); break; } } } } while (0)

struct XcdBarrier {
    unsigned* bar; unsigned x;
    volatile LAS unsigned* st;
};

__device__ __forceinline__ XcdBarrier xcd_barrier_post(unsigned* bar, volatile LAS unsigned* st) {
    XcdBarrier b; b.bar = bar; b.x = xb_xcc_id(); b.st = st;
    if (threadIdx.x == 0) (void)xb_add(&bar[XB_XCNT(b.x)], 1u);
    return b;
}
__device__ __forceinline__ void xcd_barrier_complete(unsigned* bar, unsigned x, unsigned& nloc, unsigned& nx) {
    const unsigned G = gridDim.x * gridDim.y * gridDim.z;
    unsigned sum, cnt, mine, sp = 0u;
    for (;;) {
        sum = 0u; cnt = 0u; mine = 0u;
#pragma unroll
        for (unsigned j = 0; j < 16; ++j) { const unsigned c = xb_ld(&bar[XB_XCNT(j)]); sum += c; cnt += (c > 0u) ? 1u : 0u; mine = (j == x) ? c : mine; }
        if (sum == G) break;
        __builtin_amdgcn_s_sleep(1);
        if ((++sp & 255u) == 0u) { if (xb_ld(&bar[XB_TMO])) break; if (sp > XB_SPIN_CAP) { atomicAdd(&bar[XB_TMO], 1u); break; } }
    }
    nloc = mine > 0u ? mine : 1u; nx = cnt > 0u ? cnt : 1u;
}

__device__ __forceinline__ void xcd_barrier(const XcdBarrier& b) {
    asm volatile("s_waitcnt vmcnt(0)" ::: "memory");
    __syncthreads();
    if (threadIdx.x == 0) {
        unsigned* bar = b.bar;
        __builtin_amdgcn_s_waitcnt(0);
        unsigned nloc = b.st[0], nx = b.st[1];
        if (nloc == 0u) { xcd_barrier_complete(bar, b.x, nloc, nx); b.st[0] = nloc; b.st[1] = nx; }
        const unsigned old = xb_add(&bar[XB_XSUB(b.x)], 1u);
        const unsigned gen = old / nloc;
        if (old + 1u == (gen + 1u) * nloc) {
            __builtin_amdgcn_fence(__ATOMIC_RELEASE, "agent");
            asm volatile("s_waitcnt vmcnt(0)" ::: "memory");
            const unsigned og = xb_add(&bar[XB_TOP], 1u);
            const unsigned tg = og / nx;
            if (og + 1u == (tg + 1u) * nx) xb_add(&bar[XB_TOPGEN], 1u);
            else XB_SPIN(xb_ld(&bar[XB_TOPGEN]) == tg, bar);
            __builtin_amdgcn_fence(__ATOMIC_ACQUIRE, "agent");
            xb_add(&bar[XB_XGEN(b.x)], 1u);
            asm volatile("s_waitcnt vmcnt(0)" ::: "memory");
        } else {
            XB_SPIN(xb_ld(&bar[XB_XGEN(b.x)]) == gen, bar);
            __builtin_amdgcn_fence(__ATOMIC_ACQUIRE, "agent");
            asm volatile("s_waitcnt vmcnt(0)" ::: "memory");
        }
    }
    __syncthreads();
}

using pg8::Unit;
typedef pg8::f32x4 af4;

struct EpiEvenIn {
    static constexpr bool PERM = true, AFTER_DRAIN = false;
    bf16* P; const float* cosT; const float* sinT;
    DI void operator()(const af4 (&acc)[2][2][4][2], const Unit& u, int wr, int wc, int fr, int fq) const {
        const int row0 = u.pm * 256 + wr * 64 + fr, col0 = u.pn * 256 + wc * 32 + 8 * fq;
        const bool rope = (u.pn < 4) && (u.pm < 64);
        const float qs = (u.pn < 2) ? 0.18033688011112042f : 1.f;
#pragma unroll
        for (int ai = 0; ai < 2; ++ai)
#pragma unroll
            for (int m = 0; m < 4; ++m) {
                const int row = row0 + ai * 128 + m * 16;
                bf16* rowp = P + (size_t)row * EVEN_IN + col0;
#pragma unroll
                for (int bj = 0; bj < 2; ++bj) {
                    af4 v0 = acc[ai][bj][m][0], v1 = acc[ai][bj][m][1];
                    if (rope) {
                        const int t = row & 4095, i0 = ((col0 + bj * 128) & 63) >> 1;
                        const af4 cs = *(const af4*)(cosT + t * 32 + i0), sn = *(const af4*)(sinT + t * 32 + i0);
                        af4 o0, o1;
                        o0[0] = v0[0] * cs[0] - v0[1] * sn[0]; o0[1] = v0[0] * sn[0] + v0[1] * cs[0];
                        o0[2] = v0[2] * cs[1] - v0[3] * sn[1]; o0[3] = v0[2] * sn[1] + v0[3] * cs[1];
                        o1[0] = v1[0] * cs[2] - v1[1] * sn[2]; o1[1] = v1[0] * sn[2] + v1[1] * cs[2];
                        o1[2] = v1[2] * cs[3] - v1[3] * sn[3]; o1[3] = v1[2] * sn[3] + v1[3] * cs[3];
                        v0 = o0; v1 = o1;
                    }
                    v0 = v0 * qs; v1 = v1 * qs;
                    u32x4 w; w[0] = pk2(v0[0], v0[1]); w[1] = pk2(v0[2], v0[3]); w[2] = pk2(v1[0], v1[1]); w[3] = pk2(v1[2], v1[3]);
                    *(u32x4*)(rowp + bj * 128) = w;
                }
            }
    }
};
struct EpiBf16Ab {
    static constexpr bool PERM = true, AFTER_DRAIN = false;
    bf16* O; int ldc; float* AB; int ab_pn;
    DI void operator()(const af4 (&acc)[2][2][4][2], const Unit& u, int wr, int wc, int fr, int fq) const {
        const int row0 = u.pm * 256 + wr * 64 + fr, col0 = u.pn * 256 + wc * 32 + 8 * fq;
        if (u.pn == ab_pn) {
            if (wc == 0) {
#pragma unroll
                for (int ai = 0; ai < 2; ++ai)
#pragma unroll
                    for (int m = 0; m < 4; ++m) { float* ap = AB + (size_t)(row0 + ai * 128 + m * 16) * 32 + 8 * fq; *(af4*)ap = acc[ai][0][m][0]; *(af4*)(ap + 4) = acc[ai][0][m][1]; }
            }
            return;
        }
#pragma unroll
        for (int ai = 0; ai < 2; ++ai)
#pragma unroll
            for (int m = 0; m < 4; ++m) {
                bf16* rowp = O + (size_t)(row0 + ai * 128 + m * 16) * ldc + col0;
#pragma unroll
                for (int bj = 0; bj < 2; ++bj) { const af4 v0 = acc[ai][bj][m][0], v1 = acc[ai][bj][m][1];
                    u32x4 w; w[0] = pk2(v0[0], v0[1]); w[1] = pk2(v0[2], v0[3]); w[2] = pk2(v1[0], v1[1]); w[3] = pk2(v1[2], v1[3]);
                    *(u32x4*)(rowp + bj * 128) = w; }
            }
    }
};
struct EpiSwiglu {
    static constexpr bool PERM = true, AFTER_DRAIN = false;
    bf16* O; int ldc; int nN;
    DI void operator()(const af4 (&acc)[2][2][4][2], const Unit& u, int wr, int wc, int fr, int fq) const {
        const int row0 = u.pm * 256 + wr * 64 + fr, col0 = (u.pn % nN) * 128 + wc * 32 + 8 * fq;
#pragma unroll
        for (int ai = 0; ai < 2; ++ai)
#pragma unroll
            for (int m = 0; m < 4; ++m) {
                const af4 g0 = acc[ai][0][m][0], g1 = acc[ai][0][m][1], u0 = acc[ai][1][m][0], u1 = acc[ai][1][m][1];
                float r[8];
#pragma unroll
                for (int j = 0; j < 4; ++j) { r[j] = silu_(g0[j]) * u0[j]; r[4 + j] = silu_(g1[j]) * u1[j]; }
                u32x4 w; w[0] = pk2(r[0], r[1]); w[1] = pk2(r[2], r[3]); w[2] = pk2(r[4], r[5]); w[3] = pk2(r[6], r[7]);
                *(u32x4*)(O + (size_t)(row0 + ai * 128 + m * 16) * ldc + col0) = w;
            }
    }
};
struct EpiResid {
    static constexpr bool PERM = false, AFTER_DRAIN = false;
    float* X; const float* gate;
    DI void operator()(const af4 (&acc)[2][2][4][2], const Unit& u, int wr, int wc, int fr, int fq) const {
        const int row0 = u.pm * 256 + wr * 64 + fr, col0 = u.pn * 256 + wc * 32 + 4 * fq;
        const float* gv = gate + (size_t)(u.pm < 64 ? (u.pm >> 4) : 4) * MODW + col0;
        af4 g[2][2];
#pragma unroll
        for (int bj = 0; bj < 2; ++bj)
#pragma unroll
            for (int n = 0; n < 2; ++n) g[bj][n] = *(const af4*)(gv + bj * 128 + n * 16);
#pragma unroll
        for (int ai = 0; ai < 2; ++ai)
#pragma unroll
            for (int m = 0; m < 4; ++m) { float* rowp = X + (size_t)(row0 + ai * 128 + m * 16) * D + col0;
#pragma unroll
                for (int bj = 0; bj < 2; ++bj)
#pragma unroll
                    for (int n = 0; n < 2; ++n) { af4* p = (af4*)(rowp + bj * 128 + n * 16); *p = *p + g[bj][n] * acc[ai][bj][m][n]; } }
    }
};
struct EpiPart {
    static constexpr bool PERM = false, AFTER_DRAIN = false;
    float* PART;
    DI void operator()(const af4 (&acc)[2][2][4][2], const Unit& u, int wr, int wc, int fr, int fq) const {
        const int row0 = u.pm * 256 + wr * 64 + fr, col0 = u.pn * 256 + wc * 32 + 4 * fq;
        float* base = PART + (size_t)u.pk * NCTX * D;
#pragma unroll
        for (int ai = 0; ai < 2; ++ai)
#pragma unroll
            for (int m = 0; m < 4; ++m) { float* rowp = base + (size_t)(row0 + ai * 128 + m * 16) * D + col0;
#pragma unroll
                for (int bj = 0; bj < 2; ++bj)
#pragma unroll
                    for (int n = 0; n < 2; ++n) *(af4*)(rowp + bj * 128 + n * 16) = acc[ai][bj][m][n]; }
    }
};
struct EpiF32 {
    static constexpr bool PERM = false, AFTER_DRAIN = false;
    float* C; int ldc; int nN;
    DI void operator()(const af4 (&acc)[2][2][4][2], const Unit& u, int wr, int wc, int fr, int fq) const {
        const int row0 = u.pm * 256 + wr * 64 + fr, col0 = (u.pn % nN) * 256 + wc * 32 + 4 * fq;
#pragma unroll
        for (int ai = 0; ai < 2; ++ai)
#pragma unroll
            for (int m = 0; m < 4; ++m) { float* rowp = C + (size_t)(row0 + ai * 128 + m * 16) * ldc + col0;
#pragma unroll
                for (int bj = 0; bj < 2; ++bj)
#pragma unroll
                    for (int n = 0; n < 2; ++n) *(af4*)(rowp + bj * 128 + n * 16) = acc[ai][bj][m][n]; }
    }
};
struct MoeOrder : pg8::StaticOrder {
    int tend[8];
    __device__ void initm(const unsigned* cnt, int nN_, int G_, int c_) {
        int acc = 0;
#pragma unroll
        for (int e = 0; e < 8; ++e) { acc += ((int)cnt[e] + 255) >> 8; tend[e] = acc; }
        nM = acc; nN = nN_; nwg = nM * nN; G = G_; c = c_; lim = nwg; L0 = 0; s = 1;
    }
    __device__ bool next(int i, Unit& u) const {
        if (!pg8::StaticOrder::next(i, u)) return false;
        int e = 0;
#pragma unroll
        for (int k = 0; k < 7; ++k) e += (u.pm >= tend[k]) ? 1 : 0;
        u.pn += e * nN; return true;
    }
};

struct MoeOrder2 {
    int tend[8]; int nM, nwg, G, c, Lmain, r, s, tail;
    __device__ __forceinline__ void initm(const unsigned* cnt, int G_, int c_, int tail_) {
        int acc = 0;
#pragma unroll
        for (int e = 0; e < 8; ++e) { acc += ((int)cnt[e] + 255) >> 8; tend[e] = acc; }
        nM = acc; nwg = nM * 4; G = G_; c = c_; tail = tail_; Lmain = (nwg / G) * G; r = nwg - Lmain;
        s = 1; if (r > 0) { const int q = G / r; s = q >= 14 ? 14 : (q >= 7 ? 7 : (q >= 4 ? 4 : (q >= 2 ? 2 : 1))); }
    }
    __device__ __forceinline__ int tail_row0() const { return (Lmain >> 2) * 256; }
    __device__ __forceinline__ bool next(int i, Unit& u) const {
        const int j = i * G + c; int Lp;
        if (!tail) { if (j >= Lmain) return false; Lp = (j & 7) * (Lmain >> 3) + (j >> 3); u.pk = 0; }
        else { if (j >= r * s) return false; Lp = Lmain + j / s; u.pk = j % s; }
        u.pm = Lp >> 2; int e = 0;
#pragma unroll
        for (int k = 0; k < 7; ++k) e += (u.pm >= tend[k]) ? 1 : 0;
        u.pn = e * 4 + (Lp & 3); return true;
    }
    __device__ __forceinline__ void a_ready(const Unit&) const {}
    __device__ __forceinline__ void done(const Unit&) const {}
};
struct EpiPartY {
    static constexpr bool PERM = false, AFTER_DRAIN = false;
    float* YP; int pm0, tail_rows;
    DI void operator()(const af4 (&acc)[2][2][4][2], const Unit& u, int wr, int wc, int fr, int fq) const {
        const int row0 = (u.pm - pm0) * 256 + wr * 64 + fr, col0 = (u.pn & 3) * 256 + wc * 32 + 4 * fq;
        float* base = YP + (size_t)u.pk * tail_rows * D;
#pragma unroll
        for (int ai = 0; ai < 2; ++ai)
#pragma unroll
            for (int m = 0; m < 4; ++m) { float* rowp = base + (size_t)(row0 + ai * 128 + m * 16) * D + col0;
#pragma unroll
                for (int bj = 0; bj < 2; ++bj)
#pragma unroll
                    for (int n = 0; n < 2; ++n) *(af4*)(rowp + bj * 128 + n * 16) = acc[ai][bj][m][n]; }
    }
};
DI void transpose_load(f32x4 (&v)[8], const float* W, int ldw, int k0, int n0, int lane) {
#pragma unroll
    for (int i = 0; i < 8; ++i) v[i] = *(const f32x4*)(W + (size_t)(k0 + 8 * i + (lane >> 3)) * ldw + n0 + 4 * (lane & 7));
}
DI void transpose_store(const f32x4 (&v)[8], int K, bf16* WT, int k0, int drow0, LAS float* scr, int lane) {
#pragma unroll
    for (int i = 0; i < 8; ++i) { LAS float* d = scr + (8 * i + (lane >> 3)) * 33 + 4 * (lane & 7); d[0] = v[i][0]; d[1] = v[i][1]; d[2] = v[i][2]; d[3] = v[i][3]; }
    asm volatile("s_waitcnt lgkmcnt(0)" ::: "memory");
    const int c = lane & 7;
#pragma unroll
    for (int j = 0; j < 4; ++j) { const int n = (lane >> 3) + 8 * j; const LAS float* s = scr + (8 * c) * 33 + n;
        u32x4 o; o[0] = pk2(s[0 * 33], s[1 * 33]); o[1] = pk2(s[2 * 33], s[3 * 33]); o[2] = pk2(s[4 * 33], s[5 * 33]); o[3] = pk2(s[6 * 33], s[7 * 33]);
        *(u32x4*)(WT + (size_t)(drow0 + n) * K + k0 + 8 * c) = o; }
    asm volatile("s_waitcnt lgkmcnt(0)" ::: "memory");
}
struct TJob { const float* W; bf16* WT; int ldw, K, N, F; };
DI int tjob_items(const TJob& j) { return (j.K / 64) * (j.N / 32); }
DI TJob get_tjob(const Params& p, int j) {
    const int i = j / 22, r = j % 22; unsigned char* ws = p.ws; TJob t;
    if (r == 0) t = TJob{p.in[9] + (size_t)i * D * EVEN_IN, (bf16*)(ws + WS_WEIN) + (size_t)i * 2560 * 1024, EVEN_IN, D, EVEN_IN, 0};
    else if (r == 1) t = TJob{p.in[10] + (size_t)i * D * D, (bf16*)(ws + WS_WEOUT) + (size_t)i * 1024 * 1024, D, D, D, 0};
    else if (r == 2) t = TJob{p.in[20] + (size_t)i * D * 2 * FFN, (bf16*)(ws + WS_WEF1) + (size_t)i * 5632 * 1024, 2 * FFN, D, 2 * FFN, FFN};
    else if (r == 3) t = TJob{p.in[21] + (size_t)i * FFN * D, (bf16*)(ws + WS_WEF2) + (size_t)i * 1024 * 2816, D, FFN, D, 0};
    else if (r == 4) t = TJob{p.in[22] + (size_t)i * D * ODD_IN, (bf16*)(ws + WS_WOIN) + (size_t)i * 4352 * 1024, ODD_IN, D, ODD_IN, 0};
    else if (r == 5) t = TJob{p.in[27] + (size_t)i * D * D, (bf16*)(ws + WS_WOOUT) + (size_t)i * 1024 * 1024, D, D, D, 0};
    else if (r < 14) { const int e = r - 6; t = TJob{p.in[29] + ((size_t)i * 8 + e) * D * 2 * FFE, (bf16*)(ws + WS_WXIN) + ((size_t)i * 8 + e) * 7168 * 1024, 2 * FFE, D, 2 * FFE, FFE}; }
    else { const int e = r - 14; t = TJob{p.in[30] + ((size_t)i * 8 + e) * FFE * D, (bf16*)(ws + WS_WXOUT) + ((size_t)i * 8 + e) * 1024 * 3584, D, FFE, D, 0}; }
    return t;
}
DI void convert_weights(const Ctx& C, const Params& p, int group, int gw, int NGW) {
    LAS float* scr = (LAS float*)(C.lds + 32768 + C.wave * 8704);
    const int j0 = group == 0 ? 0 : (group == 1 ? 6 : 28), j1 = group == 0 ? 6 : (group == 1 ? 28 : 44);
    int jstart = 0;
    for (int j = j0; j < j1; ++j) {
        const TJob t = get_tjob(p, j); const int ni = tjob_items(t), nblkN = t.N / 32;
        const int first = (gw - jstart % NGW + NGW) % NGW;
        auto item_geom = [&](int it, int& k0, int& n0, int& drow0) { const int kb = it / nblkN, nb = it % nblkN; k0 = kb * 64; n0 = nb * 32; drow0 = n0;
            if (t.F > 0) drow0 = (n0 < t.F) ? ((n0 / 128) * 256 + (n0 % 128)) : (((n0 - t.F) / 128) * 256 + 128 + ((n0 - t.F) % 128)); };
        f32x4 va[8], vb[8]; int k0, n0, d0;
        if (first < ni) { item_geom(first, k0, n0, d0); transpose_load(va, t.W, t.ldw, k0, n0, C.lane); }
        for (int it = first; it < ni; it += NGW) {
            const int nx = it + NGW; int k1 = 0, n1 = 0, d1 = 0;
            if (nx < ni) { item_geom(nx, k1, n1, d1); transpose_load(vb, t.W, t.ldw, k1, n1, C.lane); }
            transpose_store(va, t.K, t.WT, k0, d0, scr, C.lane);
#pragma unroll
            for (int q = 0; q < 8; ++q) va[q] = vb[q];
            k0 = k1; n0 = n1; d0 = d1;
        }
        jstart += ni;
    }
}
DI void ph_prologue(const Ctx& C, const Params& p) {
    LAS float* sil = (LAS float*)(C.lds);
    for (int i = C.tid; i < 5 * 1024; i += 512) { const int v = i >> 10, k = i & 1023; const float x = v < 4 ? p.in[1][v * 1024 + k] : p.in[3][k]; sil[i] = x / (1.f + expf(-x)); }
    __syncthreads();
    const int gw = C.blk * 8 + C.wave, NGW = C.nblk * 8;
    float* MOD = (float*)(C.ws + WS_MOD);
    for (int it = gw; it < DEPTH * (MODW / 64); it += NGW) {
        const int l = it / (MODW / 64), n = (it % (MODW / 64)) * 64 + C.lane;
        const float* w = p.in[4] + (size_t)l * 1024 * MODW + n;
        float a0 = 0.f, a1 = 0.f, a2 = 0.f, a3 = 0.f, a4 = 0.f;
#pragma unroll 8
        for (int k = 0; k < 1024; ++k) { const float wv = w[(size_t)k * MODW]; a0 += sil[k] * wv; a1 += sil[1024 + k] * wv; a2 += sil[2048 + k] * wv; a3 += sil[3072 + k] * wv; a4 += sil[4096 + k] * wv; }
        const float bb = p.in[5][l * MODW + n];
        MOD[(size_t)(l * 5 + 0) * MODW + n] = a0 + bb; MOD[(size_t)(l * 5 + 1) * MODW + n] = a1 + bb; MOD[(size_t)(l * 5 + 2) * MODW + n] = a2 + bb;
        MOD[(size_t)(l * 5 + 3) * MODW + n] = a3 + bb; MOD[(size_t)(l * 5 + 4) * MODW + n] = a4 + bb;
    }
    { float* cosT = (float*)(C.ws + WS_COS); float* sinT = (float*)(C.ws + WS_SIN);
      for (int idx = C.blk * 512 + C.tid; idx < SEQ * 32; idx += C.nblk * 512) { const int t = idx >> 5, i = idx & 31;
          const float invf = powf(10000.f, -(float)(i & 15) / 16.f); const float ang = (i < 16 ? (float)(t >> 6) : (float)(t & 63)) * invf;
          cosT[idx] = cosf(ang); sinT[idx] = sinf(ang); } }
    { for (int i = 0; i < 2; ++i) { u32x4* z = (u32x4*)((bf16*)(C.ws + WS_WOIN) + (size_t)i * 4352 * 1024 + (size_t)4128 * 1024);
          for (int idx = C.blk * 512 + C.tid; idx < 224 * 1024 / 8; idx += C.nblk * 512) z[idx] = (u32x4){0u, 0u, 0u, 0u}; } }
    convert_weights(C, p, 0, gw, NGW);
}

DI void normmod_regs(f32x4 (&v)[4], const float* g, const float* shift, const float* scale, int lane) {
    float ss = 0.f;
#pragma unroll
    for (int j = 0; j < 4; ++j) ss += (v[j][0] * v[j][0] + v[j][1] * v[j][1]) + (v[j][2] * v[j][2] + v[j][3] * v[j][3]);
    const float rs = rsqrtf(wave_sum(ss, lane) * (1.f / D) + 1e-6f);
#pragma unroll
    for (int j = 0; j < 4; ++j) { const f32x4 gg = ((const f32x4*)g)[lane + 64 * j], sh = ((const f32x4*)shift)[lane + 64 * j], sc = ((const f32x4*)scale)[lane + 64 * j];
        v[j] = v[j] * rs * gg * (sc + 1.f) + sh; }
}
DI void store_row_bf16(bf16* orow, const f32x4 (&v)[4], int lane) {
#pragma unroll
    for (int j = 0; j < 4; ++j) { u32x2 w; w[0] = pk2(v[j][0], v[j][1]); w[1] = pk2(v[j][2], v[j][3]); ((u32x2*)orow)[lane + 64 * j] = w; }
}
DI void add_ctx_partials(const Ctx& C, f32x4 (&v)[4], int r, int npart, const float* gate_ctx, float* Xrow) {
    const float* PART = (const float*)(C.ws + WS_PART) + (size_t)(r - NLAT) * D;
#pragma unroll
    for (int j = 0; j < 4; ++j) { f32x4 a = (f32x4){0.f, 0.f, 0.f, 0.f};
        for (int pk = 0; pk < npart; ++pk) a = a + ((const f32x4*)(PART + (size_t)pk * NCTX * D))[C.lane + 64 * j];
        v[j] = v[j] + ((const f32x4*)gate_ctx)[C.lane + 64 * j] * a; ((f32x4*)Xrow)[C.lane + 64 * j] = v[j]; }
}
DI void ph_normmod(const Ctx& C, const Params& p, int layer, bool second, bool from_input, int npart, int gate_off) {
    const int gw = C.blk * 8 + C.wave, NGW = C.nblk * 8;
    float* X = (float*)(C.ws + WS_X); bf16* H = (bf16*)(C.ws + WS_H);
    const float* MODl = (const float*)(C.ws + WS_MOD) + (size_t)layer * 5 * MODW;
    const float* g = (second ? p.in[7] : p.in[6]) + layer * D;
    for (int r = gw; r < NTOK; r += NGW) {
        const float* src = from_input ? (r < NLAT ? p.in[0] + (size_t)r * D : p.in[2] + (size_t)(r - NLAT) * D) : X + (size_t)r * D;
        f32x4 v[4];
#pragma unroll
        for (int j = 0; j < 4; ++j) v[j] = ((const f32x4*)src)[C.lane + 64 * j];
        if (from_input) {
#pragma unroll
            for (int j = 0; j < 4; ++j) ((f32x4*)(X + (size_t)r * D))[C.lane + 64 * j] = v[j]; }
        if (npart > 0 && r >= NLAT) add_ctx_partials(C, v, r, npart, (const float*)(C.ws + WS_MOD) + gate_off + 4 * MODW, X + (size_t)r * D);
        const float* mv = MODl + (size_t)(r < NLAT ? (r >> 12) : 4) * MODW + (second ? 3 * D : 0);
        normmod_regs(v, g, mv, mv + D, C.lane);
        store_row_bf16(H + (size_t)r * D, v, C.lane);
    }
}

DI void seq_bounds(int r, int& s0, int& s1) { if (r < NLAT) { s0 = r & ~4095; s1 = s0 + 4096; } else { s0 = NLAT + ((r - NLAT) & ~255); s1 = s0 + 256; } }

DI void ph_odd_conv(const Ctx& C, const Params& p, int i) {
    const int gw = C.blk * 8 + C.wave, NGW = C.nblk * 8;
    const bf16* PO = (const bf16*)(C.ws + WS_P); bf16* QKVN = (bf16*)(C.ws + WS_QKVN);
    const float* AB = (const float*)(C.ws + WS_AB); float* Gd = (float*)(C.ws + WS_GB); float* Bd = Gd + (size_t)2 * NTOK * 8;
    const float* cw = p.in[23] + (size_t)i * 4 * 3072;
    for (int u = gw; u < NCH * 6; u += NGW) {
        const int strip = u / 6, cgp = u % 6, r0 = strip * 64, c = cgp * 512 + 8 * C.lane;
        int s0, s1; seq_bounds(r0, s0, s1);
        float w[4][8];
#pragma unroll
        for (int tp = 0; tp < 4; ++tp) { const f32x4 w0 = *(const f32x4*)(cw + tp * 3072 + c), w1 = *(const f32x4*)(cw + tp * 3072 + c + 4);
#pragma unroll
            for (int e = 0; e < 4; ++e) { w[tp][e] = w0[e]; w[tp][4 + e] = w1[e]; } }
        u32x4 win[4];
        const u32x4 zz = (u32x4){0u, 0u, 0u, 0u};
        win[1] = (r0 - 2 >= s0) ? *(const u32x4*)(PO + (size_t)(r0 - 2) * 4352 + c) : zz;
        win[2] = (r0 - 1 >= s0) ? *(const u32x4*)(PO + (size_t)(r0 - 1) * 4352 + c) : zz;
        win[3] = *(const u32x4*)(PO + (size_t)r0 * 4352 + c);
#pragma unroll 4
        for (int rr = 0; rr < 64; ++rr) {
            const int r = r0 + rr;
            win[0] = win[1]; win[1] = win[2]; win[2] = win[3];
            win[3] = (r + 1 < s1) ? *(const u32x4*)(PO + (size_t)(r + 1) * 4352 + c) : zz;
            float a[8] = {0.f, 0.f, 0.f, 0.f, 0.f, 0.f, 0.f, 0.f};
#pragma unroll
            for (int tp = 0; tp < 4; ++tp) { const u32x4 x = win[tp];
                a[0] += w[tp][0] * bflo(x[0]); a[1] += w[tp][1] * bfhi(x[0]); a[2] += w[tp][2] * bflo(x[1]); a[3] += w[tp][3] * bfhi(x[1]);
                a[4] += w[tp][4] * bflo(x[2]); a[5] += w[tp][5] * bfhi(x[2]); a[6] += w[tp][6] * bflo(x[3]); a[7] += w[tp][7] * bfhi(x[3]); }
            float ss = 0.f;
#pragma unroll
            for (int e = 0; e < 8; ++e) { a[e] = silu_(a[e]); ss += a[e] * a[e]; }
            if (cgp < 4) {
                ss += shx(ss, 1, C.lane); ss += shx(ss, 2, C.lane); ss += shx(ss, 4, C.lane); ss += shx(ss, 8, C.lane);
                const float rn = rsqrtf(ss + 1e-6f);
#pragma unroll
                for (int e = 0; e < 8; ++e) a[e] *= rn;
            }
            u32x4 o; o[0] = pk2(a[0], a[1]); o[1] = pk2(a[2], a[3]); o[2] = pk2(a[4], a[5]); o[3] = pk2(a[6], a[7]);
            *(u32x4*)(QKVN + (size_t)r * 3072 + c) = o;
        }
    }
    for (int r = gw * 4 + (C.lane >> 4); r < NTOK; r += NGW * 4) { const int l16 = C.lane & 15, d = l16 >> 3, h = l16 & 7;
        const float x0 = AB[(size_t)r * 32 + d * 16 + h], x1 = AB[(size_t)r * 32 + d * 16 + 8 + h];
        Gd[((size_t)d * NTOK + r) * 8 + h] = -expf(p.in[24][i * 16 + d * 8 + h]) * softplus_(x0 + p.in[25][i * 16 + d * 8 + h]);
        Bd[((size_t)d * NTOK + r) * 8 + h] = 1.f / (1.f + expf(-x1)); }
}
DI void ph_gdn_out(const Ctx& C, const Params& p, int i) {
    const int gw = C.blk * 8 + C.wave, NGW = C.nblk * 8;
    const float* OG = (const float*)(C.ws + WS_OG); const bf16* PO = (const bf16*)(C.ws + WS_P); bf16* MIX = (bf16*)(C.ws + WS_MIX);
    const f32x4 go = ((const f32x4*)(p.in[26] + i * 128))[C.lane & 31];
    for (int r = gw; r < NTOK; r += NGW) {
#pragma unroll
        for (int j = 0; j < 4; ++j) {
            const f32x4 a = ((const f32x4*)(OG + (size_t)r * D))[C.lane + 64 * j], b = ((const f32x4*)(OG + ((size_t)NTOK + r) * D))[C.lane + 64 * j];
            f32x4 o = a + b;
            float ss = (o[0] * o[0] + o[1] * o[1]) + (o[2] * o[2] + o[3] * o[3]);
            ss += shx(ss, 1, C.lane); ss += shx(ss, 2, C.lane); ss += shx(ss, 4, C.lane); ss += shx(ss, 8, C.lane); ss += shx(ss, 16, C.lane);
            const float rs = rsqrtf(ss * (1.f / 128.f) + 1e-6f);
            const u32x2 z = *(const u32x2*)(PO + (size_t)r * 4352 + 3072 + 4 * C.lane + 256 * j);
            o[0] *= rs * go[0] * silu_(bflo(z[0])); o[1] *= rs * go[1] * silu_(bfhi(z[0])); o[2] *= rs * go[2] * silu_(bflo(z[1])); o[3] *= rs * go[3] * silu_(bfhi(z[1]));
            u32x2 w; w[0] = pk2(o[0], o[1]); w[1] = pk2(o[2], o[3]);
            ((u32x2*)(MIX + (size_t)r * D))[C.lane + 64 * j] = w;
        }
    }
}
struct TokInfo { int e0, p0, e1, p1; float w0, w1; int r0, r1; };
DI void ph_router(const Ctx& C, const Params& p, int layer, int ntok, int npart) {
    const int gw = C.blk * 8 + C.wave, NGW = C.nblk * 8, i = layer >> 1;
    float* X = (float*)(C.ws + WS_X); bf16* H = (bf16*)(C.ws + WS_H);
    const float* MODl = (const float*)(C.ws + WS_MOD) + (size_t)layer * 5 * MODW;
    const float* g = p.in[7] + layer * D; const float* wr = p.in[28] + (size_t)i * D * 8;
    unsigned* cnt = (unsigned*)(C.ws + WS_CTL) + CW_CNT + i * 64; TokInfo* TI = (TokInfo*)(C.ws + WS_TOK);
    LAS unsigned* cl = (LAS unsigned*)(C.lds);
    LAS int* sl = (LAS int*)(C.lds + 64);
    if (C.tid < 16) cl[C.tid] = 0u;
    __syncthreads();
    int k = 0;
    for (int r = gw; r < NTOK; r += NGW, ++k) {
        f32x4 v[4];
#pragma unroll
        for (int j = 0; j < 4; ++j) v[j] = ((const f32x4*)(X + (size_t)r * D))[C.lane + 64 * j];
        if (npart > 0 && r >= NLAT) add_ctx_partials(C, v, r, npart, MODl + 4 * MODW + 2 * D, X + (size_t)r * D);
        const float* mv = MODl + (size_t)(r < NLAT ? (r >> 12) : 4) * MODW + 3 * D;
        normmod_regs(v, g, mv, mv + D, C.lane);
        store_row_bf16(H + (size_t)r * D, v, C.lane);
        if (r >= ntok) continue;
        float lg[8] = {0.f, 0.f, 0.f, 0.f, 0.f, 0.f, 0.f, 0.f};
#pragma unroll
        for (int j = 0; j < 4; ++j)
#pragma unroll
            for (int q = 0; q < 4; ++q) { const int kk = 4 * C.lane + 256 * j + q; const f32x4 w0 = *(const f32x4*)(wr + kk * 8), w1 = *(const f32x4*)(wr + kk * 8 + 4); const float x = v[j][q];
                lg[0] += x * w0[0]; lg[1] += x * w0[1]; lg[2] += x * w0[2]; lg[3] += x * w0[3]; lg[4] += x * w1[0]; lg[5] += x * w1[1]; lg[6] += x * w1[2]; lg[7] += x * w1[3]; }
#pragma unroll
        for (int e = 0; e < 8; ++e) lg[e] = wave_sum(lg[e], C.lane);
        if (C.lane == 0) {
            int e0 = 0; float b0 = lg[0];
#pragma unroll
            for (int e = 1; e < 8; ++e) if (lg[e] > b0) { e0 = e; b0 = lg[e]; }
            int e1 = -1; float b1 = -INFINITY;
#pragma unroll
            for (int e = 0; e < 8; ++e) if (e != e0 && lg[e] > b1) { e1 = e; b1 = lg[e]; }
            const float w1 = 1.f / (1.f + expf(b0 - b1)), w0 = 1.f - w1;
            LAS int* s = sl + (k * 8 + C.wave) * 6;
            s[0] = e0; s[1] = e1; s[2] = (int)__hip_atomic_fetch_add(cl + e0, 1u, __ATOMIC_RELAXED, __HIP_MEMORY_SCOPE_WORKGROUP); s[3] = (int)__hip_atomic_fetch_add(cl + e1, 1u, __ATOMIC_RELAXED, __HIP_MEMORY_SCOPE_WORKGROUP);
            s[4] = __float_as_int(w0); s[5] = __float_as_int(w1);
        }
    }
    __syncthreads();
    if (C.tid < 8) cl[8 + C.tid] = __hip_atomic_fetch_add(cnt + C.tid, cl[C.tid], __ATOMIC_RELAXED, __HIP_MEMORY_SCOPE_AGENT);
    __syncthreads();
    if (C.lane == 0) { k = 0;
        for (int r = gw; r < ntok; r += NGW, ++k) { const LAS int* s = sl + (k * 8 + C.wave) * 6;
            TokInfo t; t.e0 = s[0]; t.e1 = s[1]; t.p0 = (int)cl[8 + s[0]] + s[2]; t.p1 = (int)cl[8 + s[1]] + s[3]; t.w0 = __int_as_float(s[4]); t.w1 = __int_as_float(s[5]); t.r0 = 0; t.r1 = 0;
            TI[r] = t; } }
    __syncthreads();
}
DI void ph_gather(const Ctx& C, int layer, int ntok) {
    const int gw = C.blk * 8 + C.wave, NGW = C.nblk * 8, i = layer >> 1;
    const unsigned* cnt = (const unsigned*)(C.ws + WS_CTL) + CW_CNT + i * 64; TokInfo* TI = (TokInfo*)(C.ws + WS_TOK);
    const bf16* H = (const bf16*)(C.ws + WS_H); bf16* XS = (bf16*)(C.ws + WS_XS);
    int base[8], cn[8]; { int acc = 0;
#pragma unroll
        for (int e = 0; e < 8; ++e) { cn[e] = (int)cnt[e]; base[e] = acc * 256; acc += (cn[e] + 255) >> 8; } }
    for (int r = gw; r < ntok; r += NGW) {
        const TokInfo t = TI[r];
        int b0 = 0, b1 = 0;
#pragma unroll
        for (int e = 0; e < 8; ++e) { b0 = (t.e0 == e) ? base[e] : b0; b1 = (t.e1 == e) ? base[e] : b1; }
        const int r0 = b0 + t.p0, r1 = b1 + t.p1;
        const u32x4 a = ((const u32x4*)(H + (size_t)r * D))[C.lane], b = ((const u32x4*)(H + (size_t)r * D))[C.lane + 64];
        ((u32x4*)(XS + (size_t)r0 * D))[C.lane] = a; ((u32x4*)(XS + (size_t)r0 * D))[C.lane + 64] = b;
        ((u32x4*)(XS + (size_t)r1 * D))[C.lane] = a; ((u32x4*)(XS + (size_t)r1 * D))[C.lane + 64] = b;
        if (C.lane == 0) { TI[r].r0 = r0; TI[r].r1 = r1; }
    }
    for (int pr = gw; pr < 8 * 256; pr += NGW) {
        const int e = pr >> 8, j = pr & 255; int be = 0, ce = 0;
#pragma unroll
        for (int k = 0; k < 8; ++k) { be = (e == k) ? base[k] : be; ce = (e == k) ? cn[k] : ce; }
        const int lim = ((ce + 255) >> 8) << 8;
        if (ce + j < lim) { u32x4* z = (u32x4*)(XS + (size_t)(be + ce + j) * D); z[C.lane] = (u32x4){0u, 0u, 0u, 0u}; z[C.lane + 64] = (u32x4){0u, 0u, 0u, 0u}; }
    }
}
DI void ph_combine(const Ctx& C, const Params& p, int layer, int ntok, const unsigned* cnt) {
    const int gw = C.blk * 8 + C.wave, NGW = C.nblk * 8;
    float* X = (float*)(C.ws + WS_X); bf16* H = (bf16*)(C.ws + WS_H); const float* Y = (const float*)(C.ws + WS_Y); const TokInfo* TI = (const TokInfo*)(C.ws + WS_TOK);
    const float* MODl = (const float*)(C.ws + WS_MOD) + (size_t)layer * 5 * MODW;
    const bool last = (layer == DEPTH - 1);
    const int nrows = last ? NLAT : NTOK;
    for (int r = gw; r < nrows; r += NGW) {
        f32x4 v[4];
#pragma unroll
        for (int j = 0; j < 4; ++j) v[j] = ((const f32x4*)(X + (size_t)r * D))[C.lane + 64 * j];
        if (r < ntok) {
            const TokInfo t = TI[r];
            const float* ga = MODl + (size_t)(r < NLAT ? (r >> 12) : 4) * MODW + 5 * D;
#pragma unroll
            for (int j = 0; j < 4; ++j) { const f32x4 y0 = ((const f32x4*)(Y + (size_t)t.r0 * D))[C.lane + 64 * j], y1 = ((const f32x4*)(Y + (size_t)t.r1 * D))[C.lane + 64 * j], gg = ((const f32x4*)ga)[C.lane + 64 * j];
                v[j] = v[j] + gg * (y0 * t.w0 + y1 * t.w1); }
        }
        if (!last) {
#pragma unroll
            for (int j = 0; j < 4; ++j) ((f32x4*)(X + (size_t)r * D))[C.lane + 64 * j] = v[j];
            const float* MODn = (const float*)(C.ws + WS_MOD) + (size_t)(layer + 1) * 5 * MODW;
            const float* mv = MODn + (size_t)(r < NLAT ? (r >> 12) : 4) * MODW;
            normmod_regs(v, p.in[6] + (layer + 1) * D, mv, mv + D, C.lane);
            store_row_bf16(H + (size_t)r * D, v, C.lane);
        } else {
            float ss = 0.f;
#pragma unroll
            for (int j = 0; j < 4; ++j) ss += (v[j][0] * v[j][0] + v[j][1] * v[j][1]) + (v[j][2] * v[j][2] + v[j][3] * v[j][3]);
            const float rs = rsqrtf(wave_sum(ss, C.lane) * (1.f / D) + 1e-6f);
#pragma unroll
            for (int j = 0; j < 4; ++j) { const f32x4 gg = ((const f32x4*)p.in[8])[C.lane + 64 * j]; ((f32x4*)(p.out + (size_t)r * D))[C.lane + 64 * j] = v[j] * rs * gg; }
        }
    }
}
constexpr int AT_KB = 0, AT_KB_SZ = 64 * 136 * 2, AT_VT = 2 * AT_KB_SZ, AT_VT_SZ = 128 * 68 * 2, AT_QL = AT_VT + 2 * AT_VT_SZ, AT_END = AT_QL + 256 * 136 * 2;
static_assert(AT_END <= LDS_MISC, "attention LDS");
DI void attn_unit(const Ctx& C, const bf16* PE, bf16* MIX, const float* gsub, float lam, float mul, int b, int h, int qb, bool ctxq) {
    LAS unsigned char* ldsb = C.lds; asm volatile("" : "+v"(ldsb));
    int tid = C.tid; asm volatile("" : "+v"(tid));
    const int lane = tid & 63, wave = __builtin_amdgcn_readfirstlane(tid >> 6), r = lane & 31, hh = lane >> 5;
    const int qrow0 = (ctxq ? NLAT + b * CTX : b * SEQ) + qb * 256;
    const int ntile = ctxq ? CTX / 64 : (CTX + SEQ) / 64;
    LAS bf16* QL = (LAS bf16*)(ldsb + AT_QL);
#pragma unroll
    for (int i = 0; i < 8; ++i) { const int c = tid + 512 * i, row = c >> 4, part = c & 15; *(LAS u32x4*)(QL + row * 136 + part * 8) = *(const u32x4*)(PE + (size_t)(qrow0 + row) * EVEN_IN + h * 128 + part * 8); }
    f32x16 O[2][4];
#pragma unroll
    for (int mp = 0; mp < 2; ++mp)
#pragma unroll
        for (int k = 0; k < 4; ++k) O[mp][k] = zero16();
    float m[2] = {-1e30f, -1e30f}, l[2] = {0.f, 0.f};
    u32x4 kA[2], vA[2];
    const int skey = tid & 63, spart = tid >> 6;
#define AT_LOAD(t, kr, vr) do { const int kidx_ = (t) * 64 + skey; const int krow_ = kidx_ < CTX ? NLAT + b * CTX + kidx_ : b * SEQ + kidx_ - CTX; \
        _Pragma("unroll") for (int i_ = 0; i_ < 2; ++i_) { const bf16* src_ = PE + (size_t)krow_ * EVEN_IN + h * 128 + (spart + 8 * i_) * 8; kr[i_] = *(const u32x4*)(src_ + 512); vr[i_] = *(const u32x4*)(src_ + 1024); } } while (0)
#define AT_STORE(buf, kr, vr) do { LAS bf16* kb_ = (LAS bf16*)(ldsb + AT_KB + (buf) * AT_KB_SZ); LAS bf16* vt_ = (LAS bf16*)(ldsb + AT_VT + (buf) * AT_VT_SZ); \
        _Pragma("unroll") for (int i_ = 0; i_ < 2; ++i_) { const int part_ = spart + 8 * i_; *(LAS u32x4*)(kb_ + skey * 136 + part_ * 8) = kr[i_]; \
            _Pragma("unroll") for (int e_ = 0; e_ < 4; ++e_) { vt_[(part_ * 8 + 2 * e_) * 68 + skey] = (bf16)(vr[i_][e_] & 0xffffu); vt_[(part_ * 8 + 2 * e_ + 1) * 68 + skey] = (bf16)(vr[i_][e_] >> 16); } } } while (0)
#define AT_TILE(t) do { const int buf = (t) & 1; \
        int tl_ = tid; asm volatile("" : "+v"(tl_)); const int lane = tl_ & 63, r = lane & 31, hh = lane >> 5, skey = lane, spart = tl_ >> 6;     \
        if ((t) + 1 < ntile) AT_LOAD((t) + 1, kA, vA); \
        const LAS bf16* kb = (const LAS bf16*)(ldsb + AT_KB + buf * AT_KB_SZ); const LAS bf16* vt = (const LAS bf16*)(ldsb + AT_VT + buf * AT_VT_SZ); \
        _Pragma("unroll") for (int ks2 = 0; ks2 < 2; ++ks2) {             \
            bf16x8 pf[2][2]; \
            _Pragma("unroll") for (int mp = 0; mp < 2; ++mp) { \
                f32x16 S = zero16(); \
                _Pragma("unroll") for (int ks = 0; ks < 4; ++ks) { const bf16x8 qf = *(const LAS bf16x8*)(QL + (wave * 32 + r) * 136 + mp * 64 + 16 * ks + 8 * hh); \
                    const bf16x8 a = *(const LAS bf16x8*)(kb + (ks2 * 32 + r) * 136 + mp * 64 + 16 * ks + 8 * hh); S = MFMA32(a, qf, S); } \
                float mx = S[0]; \
                _Pragma("unroll") for (int i = 1; i < 16; ++i) mx = fmaxf(mx, S[i]); \
                mx = fmaxf(mx, shx(mx, 32, lane)); \
                if (__any(mx > m[mp] + 8.f)) { const float mnew = fmaxf(m[mp], mx), corr = __builtin_amdgcn_exp2f(m[mp] - mnew); m[mp] = mnew; l[mp] *= corr; \
                    _Pragma("unroll") for (int k = 0; k < 4; ++k) O[mp][k] = O[mp][k] * corr; } \
                float ls = 0.f; const float mu = m[mp]; \
                _Pragma("unroll") for (int i = 0; i < 16; ++i) { S[i] = __builtin_amdgcn_exp2f(S[i] - mu); ls += S[i]; } \
                l[mp] += ls; \
                pf[mp][0] = pack_step(S, 0); pf[mp][1] = pack_step(S, 1); } \
            _Pragma("unroll") for (int s = 0; s < 2; ++s) \
                _Pragma("unroll") for (int k = 0; k < 4; ++k) { const bf16x8 a = ld_perm_frag(vt + (k * 32 + r) * 68, ks2 * 32, s, hh); O[0][k] = MFMA32(a, pf[0][s], O[0][k]); O[1][k] = MFMA32(a, pf[1][s], O[1][k]); } } \
        if ((t) + 1 < ntile) AT_STORE(buf ^ 1, kA, vA); \
        __syncthreads(); } while (0)
    AT_LOAD(0, kA, vA); AT_STORE(0, kA, vA);
    __syncthreads();
    for (int t = 0; t < ntile; ++t) AT_TILE(t);
#undef AT_TILE
#undef AT_LOAD
#undef AT_STORE
    {
        const float i0 = 1.f / (l[0] + shx(l[0], 32, lane)), i1 = lam / (l[1] + shx(l[1], 32, lane));
        float ss = 0.f;
#pragma unroll
        for (int k = 0; k < 4; ++k)
#pragma unroll
            for (int i = 0; i < 16; ++i) { const float o = O[0][k][i] * i0 - O[1][k][i] * i1; O[0][k][i] = o; ss += o * o; }
        ss += shx(ss, 32, lane);
        const float rs = rsqrtf(ss * (1.f / 128.f) + 1e-6f) * mul;
        const int qrow = qrow0 + wave * 32 + r;
#pragma unroll
        for (int k = 0; k < 4; ++k)
#pragma unroll
            for (int g4 = 0; g4 < 4; ++g4) { const int dv0 = k * 32 + 8 * g4 + 4 * hh; const f32x4 gg = *(const f32x4*)(gsub + dv0);
                u32x2 w; w[0] = pk2(O[0][k][4 * g4] * rs * gg[0], O[0][k][4 * g4 + 1] * rs * gg[1]); w[1] = pk2(O[0][k][4 * g4 + 2] * rs * gg[2], O[0][k][4 * g4 + 3] * rs * gg[3]);
                *(u32x2*)(MIX + (size_t)qrow * D + h * 128 + dv0) = w; }
    }
    __syncthreads();
}

constexpr int RGG_WT = 0, RGG_XR = 36864, RGG_XB = RGG_XR + 17408, RGG_XF = RGG_XB + 18432, RGG_END = RGG_XF + 128 * 65 * 4;
static_assert(RGG_END <= LDS_MISC && 131 * 66 * 2 <= 17408, "rg gates LDS");
DI void ph_rg_gates(const Ctx& C, const Params& p, int i) {
    const bf16* PE = (const bf16*)(C.ws + WS_P); float* RGA = (float*)(C.ws + WS_RGA); float* RGU = (float*)(C.ws + WS_RGU);
    const float* w_a = p.in[15] + (size_t)i * 2 * 8 * 64 * 64; const float* w_x = p.in[17] + (size_t)i * 2 * 8 * 64 * 64;
    const float* b_a = p.in[16] + i * 1024; const float* b_x = p.in[18] + i * 1024; const float* lamv = p.in[19] + i * 1024;
    const float* cw = p.in[13] + i * 4 * 512; const float* cb = p.in[14] + i * 512;
    int ncur = -1;
    for (int unit = C.blk; unit < (NTOK / 128) * 8; unit += C.nblk) {
        LAS unsigned char* ldsb = C.lds; asm volatile("" : "+v"(ldsb));
        int tid = C.tid; asm volatile("" : "+v"(tid));
        const int lane = tid & 63, wave = __builtin_amdgcn_readfirstlane(tid >> 6), r = lane & 31, hh = lane >> 5;
        const int n = unit & 7, tile = unit >> 3, r0 = tile * 128;
        LAS bf16* WT = (LAS bf16*)(ldsb + RGG_WT); LAS bf16* xraw = (LAS bf16*)(ldsb + RGG_XR); LAS bf16* XB = (LAS bf16*)(ldsb + RGG_XB); LAS float* XF = (LAS float*)(ldsb + RGG_XF);
        if (n != ncur) {
            __syncthreads();
            for (int idx = tid; idx < 16384; idx += 512) { const int ch = idx & 63, ci = (idx >> 6) & 63, g = (idx >> 12) & 1, d = idx >> 13;
                const float v = (g ? w_x : w_a)[((size_t)(d * 8 + n) * 64 + ci) * 64 + ch];
                WT[(((d * 2 + g) * 2 + (ch >> 5)) * 32 + (ch & 31)) * 72 + ci] = f2bf(v); }
            ncur = n;
        }
        int s0, s1; seq_bounds(r0, s0, s1);
        for (int idx = tid; idx < 131 * 8; idx += 512) { const int ri = idx >> 3, part = idx & 7, row = r0 - 2 + ri;
            u32x4 v = (u32x4){0u, 0u, 0u, 0u};
            if (row >= s0 && row < s1) v = *(const u32x4*)(PE + (size_t)row * EVEN_IN + 1536 + n * 64 + part * 8);
            LAS unsigned* dst = (LAS unsigned*)(xraw + ri * 66 + part * 8); dst[0] = v[0]; dst[1] = v[1]; dst[2] = v[2]; dst[3] = v[3]; }
        __syncthreads();
        { const int cc = tid & 63; float tap[4];
#pragma unroll
          for (int tp = 0; tp < 4; ++tp) tap[tp] = cw[tp * 512 + n * 64 + cc];
          const float cbias = cb[n * 64 + cc];
#pragma unroll 4
          for (int it = 0; it < 16; ++it) { const int tok = (tid >> 6) + 8 * it; float a = cbias;
#pragma unroll
              for (int tp = 0; tp < 4; ++tp) a += tap[tp] * bf2f(xraw[(tok + tp) * 66 + cc]);
              XF[tok * 65 + cc] = a; XB[tok * 72 + cc] = f2bf(a); } }
        __syncthreads();
        { const int ti = wave & 3, d = wave >> 2;
#pragma unroll
          for (int chblk = 0; chblk < 2; ++chblk) {
              f32x16 aa = zero16(), ax = zero16();
#pragma unroll
              for (int ks = 0; ks < 4; ++ks) { const bf16x8 xa = *(const LAS bf16x8*)(XB + (ti * 32 + r) * 72 + 16 * ks + 8 * hh);
                  const bf16x8 ba = *(const LAS bf16x8*)(WT + (((d * 2 + 0) * 2 + chblk) * 32 + r) * 72 + 16 * ks + 8 * hh), bx = *(const LAS bf16x8*)(WT + (((d * 2 + 1) * 2 + chblk) * 32 + r) * 72 + 16 * ks + 8 * hh);
                  aa = MFMA32(xa, ba, aa); ax = MFMA32(xa, bx, ax); }
              const int ch = n * 64 + chblk * 32 + r;
              const float ba_ = b_a[d * 512 + ch], bx_ = b_x[d * 512 + ch], sp = softplus_(-lamv[d * 512 + ch]);
#pragma unroll
              for (int q = 0; q < 16; ++q) { const int tok = ti * 32 + crow(q, hh);
                  const float rr = 1.f / (1.f + __expf(-(aa[q] + ba_))), ii = 1.f / (1.f + __expf(-(ax[q] + bx_)));
                  const float log_a = -8.f * rr * sp; const float a = __expf(log_a), u = sqrtf(fmaxf(1.f - a * a, 0.f)) * (ii * XF[tok * 65 + chblk * 32 + r]);
                  const size_t o = ((size_t)d * NTOK + r0 + tok) * 512 + ch; RGA[o] = a; RGU[o] = u; }
          } }
        __syncthreads();
    }
}
DI int rg_row(int b, int d, int pp) { return pp < CTX ? NLAT + b * CTX + (d ? CTX - 1 - pp : pp) : b * SEQ + (d ? SEQ - 1 - (pp - CTX) : (pp - CTX)); }
DI void rgscan_unit(const Ctx& C, int b, int cg) {
    LAS unsigned char* ldsb = C.lds; asm volatile("" : "+v"(ldsb));
    int tid = C.tid; asm volatile("" : "+v"(tid));
    const float* RGA = (const float*)(C.ws + WS_RGA); const float* RGU = (const float*)(C.ws + WS_RGU); float* HS1 = (float*)(C.ws + WS_HS1);
    const bf16* PE = (const bf16*)(C.ws + WS_P); bf16* MIX = (bf16*)(C.ws + WS_MIX);
    LAS float* sb = (LAS float*)ldsb;
    const int ch = cg * 16 + (tid & 15), chunk = tid >> 4, p0 = chunk * 136;
    for (int pass = 0; pass < 2; ++pass) {
        const int d = 1 - pass;
        const float* Ad = RGA + (size_t)d * NTOK * 512 + ch; const float* Ud = RGU + (size_t)d * NTOK * 512 + ch;
        float av[17], uv[17], an[17], un[17];
        float A = 1.f, H = 0.f;
#pragma unroll
        for (int k = 0; k < 17; ++k) { const size_t o = (size_t)rg_row(b, d, p0 + k) * 512; av[k] = Ad[o]; uv[k] = Ud[o]; }
        for (int g8 = 0; g8 < 8; ++g8) {
            if (g8 < 7) {
#pragma unroll
                for (int k = 0; k < 17; ++k) { const size_t o = (size_t)rg_row(b, d, p0 + (g8 + 1) * 17 + k) * 512; an[k] = Ad[o]; un[k] = Ud[o]; } }
#pragma unroll
            for (int k = 0; k < 17; ++k) { H = av[k] * H + uv[k]; A *= av[k]; }
#pragma unroll
            for (int k = 0; k < 17; ++k) { av[k] = an[k]; uv[k] = un[k]; }
        }
        sb[(chunk * 16 + (tid & 15)) * 2] = A; sb[(chunk * 16 + (tid & 15)) * 2 + 1] = H;
        __syncthreads();
        float h = 0.f;
        for (int k = 0; k < chunk; ++k) h = sb[(k * 16 + (tid & 15)) * 2] * h + sb[(k * 16 + (tid & 15)) * 2 + 1];
#pragma unroll
        for (int k = 0; k < 17; ++k) { const size_t o = (size_t)rg_row(b, d, p0 + k) * 512; av[k] = Ad[o]; uv[k] = Ud[o]; }
        for (int g8 = 0; g8 < 8; ++g8) {
            if (g8 < 7) {
#pragma unroll
                for (int k = 0; k < 17; ++k) { const size_t o = (size_t)rg_row(b, d, p0 + (g8 + 1) * 17 + k) * 512; an[k] = Ad[o]; un[k] = Ud[o]; } }
#pragma unroll
            for (int k = 0; k < 17; ++k) { h = av[k] * h + uv[k]; const int row = rg_row(b, d, p0 + g8 * 17 + k);
                if (pass == 0) HS1[(size_t)row * 512 + ch] = h;
                else { const float y = h + HS1[(size_t)row * 512 + ch]; MIX[(size_t)row * D + 512 + ch] = f2bf(y * gelu_tanh_(bf2f(PE[(size_t)row * EVEN_IN + 2048 + ch]))); } }
#pragma unroll
            for (int k = 0; k < 17; ++k) { av[k] = an[k]; uv[k] = un[k]; }
        }
        __syncthreads();
    }
}
DI void ph_even_mix(const Ctx& C, const Params& p, int layer, int rep) {
    const int i = layer >> 1;
    volatile LAS unsigned* misc = (volatile LAS unsigned*)(C.lds + LDS_MISC);
    unsigned* q = (unsigned*)(C.ws + WS_CTL) + CW_Q + (i + 2 * rep) * 64;
    const float lam_init = 0.8f - 0.6f * expf(-0.3f * (float)layer);
    if (C.wave == 0) { const float* lq = p.in[11] + i * 256; const float a = wave_sum(lq[C.lane] * lq[64 + C.lane], C.lane), b2 = wave_sum(lq[128 + C.lane] * lq[192 + C.lane], C.lane);
        if (C.lane == 0) ((volatile LAS float*)misc)[4] = expf(a) - expf(b2) + lam_init; }
    __syncthreads();
    const float lam = ((volatile LAS float*)misc)[4];
    const bf16* PE = (const bf16*)(C.ws + WS_P); bf16* MIX = (bf16*)(C.ws + WS_MIX);
    for (;;) {
        if (C.tid == 0) misc[8] = __hip_atomic_fetch_add(q, 1u, __ATOMIC_RELAXED, __HIP_MEMORY_SCOPE_AGENT);
        __syncthreads();
        const int u = (int)misc[8];
        __syncthreads();
#ifndef MIX_RG_REP
#define MIX_RG_REP 1
#endif
#ifndef MIX_AT_REP
#define MIX_AT_REP 1
#endif
        if (u >= 128 * MIX_RG_REP + 272 * MIX_AT_REP) break;
        if (u < 128 * MIX_RG_REP) { const int x = u & 127; rgscan_unit(C, x >> 5, x & 31); }
        else { const int y = (u - 128 * MIX_RG_REP) % 272;
            if (y < 256) attn_unit(C, PE, MIX, p.in[12] + i * 128, lam, 1.f - lam_init, y >> 6, (y >> 4) & 3, y & 15, false);
            else { const int x = y - 256; attn_unit(C, PE, MIX, p.in[12] + i * 128, lam, 1.f - lam_init, x >> 2, x & 3, 0, true); } }
    }
}
DI int chunk_row0(int cidx) { return cidx < 256 ? (cidx >> 6) * SEQ + (cidx & 63) * 64 : NLAT + (cidx - 256) * 64; }
constexpr int GA_RA = 0, GA_RB = 18432, GA_KT0 = 2 * 18432, GA_KT1 = 3 * 18432, GA_VT0 = 4 * 18432, GA_VT1 = 5 * 18432, GA_KK = 6 * 18432, GA_QK = GA_KK + 16640, GA_GC = GA_QK + 16640, GA_END = GA_GC + 1024;
static_assert(GA_END <= LDS_MISC, "GA LDS");
DI void gdn_ga_unit(const Ctx& C, int unit) {
    LAS unsigned char* ldsb = C.lds; asm volatile("" : "+v"(ldsb));
    const int h = unit & 7, cidx = unit >> 3;
    const int row0 = chunk_row0(cidx);
    const bf16* QKVN = (const bf16*)(C.ws + WS_QKVN); const float* Gd = (const float*)(C.ws + WS_GB); const float* Bd = Gd + (size_t)2 * NTOK * 8;
    const size_t ud0 = (size_t)(cidx * 8 + h) * 2;
    bf16* WG = (bf16*)(C.ws + WS_WG) + ud0 * 8192; float* UG = (float*)(C.ws + WS_UG) + ud0 * 8192; bf16* QKD = (bf16*)(C.ws + WS_QKD) + ud0 * 4096; float* SC = (float*)(C.ws + WS_SC) + ud0 * 192;
    bf16* KTG = (bf16*)(C.ws + WS_KTG) + ud0 * 8192;
    LAS bf16* Kc = (LAS bf16*)(ldsb + GA_RA); LAS bf16* Qc = (LAS bf16*)(ldsb + GA_RB);
    LAS float* KKm = (LAS float*)(ldsb + GA_KK); LAS float* QKm = (LAS float*)(ldsb + GA_QK);
    LAS float* gc = (LAS float*)(ldsb + GA_GC); LAS float* be = gc + 128;
    int tid = C.tid; asm volatile("" : "+v"(tid));
    const int lane = tid & 63, wave = __builtin_amdgcn_readfirstlane(tid >> 6), r = lane & 31, hh = lane >> 5;
#pragma unroll
    for (int i2 = 0; i2 < 2; ++i2) { const int c = tid + 512 * i2, pos = c & 63, part = c >> 6;
        const bf16* src = QKVN + (size_t)(row0 + pos) * 3072 + h * 128 + part * 8;
        const u32x4 q = *(const u32x4*)src, k = *(const u32x4*)(src + 1024), v = *(const u32x4*)(src + 2048);
        *(LAS u32x4*)(Qc + pos * 136 + part * 8) = q; *(LAS u32x4*)(Kc + pos * 136 + part * 8) = k;
        LAS bf16* kt0 = (LAS bf16*)(ldsb + GA_KT0) + (part * 8) * 72; LAS bf16* kt1 = (LAS bf16*)(ldsb + GA_KT1) + (part * 8) * 72;
        LAS bf16* vt0 = (LAS bf16*)(ldsb + GA_VT0) + (part * 8) * 72; LAS bf16* vt1 = (LAS bf16*)(ldsb + GA_VT1) + (part * 8) * 72;
#pragma unroll
        for (int e = 0; e < 4; ++e) { const bf16 k0 = (bf16)(k[e] & 0xffffu), k1 = (bf16)(k[e] >> 16), v0 = (bf16)(v[e] & 0xffffu), v1 = (bf16)(v[e] >> 16);
            kt0[(2 * e) * 72 + pos] = k0; kt0[(2 * e + 1) * 72 + pos] = k1; kt1[(2 * e) * 72 + 63 - pos] = k0; kt1[(2 * e + 1) * 72 + 63 - pos] = k1;
            vt0[(2 * e) * 72 + pos] = v0; vt0[(2 * e + 1) * 72 + pos] = v1; vt1[(2 * e) * 72 + 63 - pos] = v0; vt1[(2 * e + 1) * 72 + 63 - pos] = v1; } }
    if (wave < 2) {
        const int d = wave, row = row0 + (d ? 63 - lane : lane);
        float g = Gd[((size_t)d * NTOK + row) * 8 + h];
#pragma unroll
        for (int o = 1; o < 64; o <<= 1) { const float t = __builtin_bit_cast(float, __builtin_amdgcn_ds_bpermute((lane - o) << 2, __builtin_bit_cast(int, g))); if (lane >= o) g += t; }
        gc[d * 64 + lane] = g; be[d * 64 + lane] = Bd[((size_t)d * NTOK + row) * 8 + h];
    }
    __syncthreads();
    { const int ti = (wave & 3) >> 1, tj = wave & 1; const LAS bf16* Arows = (wave < 4 ? Kc : Qc);
      f32x16 acc = zero16();
#pragma unroll
      for (int ks = 0; ks < 8; ++ks) { const bf16x8 a = *(const LAS bf16x8*)(Arows + (ti * 32 + r) * 136 + 16 * ks + 8 * hh), bb = *(const LAS bf16x8*)(Kc + (tj * 32 + r) * 136 + 16 * ks + 8 * hh); acc = MFMA32(a, bb, acc); }
      LAS float* dst = (wave < 4 ? KKm : QKm);
#pragma unroll
      for (int i = 0; i < 16; ++i) dst[(ti * 32 + crow(i, hh)) * 65 + tj * 32 + r] = acc[i]; }
    __syncthreads();
    const float qscale = 0.08838834764831845f;
#pragma unroll
    for (int e = 0; e < 16; ++e) { const int idx = tid + 512 * e, d = idx >> 12, i = (idx >> 6) & 63, j = idx & 63, ti = d ? 63 - i : i, tj = d ? 63 - j : j;
        const float dec = (j <= i) ? __expf(gc[d * 64 + i] - gc[d * 64 + j]) : 0.f;
        ((LAS float*)(ldsb + (d ? GA_RB : GA_RA)))[i * 68 + j] = (j < i) ? KKm[ti * 65 + tj] * be[d * 64 + i] * dec : 0.f;
        QKD[idx] = f2bf(QKm[ti * 65 + tj] * qscale * dec); }
    if (tid < 128) { const int d = tid >> 6, i = tid & 63; SC[d * 192 + i] = qscale * __expf(gc[d * 64 + i]); SC[d * 192 + 64 + i] = __expf(gc[d * 64 + 63] - gc[d * 64 + i]); if (i == 0) SC[d * 192 + 128] = __expf(gc[d * 64 + 63]); }
    __syncthreads();
    if (wave < 2) {
        const int d = wave, c = lane; LAS float* Lm = (LAS float*)(ldsb + (d ? GA_RB : GA_RA)); float T[64];
#pragma unroll
        for (int i = 0; i < 64; ++i) { float a0 = (i == c) ? 1.f : 0.f, a1 = 0.f, a2 = 0.f, a3 = 0.f;
#pragma unroll
            for (int j4 = 0; j4 < (i + 3) / 4; ++j4) { const f32x4 l4 = *(const LAS f32x4*)(Lm + i * 68 + 4 * j4);
                a0 -= l4[0] * T[4 * j4]; if (4 * j4 + 1 < i) a1 -= l4[1] * T[4 * j4 + 1]; if (4 * j4 + 2 < i) a2 -= l4[2] * T[4 * j4 + 2]; if (4 * j4 + 3 < i) a3 -= l4[3] * T[4 * j4 + 3]; }
            T[i] = (a0 + a1) + (a2 + a3); asm volatile("" ::: "memory"); }
        const float s2 = be[d * 64 + c], s1 = s2 * __expf(gc[d * 64 + c]);
        LAS bf16* T1 = (LAS bf16*)Lm; LAS bf16* T2 = T1 + 64 * 72;
#pragma unroll
        for (int i = 0; i < 64; ++i) { T1[i * 72 + c] = f2bf(T[i] * s1); T2[i * 72 + c] = f2bf(T[i] * s2); }
    }
    __syncthreads();
#pragma unroll
    for (int d = 0; d < 2; ++d) {
        const LAS bf16* T1 = (const LAS bf16*)(ldsb + (d ? GA_RB : GA_RA)); const LAS bf16* T2 = T1 + 64 * 72;
        const LAS bf16* Kt = (const LAS bf16*)(ldsb + (d ? GA_KT1 : GA_KT0)); const LAS bf16* Vt = (const LAS bf16*)(ldsb + (d ? GA_VT1 : GA_VT0));
        const int ti = wave >> 2, tn = wave & 3; f32x16 aw = zero16(), au = zero16();
#pragma unroll
        for (int ks = 0; ks < 4; ++ks) { const bf16x8 a1 = *(const LAS bf16x8*)(T1 + (ti * 32 + r) * 72 + 16 * ks + 8 * hh), a2 = *(const LAS bf16x8*)(T2 + (ti * 32 + r) * 72 + 16 * ks + 8 * hh);
            const bf16x8 bk = *(const LAS bf16x8*)(Kt + (tn * 32 + r) * 72 + 16 * ks + 8 * hh), bv = *(const LAS bf16x8*)(Vt + (tn * 32 + r) * 72 + 16 * ks + 8 * hh);
            aw = MFMA32(a1, bk, aw); au = MFMA32(a2, bv, au); }
#pragma unroll
        for (int i = 0; i < 16; ++i) { const int pos = ti * 32 + crow(i, hh); WG[d * 8192 + pos * 128 + tn * 32 + r] = f2bf(aw[i]); UG[d * 8192 + pos * 128 + tn * 32 + r] = au[i]; }
#pragma unroll
        for (int i2 = 0; i2 < 2; ++i2) { const int c = tid + 512 * i2, row = c >> 3, part = c & 7; *(u32x4*)(KTG + d * 8192 + row * 64 + part * 8) = *(const LAS u32x4*)(Kt + row * 72 + part * 8); }
    }
    __syncthreads();
}
DI void ph_gdn_ga(const Ctx& C) { for (int u = C.blk; u < NCH * 8; u += C.nblk) gdn_ga_unit(C, u); }

constexpr int GB_NSL = 2;
constexpr int GB_W = 0, GB_Q = GB_W + 64 * 136 * 2, GB_KT = GB_Q + 64 * 136 * 2, GB_QK = GB_KT + 128 * 72 * 2, GB_SC = GB_QK + 64 * 72 * 2, GB_BUF = GB_SC + 1024;
static_assert(2 * GB_BUF <= LDS_MISC, "GB LDS");
DI void gdn_gb_unit(const Ctx& C, int unit) {
    LAS unsigned char* ldsb = C.lds; asm volatile("" : "+v"(ldsb));
    constexpr int NGRP = 4 / GB_NSL;
    const int grp = unit % NGRP, bhd = unit / NGRP, d = bhd & 1, h = (bhd >> 1) & 7, b = bhd >> 4;
    const bf16* QKVN = (const bf16*)(C.ws + WS_QKVN);
    const bf16* WGb = (const bf16*)(C.ws + WS_WG); const float* UGb = (const float*)(C.ws + WS_UG); const bf16* QKDb = (const bf16*)(C.ws + WS_QKD); const bf16* KTGb = (const bf16*)(C.ws + WS_KTG); const float* SCb = (const float*)(C.ws + WS_SC);
    float* OG = (float*)(C.ws + WS_OG) + (size_t)d * NTOK * D;
    int tid = C.tid; asm volatile("" : "+v"(tid));
    const int lane = tid & 63, wave = __builtin_amdgcn_readfirstlane(tid >> 6), r = lane & 31, hh = lane >> 5;
    const bool comp = wave < GB_NSL; const int dv0 = (grp * GB_NSL + wave) * 32;
    f32x16 S[4];
#pragma unroll
    for (int k = 0; k < 4; ++k) S[k] = zero16();
    constexpr int NST = 512 - GB_NSL * 64, NCK = 3584, NIT = (NCK + NST - 1) / NST;
    const int st = tid - GB_NSL * 64;
    u32x4 sreg[NIT]; float rsc = 0.f;
    auto chunk_of = [&](int step) { return step < 4 ? 256 + b * 4 + (d ? 3 - step : step) : b * 64 + (d ? 63 - (step - 4) : (step - 4)); };
#define GB_LOAD(step) do { if (!comp) { int st_ = st; asm volatile("" : "+v"(st_)); const int cidx_ = chunk_of(step), un_ = (cidx_ * 8 + h) * 2 + d, row0_ = chunk_row0(cidx_); \
        _Pragma("unroll") for (int i_ = 0; i_ < NIT; ++i_) { const int q_ = st_ + NST * i_; if (q_ < NCK) { const int reg_ = q_ >> 10, c_ = q_ & 1023, pos_ = c_ >> 4, part_ = c_ & 15, row_ = row0_ + (d ? 63 - pos_ : pos_); \
            const bf16* src_ = reg_ == 0 ? WGb + (size_t)un_ * 8192 + c_ * 8 : reg_ == 1 ? QKVN + (size_t)row_ * 3072 + h * 128 + part_ * 8 : reg_ == 2 ? KTGb + (size_t)un_ * 8192 + c_ * 8 : QKDb + (size_t)un_ * 4096 + c_ * 8; \
            sreg[i_] = *(const u32x4*)src_; } } \
        if (st_ < 192) rsc = SCb[(size_t)un_ * 192 + st_]; } } while (0)
#define GB_STORE(buf) do { if (!comp) { int st_ = st; asm volatile("" : "+v"(st_)); LAS unsigned char* B_ = ldsb + (buf) * GB_BUF; \
        _Pragma("unroll") for (int i_ = 0; i_ < NIT; ++i_) { const int q_ = st_ + NST * i_; if (q_ < NCK) { const int reg_ = q_ >> 10, c_ = q_ & 1023, pos_ = c_ >> 4, part_ = c_ & 15; \
            if (reg_ == 0) *(LAS u32x4*)((LAS bf16*)(B_ + GB_W) + pos_ * 136 + part_ * 8) = sreg[i_]; \
            else if (reg_ == 1) *(LAS u32x4*)((LAS bf16*)(B_ + GB_Q) + pos_ * 136 + part_ * 8) = sreg[i_]; \
            else if (reg_ == 2) *(LAS u32x4*)((LAS bf16*)(B_ + GB_KT) + (c_ >> 3) * 72 + (c_ & 7) * 8) = sreg[i_]; \
            else *(LAS u32x4*)((LAS bf16*)(B_ + GB_QK) + (c_ >> 3) * 72 + (c_ & 7) * 8) = sreg[i_]; } } \
        if (st_ < 192) ((LAS float*)(B_ + GB_SC))[st_] = rsc; } } while (0)
    GB_LOAD(0); GB_STORE(0);
    f32x16 Un[2];
    Un[0] = zero16(); Un[1] = zero16();
    if (comp) { const int cidx = chunk_of(0), un = (cidx * 8 + h) * 2 + d; const float* Uu = UGb + (size_t)un * 8192 + dv0 + r;
#pragma unroll
        for (int tt = 0; tt < 2; ++tt)
#pragma unroll
            for (int i = 0; i < 16; ++i) Un[tt][i] = Uu[(tt * 32 + crow(i, hh)) * 128]; }
    __syncthreads();
    for (int step = 0; step < 68; ++step) {
        const int buf = step & 1;
        if (!comp) { if (step + 1 < 68) { GB_LOAD(step + 1); GB_STORE(buf ^ 1); } }
        else {
            int ln_ = lane; asm volatile("" : "+v"(ln_)); const int r = ln_ & 31, hh = ln_ >> 5;
            const int cidx = chunk_of(step), un = (cidx * 8 + h) * 2 + d, row0 = chunk_row0(cidx);
            const LAS unsigned char* Bp = ldsb + buf * GB_BUF; const LAS bf16* Wl = (const LAS bf16*)(Bp + GB_W); const LAS bf16* Ql = (const LAS bf16*)(Bp + GB_Q);
            const LAS bf16* KTl = (const LAS bf16*)(Bp + GB_KT); const LAS bf16* QKl = (const LAS bf16*)(Bp + GB_QK); const LAS float* scl = (const LAS float*)(Bp + GB_SC);
#pragma unroll
            for (int tt = 0; tt < 2; ++tt) {
                f32x16 aw = zero16();
#pragma unroll
                for (int kb = 0; kb < 4; ++kb)
#pragma unroll
                    for (int s = 0; s < 2; ++s) aw = MFMA32(ld_perm_frag(Wl + (tt * 32 + r) * 136, kb * 32, s, hh), pack_step(S[kb], s), aw);
#pragma unroll
                for (int i = 0; i < 16; ++i) Un[tt][i] -= aw[i];
                asm volatile("" ::: "memory");
            }
            bf16x8 vp[2][2];
#pragma unroll
            for (int jt = 0; jt < 2; ++jt) { vp[jt][0] = pack_step(Un[jt], 0); vp[jt][1] = pack_step(Un[jt], 1); }
#pragma unroll
            for (int tt = 0; tt < 2; ++tt) {
                f32x16 aq = zero16();
#pragma unroll
                for (int kb = 0; kb < 4; ++kb)
#pragma unroll
                    for (int s = 0; s < 2; ++s) aq = MFMA32(ld_perm_frag(Ql + (tt * 32 + r) * 136, kb * 32, s, hh), pack_step(S[kb], s), aq);
#pragma unroll
                for (int i = 0; i < 16; ++i) aq[i] *= scl[tt * 32 + crow(i, hh)];
#pragma unroll
                for (int jt = 0; jt < 2; ++jt)
#pragma unroll
                    for (int s = 0; s < 2; ++s) aq = MFMA32(ld_perm_frag(QKl + (tt * 32 + r) * 72, jt * 32, s, hh), vp[jt][s], aq);
#pragma unroll
                for (int i = 0; i < 16; ++i) { const int pos = tt * 32 + crow(i, hh), row = row0 + (d ? 63 - pos : pos); OG[(size_t)row * D + h * 128 + dv0 + r] = aq[i]; }
                asm volatile("" ::: "memory");
            }
#pragma unroll
            for (int jt = 0; jt < 2; ++jt) {
#pragma unroll
                for (int i = 0; i < 16; ++i) Un[jt][i] *= scl[64 + jt * 32 + crow(i, hh)];
                vp[jt][0] = pack_step(Un[jt], 0); vp[jt][1] = pack_step(Un[jt], 1); }
            if (step + 1 < 68) { const int cn = chunk_of(step + 1), unn = (cn * 8 + h) * 2 + d; const float* Uu = UGb + (size_t)unn * 8192 + dv0 + r;
#pragma unroll
                for (int tt = 0; tt < 2; ++tt)
#pragma unroll
                    for (int i = 0; i < 16; ++i) Un[tt][i] = Uu[(tt * 32 + crow(i, hh)) * 128]; }
            const float gtot = scl[128];
#pragma unroll
            for (int kb = 0; kb < 4; ++kb) { S[kb] = S[kb] * gtot;
#pragma unroll
                for (int jt = 0; jt < 2; ++jt)
#pragma unroll
                    for (int s = 0; s < 2; ++s) S[kb] = MFMA32(ld_perm_frag(KTl + (kb * 32 + r) * 72, jt * 32, s, hh), vp[jt][s], S[kb]);
                asm volatile("" ::: "memory"); }
        }
        __syncthreads();
    }
#undef GB_LOAD
#undef GB_STORE
}
DI void ph_gdn_gb(const Ctx& C, const Params& p, int lp) {
    constexpr int NU = 64 * (4 / GB_NSL);
    for (int u = C.blk; u < NU; u += C.nblk) gdn_gb_unit(C, u);
    if (C.nblk > NU) { if (C.blk >= NU) convert_weights(C, p, 1 + lp, (C.blk - NU) * 8 + C.wave, (C.nblk - NU) * 8); }
    else convert_weights(C, p, 1 + lp, C.blk * 8 + C.wave, C.nblk * 8);
}
constexpr int NPH_PAIR = 20, NPHASE = 1 + 2 * NPH_PAIR;
DI void fresh(Ctx& C) { int t = C.wave0 * 64 + (int)__builtin_amdgcn_mbcnt_hi(~0u, __builtin_amdgcn_mbcnt_lo(~0u, 0u)); asm volatile("" : "+v"(t));     int b = blockIdx.x; asm volatile("" : "+s"(b)); unsigned char* w_ = C.ws0; asm volatile("" : "+s"(w_)); C.ws = w_; C.tid = t; C.lane = t & 63; C.wave = __builtin_amdgcn_readfirstlane(t >> 6); C.blk = b; }
__global__ void __launch_bounds__(512, 2) fused_fwd(Params p) {
    extern __shared__ __attribute__((aligned(16))) unsigned char lds_raw[];
    Ctx C; C.lds = (LAS unsigned char*)lds_raw; C.ws = p.ws; C.ws0 = p.ws; C.tid = threadIdx.x; C.lane = C.tid & 63; C.wave = __builtin_amdgcn_readfirstlane(C.tid >> 6); C.wave0 = C.wave; C.nblk = gridDim.x; C.blk = blockIdx.x;
    volatile LAS unsigned* misc = (volatile LAS unsigned*)(C.lds + LDS_MISC);
    if (C.tid < 16) misc[C.tid] = 0u;
    __syncthreads();
    unsigned* ctl = (unsigned*)(p.ws + WS_CTL);
    const bool single = (p.ph_lo == 0 && p.ph_hi == NPHASE);
    XcdBarrier bar; bar.bar = ctl + CW_BAR; bar.x = 0; bar.st = misc;
    if (single) bar = xcd_barrier_post(ctl + CW_BAR, misc);
    const int lo = p.ph_lo, hi = p.ph_hi;
#ifndef PH_MASK
#define PH_MASK 0x1FFFFFu
#endif
#define PHEN(k) (((PH_MASK) >> (k)) & 1u)
#ifndef XTRA_BAR
#define XTRA_BAR 0
#endif
#ifndef REP_MASK
#define REP_MASK 0u
#endif
#define NREP(k) (1 + (int)(((REP_MASK) >> (k)) & 1u))
#define IN(k) (fresh(C), lo <= (k) && (k) < hi)
#define SEAM(k) do { if (single) { unsigned* bp_ = ctl + CW_BAR; asm volatile("" : "+s"(bp_)); bar.bar = bp_; xcd_barrier(bar); for (int xb_ = 0; xb_ < XTRA_BAR; ++xb_) xcd_barrier(bar); } } while (0)
#define H ((bf16*)(C.ws + WS_H))
#define MIX ((bf16*)(C.ws + WS_MIX))
#define P ((bf16*)(C.ws + WS_P))
#define X ((float*)(C.ws + WS_X))
#define MOD ((const float*)(C.ws + WS_MOD))
    for (int rep_ = 0; rep_ < NREP(0); ++rep_) { if (rep_) { SEAM(0); } if (PHEN(0) && IN(0)) ph_prologue(C, p); }
    SEAM(0);
    for (int lp = 0; lp < 2; ++lp) {
        const int pb = 1 + lp * NPH_PAIR, le = 2 * lp, lod = 2 * lp + 1;
        for (int rep_ = 0; rep_ < NREP(1); ++rep_) { if (rep_) { SEAM(0); } if (PHEN(1) && IN(pb + 0)) { if (lp == 0) ph_normmod(C, p, 0, false, true, 0, 0); } }
        SEAM(pb + 0);
        for (int rep_ = 0; rep_ < NREP(2); ++rep_) { if (rep_) { SEAM(0); } if (PHEN(2) && IN(pb + 1)) { pg8::Gemm g{H, (const bf16*)(C.ws + WS_WEIN) + (size_t)lp * 2560 * 1024, NTOK, EVEN_IN, D, 0}; pg8::StaticOrder S; S.init(NTOK, EVEN_IN, C.nblk, C.blk);
            EpiEvenIn E{P, (const float*)(C.ws + WS_COS), (const float*)(C.ws + WS_SIN)}; pg8::gemm_phase<EpiEvenIn, pg8::StaticOrder>(C.lds, g, S, E, C.tid); } }
        SEAM(pb + 1);
        for (int rep_ = 0; rep_ < NREP(20); ++rep_) { if (rep_) { SEAM(0); } if (PHEN(20) && IN(pb + 2)) ph_rg_gates(C, p, lp); }
        SEAM(pb + 2);
        for (int rep_ = 0; rep_ < NREP(3); ++rep_) { if (rep_) { SEAM(0); } if (PHEN(3) && IN(pb + 3)) ph_even_mix(C, p, le, rep_); }
        SEAM(pb + 3);
        for (int rep_ = NREP(4) - 1; rep_ >= 0; --rep_) { if (PHEN(4) && IN(pb + 4)) {
            { pg8::Gemm g{MIX, (const bf16*)(C.ws + WS_WEOUT) + (size_t)lp * 1024 * 1024, NLAT, D, D, 0}; pg8::StaticOrder S; S.init(NLAT, D, C.nblk, C.blk);
              EpiResid E{rep_ ? (float*)(C.ws + WS_U + (size_t)200 * 1024 * 1024) : X, MOD + (size_t)le * 5 * MODW + 2 * D}; pg8::gemm_phase<EpiResid, pg8::StaticOrder>(C.lds, g, S, E, C.tid); }
            { fresh(C); pg8::Gemm g{MIX + (size_t)NLAT * D, (const bf16*)(C.ws + WS_WEOUT) + (size_t)lp * 1024 * 1024, NCTX, D, D, D / 4}; pg8::StaticOrder S; S.init(NCTX, D, C.nblk, C.blk); S.lim = S.nwg * 4; S.s = 4;
              EpiPart E{(float*)(C.ws + WS_PART)}; pg8::gemm_phase<EpiPart, pg8::StaticOrder>(C.lds, g, S, E, C.tid); } } if (rep_) { SEAM(0); } }
        SEAM(pb + 4);
        for (int rep_ = 0; rep_ < NREP(5); ++rep_) { if (rep_) { SEAM(0); } if (PHEN(5) && IN(pb + 5)) ph_normmod(C, p, le, true, false, 4, le * 5 * MODW + 2 * D); }
        SEAM(pb + 5);
        for (int rep_ = 0; rep_ < NREP(6); ++rep_) { if (rep_) { SEAM(0); } if (PHEN(6) && IN(pb + 6)) { pg8::Gemm g{H, (const bf16*)(C.ws + WS_WEF1) + (size_t)lp * 5632 * 1024, NTOK, 2 * FFN, D, 0}; pg8::StaticOrder S; S.init(NTOK, 2 * FFN, C.nblk, C.blk);
            EpiSwiglu E{P, FFN, 2 * FFN / 256}; pg8::gemm_phase<EpiSwiglu, pg8::StaticOrder>(C.lds, g, S, E, C.tid); } }
        SEAM(pb + 6);
        for (int rep_ = NREP(7) - 1; rep_ >= 0; --rep_) { if (PHEN(7) && IN(pb + 7)) {
            { pg8::Gemm g{P, (const bf16*)(C.ws + WS_WEF2) + (size_t)lp * 1024 * 2816, NLAT, D, FFN, 0}; pg8::StaticOrder S; S.init(NLAT, D, C.nblk, C.blk);
              EpiResid E{rep_ ? (float*)(C.ws + WS_U + (size_t)200 * 1024 * 1024) : X, MOD + (size_t)le * 5 * MODW + 5 * D}; pg8::gemm_phase<EpiResid, pg8::StaticOrder>(C.lds, g, S, E, C.tid); }
            { fresh(C); pg8::Gemm g{P + (size_t)NLAT * FFN, (const bf16*)(C.ws + WS_WEF2) + (size_t)lp * 1024 * 2816, NCTX, D, FFN, FFN / 11}; pg8::StaticOrder S; S.init(NCTX, D, C.nblk, C.blk); S.lim = S.nwg * 11; S.s = 11;
              EpiPart E{(float*)(C.ws + WS_PART)}; pg8::gemm_phase<EpiPart, pg8::StaticOrder>(C.lds, g, S, E, C.tid); } } if (rep_) { SEAM(0); } }
        SEAM(pb + 7);
        const int ntok = (lod < DEPTH - 1) ? NTOK : NLAT;
        for (int rep_ = 0; rep_ < NREP(8); ++rep_) { if (rep_) { SEAM(0); } if (PHEN(8) && IN(pb + 8)) ph_normmod(C, p, lod, false, false, 11, le * 5 * MODW + 5 * D); }
        SEAM(pb + 8);
        for (int rep_ = 0; rep_ < NREP(9); ++rep_) { if (rep_) { SEAM(0); } if (PHEN(9) && IN(pb + 9)) { pg8::Gemm g{H, (const bf16*)(C.ws + WS_WOIN) + (size_t)lp * 4352 * 1024, NTOK, 4352, D, 0}; pg8::StaticOrder S; S.init(NTOK, 4352, C.nblk, C.blk);
            EpiBf16Ab E{P, 4352, (float*)(C.ws + WS_AB), 16}; pg8::gemm_phase<EpiBf16Ab, pg8::StaticOrder>(C.lds, g, S, E, C.tid); } }
        SEAM(pb + 9);
        for (int rep_ = 0; rep_ < NREP(10); ++rep_) { if (rep_) { SEAM(0); } if (PHEN(10) && IN(pb + 10)) ph_odd_conv(C, p, lp); }
        SEAM(pb + 10);
        for (int rep_ = 0; rep_ < NREP(11); ++rep_) { if (rep_) { SEAM(0); } if (PHEN(11) && IN(pb + 11)) ph_gdn_ga(C); }
        SEAM(pb + 11);
        for (int rep_ = 0; rep_ < NREP(12); ++rep_) { if (rep_) { SEAM(0); } if (PHEN(12) && IN(pb + 12)) ph_gdn_gb(C, p, lp); }
        SEAM(pb + 12);
        for (int rep_ = 0; rep_ < NREP(13); ++rep_) { if (rep_) { SEAM(0); } if (PHEN(13) && IN(pb + 13)) ph_gdn_out(C, p, lp); }
        SEAM(pb + 13);
        for (int rep_ = NREP(14) - 1; rep_ >= 0; --rep_) { if (PHEN(14) && IN(pb + 14)) {
            { pg8::Gemm g{MIX, (const bf16*)(C.ws + WS_WOOUT) + (size_t)lp * 1024 * 1024, NLAT, D, D, 0}; pg8::StaticOrder S; S.init(NLAT, D, C.nblk, C.blk);
              EpiResid E{rep_ ? (float*)(C.ws + WS_U + (size_t)200 * 1024 * 1024) : X, MOD + (size_t)lod * 5 * MODW + 2 * D}; pg8::gemm_phase<EpiResid, pg8::StaticOrder>(C.lds, g, S, E, C.tid); }
            if (lod < DEPTH - 1) { fresh(C); pg8::Gemm g{MIX + (size_t)NLAT * D, (const bf16*)(C.ws + WS_WOOUT) + (size_t)lp * 1024 * 1024, NCTX, D, D, D / 4}; pg8::StaticOrder S; S.init(NCTX, D, C.nblk, C.blk); S.lim = S.nwg * 4; S.s = 4;
              EpiPart E{(float*)(C.ws + WS_PART)}; pg8::gemm_phase<EpiPart, pg8::StaticOrder>(C.lds, g, S, E, C.tid); } } if (rep_) { SEAM(0); } }
        SEAM(pb + 14);
        if (PHEN(15) && IN(pb + 15)) ph_router(C, p, lod, ntok, (lod < DEPTH - 1) ? 4 : 0);
        SEAM(pb + 15);
        for (int rep_ = 0; rep_ < NREP(16); ++rep_) { if (rep_) { SEAM(0); } if (PHEN(16) && IN(pb + 16)) ph_gather(C, lod, ntok); }
        SEAM(pb + 16);
        for (int rep_ = 0; rep_ < NREP(17); ++rep_) { if (rep_) { SEAM(0); } if (PHEN(17) && IN(pb + 17)) { pg8::Gemm g{(const bf16*)(C.ws + WS_XS), (const bf16*)(C.ws + WS_WXIN) + (size_t)lp * 8 * 7168 * 1024, RMAX, 8 * 7168, D, 0}; MoeOrder S; S.initm(ctl + CW_CNT + lp * 64, 28, C.nblk, C.blk);
            EpiSwiglu E{(bf16*)(C.ws + WS_HIDM), FFE, 28}; pg8::gemm_phase<EpiSwiglu, MoeOrder>(C.lds, g, S, E, C.tid); } }
        SEAM(pb + 17);
        for (int rep_ = 0; rep_ < NREP(18); ++rep_) { if (rep_) { SEAM(0); } if (PHEN(18) && IN(pb + 18)) {
            pg8::Gemm g{(const bf16*)(C.ws + WS_HIDM), (const bf16*)(C.ws + WS_WXOUT) + (size_t)lp * 8 * 1024 * 3584, RMAX, 8 * 1024, FFE, 0}; MoeOrder S; S.initm(ctl + CW_CNT + lp * 64, 4, C.nblk, C.blk);
            EpiF32 E{(float*)(C.ws + WS_Y), D, 4}; pg8::gemm_phase<EpiF32, MoeOrder>(C.lds, g, S, E, C.tid); } }
        SEAM(pb + 18);
        if (PHEN(19) && IN(pb + 19)) ph_combine(C, p, lod, ntok, ctl + CW_CNT + lp * 64);
        SEAM(pb + 19);
    }
#undef IN
#undef SEAM
#undef H
#undef MIX
#undef P
#undef X
#undef MOD
}

static int fused_setup() {
    static int grid = 0;
    if (grid == 0) {
        int dev = 0, cus = 0, per_cu = 0;
        if (hipGetDevice(&dev) != hipSuccess || hipDeviceGetAttribute(&cus, hipDeviceAttributeMultiprocessorCount, dev) != hipSuccess) { fprintf(stderr, "fused_setup: device query failed\n"); grid = -1; return grid; }
        if (hipFuncSetAttribute((const void*)fused_fwd, hipFuncAttributeMaxDynamicSharedMemorySize, LDS_BYTES) != hipSuccess) { fprintf(stderr, "fused_setup: hipFuncSetAttribute failed\n"); grid = -1; return grid; }
        if (hipOccupancyMaxActiveBlocksPerMultiprocessor(&per_cu, (const void*)fused_fwd, 512, LDS_BYTES) != hipSuccess || per_cu < 1) { fprintf(stderr, "fused_setup: occupancy query says %d blocks per CU\n", per_cu); (void)hipGetLastError(); }
        grid = cus;
    }
    return grid;
}
static void launch_fused(const Params& p0, int lo, int hi, hipStream_t s) {
    const int grid = fused_setup(); if (grid <= 0) return;
    Params p = p0; p.ph_lo = lo; p.ph_hi = hi;
    hipLaunchKernelGGL(fused_fwd, dim3(grid), dim3(512), LDS_BYTES, s, p);
}
}
#ifdef DEBUG_MODE
namespace dbg {
using namespace cfg;
__global__ void k_cmp_f32_bf16(const float* __restrict__ A, const unsigned short* __restrict__ R, size_t n, float* __restrict__ res) {
    float d2 = 0.f, r2 = 0.f;
    for (size_t i = (size_t)blockIdx.x * 256 + threadIdx.x; i < n; i += (size_t)gridDim.x * 256) { const float r = __uint_as_float((unsigned)R[i] << 16), a = A[i]; d2 += (a - r) * (a - r); r2 += r * r; }
    for (int o = 32; o >= 1; o >>= 1) { d2 += __shfl_xor(d2, o); r2 += __shfl_xor(r2, o); }
    if ((threadIdx.x & 63) == 0) { atomicAdd(res, d2); atomicAdd(res + 1, r2); }
}
__global__ void k_cmp_bf16_f32(const unsigned short* __restrict__ A, int fp, int fo, const float* __restrict__ R, int rp, int ro, int nrows, int ncols, float rscale, float* __restrict__ res) {
    float d2 = 0.f, r2 = 0.f;
    for (size_t i = (size_t)blockIdx.x * 256 + threadIdx.x; i < (size_t)nrows * ncols; i += (size_t)gridDim.x * 256) { const int row = (int)(i / ncols), c = (int)(i % ncols);
        const float a = __uint_as_float((unsigned)A[(size_t)row * fp + fo + c] << 16), r = R[(size_t)row * rp + ro + c] * rscale; d2 += (a - r) * (a - r); r2 += r * r; }
    for (int o = 32; o >= 1; o >>= 1) { d2 += __shfl_xor(d2, o); r2 += __shfl_xor(r2, o); }
    if ((threadIdx.x & 63) == 0) { atomicAdd(res, d2); atomicAdd(res + 1, r2); }
}
__global__ void k_cmp_f32_f32(const float* __restrict__ A, int fp, int fo, const float* __restrict__ R, int rp, int ro, int nrows, int ncols, float* __restrict__ res) {
    float d2 = 0.f, r2 = 0.f;
    for (size_t i = (size_t)blockIdx.x * 256 + threadIdx.x; i < (size_t)nrows * ncols; i += (size_t)gridDim.x * 256) { const int row = (int)(i / ncols), c = (int)(i % ncols);
        const float a = A[(size_t)row * fp + fo + c], r = R[(size_t)row * rp + ro + c]; d2 += (a - r) * (a - r); r2 += r * r; }
    for (int o = 32; o >= 1; o >>= 1) { d2 += __shfl_xor(d2, o); r2 += __shfl_xor(r2, o); }
    if ((threadIdx.x & 63) == 0) { atomicAdd(res, d2); atomicAdd(res + 1, r2); }
}
__global__ void k_decide(const float* __restrict__ res, int nchk, float tol, float* __restrict__ out, size_t nout) {
    int code = 0; float frac = 0.f;
    for (int k = 0; k < nchk; ++k) { const float err = res[2 * k] / res[2 * k + 1]; if (!(err <= tol)) { code = k + 1; float l = (err == err && err > 0.f) ? log10f(err) : 0.f; frac = fminf(fmaxf((l + 4.f) / 4.f * 0.9f, 0.f), 0.9f); break; } }
    if (code == 0) return;
    const float c = sqrtf((float)code + frac);
    for (size_t i = (size_t)blockIdx.x * 256 + threadIdx.x; i < nout; i += (size_t)gridDim.x * 256) out[i] = c;
}
}
#endif

static nv::NaiveWs carve_naive(char* base, size_t& off) {
    using namespace cfg;
    nv::NaiveWs w{};
    auto take = [&](size_t nfloats) { float* p = (float*)(base + off); off += ((nfloats * 4 + 255) / 256) * 256; return p; };
    w.MOD = take((size_t)DEPTH * 5 * MODW);
    w.X = take((size_t)NTOK * D); w.H = take((size_t)NTOK * D); w.P = take((size_t)NTOK * ODD_IN); w.MIX = take((size_t)NTOK * D);
    w.T0 = take((size_t)NTOK * 512); w.T1 = take((size_t)NTOK * 3072); w.T2 = take((size_t)NTOK * 2048);
    w.FOUT = take((size_t)NTOK * D); w.HID = take((size_t)NTOK * FFE);
    w.lam = take(64); w.cnt = (int*)take(64); w.list_tok = (int*)take((size_t)NEXP * NTOK); w.list_w = take((size_t)NEXP * NTOK);
    return w;
}
extern "C" void kernel_launch(void* const* d_in, const int* in_sizes, int n_in, void* d_out, int out_size, void* d_ws, size_t ws_size, hipStream_t stream) {
    using namespace cfg;
    if (n_in != 31 || out_size != NLAT * D) { fprintf(stderr, "kernel_launch: unexpected n_in %d / out_size %d\n", n_in, out_size); return; }
    fk::Params p{}; for (int i = 0; i < 31; ++i) p.in[i] = (const float*)d_in[i];
    p.out = (float*)d_out; p.ws = (unsigned char*)d_ws;
#ifdef DEBUG_MODE
    const size_t snap_bytes = (size_t)NTOK * D * 2, CK_BYTES = 8 * snap_bytes + (size_t)NLAT * D * 4 + 4096;
    if (ws_size < fk::WS_END + CK_BYTES) { fprintf(stderr, "kernel_launch(debug): workspace too small\n"); return; }
    char* ckb = (char*)d_ws + ws_size - CK_BYTES; ckb -= ((size_t)ckb & 255);
    unsigned short* snaps = (unsigned short*)ckb; float* nout = (float*)(ckb + 8 * snap_bytes); float* res = (float*)(ckb + 8 * snap_bytes + (size_t)NLAT * D * 4);
    {
        nv::Inputs in{}; for (int i = 0; i < 31; ++i) in.p[i] = (const float*)d_in[i];
        size_t off = 0; nv::NaiveWs w = carve_naive((char*)d_ws, off);
        if ((char*)d_ws + off > ckb) { fprintf(stderr, "kernel_launch(debug): oracle scratch overlaps snapshots\n"); return; }
        nv::run_naive(in, w, nout, snaps, stream);
    }
    (void)hipMemsetAsync(res, 0, 4096, stream);
    (void)hipMemsetAsync((char*)d_ws + fk::WS_CTL, 0, fk::CTL_BYTES, stream);
    int chk = 0;
    for (int ph = 0; ph < fk::NPHASE; ++ph) {
        fk::launch_fused(p, ph, ph + 1, stream);
        if (ph == 0) continue;
        const int lp = (ph - 1) / fk::NPH_PAIR, k = (ph - 1) % fk::NPH_PAIR;
        int snap = -1;
        if (k == 4) snap = 4 * lp + 0; else if (k == 7) snap = 4 * lp + 1; else if (k == 14) snap = 4 * lp + 2; else if (k == 19 && lp == 0) snap = 3;
        if (snap >= 0) { hipLaunchKernelGGL(dbg::k_cmp_f32_bf16, dim3(2048), dim3(256), 0, stream, (const float*)((char*)d_ws + fk::WS_X), snaps + (size_t)snap * NTOK * D, (size_t)NTOK * D, res + 2 * chk); ++chk; }
    }
    hipLaunchKernelGGL(dbg::k_cmp_f32_f32, dim3(2048), dim3(256), 0, stream, (const float*)d_out, D, 0, (const float*)nout, D, 0, NLAT, D, res + 2 * chk); ++chk;
    hipLaunchKernelGGL(dbg::k_decide, dim3(1024), dim3(256), 0, stream, (const float*)res, chk, DEBUG_TOL, (float*)d_out, (size_t)NLAT * D);
#else
    if (ws_size < fk::WS_END) { fprintf(stderr, "kernel_launch: workspace too small: need %zu have %zu\n", (size_t)fk::WS_END, ws_size); return; }
    (void)hipMemsetAsync((char*)d_ws + fk::WS_CTL, 0, fk::CTL_BYTES, stream);
    fk::launch_fused(p, 0, fk::NPHASE, stream);
#endif
}
```

```cpp
#include <hip/hip_runtime.h>
#include <cstdio>
#include <cstdint>
#include <cmath>
namespace cfg {
constexpr int D = 1024, B = 4, SEQ = 4096, CTX = 256, DEPTH = 4;
constexpr int NLAT = B * SEQ, NCTX = B * CTX, NTOK = NLAT + NCTX;
constexpr int NMOD = 6, MODW = NMOD * D;
constexpr int EVEN_IN = 2560, ODD_IN = 4128, FFN = 2816, FFE = 3584, NEXP = 8;
}
namespace nv {
using namespace cfg;
struct NaiveWs { float *MOD, *X, *H, *P, *MIX, *T0, *T1, *T2, *FOUT, *HID, *lam; int* cnt; int* list_tok; float* list_w; };
}
namespace pg8 {
#define PG8_LAS __attribute__((address_space(3)))
#define PG8_GAS __attribute__((address_space(1)))
typedef unsigned short bf16_t;
typedef short bf16x8 __attribute__((ext_vector_type(8)));
typedef float f32x4 __attribute__((ext_vector_type(4)));
typedef unsigned u32x4 __attribute__((ext_vector_type(4)));
constexpr int BM = 256, BK = 64, HALF = 128, HTB = HALF * BK * 2  , STAGE_BYTES = 8 * HTB, NXCD = 8, WGM = 8;

__host__ __device__ __forceinline__ int lds_byte(int r, int c) { const int st = (r >> 4) * 2 + (c >> 5), rr = r & 15, cc = c & 31, ob = rr * 64 + cc * 2; return st * 1024 + (ob ^ (((ob >> 9) & 1) << 5)); }
__host__ __device__ __forceinline__ void stage_rc(int b, int& R, int& C) { const int st = b / 1024, sb = b % 1024, swz = sb ^ (((sb >> 9) & 1) << 5); R = (st >> 1) * 16 + swz / 64; C = (st & 1) * 32 + (swz % 64) / 2; }
__host__ __device__ __forceinline__ int perm32(int rho) { const int n = rho >> 4, i = rho & 15; return 8 * (i >> 2) + 4 * n + (i & 3); }

struct Unit { int pm, pn, pk; };
struct Gemm { const PG8_GAS bf16_t* A; const PG8_GAS bf16_t* Bt; int M, N, K, Kh; };

struct StaticOrder {
    int nM, nN, nwg, G, c;
    int lim, L0, s;
    __host__ __device__ void init(int M, int N, int G_, int c_) { nM = M / BM; nN = N / BM; nwg = nM * nN; G = G_; c = c_; lim = nwg; L0 = 0; s = 1; }
    __host__ __device__ void decode(int wgid, Unit& u) const {
        { const int q = nwg / NXCD, r = nwg % NXCD, xcd = wgid % NXCD, off = wgid / NXCD; wgid = (xcd < r ? xcd * (q + 1) : r * (q + 1) + (xcd - r) * q) + off; }
        const int nig = WGM * nN, gid = wgid / nig, fm = gid * WGM, gsz = (nM - fm) < WGM ? (nM - fm) : WGM;
        u.pm = fm + ((wgid % nig) % gsz); u.pn = (wgid % nig) / gsz;
    }
    __host__ __device__ bool next(int i, Unit& u) const {
        const long j = (long)i * G + c; if (j >= lim) return false;
        u.pk = (int)(j % s); decode(L0 + (int)(j / s), u); return true;
    }
    __host__ __device__ void main_part() { lim = (nwg / G) * G; L0 = 0; s = 1; }
    __host__ __device__ void tail_part(int s_) { L0 = (nwg / G) * G; s = s_; lim = (nwg - L0) * s_; }
    __host__ __device__ int tail_tiles() const { return nwg - (nwg / G) * G; }
    __device__ __forceinline__ void a_ready(const Unit&) const {}
    __device__ __forceinline__ void done(const Unit&) const {}
};
template <class Epi, class Sched, bool ALIGN_EPI = true, bool SP2 = true>
__device__ __forceinline__ void gemm_phase(PG8_LAS unsigned char* lds, const Gemm g, const Sched& S, const Epi& E, const int tid) {
    const int wid = __builtin_amdgcn_readfirstlane(tid >> 6), lane = tid & 63, wr = wid >> 2, wc = wid & 3, fr = lane & 15, fq = lane >> 4;
    const int K = g.K, Kh = g.Kh ? g.Kh : g.K, nt = Kh / BK;
    unsigned voffA[2], voffB[2];
#pragma unroll
    for (int i = 0; i < 2; ++i) { int R, C; stage_rc(tid * 16 + i * 8192, R, C); const int Rb = Epi::PERM ? ((R & ~31) + perm32(R & 31)) : R;
        voffA[i] = (unsigned)(R * K + C) * 2u; voffB[i] = (unsigned)(Rb * K + C) * 2u; }
    const size_t kstep = (size_t)(BK * 2);
    const size_t hstep = (size_t)HALF * K * 2;
    const size_t tstep = 2 * hstep;
    const unsigned ldsw = (unsigned)wid * 1024u;
    const int aoff = lds_byte(wr * 64 + fr, fq * 8), boff = lds_byte(wc * 32 + fr, fq * 8);
#define PG8_SA(b, h) (((b) * 2 + (h)) * HTB)
#define PG8_SB(b, h) ((4 + (b) * 2 + (h)) * HTB)
#define PG8_STAGE(bufoff, gbase, voff) do { _Pragma("unroll") for (int _i = 0; _i < 2; ++_i) \
        __builtin_amdgcn_global_load_lds((const PG8_GAS unsigned*)((const PG8_GAS char*)(gbase) + (voff)[_i]), (PG8_LAS unsigned*)(lds + (bufoff) + ldsw + _i * 8192), 16, 0, 0); } while (0)
#define PG8_LDA(dst, b, h) do { _Pragma("unroll") for (int m = 0; m < 4; ++m) _Pragma("unroll") for (int k = 0; k < 2; ++k) dst[m][k] = *(const PG8_LAS bf16x8*)(lds + PG8_SA(b, h) + aoff + m * 2048 + k * 1024); } while (0)
#define PG8_LDB(dst, b, h) do { _Pragma("unroll") for (int n = 0; n < 2; ++n) _Pragma("unroll") for (int k = 0; k < 2; ++k) dst[n][k] = *(const PG8_LAS bf16x8*)(lds + PG8_SB(b, h) + boff + n * 2048 + k * 1024); } while (0)
#define PG8_MMA(ai, bj, At, Bt) do { __builtin_amdgcn_s_setprio(1); _Pragma("unroll") for (int m = 0; m < 4; ++m) _Pragma("unroll") for (int n = 0; n < 2; ++n) _Pragma("unroll") for (int k = 0; k < 2; ++k) \
        acc[ai][bj][m][n] = __builtin_amdgcn_mfma_f32_16x16x32_bf16(Bt[n][k], At[m][k], acc[ai][bj][m][n], 0, 0, 0); __builtin_amdgcn_s_setprio(0); } while (0)
#define PG8_WAIT_V(n) asm volatile("s_waitcnt vmcnt(" #n ")" ::: "memory")
#define PG8_WAIT_L(n) asm volatile("s_waitcnt lgkmcnt(" #n ")" ::: "memory")
#define PG8_BAR __builtin_amdgcn_s_barrier()
#define PG8_SCHED __builtin_amdgcn_sched_barrier(0)
    Unit cur, nxt; int ui = 0;
    if (!S.next(0, cur)) return;
    f32x4 acc[2][2][4][2];
#pragma unroll
    for (int a = 0; a < 2; ++a)
#pragma unroll
        for (int b = 0; b < 2; ++b)
#pragma unroll
            for (int m = 0; m < 4; ++m)
#pragma unroll
                for (int n = 0; n < 2; ++n) acc[a][b][m][n] = (f32x4){0.f, 0.f, 0.f, 0.f};
    bf16x8 At[4][2], B0[2][2], B1[2][2];
    const PG8_GAS char* cA = (const PG8_GAS char*)g.A + (size_t)cur.pm * tstep + (size_t)cur.pk * Kh * 2; const PG8_GAS char* cB = (const PG8_GAS char*)g.Bt + (size_t)cur.pn * tstep + (size_t)cur.pk * Kh * 2;
    S.a_ready(cur);
    if constexpr (SP2) {
        PG8_STAGE(PG8_SB(0, 0), cB, voffB); PG8_STAGE(PG8_SB(0, 1), cB + hstep, voffB); PG8_STAGE(PG8_SA(0, 0), cA, voffA); PG8_STAGE(PG8_SA(0, 1), cA + hstep, voffA);
        if (wr == 1) PG8_BAR;
        PG8_WAIT_V(2); PG8_BAR;
        PG8_STAGE(PG8_SB(1, 0), cB + kstep, voffB); PG8_STAGE(PG8_SA(1, 0), cA + kstep, voffA); PG8_STAGE(PG8_SB(1, 1), cB + hstep + kstep, voffB);
        PG8_WAIT_V(6); PG8_BAR;
    } else {
    PG8_STAGE(PG8_SB(0, 0), cB, voffB); PG8_STAGE(PG8_SA(0, 0), cA, voffA); PG8_STAGE(PG8_SB(0, 1), cB + hstep, voffB); PG8_STAGE(PG8_SA(0, 1), cA + hstep, voffA);
    if (wr == 1) PG8_BAR;
    PG8_WAIT_V(4); PG8_BAR;
    PG8_STAGE(PG8_SB(1, 0), cB + kstep, voffB); PG8_STAGE(PG8_SA(1, 0), cA + kstep, voffA); PG8_STAGE(PG8_SB(1, 1), cB + hstep + kstep, voffB);
    PG8_WAIT_V(6); PG8_BAR;
    }
    for (;;) {
        const bool has_next = S.next(ui + 1, nxt);
        const PG8_GAS char* nA = has_next ? (const PG8_GAS char*)g.A + (size_t)nxt.pm * tstep + (size_t)nxt.pk * Kh * 2 : cA; const PG8_GAS char* nB = has_next ? (const PG8_GAS char*)g.Bt + (size_t)nxt.pn * tstep + (size_t)nxt.pk * Kh * 2 : cB;
        for (int t = 0; t < nt; t += 2) {
            const bool last = (t == nt - 2);
            const PG8_GAS char* a1 = cA + (size_t)(t + 1) * kstep;
            const PG8_GAS char* a2 = last ? nA : cA + (size_t)(t + 2) * kstep; const PG8_GAS char* b2 = last ? nB : cB + (size_t)(t + 2) * kstep;
            const PG8_GAS char* a3 = a2 + kstep; const PG8_GAS char* b3 = b2 + kstep;
            if (last && has_next) S.a_ready(nxt);
            if constexpr (SP2) {
            PG8_LDB(B0, 0, 0); PG8_LDB(B1, 0, 1); PG8_SCHED; PG8_LDA(At, 0, 0); PG8_STAGE(PG8_SA(1, 1), a1 + hstep, voffA);
            PG8_WAIT_V(8); PG8_WAIT_L(0); PG8_BAR; PG8_MMA(0, 0, At, B0); PG8_MMA(0, 1, At, B1); PG8_BAR; PG8_SCHED;
            PG8_LDA(At, 0, 1); PG8_STAGE(PG8_SB(0, 0), b2, voffB); PG8_STAGE(PG8_SB(0, 1), b2 + hstep, voffB); PG8_STAGE(PG8_SA(0, 0), a2, voffA);
            PG8_WAIT_V(8); PG8_WAIT_L(0); PG8_BAR; PG8_MMA(1, 0, At, B0); PG8_MMA(1, 1, At, B1); PG8_BAR; PG8_SCHED;
            PG8_LDB(B0, 1, 0); PG8_LDB(B1, 1, 1); PG8_SCHED; PG8_LDA(At, 1, 0); PG8_STAGE(PG8_SA(0, 1), a2 + hstep, voffA);
            PG8_WAIT_V(8); PG8_WAIT_L(0); PG8_BAR; PG8_MMA(0, 0, At, B0); PG8_MMA(0, 1, At, B1); PG8_BAR; PG8_SCHED;
            PG8_LDA(At, 1, 1); PG8_STAGE(PG8_SB(1, 0), b3, voffB); PG8_STAGE(PG8_SB(1, 1), b3 + hstep, voffB); PG8_STAGE(PG8_SA(1, 0), a3, voffA);
            PG8_WAIT_V(8); PG8_WAIT_L(0); PG8_BAR; PG8_MMA(1, 0, At, B0); PG8_MMA(1, 1, At, B1); PG8_BAR; PG8_SCHED;
            } else {
            PG8_LDB(B0, 0, 0); PG8_SCHED; PG8_LDA(At, 0, 0); PG8_STAGE(PG8_SA(1, 1), a1 + hstep, voffA);
            PG8_WAIT_L(8); PG8_BAR; PG8_WAIT_L(0); PG8_MMA(0, 0, At, B0); PG8_BAR; PG8_SCHED;
            PG8_LDB(B1, 0, 1); PG8_STAGE(PG8_SB(0, 0), b2, voffB);
            PG8_BAR; PG8_WAIT_L(0); PG8_MMA(0, 1, At, B1); PG8_BAR;
            PG8_LDA(At, 0, 1); PG8_STAGE(PG8_SA(0, 0), a2, voffA);
            PG8_BAR; PG8_WAIT_L(0); PG8_MMA(1, 0, At, B0); PG8_BAR; PG8_SCHED;
            PG8_STAGE(PG8_SB(0, 1), b2 + hstep, voffB);
            PG8_WAIT_V(6); PG8_BAR; PG8_MMA(1, 1, At, B1); PG8_BAR;
            PG8_LDB(B0, 1, 0); PG8_SCHED; PG8_LDA(At, 1, 0); PG8_STAGE(PG8_SA(0, 1), a2 + hstep, voffA);
            PG8_WAIT_L(8); PG8_BAR; PG8_WAIT_L(0); PG8_MMA(0, 0, At, B0); PG8_BAR; PG8_SCHED;
            PG8_LDB(B1, 1, 1); PG8_STAGE(PG8_SB(1, 0), b3, voffB);
            PG8_BAR; PG8_WAIT_L(0); PG8_MMA(0, 1, At, B1); PG8_BAR;
            PG8_LDA(At, 1, 1); PG8_STAGE(PG8_SA(1, 0), a3, voffA);
            PG8_BAR; PG8_WAIT_L(0); PG8_MMA(1, 0, At, B0); PG8_BAR; PG8_SCHED;
            PG8_STAGE(PG8_SB(1, 1), b3 + hstep, voffB);
            PG8_WAIT_V(6); PG8_BAR; PG8_MMA(1, 1, At, B1); PG8_BAR;
            }
        }
        if constexpr (ALIGN_EPI) { if (wr == 0) PG8_BAR; }
        if constexpr (!Epi::AFTER_DRAIN) { E(acc, cur, wr, wc, fr, fq); S.done(cur); }
        if (!has_next) break;
#pragma unroll
        for (int a = 0; a < 2; ++a)
#pragma unroll
            for (int b = 0; b < 2; ++b)
#pragma unroll
                for (int m = 0; m < 4; ++m)
#pragma unroll
                    for (int n = 0; n < 2; ++n) acc[a][b][m][n] = (f32x4){0.f, 0.f, 0.f, 0.f};
        cur = nxt; cA = nA; cB = nB; ++ui;
        if constexpr (ALIGN_EPI) { if (wr == 1) PG8_BAR; }
    }
    PG8_WAIT_V(0);
    if constexpr (!ALIGN_EPI) { if (wr == 0) PG8_BAR; }
    PG8_BAR;
    if constexpr (Epi::AFTER_DRAIN) { E.fused(acc, cur, wr, wc, fr, fq, lds, wid, lane); S.done(cur); }
#undef PG8_SA
#undef PG8_SB
#undef PG8_STAGE
#undef PG8_LDA
#undef PG8_LDB
#undef PG8_MMA
#undef PG8_WAIT_V
#undef PG8_WAIT_L
#undef PG8_BAR
#undef PG8_SCHED
}
}
namespace fk {
using namespace cfg;
#define LAS __attribute__((address_space(3)))
typedef unsigned short bf16;
typedef short bf16x8 __attribute__((ext_vector_type(8)));
typedef short s16x4 __attribute__((ext_vector_type(4)));
typedef float f32x4 __attribute__((ext_vector_type(4)));
typedef float f32x2 __attribute__((ext_vector_type(2)));
typedef float f32x16 __attribute__((ext_vector_type(16)));
typedef unsigned u32x4 __attribute__((ext_vector_type(4)));
typedef unsigned u32x2 __attribute__((ext_vector_type(2)));
typedef __bf16 bf16x2_t __attribute__((ext_vector_type(2)));
#define DI __device__ __forceinline__
#define GAS __attribute__((address_space(1)))
typedef GAS float gfloat; typedef GAS unsigned short gbf16; typedef GAS unsigned guint; typedef GAS int gint; typedef GAS unsigned char guchar;
#define MFMA32(a, b, c) __builtin_amdgcn_mfma_f32_32x32x16_bf16((a), (b), (c), 0, 0, 0)

DI unsigned pk2(float a, float b) { f32x2 f = {a, b}; bf16x2_t r = __builtin_convertvector(f, bf16x2_t); return __builtin_bit_cast(unsigned, r); }
DI bf16 f2bf(float a) { return (bf16)(pk2(a, 0.f) & 0xffffu); }
DI float bf2f(bf16 v) { return __builtin_bit_cast(float, (unsigned)v << 16); }
DI float bflo(unsigned w) { return __builtin_bit_cast(float, w << 16); }
DI float bfhi(unsigned w) { return __builtin_bit_cast(float, w & 0xffff0000u); }
DI float sigmoid_(float x) { return __builtin_amdgcn_rcpf(1.f + __expf(-x)); }
DI float silu_(float x) { return x * __builtin_amdgcn_rcpf(1.f + __expf(-x)); }
DI float softplus_(float x) { return fmaxf(x, 0.f) + log1pf(expf(-fabsf(x))); }
DI float gelu_tanh_(float x) { const float u = 0.7978845608028654f * (x + 0.044715f * x * x * x); const float e = __expf(2.f * u); return x * (1.f - __builtin_amdgcn_rcpf(e + 1.f)); }
DI int crow(int reg, int h) { return (reg & 3) + 8 * (reg >> 2) + 4 * h; }
DI f32x16 zero16() { f32x16 z; for (int i = 0; i < 16; ++i) z[i] = 0.f; return z; }
DI bf16x8 pack_step(const f32x16& x, int s) {
    u32x4 p; p[0] = pk2(x[8 * s], x[8 * s + 1]); p[1] = pk2(x[8 * s + 2], x[8 * s + 3]); p[2] = pk2(x[8 * s + 4], x[8 * s + 5]); p[3] = pk2(x[8 * s + 6], x[8 * s + 7]);
    return __builtin_bit_cast(bf16x8, p);
}
DI bf16x8 ld_perm_frag(const LAS bf16* rowp, int kbase, int s, int h) {
    const s16x4 lo = *(const LAS s16x4*)(rowp + kbase + 16 * s + 4 * h);
    const s16x4 hi = *(const LAS s16x4*)(rowp + kbase + 16 * s + 8 + 4 * h);
    return __builtin_shufflevector(lo, hi, 0, 1, 2, 3, 4, 5, 6, 7);
}
DI float shx(float v, int o, int lane) { return __builtin_bit_cast(float, __builtin_amdgcn_ds_bpermute((lane ^ o) << 2, __builtin_bit_cast(int, v))); }
DI float wave_sum(float v, int lane) {
#pragma unroll
    for (int o = 1; o < 64; o <<= 1) v += shx(v, o, lane);
    return v;
}

constexpr size_t al256(size_t x) { return (x + 255) / 256 * 256; }
constexpr int RMAX = 36864;
constexpr int NCH = NTOK / 64;
constexpr int NCHD = NCH * 8 * 2;
constexpr size_t WS_CTL = 0, CTL_BYTES = 1u << 20;
constexpr size_t WS_MOD = CTL_BYTES;
constexpr size_t WS_COS = WS_MOD + al256((size_t)DEPTH * 5 * MODW * 4);
constexpr size_t WS_SIN = WS_COS + (size_t)SEQ * 32 * 4;
constexpr size_t WS_WEIN = WS_SIN + (size_t)SEQ * 32 * 4;
constexpr size_t WS_WEOUT = WS_WEIN + (size_t)2 * 2560 * 1024 * 2;
constexpr size_t WS_WEF1 = WS_WEOUT + (size_t)2 * 1024 * 1024 * 2;
constexpr size_t WS_WEF2 = WS_WEF1 + (size_t)2 * 5632 * 1024 * 2;
constexpr size_t WS_WOIN = WS_WEF2 + (size_t)2 * 1024 * 2816 * 2;
constexpr size_t WS_WOOUT = WS_WOIN + (size_t)2 * 4352 * 1024 * 2;
constexpr size_t WS_WXIN = WS_WOOUT + (size_t)2 * 1024 * 1024 * 2;
constexpr size_t WS_WXOUT = WS_WXIN + (size_t)2 * 8 * 7168 * 1024 * 2;
constexpr size_t WS_X = WS_WXOUT + (size_t)2 * 8 * 1024 * 3584 * 2;
constexpr size_t WS_H = WS_X + (size_t)NTOK * D * 4;
constexpr size_t WS_MIX = WS_H + (size_t)NTOK * D * 2;
constexpr size_t WS_P = WS_MIX + (size_t)NTOK * D * 2;
constexpr size_t WS_HS1 = WS_P + (size_t)NTOK * 4352 * 2;
constexpr size_t WS_U = WS_HS1 + (size_t)NTOK * 512 * 4;
constexpr size_t WS_PART = WS_U + (size_t)400 * 1024 * 1024;
constexpr size_t WS_RGA = WS_U;
constexpr size_t WS_RGU = WS_RGA + (size_t)2 * NTOK * 512 * 4;
constexpr size_t WS_QKVN = WS_U;
constexpr size_t WS_WG = WS_QKVN + (size_t)NTOK * 3072 * 2;
constexpr size_t WS_UG = WS_WG + (size_t)NCHD * 64 * 128 * 2;
constexpr size_t WS_QKD = WS_UG + (size_t)NCHD * 64 * 128 * 4;
constexpr size_t WS_SC = WS_QKD + (size_t)NCHD * 64 * 64 * 2;
constexpr size_t WS_KTG = WS_SC + (size_t)NCHD * 192 * 4;
constexpr size_t WS_OG = WS_KTG + (size_t)NCHD * 128 * 64 * 2;
constexpr size_t WS_U_END1 = WS_OG + (size_t)2 * NTOK * D * 4;
constexpr size_t WS_XS = WS_U;
constexpr size_t WS_HIDM = WS_XS + (size_t)RMAX * D * 2;
constexpr size_t WS_Y = WS_HIDM + (size_t)RMAX * FFE * 2;
constexpr size_t WS_YP = WS_Y + (size_t)RMAX * D * 4;
constexpr size_t WS_U_END2 = WS_YP + (size_t)64 * 256 * D * 4;
constexpr size_t WS_TOK = (WS_U_END1 > WS_U_END2 ? WS_U_END1 : WS_U_END2);
constexpr size_t WS_END = WS_TOK + (size_t)NTOK * 32;
constexpr size_t WS_AB = WS_HS1;
constexpr size_t WS_GB = WS_AB + (size_t)NTOK * 32 * 4;

constexpr int CW_BAR = 4096;
constexpr int CW_CNT = 8192;
constexpr int CW_Q = 8448;

constexpr int LDS_BYTES = 152 * 1024;
constexpr int LDS_MISC = LDS_BYTES - 256;

struct Params { const float* in[31]; float* out; unsigned char* ws; int ph_lo, ph_hi; int dbg0, dbg1; };

DI const gfloat* gin(const Params& p, int k) { return (const gfloat*)p.in[k]; }
struct Ctx {
    LAS unsigned char* lds;
    guchar* ws; guchar* ws0;
    int tid, lane, wave, nblk, blk, wave0;
};
#define XB_TMO      128
#define XB_XCNT(j)  (256  + 64 * (j))
#define XB_XSUB(j)  (1280 + 64 * (j))
#define XB_XGEN(j)  (2304 + 64 * (j))
#define XB_TOP      3328
#define XB_TOPGEN   3392
#define XCD_BAR_WORDS 3456
#define XB_SPIN_CAP (1u << 27)

__device__ __forceinline__ unsigned xb_ld(unsigned* p)              { return __hip_atomic_load(p, __ATOMIC_RELAXED, __HIP_MEMORY_SCOPE_AGENT); }
__device__ __forceinline__ unsigned xb_add(unsigned* p, unsigned v) { return __hip_atomic_fetch_add(p, v, __ATOMIC_RELAXED, __HIP_MEMORY_SCOPE_AGENT); }
__device__ __forceinline__ unsigned xb_xcc_id() { return (unsigned)__builtin_amdgcn_s_getreg((3 << 11) | 20) & 0xFu; }
#define XB_SPIN(cond, bar) do { unsigned _sp = 0; while (cond) { __builtin_amdgcn_s_sleep(1); \
    if ((++_sp & 255u) == 0u) { if (xb_ld(&(bar)[XB_TMO])) break; if (_sp > XB_SPIN_CAP) { atomicAdd(&(bar)[XB_TMO], 1u); break; } } } } while (0)

struct XcdBarrier {
    unsigned* bar; unsigned x;
    volatile LAS unsigned* st;
};

__device__ __forceinline__ XcdBarrier xcd_barrier_post(unsigned* bar, volatile LAS unsigned* st) {
    XcdBarrier b; b.bar = bar; b.x = xb_xcc_id(); b.st = st;
    if (threadIdx.x == 0) (void)xb_add(&bar[XB_XCNT(b.x)], 1u);
    return b;
}
__device__ __forceinline__ void xcd_barrier_complete(unsigned* bar, unsigned x, unsigned& nloc, unsigned& nx) {
    const unsigned G = gridDim.x * gridDim.y * gridDim.z;
    unsigned sum, cnt, mine, sp = 0u;
    for (;;) {
        sum = 0u; cnt = 0u; mine = 0u;
#pragma unroll
        for (unsigned j = 0; j < 16; ++j) { const unsigned c = xb_ld(&bar[XB_XCNT(j)]); sum += c; cnt += (c > 0u) ? 1u : 0u; mine = (j == x) ? c : mine; }
        if (sum == G) break;
        __builtin_amdgcn_s_sleep(1);
        if ((++sp & 255u) == 0u) { if (xb_ld(&bar[XB_TMO])) break; if (sp > XB_SPIN_CAP) { atomicAdd(&bar[XB_TMO], 1u); break; } }
    }
    nloc = mine > 0u ? mine : 1u; nx = cnt > 0u ? cnt : 1u;
}

__device__ __forceinline__ void xcd_barrier(const XcdBarrier& b) {
    asm volatile("s_waitcnt vmcnt(0)" ::: "memory");
    __syncthreads();
    if (threadIdx.x == 0) {
        unsigned* bar = b.bar;
        __builtin_amdgcn_s_waitcnt(0);
        unsigned nloc = b.st[0], nx = b.st[1];
        if (nloc == 0u) { xcd_barrier_complete(bar, b.x, nloc, nx); b.st[0] = nloc; b.st[1] = nx; }
        const unsigned old = xb_add(&bar[XB_XSUB(b.x)], 1u);
        const unsigned gen = old / nloc;
        if (old + 1u == (gen + 1u) * nloc) {
            __builtin_amdgcn_fence(__ATOMIC_RELEASE, "agent");
            asm volatile("s_waitcnt vmcnt(0)" ::: "memory");
            const unsigned og = xb_add(&bar[XB_TOP], 1u);
            const unsigned tg = og / nx;
            if (og + 1u == (tg + 1u) * nx) xb_add(&bar[XB_TOPGEN], 1u);
            else XB_SPIN(xb_ld(&bar[XB_TOPGEN]) == tg, bar);
            __builtin_amdgcn_fence(__ATOMIC_ACQUIRE, "agent");
            xb_add(&bar[XB_XGEN(b.x)], 1u);
            asm volatile("s_waitcnt vmcnt(0)" ::: "memory");
        } else {
            XB_SPIN(xb_ld(&bar[XB_XGEN(b.x)]) == gen, bar);
            __builtin_amdgcn_fence(__ATOMIC_ACQUIRE, "agent");
            asm volatile("s_waitcnt vmcnt(0)" ::: "memory");
        }
    }
    __syncthreads();
}

using pg8::Unit;
typedef pg8::f32x4 af4;

struct EpiEvenIn {
    static constexpr bool PERM = true, AFTER_DRAIN = false;
    gbf16* P; const gfloat* cosT; const gfloat* sinT;
    DI void operator()(const af4 (&acc)[2][2][4][2], const Unit& u, int wr, int wc, int fr, int fq) const {
        const int row0 = u.pm * 256 + wr * 64 + fr, col0 = u.pn * 256 + wc * 32 + 8 * fq;
        const bool rope = (u.pn < 4) && (u.pm < 64);
        const float qs = (u.pn < 2) ? 0.18033688011112042f : 1.f;
#pragma unroll
        for (int ai = 0; ai < 2; ++ai)
#pragma unroll
            for (int m = 0; m < 4; ++m) {
                const int row = row0 + ai * 128 + m * 16;
                gbf16* rowp = P + (size_t)row * EVEN_IN + col0;
#pragma unroll
                for (int bj = 0; bj < 2; ++bj) {
                    af4 v0 = acc[ai][bj][m][0], v1 = acc[ai][bj][m][1];
                    if (rope) {
                        const int t = row & 4095, i0 = ((col0 + bj * 128) & 63) >> 1;
                        const af4 cs = *(const GAS af4*)(cosT + t * 32 + i0), sn = *(const GAS af4*)(sinT + t * 32 + i0);
                        af4 o0, o1;
                        o0[0] = v0[0] * cs[0] - v0[1] * sn[0]; o0[1] = v0[0] * sn[0] + v0[1] * cs[0];
                        o0[2] = v0[2] * cs[1] - v0[3] * sn[1]; o0[3] = v0[2] * sn[1] + v0[3] * cs[1];
                        o1[0] = v1[0] * cs[2] - v1[1] * sn[2]; o1[1] = v1[0] * sn[2] + v1[1] * cs[2];
                        o1[2] = v1[2] * cs[3] - v1[3] * sn[3]; o1[3] = v1[2] * sn[3] + v1[3] * cs[3];
                        v0 = o0; v1 = o1;
                    }
                    v0 = v0 * qs; v1 = v1 * qs;
                    u32x4 w; w[0] = pk2(v0[0], v0[1]); w[1] = pk2(v0[2], v0[3]); w[2] = pk2(v1[0], v1[1]); w[3] = pk2(v1[2], v1[3]);
                    *(GAS u32x4*)(rowp + bj * 128) = w;
                }
            }
    }
};
struct EpiBf16Ab {
    static constexpr bool PERM = true, AFTER_DRAIN = false;
    gbf16* O; int ldc; gfloat* AB; int ab_pn;
    DI void operator()(const af4 (&acc)[2][2][4][2], const Unit& u, int wr, int wc, int fr, int fq) const {
        const int row0 = u.pm * 256 + wr * 64 + fr, col0 = u.pn * 256 + wc * 32 + 8 * fq;
        if (u.pn == ab_pn) {
            if (wc == 0) {
#pragma unroll
                for (int ai = 0; ai < 2; ++ai)
#pragma unroll
                    for (int m = 0; m < 4; ++m) { gfloat* ap = AB + (size_t)(row0 + ai * 128 + m * 16) * 32 + 8 * fq; *(GAS af4*)ap = acc[ai][0][m][0]; *(GAS af4*)(ap + 4) = acc[ai][0][m][1]; }
            }
            return;
        }
#pragma unroll
        for (int ai = 0; ai < 2; ++ai)
#pragma unroll
            for (int m = 0; m < 4; ++m) {
                gbf16* rowp = O + (size_t)(row0 + ai * 128 + m * 16) * ldc + col0;
#pragma unroll
                for (int bj = 0; bj < 2; ++bj) { const af4 v0 = acc[ai][bj][m][0], v1 = acc[ai][bj][m][1];
                    u32x4 w; w[0] = pk2(v0[0], v0[1]); w[1] = pk2(v0[2], v0[3]); w[2] = pk2(v1[0], v1[1]); w[3] = pk2(v1[2], v1[3]);
                    *(GAS u32x4*)(rowp + bj * 128) = w; }
            }
    }
};
struct EpiSwiglu {
    static constexpr bool PERM = true, AFTER_DRAIN = false;
    gbf16* O; int ldc; int nN;
    DI void operator()(const af4 (&acc)[2][2][4][2], const Unit& u, int wr, int wc, int fr, int fq) const {
        const int row0 = u.pm * 256 + wr * 64 + fr, col0 = (u.pn % nN) * 128 + wc * 32 + 8 * fq;
#pragma unroll
        for (int ai = 0; ai < 2; ++ai)
#pragma unroll
            for (int m = 0; m < 4; ++m) {
                const af4 g0 = acc[ai][0][m][0], g1 = acc[ai][0][m][1], u0 = acc[ai][1][m][0], u1 = acc[ai][1][m][1];
                float r[8];
#pragma unroll
                for (int j = 0; j < 4; ++j) { r[j] = silu_(g0[j]) * u0[j]; r[4 + j] = silu_(g1[j]) * u1[j]; }
                u32x4 w; w[0] = pk2(r[0], r[1]); w[1] = pk2(r[2], r[3]); w[2] = pk2(r[4], r[5]); w[3] = pk2(r[6], r[7]);
                *(GAS u32x4*)(O + (size_t)(row0 + ai * 128 + m * 16) * ldc + col0) = w;
            }
    }
};
struct EpiResid {
    static constexpr bool PERM = false, AFTER_DRAIN = false;
    gfloat* X; const gfloat* gate;
    DI void operator()(const af4 (&acc)[2][2][4][2], const Unit& u, int wr, int wc, int fr, int fq) const {
        const int row0 = u.pm * 256 + wr * 64 + fr, col0 = u.pn * 256 + wc * 32 + 4 * fq;
        const gfloat* gv = gate + (size_t)(u.pm < 64 ? (u.pm >> 4) : 4) * MODW + col0;
        af4 g[2][2];
#pragma unroll
        for (int bj = 0; bj < 2; ++bj)
#pragma unroll
            for (int n = 0; n < 2; ++n) g[bj][n] = *(const GAS af4*)(gv + bj * 128 + n * 16);
#pragma unroll
        for (int ai = 0; ai < 2; ++ai)
#pragma unroll
            for (int m = 0; m < 4; ++m) { gfloat* rowp = X + (size_t)(row0 + ai * 128 + m * 16) * D + col0;
#pragma unroll
                for (int bj = 0; bj < 2; ++bj)
#pragma unroll
                    for (int n = 0; n < 2; ++n) { GAS af4* p = (GAS af4*)(rowp + bj * 128 + n * 16); *p = *p + g[bj][n] * acc[ai][bj][m][n]; } }
    }
};
struct EpiPart {
    static constexpr bool PERM = false, AFTER_DRAIN = false;
    gfloat* PART;
    DI void operator()(const af4 (&acc)[2][2][4][2], const Unit& u, int wr, int wc, int fr, int fq) const {
        const int row0 = u.pm * 256 + wr * 64 + fr, col0 = u.pn * 256 + wc * 32 + 4 * fq;
        gfloat* base = PART + (size_t)u.pk * NCTX * D;
#pragma unroll
        for (int ai = 0; ai < 2; ++ai)
#pragma unroll
            for (int m = 0; m < 4; ++m) { gfloat* rowp = base + (size_t)(row0 + ai * 128 + m * 16) * D + col0;
#pragma unroll
                for (int bj = 0; bj < 2; ++bj)
#pragma unroll
                    for (int n = 0; n < 2; ++n) *(GAS af4*)(rowp + bj * 128 + n * 16) = acc[ai][bj][m][n]; }
    }
};
struct EpiF32 {
    static constexpr bool PERM = false, AFTER_DRAIN = false;
    gfloat* C; int ldc; int nN;
    DI void operator()(const af4 (&acc)[2][2][4][2], const Unit& u, int wr, int wc, int fr, int fq) const {
        const int row0 = u.pm * 256 + wr * 64 + fr, col0 = (u.pn % nN) * 256 + wc * 32 + 4 * fq;
#pragma unroll
        for (int ai = 0; ai < 2; ++ai)
#pragma unroll
            for (int m = 0; m < 4; ++m) { gfloat* rowp = C + (size_t)(row0 + ai * 128 + m * 16) * ldc + col0;
#pragma unroll
                for (int bj = 0; bj < 2; ++bj)
#pragma unroll
                    for (int n = 0; n < 2; ++n) *(GAS af4*)(rowp + bj * 128 + n * 16) = acc[ai][bj][m][n]; }
    }
};
struct MoeOrder : pg8::StaticOrder {
    int tend[8];
    __device__ void initm(const guint* cnt, int nN_, int G_, int c_) {
        int acc = 0;
#pragma unroll
        for (int e = 0; e < 8; ++e) { acc += ((int)cnt[e] + 255) >> 8; tend[e] = acc; }
        nM = acc; nN = nN_; nwg = nM * nN; G = G_; c = c_; lim = nwg; L0 = 0; s = 1;
    }
    __device__ bool next(int i, Unit& u) const {
        if (!pg8::StaticOrder::next(i, u)) return false;
        int e = 0;
#pragma unroll
        for (int k = 0; k < 7; ++k) e += (u.pm >= tend[k]) ? 1 : 0;
        u.pn += e * nN; return true;
    }
};

struct MoeOrder2 {
    int tend[8]; int nM, nwg, G, c, Lmain, r, s, tail;
    __device__ __forceinline__ void initm(const guint* cnt, int G_, int c_, int tail_) {
        int acc = 0;
#pragma unroll
        for (int e = 0; e < 8; ++e) { acc += ((int)cnt[e] + 255) >> 8; tend[e] = acc; }
        nM = acc; nwg = nM * 4; G = G_; c = c_; tail = tail_; Lmain = (nwg / G) * G; r = nwg - Lmain;
        s = 1; if (r > 0) { const int q = G / r; s = q >= 14 ? 14 : (q >= 7 ? 7 : (q >= 4 ? 4 : (q >= 2 ? 2 : 1))); }
    }
    __device__ __forceinline__ int tail_row0() const { return (Lmain >> 2) * 256; }
    __device__ __forceinline__ bool next(int i, Unit& u) const {
        const int j = i * G + c; int Lp;
        if (!tail) { if (j >= Lmain) return false; Lp = (j & 7) * (Lmain >> 3) + (j >> 3); u.pk = 0; }
        else { if (j >= r * s) return false; Lp = Lmain + j / s; u.pk = j % s; }
        u.pm = Lp >> 2; int e = 0;
#pragma unroll
        for (int k = 0; k < 7; ++k) e += (u.pm >= tend[k]) ? 1 : 0;
        u.pn = e * 4 + (Lp & 3); return true;
    }
    __device__ __forceinline__ void a_ready(const Unit&) const {}
    __device__ __forceinline__ void done(const Unit&) const {}
};
struct EpiPartY {
    static constexpr bool PERM = false, AFTER_DRAIN = false;
    gfloat* YP; int pm0, tail_rows;
    DI void operator()(const af4 (&acc)[2][2][4][2], const Unit& u, int wr, int wc, int fr, int fq) const {
        const int row0 = (u.pm - pm0) * 256 + wr * 64 + fr, col0 = (u.pn & 3) * 256 + wc * 32 + 4 * fq;
        gfloat* base = YP + (size_t)u.pk * tail_rows * D;
#pragma unroll
        for (int ai = 0; ai < 2; ++ai)
#pragma unroll
            for (int m = 0; m < 4; ++m) { gfloat* rowp = base + (size_t)(row0 + ai * 128 + m * 16) * D + col0;
#pragma unroll
                for (int bj = 0; bj < 2; ++bj)
#pragma unroll
                    for (int n = 0; n < 2; ++n) *(GAS af4*)(rowp + bj * 128 + n * 16) = acc[ai][bj][m][n]; }
    }
};
DI void transpose_load(f32x4 (&v)[8], const gfloat* W, int ldw, int k0, int n0, int lane) {
#pragma unroll
    for (int i = 0; i < 8; ++i) v[i] = *(const GAS f32x4*)(W + (size_t)(k0 + 8 * i + (lane >> 3)) * ldw + n0 + 4 * (lane & 7));
}
DI void transpose_store(const f32x4 (&v)[8], int K, gbf16* WT, int k0, int drow0, LAS float* scr, int lane) {
#pragma unroll
    for (int i = 0; i < 8; ++i) { LAS float* d = scr + (8 * i + (lane >> 3)) * 33 + 4 * (lane & 7); d[0] = v[i][0]; d[1] = v[i][1]; d[2] = v[i][2]; d[3] = v[i][3]; }
    asm volatile("s_waitcnt lgkmcnt(0)" ::: "memory");
    const int c = lane & 7;
#pragma unroll
    for (int j = 0; j < 4; ++j) { const int n = (lane >> 3) + 8 * j; const LAS float* s = scr + (8 * c) * 33 + n;
        u32x4 o; o[0] = pk2(s[0 * 33], s[1 * 33]); o[1] = pk2(s[2 * 33], s[3 * 33]); o[2] = pk2(s[4 * 33], s[5 * 33]); o[3] = pk2(s[6 * 33], s[7 * 33]);
        *(GAS u32x4*)(WT + (size_t)(drow0 + n) * K + k0 + 8 * c) = o; }
    asm volatile("s_waitcnt lgkmcnt(0)" ::: "memory");
}
struct TJob { const gfloat* W; gbf16* WT; int ldw, K, N, F; };
DI int tjob_items(const TJob& j) { return (j.K / 64) * (j.N / 32); }
DI TJob get_tjob(const Params& p, int j) {
    const int i = j / 22, r = j % 22; unsigned char* ws = p.ws; TJob t;
    if (r == 0) t = TJob{gin(p, 9) + (size_t)i * D * EVEN_IN, (gbf16*)(ws + WS_WEIN) + (size_t)i * 2560 * 1024, EVEN_IN, D, EVEN_IN, 0};
    else if (r == 1) t = TJob{gin(p, 10) + (size_t)i * D * D, (gbf16*)(ws + WS_WEOUT) + (size_t)i * 1024 * 1024, D, D, D, 0};
    else if (r == 2) t = TJob{gin(p, 20) + (size_t)i * D * 2 * FFN, (gbf16*)(ws + WS_WEF1) + (size_t)i * 5632 * 1024, 2 * FFN, D, 2 * FFN, FFN};
    else if (r == 3) t = TJob{gin(p, 21) + (size_t)i * FFN * D, (gbf16*)(ws + WS_WEF2) + (size_t)i * 1024 * 2816, D, FFN, D, 0};
    else if (r == 4) t = TJob{gin(p, 22) + (size_t)i * D * ODD_IN, (gbf16*)(ws + WS_WOIN) + (size_t)i * 4352 * 1024, ODD_IN, D, ODD_IN, 0};
    else if (r == 5) t = TJob{gin(p, 27) + (size_t)i * D * D, (gbf16*)(ws + WS_WOOUT) + (size_t)i * 1024 * 1024, D, D, D, 0};
    else if (r < 14) { const int e = r - 6; t = TJob{gin(p, 29) + ((size_t)i * 8 + e) * D * 2 * FFE, (gbf16*)(ws + WS_WXIN) + ((size_t)i * 8 + e) * 7168 * 1024, 2 * FFE, D, 2 * FFE, FFE}; }
    else { const int e = r - 14; t = TJob{gin(p, 30) + ((size_t)i * 8 + e) * FFE * D, (gbf16*)(ws + WS_WXOUT) + ((size_t)i * 8 + e) * 1024 * 3584, D, FFE, D, 0}; }
    return t;
}
#ifndef CONV_DEFER
#define CONV_DEFER 1
#endif
DI void convert_weights(const Ctx& C, const Params& p, int group, int gw, int NGW) {
    LAS float* scr = (LAS float*)(C.lds + 32768 + C.wave * 8704);
    const int j0 = group == 0 ? 0 : (group == 1 ? 6 : 28), j1 = group == 0 ? 6 : (group == 1 ? 28 : 44);
    int jstart = 0;
    for (int j = j0; j < j1; ++j) {
        const TJob t = get_tjob(p, j); const int ni = tjob_items(t), nblkN = t.N / 32;
        const int first = (gw - jstart % NGW + NGW) % NGW;
        auto item_geom = [&](int it, int& k0, int& n0, int& drow0) { const int kb = it / nblkN, nb = it % nblkN; k0 = kb * 64; n0 = nb * 32; drow0 = n0;
            if (t.F > 0) drow0 = (n0 < t.F) ? ((n0 / 128) * 256 + (n0 % 128)) : (((n0 - t.F) / 128) * 256 + 128 + ((n0 - t.F) % 128)); };
        f32x4 va[8], vb[8], vc[8]; int k0 = 0, n0 = 0, d0 = 0, k1 = 0, n1 = 0, d1 = 0;
        if (first < ni) { item_geom(first, k0, n0, d0); transpose_load(va, t.W, t.ldw, k0, n0, C.lane); }
        if (first + NGW < ni) { item_geom(first + NGW, k1, n1, d1); transpose_load(vb, t.W, t.ldw, k1, n1, C.lane); }
        for (int it = first; it < ni; it += NGW) {
            const int nx = it + 2 * NGW; int k2 = 0, n2 = 0, d2 = 0;
            if (nx < ni) { item_geom(nx, k2, n2, d2); transpose_load(vc, t.W, t.ldw, k2, n2, C.lane); }
            transpose_store(va, t.K, t.WT, k0, d0, scr, C.lane);
#pragma unroll
            for (int q = 0; q < 8; ++q) { va[q] = vb[q]; vb[q] = vc[q]; }
            k0 = k1; n0 = n1; d0 = d1; k1 = k2; n1 = n2; d1 = d2;
        }
        jstart += ni;
    }
}
DI void ph_prologue(const Ctx& C, const Params& p) {
    LAS float* sil = (LAS float*)(C.lds);
    for (int i = C.tid; i < 5 * 1024; i += 512) { const int v = i >> 10, k = i & 1023; const float x = v < 4 ? gin(p, 1)[v * 1024 + k] : gin(p, 3)[k]; sil[i] = x / (1.f + expf(-x)); }
    __syncthreads();
    const int gw = C.blk * 8 + C.wave, NGW = C.nblk * 8;
    gfloat* MOD = (gfloat*)(C.ws + WS_MOD);
    for (int it = gw; it < DEPTH * (MODW / 64); it += NGW) {
        const int l = it / (MODW / 64), n = (it % (MODW / 64)) * 64 + C.lane;
        const gfloat* w = gin(p, 4) + (size_t)l * 1024 * MODW + n;
        float a0 = 0.f, a1 = 0.f, a2 = 0.f, a3 = 0.f, a4 = 0.f;
#pragma unroll 8
        for (int k = 0; k < 1024; ++k) { const float wv = w[(size_t)k * MODW]; a0 += sil[k] * wv; a1 += sil[1024 + k] * wv; a2 += sil[2048 + k] * wv; a3 += sil[3072 + k] * wv; a4 += sil[4096 + k] * wv; }
        const float bb = gin(p, 5)[l * MODW + n];
        MOD[(size_t)(l * 5 + 0) * MODW + n] = a0 + bb; MOD[(size_t)(l * 5 + 1) * MODW + n] = a1 + bb; MOD[(size_t)(l * 5 + 2) * MODW + n] = a2 + bb;
        MOD[(size_t)(l * 5 + 3) * MODW + n] = a3 + bb; MOD[(size_t)(l * 5 + 4) * MODW + n] = a4 + bb;
    }
    { gfloat* cosT = (gfloat*)(C.ws + WS_COS); gfloat* sinT = (gfloat*)(C.ws + WS_SIN);
      for (int idx = C.blk * 512 + C.tid; idx < SEQ * 32; idx += C.nblk * 512) { const int t = idx >> 5, i = idx & 31;
          const float invf = powf(10000.f, -(float)(i & 15) / 16.f); const float ang = (i < 16 ? (float)(t >> 6) : (float)(t & 63)) * invf;
          cosT[idx] = cosf(ang); sinT[idx] = sinf(ang); } }
    { for (int i = 0; i < 2; ++i) { GAS u32x4* z = (GAS u32x4*)((gbf16*)(C.ws + WS_WOIN) + (size_t)i * 4352 * 1024 + (size_t)4128 * 1024);
          for (int idx = C.blk * 512 + C.tid; idx < 224 * 1024 / 8; idx += C.nblk * 512) z[idx] = (u32x4){0u, 0u, 0u, 0u}; } }
    convert_weights(C, p, 0, gw, NGW);
#if CONV_DEFER == 0
    convert_weights(C, p, 1, gw, NGW); convert_weights(C, p, 2, gw, NGW);
#endif
}

DI void normmod_regs(f32x4 (&v)[4], const gfloat* g, const gfloat* shift, const gfloat* scale, int lane) {
    float ss = 0.f;
#pragma unroll
    for (int j = 0; j < 4; ++j) ss += (v[j][0] * v[j][0] + v[j][1] * v[j][1]) + (v[j][2] * v[j][2] + v[j][3] * v[j][3]);
    const float rs = rsqrtf(wave_sum(ss, lane) * (1.f / D) + 1e-6f);
#pragma unroll
    for (int j = 0; j < 4; ++j) { const f32x4 gg = ((const GAS f32x4*)g)[lane + 64 * j], sh = ((const GAS f32x4*)shift)[lane + 64 * j], sc = ((const GAS f32x4*)scale)[lane + 64 * j];
        v[j] = v[j] * rs * gg * (sc + 1.f) + sh; }
}
DI void store_row_bf16(gbf16* orow, const f32x4 (&v)[4], int lane) {
#pragma unroll
    for (int j = 0; j < 4; ++j) { u32x2 w; w[0] = pk2(v[j][0], v[j][1]); w[1] = pk2(v[j][2], v[j][3]); ((GAS u32x2*)orow)[lane + 64 * j] = w; }
}
DI void add_ctx_partials(const Ctx& C, f32x4 (&v)[4], int r, int npart, const gfloat* gate_ctx, gfloat* Xrow) {
    const gfloat* PART = (const gfloat*)(C.ws + WS_PART) + (size_t)(r - NLAT) * D;
#pragma unroll
    for (int j = 0; j < 4; ++j) { f32x4 a = (f32x4){0.f, 0.f, 0.f, 0.f};
        for (int pk = 0; pk < npart; ++pk) a = a + ((const GAS f32x4*)(PART + (size_t)pk * NCTX * D))[C.lane + 64 * j];
        v[j] = v[j] + ((const GAS f32x4*)gate_ctx)[C.lane + 64 * j] * a; ((GAS f32x4*)Xrow)[C.lane + 64 * j] = v[j]; }
}
DI void ph_normmod(const Ctx& C, const Params& p, int layer, bool second, bool from_input, int npart, int gate_off) {
    const int gw = C.blk * 8 + C.wave, NGW = C.nblk * 8;
    gfloat* X = (gfloat*)(C.ws + WS_X); gbf16* H = (gbf16*)(C.ws + WS_H);
    const gfloat* MODl = (const gfloat*)(C.ws + WS_MOD) + (size_t)layer * 5 * MODW;
    const gfloat* g = (second ? gin(p, 7) : gin(p, 6)) + layer * D;
    auto srcrow = [&](int r) { return from_input ? (r < NLAT ? gin(p, 0) + (size_t)r * D : gin(p, 2) + (size_t)(r - NLAT) * D) : (const gfloat*)X + (size_t)r * D; };
    f32x4 v[4], vn[4];
    if (gw < NTOK) { const gfloat* src = srcrow(gw);
#pragma unroll
        for (int j = 0; j < 4; ++j) v[j] = ((const GAS f32x4*)src)[C.lane + 64 * j]; }
    for (int r = gw; r < NTOK; r += NGW) {
        const int rn = r + NGW;
        if (rn < NTOK) { const gfloat* src = srcrow(rn);
#pragma unroll
            for (int j = 0; j < 4; ++j) vn[j] = ((const GAS f32x4*)src)[C.lane + 64 * j]; }
        if (from_input) {
#pragma unroll
            for (int j = 0; j < 4; ++j) ((GAS f32x4*)(X + (size_t)r * D))[C.lane + 64 * j] = v[j]; }
        if (npart > 0 && r >= NLAT) add_ctx_partials(C, v, r, npart, (const gfloat*)(C.ws + WS_MOD) + gate_off + 4 * MODW, X + (size_t)r * D);
        const gfloat* mv = MODl + (size_t)(r < NLAT ? (r >> 12) : 4) * MODW + (second ? 3 * D : 0);
        normmod_regs(v, g, mv, mv + D, C.lane);
        store_row_bf16(H + (size_t)r * D, v, C.lane);
#pragma unroll
        for (int j = 0; j < 4; ++j) v[j] = vn[j];
    }
}

DI void seq_bounds(int r, int& s0, int& s1) { if (r < NLAT) { s0 = r & ~4095; s1 = s0 + 4096; } else { s0 = NLAT + ((r - NLAT) & ~255); s1 = s0 + 256; } }

DI void ph_odd_conv(const Ctx& C, const Params& p, int i) {
    const int gw = C.blk * 8 + C.wave, NGW = C.nblk * 8;
    const gbf16* PO = (const gbf16*)(C.ws + WS_P); gbf16* QKVN = (gbf16*)(C.ws + WS_QKVN);
    const gfloat* AB = (const gfloat*)(C.ws + WS_AB); gfloat* Gd = (gfloat*)(C.ws + WS_GB); gfloat* Bd = Gd + (size_t)2 * NTOK * 8;
    const gfloat* cw = gin(p, 23) + (size_t)i * 4 * 3072;
    for (int u = gw; u < NCH * 6; u += NGW) {
        const int strip = u / 6, cgp = u % 6, r0 = strip * 64, c = cgp * 512 + 8 * C.lane;
        int s0, s1; seq_bounds(r0, s0, s1);
        float w[4][8];
#pragma unroll
        for (int tp = 0; tp < 4; ++tp) { const f32x4 w0 = *(const GAS f32x4*)(cw + tp * 3072 + c), w1 = *(const GAS f32x4*)(cw + tp * 3072 + c + 4);
#pragma unroll
            for (int e = 0; e < 4; ++e) { w[tp][e] = w0[e]; w[tp][4 + e] = w1[e]; } }
        u32x4 win[4];
        const u32x4 zz = (u32x4){0u, 0u, 0u, 0u};
        win[1] = (r0 - 2 >= s0) ? *(const GAS u32x4*)(PO + (size_t)(r0 - 2) * 4352 + c) : zz;
        win[2] = (r0 - 1 >= s0) ? *(const GAS u32x4*)(PO + (size_t)(r0 - 1) * 4352 + c) : zz;
        win[3] = *(const GAS u32x4*)(PO + (size_t)r0 * 4352 + c);
#pragma unroll 4
        for (int rr = 0; rr < 64; ++rr) {
            const int r = r0 + rr;
            win[0] = win[1]; win[1] = win[2]; win[2] = win[3];
            win[3] = (r + 1 < s1) ? *(const GAS u32x4*)(PO + (size_t)(r + 1) * 4352 + c) : zz;
            float a[8] = {0.f, 0.f, 0.f, 0.f, 0.f, 0.f, 0.f, 0.f};
#pragma unroll
            for (int tp = 0; tp < 4; ++tp) { const u32x4 x = win[tp];
                a[0] += w[tp][0] * bflo(x[0]); a[1] += w[tp][1] * bfhi(x[0]); a[2] += w[tp][2] * bflo(x[1]); a[3] += w[tp][3] * bfhi(x[1]);
                a[4] += w[tp][4] * bflo(x[2]); a[5] += w[tp][5] * bfhi(x[2]); a[6] += w[tp][6] * bflo(x[3]); a[7] += w[tp][7] * bfhi(x[3]); }
            float ss = 0.f;
#pragma unroll
            for (int e = 0; e < 8; ++e) { a[e] = silu_(a[e]); ss += a[e] * a[e]; }
            if (cgp < 4) {
                ss += shx(ss, 1, C.lane); ss += shx(ss, 2, C.lane); ss += shx(ss, 4, C.lane); ss += shx(ss, 8, C.lane);
                const float rn = rsqrtf(ss + 1e-6f);
#pragma unroll
                for (int e = 0; e < 8; ++e) a[e] *= rn;
            }
            u32x4 o; o[0] = pk2(a[0], a[1]); o[1] = pk2(a[2], a[3]); o[2] = pk2(a[4], a[5]); o[3] = pk2(a[6], a[7]);
            *(GAS u32x4*)(QKVN + (size_t)r * 3072 + c) = o;
        }
    }
    for (int r = gw * 4 + (C.lane >> 4); r < NTOK; r += NGW * 4) { const int l16 = C.lane & 15, d = l16 >> 3, h = l16 & 7;
        const float x0 = AB[(size_t)r * 32 + d * 16 + h], x1 = AB[(size_t)r * 32 + d * 16 + 8 + h];
        Gd[((size_t)d * NTOK + r) * 8 + h] = -expf(gin(p, 24)[i * 16 + d * 8 + h]) * softplus_(x0 + gin(p, 25)[i * 16 + d * 8 + h]);
        Bd[((size_t)d * NTOK + r) * 8 + h] = 1.f / (1.f + expf(-x1)); }
}
DI void ph_gdn_out(const Ctx& C, const Params& p, int i) {
    const int gw = C.blk * 8 + C.wave, NGW = C.nblk * 8;
    const gfloat* OG = (const gfloat*)(C.ws + WS_OG); const gbf16* PO = (const gbf16*)(C.ws + WS_P); gbf16* MIX = (gbf16*)(C.ws + WS_MIX);
    const f32x4 go = ((const GAS f32x4*)(gin(p, 26) + i * 128))[C.lane & 31];
    f32x4 ca[4], cb[4], na[4], nb[4]; u32x2 cz[4], nz[4];
#define GO_LOAD(r_, A_, B_, Z_) do { _Pragma("unroll") for (int j = 0; j < 4; ++j) { A_[j] = ((const GAS f32x4*)(OG + (size_t)(r_) * D))[C.lane + 64 * j]; B_[j] = ((const GAS f32x4*)(OG + ((size_t)NTOK + (r_)) * D))[C.lane + 64 * j]; \
        Z_[j] = *(const GAS u32x2*)(PO + (size_t)(r_) * 4352 + 3072 + 4 * C.lane + 256 * j); } } while (0)
    if (gw < NTOK) GO_LOAD(gw, ca, cb, cz);
    for (int r = gw; r < NTOK; r += NGW) {
        const int rn = r + NGW;
        if (rn < NTOK) GO_LOAD(rn, na, nb, nz);
#pragma unroll
        for (int j = 0; j < 4; ++j) {
            f32x4 o = ca[j] + cb[j];
            float ss = (o[0] * o[0] + o[1] * o[1]) + (o[2] * o[2] + o[3] * o[3]);
            ss += shx(ss, 1, C.lane); ss += shx(ss, 2, C.lane); ss += shx(ss, 4, C.lane); ss += shx(ss, 8, C.lane); ss += shx(ss, 16, C.lane);
            const float rs = rsqrtf(ss * (1.f / 128.f) + 1e-6f);
            const u32x2 z = cz[j];
            o[0] *= rs * go[0] * silu_(bflo(z[0])); o[1] *= rs * go[1] * silu_(bfhi(z[0])); o[2] *= rs * go[2] * silu_(bflo(z[1])); o[3] *= rs * go[3] * silu_(bfhi(z[1]));
            u32x2 w; w[0] = pk2(o[0], o[1]); w[1] = pk2(o[2], o[3]);
            ((GAS u32x2*)(MIX + (size_t)r * D))[C.lane + 64 * j] = w;
        }
#pragma unroll
        for (int j = 0; j < 4; ++j) { ca[j] = na[j]; cb[j] = nb[j]; cz[j] = nz[j]; }
    }
#undef GO_LOAD
}
struct TokInfo { int e0, p0, e1, p1; float w0, w1; int r0, r1; };
DI void ti_store(GAS TokInfo* q, const TokInfo& t) { u32x4 a, b; a[0] = (unsigned)t.e0; a[1] = (unsigned)t.p0; a[2] = (unsigned)t.e1; a[3] = (unsigned)t.p1; b[0] = __float_as_uint(t.w0); b[1] = __float_as_uint(t.w1); b[2] = (unsigned)t.r0; b[3] = (unsigned)t.r1;
    ((GAS u32x4*)q)[0] = a; ((GAS u32x4*)q)[1] = b; }
DI TokInfo ti_load(const GAS TokInfo* q) { const u32x4 a = ((const GAS u32x4*)q)[0], b = ((const GAS u32x4*)q)[1]; TokInfo t; t.e0 = (int)a[0]; t.p0 = (int)a[1]; t.e1 = (int)a[2]; t.p1 = (int)a[3]; t.w0 = __uint_as_float(b[0]); t.w1 = __uint_as_float(b[1]); t.r0 = (int)b[2]; t.r1 = (int)b[3]; return t; }
DI void ph_router(const Ctx& C, const Params& p, int layer, int ntok, int npart) {
    const int gw = C.blk * 8 + C.wave, NGW = C.nblk * 8, i = layer >> 1;
    gfloat* X = (gfloat*)(C.ws + WS_X); gbf16* H = (gbf16*)(C.ws + WS_H);
    const gfloat* MODl = (const gfloat*)(C.ws + WS_MOD) + (size_t)layer * 5 * MODW;
    const gfloat* g = gin(p, 7) + layer * D; const gfloat* wr = gin(p, 28) + (size_t)i * D * 8;
    guint* cnt = (guint*)(C.ws + WS_CTL) + CW_CNT + i * 64; GAS TokInfo* TI = (GAS TokInfo*)(C.ws + WS_TOK);
    LAS unsigned* cl = (LAS unsigned*)(C.lds);
    LAS int* sl = (LAS int*)(C.lds + 64);
    if (C.tid < 16) cl[C.tid] = 0u;
    __syncthreads();
    int k = 0;
    for (int r = gw; r < NTOK; r += NGW, ++k) {
        f32x4 v[4];
#pragma unroll
        for (int j = 0; j < 4; ++j) v[j] = ((const GAS f32x4*)(X + (size_t)r * D))[C.lane + 64 * j];
        if (npart > 0 && r >= NLAT) add_ctx_partials(C, v, r, npart, MODl + 4 * MODW + 2 * D, X + (size_t)r * D);
        const gfloat* mv = MODl + (size_t)(r < NLAT ? (r >> 12) : 4) * MODW + 3 * D;
        normmod_regs(v, g, mv, mv + D, C.lane);
        store_row_bf16(H + (size_t)r * D, v, C.lane);
        if (r >= ntok) continue;
        float lg[8] = {0.f, 0.f, 0.f, 0.f, 0.f, 0.f, 0.f, 0.f};
#pragma unroll
        for (int j = 0; j < 4; ++j)
#pragma unroll
            for (int q = 0; q < 4; ++q) { const int kk = 4 * C.lane + 256 * j + q; const f32x4 w0 = *(const GAS f32x4*)(wr + kk * 8), w1 = *(const GAS f32x4*)(wr + kk * 8 + 4); const float x = v[j][q];
                lg[0] += x * w0[0]; lg[1] += x * w0[1]; lg[2] += x * w0[2]; lg[3] += x * w0[3]; lg[4] += x * w1[0]; lg[5] += x * w1[1]; lg[6] += x * w1[2]; lg[7] += x * w1[3]; }
#pragma unroll
        for (int e = 0; e < 8; ++e) lg[e] = wave_sum(lg[e], C.lane);
        if (C.lane == 0) {
            int e0 = 0; float b0 = lg[0];
#pragma unroll
            for (int e = 1; e < 8; ++e) if (lg[e] > b0) { e0 = e; b0 = lg[e]; }
            int e1 = -1; float b1 = -INFINITY;
#pragma unroll
            for (int e = 0; e < 8; ++e) if (e != e0 && lg[e] > b1) { e1 = e; b1 = lg[e]; }
            const float w1 = 1.f / (1.f + expf(b0 - b1)), w0 = 1.f - w1;
            LAS int* s = sl + (k * 8 + C.wave) * 6;
            s[0] = e0; s[1] = e1; s[2] = (int)__hip_atomic_fetch_add(cl + e0, 1u, __ATOMIC_RELAXED, __HIP_MEMORY_SCOPE_WORKGROUP); s[3] = (int)__hip_atomic_fetch_add(cl + e1, 1u, __ATOMIC_RELAXED, __HIP_MEMORY_SCOPE_WORKGROUP);
            s[4] = __float_as_int(w0); s[5] = __float_as_int(w1);
        }
    }
    __syncthreads();
    if (C.tid < 8) cl[8 + C.tid] = __hip_atomic_fetch_add(cnt + C.tid, cl[C.tid], __ATOMIC_RELAXED, __HIP_MEMORY_SCOPE_AGENT);
    __syncthreads();
    if (C.lane == 0) { k = 0;
        for (int r = gw; r < ntok; r += NGW, ++k) { const LAS int* s = sl + (k * 8 + C.wave) * 6;
            TokInfo t; t.e0 = s[0]; t.e1 = s[1]; t.p0 = (int)cl[8 + s[0]] + s[2]; t.p1 = (int)cl[8 + s[1]] + s[3]; t.w0 = __int_as_float(s[4]); t.w1 = __int_as_float(s[5]); t.r0 = 0; t.r1 = 0;
            ti_store(TI + r, t); } }
    __syncthreads();
}
DI void ph_gather(const Ctx& C, int layer, int ntok) {
    const int gw = C.blk * 8 + C.wave, NGW = C.nblk * 8, i = layer >> 1;
    const guint* cnt = (const guint*)(C.ws + WS_CTL) + CW_CNT + i * 64; GAS TokInfo* TI = (GAS TokInfo*)(C.ws + WS_TOK);
    const gbf16* H = (const gbf16*)(C.ws + WS_H); gbf16* XS = (gbf16*)(C.ws + WS_XS);
    int base[8], cn[8]; { int acc = 0;
#pragma unroll
        for (int e = 0; e < 8; ++e) { cn[e] = (int)cnt[e]; base[e] = acc * 256; acc += (cn[e] + 255) >> 8; } }
    for (int r = gw; r < ntok; r += NGW) {
        const TokInfo t = ti_load(TI + r);
        int b0 = 0, b1 = 0;
#pragma unroll
        for (int e = 0; e < 8; ++e) { b0 = (t.e0 == e) ? base[e] : b0; b1 = (t.e1 == e) ? base[e] : b1; }
        const int r0 = b0 + t.p0, r1 = b1 + t.p1;
        const u32x4 a = ((const GAS u32x4*)(H + (size_t)r * D))[C.lane], b = ((const GAS u32x4*)(H + (size_t)r * D))[C.lane + 64];
        ((GAS u32x4*)(XS + (size_t)r0 * D))[C.lane] = a; ((GAS u32x4*)(XS + (size_t)r0 * D))[C.lane + 64] = b;
        ((GAS u32x4*)(XS + (size_t)r1 * D))[C.lane] = a; ((GAS u32x4*)(XS + (size_t)r1 * D))[C.lane + 64] = b;
        if (C.lane == 0) { ((GAS int*)(TI + r))[6] = r0; ((GAS int*)(TI + r))[7] = r1; }
    }
    for (int pr = gw; pr < 8 * 256; pr += NGW) {
        const int e = pr >> 8, j = pr & 255; int be = 0, ce = 0;
#pragma unroll
        for (int k = 0; k < 8; ++k) { be = (e == k) ? base[k] : be; ce = (e == k) ? cn[k] : ce; }
        const int lim = ((ce + 255) >> 8) << 8;
        if (ce + j < lim) { GAS u32x4* z = (GAS u32x4*)(XS + (size_t)(be + ce + j) * D); z[C.lane] = (u32x4){0u, 0u, 0u, 0u}; z[C.lane + 64] = (u32x4){0u, 0u, 0u, 0u}; }
    }
}
DI void ph_combine(const Ctx& C, const Params& p, int layer, int ntok, const guint* cnt) {
    const int gw = C.blk * 8 + C.wave, NGW = C.nblk * 8;
    gfloat* X = (gfloat*)(C.ws + WS_X); gbf16* H = (gbf16*)(C.ws + WS_H); const gfloat* Y = (const gfloat*)(C.ws + WS_Y); const GAS TokInfo* TI = (const GAS TokInfo*)(C.ws + WS_TOK);
    const gfloat* MODl = (const gfloat*)(C.ws + WS_MOD) + (size_t)layer * 5 * MODW;
    const bool last = (layer == DEPTH - 1);
    const int nrows = last ? NLAT : NTOK;
    for (int r = gw; r < nrows; r += NGW) {
        f32x4 v[4];
#pragma unroll
        for (int j = 0; j < 4; ++j) v[j] = ((const GAS f32x4*)(X + (size_t)r * D))[C.lane + 64 * j];
        if (r < ntok) {
            const TokInfo t = ti_load(TI + r);
            const gfloat* ga = MODl + (size_t)(r < NLAT ? (r >> 12) : 4) * MODW + 5 * D;
#pragma unroll
            for (int j = 0; j < 4; ++j) { const f32x4 y0 = ((const GAS f32x4*)(Y + (size_t)t.r0 * D))[C.lane + 64 * j], y1 = ((const GAS f32x4*)(Y + (size_t)t.r1 * D))[C.lane + 64 * j], gg = ((const GAS f32x4*)ga)[C.lane + 64 * j];
                v[j] = v[j] + gg * (y0 * t.w0 + y1 * t.w1); }
        }
        if (!last) {
#pragma unroll
            for (int j = 0; j < 4; ++j) ((GAS f32x4*)(X + (size_t)r * D))[C.lane + 64 * j] = v[j];
            const gfloat* MODn = (const gfloat*)(C.ws + WS_MOD) + (size_t)(layer + 1) * 5 * MODW;
            const gfloat* mv = MODn + (size_t)(r < NLAT ? (r >> 12) : 4) * MODW;
            normmod_regs(v, gin(p, 6) + (layer + 1) * D, mv, mv + D, C.lane);
            store_row_bf16(H + (size_t)r * D, v, C.lane);
        } else {
            float ss = 0.f;
#pragma unroll
            for (int j = 0; j < 4; ++j) ss += (v[j][0] * v[j][0] + v[j][1] * v[j][1]) + (v[j][2] * v[j][2] + v[j][3] * v[j][3]);
            const float rs = rsqrtf(wave_sum(ss, C.lane) * (1.f / D) + 1e-6f);
#pragma unroll
            for (int j = 0; j < 4; ++j) { const f32x4 gg = ((const GAS f32x4*)gin(p, 8))[C.lane + 64 * j]; ((GAS f32x4*)(((gfloat*)p.out) + (size_t)r * D))[C.lane + 64 * j] = v[j] * rs * gg; }
        }
    }
}
constexpr int AT_KB = 0, AT_KB_SZ = 64 * 136 * 2, AT_VT = 2 * AT_KB_SZ, AT_VT_SZ = 128 * 68 * 2, AT_QL = AT_VT + 2 * AT_VT_SZ, AT_END = AT_QL + 256 * 136 * 2;
static_assert(AT_END <= LDS_MISC, "attention LDS");
DI void attn_unit(const Ctx& C, const gbf16* PE, gbf16* MIX, const gfloat* gsub, float lam, float mul, int b, int h, int qb, bool ctxq) {
    LAS unsigned char* ldsb = C.lds; asm volatile("" : "+v"(ldsb));
    int tid = C.tid; asm volatile("" : "+v"(tid));
    const int lane = tid & 63, wave = __builtin_amdgcn_readfirstlane(tid >> 6), r = lane & 31, hh = lane >> 5;
    const int qrow0 = (ctxq ? NLAT + b * CTX : b * SEQ) + qb * 256;
    const int ntile = ctxq ? CTX / 64 : (CTX + SEQ) / 64;
    LAS bf16* QL = (LAS bf16*)(ldsb + AT_QL);
#pragma unroll
    for (int i = 0; i < 8; ++i) { const int c = tid + 512 * i, row = c >> 4, part = c & 15; *(LAS u32x4*)(QL + row * 136 + part * 8) = *(const GAS u32x4*)(PE + (size_t)(qrow0 + row) * EVEN_IN + h * 128 + part * 8); }
    __syncthreads();
    bf16x8 qreg[2][4];
#pragma unroll
    for (int mp = 0; mp < 2; ++mp)
#pragma unroll
        for (int ks = 0; ks < 4; ++ks) qreg[mp][ks] = *(const LAS bf16x8*)(QL + (wave * 32 + r) * 136 + mp * 64 + 16 * ks + 8 * hh);
    f32x16 O[2][4];
#pragma unroll
    for (int mp = 0; mp < 2; ++mp)
#pragma unroll
        for (int k = 0; k < 4; ++k) O[mp][k] = zero16();
    float m[2] = {-1e30f, -1e30f}, l[2] = {0.f, 0.f};
    u32x4 vA[2];
    const int skey = tid & 63, spart = tid >> 6;
#define AT_LOAD(t, kr, vr) do { \
        { const int kidx_ = (t) * 64 + skey; const int krow_ = kidx_ < CTX ? NLAT + b * CTX + kidx_ : b * SEQ + kidx_ - CTX; \
          _Pragma("unroll") for (int i_ = 0; i_ < 2; ++i_) { const gbf16* src_ = PE + (size_t)krow_ * EVEN_IN + h * 128 + (spart + 8 * i_) * 8; vr[i_] = *(const GAS u32x4*)(src_ + 1024); } } \
        { LAS unsigned char* kd_ = ldsb + AT_KB + (((t) & 1)) * AT_KB_SZ; \
          _Pragma("unroll") for (int i_ = 0; i_ < 8; ++i_) { const int key_ = wave * 8 + i_, kidx_ = (t) * 64 + key_; const int krow_ = kidx_ < CTX ? NLAT + b * CTX + kidx_ : b * SEQ + kidx_ - CTX; \
              __builtin_amdgcn_global_load_lds((const GAS unsigned*)(PE + (size_t)krow_ * EVEN_IN + 512 + h * 128) + lane, (LAS unsigned*)(kd_ + key_ * 272), 4, 0, 0); } } } while (0)
#define AT_STORE(buf, kr, vr) do { LAS bf16* vt_ = (LAS bf16*)(ldsb + AT_VT + (buf) * AT_VT_SZ); \
        _Pragma("unroll") for (int i_ = 0; i_ < 2; ++i_) { const int part_ = spart + 8 * i_; \
            _Pragma("unroll") for (int e_ = 0; e_ < 4; ++e_) { vt_[(part_ * 8 + 2 * e_) * 68 + skey] = (bf16)(vr[i_][e_] & 0xffffu); vt_[(part_ * 8 + 2 * e_ + 1) * 68 + skey] = (bf16)(vr[i_][e_] >> 16); } } } while (0)
#define AT_TILE(t) do { const int buf = (t) & 1; \
        int tl_ = tid; asm volatile("" : "+v"(tl_)); const int lane = tl_ & 63, r = lane & 31, hh = lane >> 5, skey = lane, spart = tl_ >> 6;     \
        if ((t) + 1 < ntile) AT_LOAD((t) + 1, vA, vA); \
        const LAS bf16* kb = (const LAS bf16*)(ldsb + AT_KB + buf * AT_KB_SZ); const LAS bf16* vt = (const LAS bf16*)(ldsb + AT_VT + buf * AT_VT_SZ); \
        _Pragma("unroll") for (int ks2 = 0; ks2 < 2; ++ks2) {             \
            bf16x8 pf[2][2]; \
            _Pragma("unroll") for (int mp = 0; mp < 2; ++mp) { \
                f32x16 S = zero16(); \
                _Pragma("unroll") for (int ks = 0; ks < 4; ++ks) { const bf16x8 a = *(const LAS bf16x8*)(kb + (ks2 * 32 + r) * 136 + mp * 64 + 16 * ks + 8 * hh); S = MFMA32(a, qreg[mp][ks], S); } \
                float mx = S[0]; \
                _Pragma("unroll") for (int i = 1; i < 16; ++i) mx = fmaxf(mx, S[i]); \
                mx = fmaxf(mx, shx(mx, 32, lane)); \
                if (__any(mx > m[mp] + 8.f)) { const float mnew = fmaxf(m[mp], mx), corr = __builtin_amdgcn_exp2f(m[mp] - mnew); m[mp] = mnew; l[mp] *= corr; \
                    _Pragma("unroll") for (int k = 0; k < 4; ++k) O[mp][k] = O[mp][k] * corr; } \
                float ls = 0.f; const float mu = m[mp]; \
                _Pragma("unroll") for (int i = 0; i < 16; ++i) { S[i] = __builtin_amdgcn_exp2f(S[i] - mu); ls += S[i]; } \
                l[mp] += ls; \
                pf[mp][0] = pack_step(S, 0); pf[mp][1] = pack_step(S, 1); } \
            _Pragma("unroll") for (int s = 0; s < 2; ++s) \
                _Pragma("unroll") for (int k = 0; k < 4; ++k) { const bf16x8 a = ld_perm_frag(vt + (k * 32 + r) * 68, ks2 * 32, s, hh); O[0][k] = MFMA32(a, pf[0][s], O[0][k]); O[1][k] = MFMA32(a, pf[1][s], O[1][k]); } } \
        if ((t) + 1 < ntile) AT_STORE(buf ^ 1, vA, vA); \
        __syncthreads(); } while (0)
    AT_LOAD(0, vA, vA); AT_STORE(0, vA, vA);
    __syncthreads();
    for (int t = 0; t < ntile; ++t) AT_TILE(t);
#undef AT_TILE
#undef AT_LOAD
#undef AT_STORE
    {
        const float i0 = 1.f / (l[0] + shx(l[0], 32, lane)), i1 = lam / (l[1] + shx(l[1], 32, lane));
        float ss = 0.f;
#pragma unroll
        for (int k = 0; k < 4; ++k)
#pragma unroll
            for (int i = 0; i < 16; ++i) { const float o = O[0][k][i] * i0 - O[1][k][i] * i1; O[0][k][i] = o; ss += o * o; }
        ss += shx(ss, 32, lane);
        const float rs = rsqrtf(ss * (1.f / 128.f) + 1e-6f) * mul;
        const int qrow = qrow0 + wave * 32 + r;
#pragma unroll
        for (int k = 0; k < 4; ++k)
#pragma unroll
            for (int g4 = 0; g4 < 4; ++g4) { const int dv0 = k * 32 + 8 * g4 + 4 * hh; const f32x4 gg = *(const GAS f32x4*)(gsub + dv0);
                u32x2 w; w[0] = pk2(O[0][k][4 * g4] * rs * gg[0], O[0][k][4 * g4 + 1] * rs * gg[1]); w[1] = pk2(O[0][k][4 * g4 + 2] * rs * gg[2], O[0][k][4 * g4 + 3] * rs * gg[3]);
                *(GAS u32x2*)(MIX + (size_t)qrow * D + h * 128 + dv0) = w; }
    }
    __syncthreads();
}

constexpr int RGG_WT = 0, RGG_XR = 36864, RGG_XB = RGG_XR + 17408, RGG_XF = RGG_XB + 18432, RGG_END = RGG_XF + 128 * 65 * 4;
static_assert(RGG_END <= LDS_MISC && 131 * 66 * 2 <= 17408, "rg gates LDS");
DI void ph_rg_gates(const Ctx& C, const Params& p, int i) {
    const gbf16* PE = (const gbf16*)(C.ws + WS_P); gfloat* RGA = (gfloat*)(C.ws + WS_RGA); gfloat* RGU = (gfloat*)(C.ws + WS_RGU);
    const gfloat* w_a = gin(p, 15) + (size_t)i * 2 * 8 * 64 * 64; const gfloat* w_x = gin(p, 17) + (size_t)i * 2 * 8 * 64 * 64;
    const gfloat* b_a = gin(p, 16) + i * 1024; const gfloat* b_x = gin(p, 18) + i * 1024; const gfloat* lamv = gin(p, 19) + i * 1024;
    const gfloat* cw = gin(p, 13) + i * 4 * 512; const gfloat* cb = gin(p, 14) + i * 512;
    int ncur = -1;
    for (int unit = C.blk; unit < (NTOK / 128) * 8; unit += C.nblk) {
        LAS unsigned char* ldsb = C.lds; asm volatile("" : "+v"(ldsb));
        int tid = C.tid; asm volatile("" : "+v"(tid));
        const int lane = tid & 63, wave = __builtin_amdgcn_readfirstlane(tid >> 6), r = lane & 31, hh = lane >> 5;
        const int n = unit & 7, tile = unit >> 3, r0 = tile * 128;
        LAS bf16* WT = (LAS bf16*)(ldsb + RGG_WT); LAS bf16* xraw = (LAS bf16*)(ldsb + RGG_XR); LAS bf16* XB = (LAS bf16*)(ldsb + RGG_XB); LAS float* XF = (LAS float*)(ldsb + RGG_XF);
        if (n != ncur) {
            __syncthreads();
            for (int idx = tid; idx < 16384; idx += 512) { const int ch = idx & 63, ci = (idx >> 6) & 63, g = (idx >> 12) & 1, d = idx >> 13;
                const float v = (g ? w_x : w_a)[((size_t)(d * 8 + n) * 64 + ci) * 64 + ch];
                WT[(((d * 2 + g) * 2 + (ch >> 5)) * 32 + (ch & 31)) * 72 + ci] = f2bf(v); }
            ncur = n;
        }
        int s0, s1; seq_bounds(r0, s0, s1);
        for (int idx = tid; idx < 131 * 8; idx += 512) { const int ri = idx >> 3, part = idx & 7, row = r0 - 2 + ri;
            u32x4 v = (u32x4){0u, 0u, 0u, 0u};
            if (row >= s0 && row < s1) v = *(const GAS u32x4*)(PE + (size_t)row * EVEN_IN + 1536 + n * 64 + part * 8);
            LAS unsigned* dst = (LAS unsigned*)(xraw + ri * 66 + part * 8); dst[0] = v[0]; dst[1] = v[1]; dst[2] = v[2]; dst[3] = v[3]; }
        __syncthreads();
        { const int cc = tid & 63; float tap[4];
#pragma unroll
          for (int tp = 0; tp < 4; ++tp) tap[tp] = cw[tp * 512 + n * 64 + cc];
          const float cbias = cb[n * 64 + cc];
#pragma unroll 4
          for (int it = 0; it < 16; ++it) { const int tok = (tid >> 6) + 8 * it; float a = cbias;
#pragma unroll
              for (int tp = 0; tp < 4; ++tp) a += tap[tp] * bf2f(xraw[(tok + tp) * 66 + cc]);
              XF[tok * 65 + cc] = a; XB[tok * 72 + cc] = f2bf(a); } }
        __syncthreads();
        { const int ti = wave & 3, d = wave >> 2;
#pragma unroll
          for (int chblk = 0; chblk < 2; ++chblk) {
              f32x16 aa = zero16(), ax = zero16();
#pragma unroll
              for (int ks = 0; ks < 4; ++ks) { const bf16x8 xa = *(const LAS bf16x8*)(XB + (ti * 32 + r) * 72 + 16 * ks + 8 * hh);
                  const bf16x8 ba = *(const LAS bf16x8*)(WT + (((d * 2 + 0) * 2 + chblk) * 32 + r) * 72 + 16 * ks + 8 * hh), bx = *(const LAS bf16x8*)(WT + (((d * 2 + 1) * 2 + chblk) * 32 + r) * 72 + 16 * ks + 8 * hh);
                  aa = MFMA32(xa, ba, aa); ax = MFMA32(xa, bx, ax); }
              const int ch = n * 64 + chblk * 32 + r;
              const float ba_ = b_a[d * 512 + ch], bx_ = b_x[d * 512 + ch], sp = softplus_(-lamv[d * 512 + ch]);
#pragma unroll
              for (int q = 0; q < 16; ++q) { const int tok = ti * 32 + crow(q, hh);
                  const float rr = sigmoid_(aa[q] + ba_), ii = sigmoid_(ax[q] + bx_);
                  const float log_a = -8.f * rr * sp; const float a = __expf(log_a), u = sqrtf(fmaxf(1.f - a * a, 0.f)) * (ii * XF[tok * 65 + chblk * 32 + r]);
                  const size_t o = ((size_t)d * NTOK + r0 + tok) * 512 + ch; RGA[o] = a; RGU[o] = u; }
          } }
        __syncthreads();
    }
}
DI int rg_row(int b, int d, int pp) { return pp < CTX ? NLAT + b * CTX + (d ? CTX - 1 - pp : pp) : b * SEQ + (d ? SEQ - 1 - (pp - CTX) : (pp - CTX)); }
DI void rgscan_unit(const Ctx& C, int b, int cg) {
    LAS unsigned char* ldsb = C.lds; asm volatile("" : "+v"(ldsb));
    int tid = C.tid; asm volatile("" : "+v"(tid));
    const gfloat* RGA = (const gfloat*)(C.ws + WS_RGA); const gfloat* RGU = (const gfloat*)(C.ws + WS_RGU); gfloat* HS1 = (gfloat*)(C.ws + WS_HS1);
    const gbf16* PE = (const gbf16*)(C.ws + WS_P); gbf16* MIX = (gbf16*)(C.ws + WS_MIX);
    LAS float* sb = (LAS float*)ldsb;
    const int ch = cg * 16 + (tid & 15), chunk = tid >> 4, p0 = chunk * 136;
    for (int pass = 0; pass < 2; ++pass) {
        const int d = 1 - pass;
        const gfloat* Ad = RGA + (size_t)d * NTOK * 512 + ch; const gfloat* Ud = RGU + (size_t)d * NTOK * 512 + ch;
        float av[17], uv[17], an[17], un[17];
        float A = 1.f, H = 0.f;
#pragma unroll
        for (int k = 0; k < 17; ++k) { const size_t o = (size_t)rg_row(b, d, p0 + k) * 512; av[k] = Ad[o]; uv[k] = Ud[o]; }
        for (int g8 = 0; g8 < 8; ++g8) {
            if (g8 < 7) {
#pragma unroll
                for (int k = 0; k < 17; ++k) { const size_t o = (size_t)rg_row(b, d, p0 + (g8 + 1) * 17 + k) * 512; an[k] = Ad[o]; un[k] = Ud[o]; } }
#pragma unroll
            for (int k = 0; k < 17; ++k) { H = av[k] * H + uv[k]; A *= av[k]; }
#pragma unroll
            for (int k = 0; k < 17; ++k) { av[k] = an[k]; uv[k] = un[k]; }
        }
        sb[(chunk * 16 + (tid & 15)) * 2] = A; sb[(chunk * 16 + (tid & 15)) * 2 + 1] = H;
        __syncthreads();
        float h = 0.f;
        for (int k = 0; k < chunk; ++k) h = sb[(k * 16 + (tid & 15)) * 2] * h + sb[(k * 16 + (tid & 15)) * 2 + 1];
#pragma unroll
        for (int k = 0; k < 17; ++k) { const size_t o = (size_t)rg_row(b, d, p0 + k) * 512; av[k] = Ad[o]; uv[k] = Ud[o]; }
        for (int g8 = 0; g8 < 8; ++g8) {
            if (g8 < 7) {
#pragma unroll
                for (int k = 0; k < 17; ++k) { const size_t o = (size_t)rg_row(b, d, p0 + (g8 + 1) * 17 + k) * 512; an[k] = Ad[o]; un[k] = Ud[o]; } }
#pragma unroll
            for (int k = 0; k < 17; ++k) { h = av[k] * h + uv[k]; const int row = rg_row(b, d, p0 + g8 * 17 + k);
                if (pass == 0) HS1[(size_t)row * 512 + ch] = h;
                else { const float y = h + HS1[(size_t)row * 512 + ch]; MIX[(size_t)row * D + 512 + ch] = f2bf(y * gelu_tanh_(bf2f(PE[(size_t)row * EVEN_IN + 2048 + ch]))); } }
#pragma unroll
            for (int k = 0; k < 17; ++k) { av[k] = an[k]; uv[k] = un[k]; }
        }
        __syncthreads();
    }
}
DI void ph_even_mix(const Ctx& C, const Params& p, int layer, int rep) {
    const int i = layer >> 1;
    volatile LAS unsigned* misc = (volatile LAS unsigned*)(C.lds + LDS_MISC);
    guint* q = (guint*)(C.ws + WS_CTL) + CW_Q + (i + 2 * rep) * 64;
    const float lam_init = 0.8f - 0.6f * expf(-0.3f * (float)layer);
    if (C.wave == 0) { const gfloat* lq = gin(p, 11) + i * 256; const float a = wave_sum(lq[C.lane] * lq[64 + C.lane], C.lane), b2 = wave_sum(lq[128 + C.lane] * lq[192 + C.lane], C.lane);
        if (C.lane == 0) ((volatile LAS float*)misc)[4] = expf(a) - expf(b2) + lam_init; }
    __syncthreads();
    const float lam = ((volatile LAS float*)misc)[4];
    const gbf16* PE = (const gbf16*)(C.ws + WS_P); gbf16* MIX = (gbf16*)(C.ws + WS_MIX);
    for (;;) {
        if (C.tid == 0) misc[8] = __hip_atomic_fetch_add(q, 1u, __ATOMIC_RELAXED, __HIP_MEMORY_SCOPE_AGENT);
        __syncthreads();
        const int u = (int)misc[8];
        __syncthreads();
#ifndef MIX_RG_REP
#define MIX_RG_REP 1
#endif
#ifndef MIX_AT_REP
#define MIX_AT_REP 1
#endif
        if (u >= 128 * MIX_RG_REP + 272 * MIX_AT_REP) break;
        if (u < 128 * MIX_RG_REP) { const int x = u & 127; rgscan_unit(C, x >> 5, x & 31); }
        else { const int y = (u - 128 * MIX_RG_REP) % 272;
            if (y < 256) attn_unit(C, PE, MIX, gin(p, 12) + i * 128, lam, 1.f - lam_init, y >> 6, (y >> 4) & 3, y & 15, false);
            else { const int x = y - 256; attn_unit(C, PE, MIX, gin(p, 12) + i * 128, lam, 1.f - lam_init, x >> 2, x & 3, 0, true); } }
    }
}
DI int chunk_row0(int cidx) { return cidx < 256 ? (cidx >> 6) * SEQ + (cidx & 63) * 64 : NLAT + (cidx - 256) * 64; }
constexpr int GA_RA = 0, GA_RB = 18432, GA_KT0 = 2 * 18432, GA_KT1 = 3 * 18432, GA_VT0 = 4 * 18432, GA_VT1 = 5 * 18432, GA_KK = 6 * 18432, GA_QK = GA_KK + 16640, GA_GC = GA_QK + 16640, GA_END = GA_GC + 1024;
static_assert(GA_END <= LDS_MISC, "GA LDS");
DI void gdn_ga_unit(const Ctx& C, int unit) {
    LAS unsigned char* ldsb = C.lds; asm volatile("" : "+v"(ldsb));
    const int h = unit & 7, cidx = unit >> 3;
    const int row0 = chunk_row0(cidx);
    const gbf16* QKVN = (const gbf16*)(C.ws + WS_QKVN); const gfloat* Gd = (const gfloat*)(C.ws + WS_GB); const gfloat* Bd = Gd + (size_t)2 * NTOK * 8;
    const size_t ud0 = (size_t)(cidx * 8 + h) * 2;
    gbf16* WG = (gbf16*)(C.ws + WS_WG) + ud0 * 8192; gfloat* UG = (gfloat*)(C.ws + WS_UG) + ud0 * 8192; gbf16* QKD = (gbf16*)(C.ws + WS_QKD) + ud0 * 4096; gfloat* SC = (gfloat*)(C.ws + WS_SC) + ud0 * 192;
    gbf16* KTG = (gbf16*)(C.ws + WS_KTG) + ud0 * 8192;
    LAS bf16* Kc = (LAS bf16*)(ldsb + GA_RA); LAS bf16* Qc = (LAS bf16*)(ldsb + GA_RB);
    LAS float* KKm = (LAS float*)(ldsb + GA_KK); LAS float* QKm = (LAS float*)(ldsb + GA_QK);
    LAS float* gc = (LAS float*)(ldsb + GA_GC); LAS float* be = gc + 128;
    int tid = C.tid; asm volatile("" : "+v"(tid));
    const int lane = tid & 63, wave = __builtin_amdgcn_readfirstlane(tid >> 6), r = lane & 31, hh = lane >> 5;
#pragma unroll
    for (int i2 = 0; i2 < 2; ++i2) { const int c = tid + 512 * i2, pos = c & 63, part = c >> 6;
        const gbf16* src = QKVN + (size_t)(row0 + pos) * 3072 + h * 128 + part * 8;
        const u32x4 q = *(const GAS u32x4*)src, k = *(const GAS u32x4*)(src + 1024), v = *(const GAS u32x4*)(src + 2048);
        *(LAS u32x4*)(Qc + pos * 136 + part * 8) = q; *(LAS u32x4*)(Kc + pos * 136 + part * 8) = k;
        LAS bf16* kt0 = (LAS bf16*)(ldsb + GA_KT0) + (part * 8) * 72; LAS bf16* kt1 = (LAS bf16*)(ldsb + GA_KT1) + (part * 8) * 72;
        LAS bf16* vt0 = (LAS bf16*)(ldsb + GA_VT0) + (part * 8) * 72; LAS bf16* vt1 = (LAS bf16*)(ldsb + GA_VT1) + (part * 8) * 72;
#pragma unroll
        for (int e = 0; e < 4; ++e) { const bf16 k0 = (bf16)(k[e] & 0xffffu), k1 = (bf16)(k[e] >> 16), v0 = (bf16)(v[e] & 0xffffu), v1 = (bf16)(v[e] >> 16);
            kt0[(2 * e) * 72 + pos] = k0; kt0[(2 * e + 1) * 72 + pos] = k1; kt1[(2 * e) * 72 + 63 - pos] = k0; kt1[(2 * e + 1) * 72 + 63 - pos] = k1;
            vt0[(2 * e) * 72 + pos] = v0; vt0[(2 * e + 1) * 72 + pos] = v1; vt1[(2 * e) * 72 + 63 - pos] = v0; vt1[(2 * e + 1) * 72 + 63 - pos] = v1; } }
    if (wave < 2) {
        const int d = wave, row = row0 + (d ? 63 - lane : lane);
        float g = Gd[((size_t)d * NTOK + row) * 8 + h];
#pragma unroll
        for (int o = 1; o < 64; o <<= 1) { const float t = __builtin_bit_cast(float, __builtin_amdgcn_ds_bpermute((lane - o) << 2, __builtin_bit_cast(int, g))); if (lane >= o) g += t; }
        gc[d * 64 + lane] = g; be[d * 64 + lane] = Bd[((size_t)d * NTOK + row) * 8 + h];
    }
    __syncthreads();
    { const int ti = (wave & 3) >> 1, tj = wave & 1; const LAS bf16* Arows = (wave < 4 ? Kc : Qc);
      f32x16 acc = zero16();
#pragma unroll
      for (int ks = 0; ks < 8; ++ks) { const bf16x8 a = *(const LAS bf16x8*)(Arows + (ti * 32 + r) * 136 + 16 * ks + 8 * hh), bb = *(const LAS bf16x8*)(Kc + (tj * 32 + r) * 136 + 16 * ks + 8 * hh); acc = MFMA32(a, bb, acc); }
      LAS float* dst = (wave < 4 ? KKm : QKm);
#pragma unroll
      for (int i = 0; i < 16; ++i) dst[(ti * 32 + crow(i, hh)) * 65 + tj * 32 + r] = acc[i]; }
    __syncthreads();
    const float qscale = 0.08838834764831845f;
#pragma unroll
    for (int e = 0; e < 16; ++e) { const int idx = tid + 512 * e, d = idx >> 12, i = (idx >> 6) & 63, j = idx & 63, ti = d ? 63 - i : i, tj = d ? 63 - j : j;
        const float dec = (j <= i) ? __expf(gc[d * 64 + i] - gc[d * 64 + j]) : 0.f;
        ((LAS float*)(ldsb + (d ? GA_RB : GA_RA)))[i * 68 + j] = (j < i) ? KKm[ti * 65 + tj] * be[d * 64 + i] * dec : 0.f;
        QKD[idx] = f2bf(QKm[ti * 65 + tj] * qscale * dec); }
    if (tid < 128) { const int d = tid >> 6, i = tid & 63; SC[d * 192 + i] = qscale * __expf(gc[d * 64 + i]); SC[d * 192 + 64 + i] = __expf(gc[d * 64 + 63] - gc[d * 64 + i]); if (i == 0) SC[d * 192 + 128] = __expf(gc[d * 64 + 63]); }
    __syncthreads();
    if (wave < 2) {
        const int d = wave, c = lane; LAS float* Lm = (LAS float*)(ldsb + (d ? GA_RB : GA_RA)); float T[64];
#pragma unroll
        for (int i = 0; i < 64; ++i) { float a0 = (i == c) ? 1.f : 0.f, a1 = 0.f, a2 = 0.f, a3 = 0.f;
#pragma unroll
            for (int j4 = 0; j4 < (i + 3) / 4; ++j4) { const f32x4 l4 = *(const LAS f32x4*)(Lm + i * 68 + 4 * j4);
                a0 -= l4[0] * T[4 * j4]; if (4 * j4 + 1 < i) a1 -= l4[1] * T[4 * j4 + 1]; if (4 * j4 + 2 < i) a2 -= l4[2] * T[4 * j4 + 2]; if (4 * j4 + 3 < i) a3 -= l4[3] * T[4 * j4 + 3]; }
            T[i] = (a0 + a1) + (a2 + a3); asm volatile("" ::: "memory"); }
        const float s2 = be[d * 64 + c], s1 = s2 * __expf(gc[d * 64 + c]);
        LAS bf16* T1 = (LAS bf16*)Lm; LAS bf16* T2 = T1 + 64 * 72;
#pragma unroll
        for (int i = 0; i < 64; ++i) { T1[i * 72 + c] = f2bf(T[i] * s1); T2[i * 72 + c] = f2bf(T[i] * s2); }
    }
    __syncthreads();
#pragma unroll
    for (int d = 0; d < 2; ++d) {
        const LAS bf16* T1 = (const LAS bf16*)(ldsb + (d ? GA_RB : GA_RA)); const LAS bf16* T2 = T1 + 64 * 72;
        const LAS bf16* Kt = (const LAS bf16*)(ldsb + (d ? GA_KT1 : GA_KT0)); const LAS bf16* Vt = (const LAS bf16*)(ldsb + (d ? GA_VT1 : GA_VT0));
        const int ti = wave >> 2, tn = wave & 3; f32x16 aw = zero16(), au = zero16();
#pragma unroll
        for (int ks = 0; ks < 4; ++ks) { const bf16x8 a1 = *(const LAS bf16x8*)(T1 + (ti * 32 + r) * 72 + 16 * ks + 8 * hh), a2 = *(const LAS bf16x8*)(T2 + (ti * 32 + r) * 72 + 16 * ks + 8 * hh);
            const bf16x8 bk = *(const LAS bf16x8*)(Kt + (tn * 32 + r) * 72 + 16 * ks + 8 * hh), bv = *(const LAS bf16x8*)(Vt + (tn * 32 + r) * 72 + 16 * ks + 8 * hh);
            aw = MFMA32(a1, bk, aw); au = MFMA32(a2, bv, au); }
#pragma unroll
        for (int i = 0; i < 16; ++i) { const int pos = ti * 32 + crow(i, hh); WG[d * 8192 + pos * 128 + tn * 32 + r] = f2bf(aw[i]); UG[d * 8192 + pos * 128 + tn * 32 + r] = au[i]; }
#pragma unroll
        for (int i2 = 0; i2 < 2; ++i2) { const int c = tid + 512 * i2, row = c >> 3, part = c & 7; *(GAS u32x4*)(KTG + d * 8192 + row * 64 + part * 8) = *(const LAS u32x4*)(Kt + row * 72 + part * 8); }
    }
    __syncthreads();
}
DI void ph_gdn_ga(const Ctx& C) { for (int u = C.blk; u < NCH * 8; u += C.nblk) gdn_ga_unit(C, u); }

constexpr int GB_NSL = 2;
constexpr int GB_W = 0, GB_Q = GB_W + 64 * 136 * 2, GB_KT = GB_Q + 64 * 136 * 2, GB_QK = GB_KT + 128 * 72 * 2, GB_SC = GB_QK + 64 * 72 * 2, GB_BUF = GB_SC + 1024;
static_assert(2 * GB_BUF <= LDS_MISC, "GB LDS");
template <int VAR> DI void gdn_gb_unit(const Ctx& C, int unit) {
    LAS unsigned char* ldsb = C.lds; asm volatile("" : "+v"(ldsb));
    constexpr int NGRP = 4 / GB_NSL;
    const int grp = unit % NGRP, bhd = unit / NGRP, d = bhd & 1, h = (bhd >> 1) & 7, b = bhd >> 4;
    const gbf16* QKVN = (const gbf16*)(C.ws + WS_QKVN);
    const gbf16* WGb = (const gbf16*)(C.ws + WS_WG); const gfloat* UGb = (const gfloat*)(C.ws + WS_UG); const gbf16* QKDb = (const gbf16*)(C.ws + WS_QKD); const gbf16* KTGb = (const gbf16*)(C.ws + WS_KTG); const gfloat* SCb = (const gfloat*)(C.ws + WS_SC);
    gfloat* OG = (gfloat*)(C.ws + (VAR ? WS_XS : WS_OG)) + (size_t)d * NTOK * D;
    int tid = C.tid; asm volatile("" : "+v"(tid));
    const int lane = tid & 63, wave = __builtin_amdgcn_readfirstlane(tid >> 6), r = lane & 31, hh = lane >> 5;
    const bool comp = wave < GB_NSL; const int dv0 = (grp * GB_NSL + wave) * 32;
    f32x16 S[4];
#pragma unroll
    for (int k = 0; k < 4; ++k) S[k] = zero16();
    constexpr int NSW = 8 - GB_NSL, NIT = (56 + NSW - 1) / NSW, NRD = 1;
    const int wv = wave - GB_NSL, st = tid - GB_NSL * 64;
    u32x4 sreg[NIT], sreg2[NIT]; float rsc = 0.f, rsc2 = 0.f;
    auto chunk_of = [&](int step) { return step < 4 ? 256 + b * 4 + (d ? 3 - step : step) : b * 64 + (d ? 63 - (step - 4) : (step - 4)); };
#define GB_LOAD(step, rd, SR, RS) do { if (!comp) { int ln2_ = lane; asm volatile("" : "+v"(ln2_)); const int cidx_ = chunk_of(step), un_ = (cidx_ * 8 + h) * 2 + d, row0_ = chunk_row0(cidx_); \
        _Pragma("unroll") for (int i_ = 0; i_ < NIT; ++i_) { const int blk_ = wv + NSW * i_; if (blk_ < 56) { const gbf16* src_; \
            if (blk_ < 16) { const int c_ = blk_ * 64 + ln2_; src_ = WGb + (size_t)un_ * 8192 + c_ * 8; } \
            else if (blk_ < 32) { const int c_ = (blk_ - 16) * 64 + ln2_, pos_ = c_ >> 4, part_ = c_ & 15, row_ = row0_ + (d ? 63 - pos_ : pos_); src_ = QKVN + (size_t)row_ * 3072 + h * 128 + part_ * 8; } \
            else if (blk_ < 48) { const int c_ = (blk_ - 32) * 64 + ln2_; src_ = KTGb + (size_t)un_ * 8192 + c_ * 8; } \
            else { const int c_ = (blk_ - 48) * 64 + ln2_; src_ = QKDb + (size_t)un_ * 4096 + c_ * 8; } \
            SR[i_] = *(const GAS u32x4*)src_; } } \
        if (st < 192) RS = SCb[(size_t)un_ * 192 + st]; } } while (0)
#define GB_STORE(buf, rd, SR, RS) do { if (!comp) { int ln2_ = lane; asm volatile("" : "+v"(ln2_)); LAS unsigned char* B_ = ldsb + (buf) * GB_BUF; \
        _Pragma("unroll") for (int i_ = 0; i_ < NIT; ++i_) { const int blk_ = wv + NSW * i_; if (blk_ < 56) { \
            if (blk_ < 16) { const int c_ = blk_ * 64 + ln2_; *(LAS u32x4*)((LAS bf16*)(B_ + GB_W) + (c_ >> 4) * 136 + (c_ & 15) * 8) = SR[i_]; } \
            else if (blk_ < 32) { const int c_ = (blk_ - 16) * 64 + ln2_; *(LAS u32x4*)((LAS bf16*)(B_ + GB_Q) + (c_ >> 4) * 136 + (c_ & 15) * 8) = SR[i_]; } \
            else if (blk_ < 48) { const int c_ = (blk_ - 32) * 64 + ln2_; *(LAS u32x4*)((LAS bf16*)(B_ + GB_KT) + (c_ >> 3) * 72 + (c_ & 7) * 8) = SR[i_]; } \
            else { const int c_ = (blk_ - 48) * 64 + ln2_; *(LAS u32x4*)((LAS bf16*)(B_ + GB_QK) + (c_ >> 3) * 72 + (c_ & 7) * 8) = SR[i_]; } } } \
        if (st < 192) ((LAS float*)(B_ + GB_SC))[st] = RS; } } while (0)
    static_assert(NRD == 1, "two-steps-ahead staging is written for one round per step");
    GB_LOAD(0, 0, sreg, rsc); GB_STORE(0, 0, sreg, rsc); GB_LOAD(1, 0, sreg, rsc);
    f32x16 Un[2];
    Un[0] = zero16(); Un[1] = zero16();
    if (comp) { const int cidx = chunk_of(0), un = (cidx * 8 + h) * 2 + d; const gfloat* Uu = UGb + (size_t)un * 8192 + dv0 + r;
#pragma unroll
        for (int tt = 0; tt < 2; ++tt)
#pragma unroll
            for (int i = 0; i < 16; ++i) Un[tt][i] = Uu[(tt * 32 + crow(i, hh)) * 128]; }
    __syncthreads();
    if (!comp) {
        for (int step = 0; step < 68; ++step) {
            const int buf = step & 1;
            if (VAR != 2) { if (step + 2 < 68) GB_LOAD(step + 2, 0, sreg2, rsc2);
            if (step + 1 < 68) GB_STORE(buf ^ 1, 0, sreg, rsc); }
#pragma unroll
            for (int i_ = 0; i_ < NIT; ++i_) sreg[i_] = sreg2[i_];
            rsc = rsc2;
            asm volatile("s_waitcnt lgkmcnt(0)\n\ts_barrier" ::: "memory");
        }
    } else {
        for (int step = 0; step < 68; ++step) {
            const int buf = step & 1;
            if (VAR != 1) {
            int ln_ = lane; asm volatile("" : "+v"(ln_)); const int r = ln_ & 31, hh = ln_ >> 5;
            const int cidx = chunk_of(step), un = (cidx * 8 + h) * 2 + d, row0 = chunk_row0(cidx);
            const LAS unsigned char* Bp = ldsb + buf * GB_BUF; const LAS bf16* Wl = (const LAS bf16*)(Bp + GB_W); const LAS bf16* Ql = (const LAS bf16*)(Bp + GB_Q);
            const LAS bf16* KTl = (const LAS bf16*)(Bp + GB_KT); const LAS bf16* QKl = (const LAS bf16*)(Bp + GB_QK); const LAS float* scl = (const LAS float*)(Bp + GB_SC);
            bf16x8 sp[4][2];
#pragma unroll
            for (int kb = 0; kb < 4; ++kb) { sp[kb][0] = pack_step(S[kb], 0); sp[kb][1] = pack_step(S[kb], 1); }
            f32x16 aw0 = zero16(), aw1 = zero16();
#pragma unroll
            for (int kb = 0; kb < 4; ++kb)
#pragma unroll
                for (int s = 0; s < 2; ++s) { aw0 = MFMA32(ld_perm_frag(Wl + r * 136, kb * 32, s, hh), sp[kb][s], aw0); aw1 = MFMA32(ld_perm_frag(Wl + (32 + r) * 136, kb * 32, s, hh), sp[kb][s], aw1); }
#pragma unroll
            for (int i = 0; i < 16; ++i) { Un[0][i] -= aw0[i]; Un[1][i] -= aw1[i]; }
            f32x16 aq0 = zero16(), aq1 = zero16();
#pragma unroll
            for (int kb = 0; kb < 4; ++kb)
#pragma unroll
                for (int s = 0; s < 2; ++s) { aq0 = MFMA32(ld_perm_frag(Ql + r * 136, kb * 32, s, hh), sp[kb][s], aq0); aq1 = MFMA32(ld_perm_frag(Ql + (32 + r) * 136, kb * 32, s, hh), sp[kb][s], aq1); }
            bf16x8 vp[2][2];
#pragma unroll
            for (int jt = 0; jt < 2; ++jt) { vp[jt][0] = pack_step(Un[jt], 0); vp[jt][1] = pack_step(Un[jt], 1); }
#pragma unroll
            for (int i = 0; i < 16; ++i) { aq0[i] *= scl[crow(i, hh)]; aq1[i] *= scl[32 + crow(i, hh)]; }
#pragma unroll
            for (int jt = 0; jt < 2; ++jt)
#pragma unroll
                for (int s = 0; s < 2; ++s) { aq0 = MFMA32(ld_perm_frag(QKl + r * 72, jt * 32, s, hh), vp[jt][s], aq0); aq1 = MFMA32(ld_perm_frag(QKl + (32 + r) * 72, jt * 32, s, hh), vp[jt][s], aq1); }
#pragma unroll
            for (int jt = 0; jt < 2; ++jt) {
#pragma unroll
                for (int i = 0; i < 16; ++i) Un[jt][i] *= scl[64 + jt * 32 + crow(i, hh)];
                vp[jt][0] = pack_step(Un[jt], 0); vp[jt][1] = pack_step(Un[jt], 1); }
            if (step + 1 < 68) { const int cn = chunk_of(step + 1), unn = (cn * 8 + h) * 2 + d; const gfloat* Uu = UGb + (size_t)unn * 8192 + dv0 + r;
#pragma unroll
                for (int tt = 0; tt < 2; ++tt)
#pragma unroll
                    for (int i = 0; i < 16; ++i) Un[tt][i] = Uu[(tt * 32 + crow(i, hh)) * 128]; }
            const float gtot = scl[128];
#pragma unroll
            for (int kb = 0; kb < 4; ++kb) S[kb] = S[kb] * gtot;
#pragma unroll
            for (int jt = 0; jt < 2; ++jt)
#pragma unroll
                for (int s = 0; s < 2; ++s)
#pragma unroll
                    for (int kb = 0; kb < 4; ++kb) S[kb] = MFMA32(ld_perm_frag(KTl + (kb * 32 + r) * 72, jt * 32, s, hh), vp[jt][s], S[kb]);
#pragma unroll
            for (int i = 0; i < 16; ++i) { const int pos = crow(i, hh), row = row0 + (d ? 63 - pos : pos); OG[(size_t)row * D + h * 128 + dv0 + r] = aq0[i]; }
#pragma unroll
            for (int i = 0; i < 16; ++i) { const int pos = 32 + crow(i, hh), row = row0 + (d ? 63 - pos : pos); OG[(size_t)row * D + h * 128 + dv0 + r] = aq1[i]; }
            }
            asm volatile("s_waitcnt lgkmcnt(0)\n\ts_barrier" ::: "memory");
        }
    }
#undef GB_LOAD
#undef GB_STORE
}
DI void ph_gdn_gb(const Ctx& C, const Params& p, int lp, int rep) {
    constexpr int NU = 64 * (4 / GB_NSL);
#ifndef GB_PROBE_VAR
    for (int u = C.blk; u < NU; u += C.nblk) gdn_gb_unit<0>(C, u);
#else
    if (rep) { for (int u = C.blk; u < NU; u += C.nblk) gdn_gb_unit<GB_PROBE_VAR>(C, u); return; }
    for (int u = C.blk; u < NU; u += C.nblk) gdn_gb_unit<0>(C, u);
#endif
#if CONV_DEFER
    if (C.nblk > NU) { if (C.blk >= NU) convert_weights(C, p, 1 + lp, (C.blk - NU) * 8 + C.wave, (C.nblk - NU) * 8); }
    else convert_weights(C, p, 1 + lp, C.blk * 8 + C.wave, C.nblk * 8);
#endif
}
constexpr int NPH_PAIR = 20, NPHASE = 1 + 2 * NPH_PAIR;
DI void fresh(Ctx& C) { int t = C.wave0 * 64 + (int)__builtin_amdgcn_mbcnt_hi(~0u, __builtin_amdgcn_mbcnt_lo(~0u, 0u)); asm volatile("" : "+v"(t));     int b = blockIdx.x; asm volatile("" : "+s"(b)); guchar* w_ = C.ws0; asm volatile("" : "+s"(w_)); C.ws = w_; C.tid = t; C.lane = t & 63; C.wave = __builtin_amdgcn_readfirstlane(t >> 6); C.blk = b; }
__global__ void __launch_bounds__(512, 2) fused_fwd(Params p) {
    extern __shared__ __attribute__((aligned(16))) unsigned char lds_raw[];
    Ctx C; C.lds = (LAS unsigned char*)lds_raw; C.ws = (guchar*)p.ws; C.ws0 = (guchar*)p.ws; C.tid = threadIdx.x; C.lane = C.tid & 63; C.wave = __builtin_amdgcn_readfirstlane(C.tid >> 6); C.wave0 = C.wave; C.nblk = gridDim.x; C.blk = blockIdx.x;
    volatile LAS unsigned* misc = (volatile LAS unsigned*)(C.lds + LDS_MISC);
    if (C.tid < 16) misc[C.tid] = 0u;
    __syncthreads();
    unsigned* ctl = (unsigned*)(p.ws + WS_CTL);
    const bool single = (p.ph_lo == 0 && p.ph_hi == NPHASE);
    XcdBarrier bar; bar.bar = ctl + CW_BAR; bar.x = 0; bar.st = misc;
    if (single) bar = xcd_barrier_post(ctl + CW_BAR, misc);
    const int lo = p.ph_lo, hi = p.ph_hi;
#ifndef PH_MASK
#define PH_MASK 0x1FFFFFu
#endif
#define PHEN(k) (((PH_MASK) >> (k)) & 1u)
#ifndef XTRA_BAR
#define XTRA_BAR 0
#endif
#ifndef REP_MASK
#define REP_MASK 0u
#endif
#define NREP(k) (1 + (int)(((REP_MASK) >> (k)) & 1u))
#define IN(k) (fresh(C), lo <= (k) && (k) < hi)
#define SEAM(k) do { if (single) { unsigned* bp_ = ctl + CW_BAR; asm volatile("" : "+s"(bp_)); bar.bar = bp_; xcd_barrier(bar); for (int xb_ = 0; xb_ < XTRA_BAR; ++xb_) xcd_barrier(bar); } } while (0)
#define H ((gbf16*)(C.ws + WS_H))
#define MIX ((gbf16*)(C.ws + WS_MIX))
#define P ((gbf16*)(C.ws + WS_P))
#define X ((gfloat*)(C.ws + WS_X))
#define MOD ((const gfloat*)(C.ws + WS_MOD))
    for (int rep_ = 0; rep_ < NREP(0); ++rep_) { if (rep_) { SEAM(0); } if (PHEN(0) && IN(0)) ph_prologue(C, p); }
    SEAM(0);
    for (int lp = 0; lp < 2; ++lp) {
        const int pb = 1 + lp * NPH_PAIR, le = 2 * lp, lod = 2 * lp + 1;
        for (int rep_ = 0; rep_ < NREP(1); ++rep_) { if (rep_) { SEAM(0); } if (PHEN(1) && IN(pb + 0)) { if (lp == 0) ph_normmod(C, p, 0, false, true, 0, 0); } }
        SEAM(pb + 0);
        for (int rep_ = 0; rep_ < NREP(2); ++rep_) { if (rep_) { SEAM(0); } if (PHEN(2) && IN(pb + 1)) { pg8::Gemm g{H, (const gbf16*)(C.ws + WS_WEIN) + (size_t)lp * 2560 * 1024, NTOK, EVEN_IN, D, 0}; pg8::StaticOrder S; S.init(NTOK, EVEN_IN, C.nblk, C.blk);
            EpiEvenIn E{P, (const gfloat*)(C.ws + WS_COS), (const gfloat*)(C.ws + WS_SIN)}; pg8::gemm_phase<EpiEvenIn, pg8::StaticOrder>(C.lds, g, S, E, C.tid); } }
        SEAM(pb + 1);
        for (int rep_ = 0; rep_ < NREP(20); ++rep_) { if (rep_) { SEAM(0); } if (PHEN(20) && IN(pb + 2)) ph_rg_gates(C, p, lp); }
        SEAM(pb + 2);
        for (int rep_ = 0; rep_ < NREP(3); ++rep_) { if (rep_) { SEAM(0); } if (PHEN(3) && IN(pb + 3)) ph_even_mix(C, p, le, rep_); }
        SEAM(pb + 3);
        for (int rep_ = NREP(4) - 1; rep_ >= 0; --rep_) { if (PHEN(4) && IN(pb + 4)) {
            { pg8::Gemm g{MIX, (const gbf16*)(C.ws + WS_WEOUT) + (size_t)lp * 1024 * 1024, NLAT, D, D, 0}; pg8::StaticOrder S; S.init(NLAT, D, C.nblk, C.blk);
              EpiResid E{rep_ ? (gfloat*)(C.ws + WS_U + (size_t)200 * 1024 * 1024) : X, MOD + (size_t)le * 5 * MODW + 2 * D}; pg8::gemm_phase<EpiResid, pg8::StaticOrder>(C.lds, g, S, E, C.tid); }
            { fresh(C); pg8::Gemm g{MIX + (size_t)NLAT * D, (const gbf16*)(C.ws + WS_WEOUT) + (size_t)lp * 1024 * 1024, NCTX, D, D, D / 4}; pg8::StaticOrder S; S.init(NCTX, D, C.nblk, C.blk); S.lim = S.nwg * 4; S.s = 4;
              EpiPart E{(gfloat*)(C.ws + WS_PART)}; pg8::gemm_phase<EpiPart, pg8::StaticOrder>(C.lds, g, S, E, C.tid); } } if (rep_) { SEAM(0); } }
        SEAM(pb + 4);
        for (int rep_ = 0; rep_ < NREP(5); ++rep_) { if (rep_) { SEAM(0); } if (PHEN(5) && IN(pb + 5)) ph_normmod(C, p, le, true, false, 4, le * 5 * MODW + 2 * D); }
        SEAM(pb + 5);
        for (int rep_ = 0; rep_ < NREP(6); ++rep_) { if (rep_) { SEAM(0); } if (PHEN(6) && IN(pb + 6)) { pg8::Gemm g{H, (const gbf16*)(C.ws + WS_WEF1) + (size_t)lp * 5632 * 1024, NTOK, 2 * FFN, D, 0}; pg8::StaticOrder S; S.init(NTOK, 2 * FFN, C.nblk, C.blk);
            EpiSwiglu E{P, FFN, 2 * FFN / 256}; pg8::gemm_phase<EpiSwiglu, pg8::StaticOrder>(C.lds, g, S, E, C.tid); } }
        SEAM(pb + 6);
        for (int rep_ = NREP(7) - 1; rep_ >= 0; --rep_) { if (PHEN(7) && IN(pb + 7)) {
            { pg8::Gemm g{P, (const gbf16*)(C.ws + WS_WEF2) + (size_t)lp * 1024 * 2816, NLAT, D, FFN, 0}; pg8::StaticOrder S; S.init(NLAT, D, C.nblk, C.blk);
              EpiResid E{rep_ ? (gfloat*)(C.ws + WS_U + (size_t)200 * 1024 * 1024) : X, MOD + (size_t)le * 5 * MODW + 5 * D}; pg8::gemm_phase<EpiResid, pg8::StaticOrder>(C.lds, g, S, E, C.tid); }
            { fresh(C); pg8::Gemm g{P + (size_t)NLAT * FFN, (const gbf16*)(C.ws + WS_WEF2) + (size_t)lp * 1024 * 2816, NCTX, D, FFN, FFN / 11}; pg8::StaticOrder S; S.init(NCTX, D, C.nblk, C.blk); S.lim = S.nwg * 11; S.s = 11;
              EpiPart E{(gfloat*)(C.ws + WS_PART)}; pg8::gemm_phase<EpiPart, pg8::StaticOrder>(C.lds, g, S, E, C.tid); } } if (rep_) { SEAM(0); } }
        SEAM(pb + 7);
        const int ntok = (lod < DEPTH - 1) ? NTOK : NLAT;
        for (int rep_ = 0; rep_ < NREP(8); ++rep_) { if (rep_) { SEAM(0); } if (PHEN(8) && IN(pb + 8)) ph_normmod(C, p, lod, false, false, 11, le * 5 * MODW + 5 * D); }
        SEAM(pb + 8);
        for (int rep_ = 0; rep_ < NREP(9); ++rep_) { if (rep_) { SEAM(0); } if (PHEN(9) && IN(pb + 9)) { pg8::Gemm g{H, (const gbf16*)(C.ws + WS_WOIN) + (size_t)lp * 4352 * 1024, NTOK, 4352, D, 0}; pg8::StaticOrder S; S.init(NTOK, 4352, C.nblk, C.blk);
            EpiBf16Ab E{P, 4352, (gfloat*)(C.ws + WS_AB), 16}; pg8::gemm_phase<EpiBf16Ab, pg8::StaticOrder>(C.lds, g, S, E, C.tid); } }
        SEAM(pb + 9);
        for (int rep_ = 0; rep_ < NREP(10); ++rep_) { if (rep_) { SEAM(0); } if (PHEN(10) && IN(pb + 10)) ph_odd_conv(C, p, lp); }
        SEAM(pb + 10);
        for (int rep_ = 0; rep_ < NREP(11); ++rep_) { if (rep_) { SEAM(0); } if (PHEN(11) && IN(pb + 11)) ph_gdn_ga(C); }
        SEAM(pb + 11);
        for (int rep_ = 0; rep_ < NREP(12); ++rep_) { if (rep_) { SEAM(0); } if (PHEN(12) && IN(pb + 12)) ph_gdn_gb(C, p, lp, rep_); }
        SEAM(pb + 12);
        for (int rep_ = 0; rep_ < NREP(13); ++rep_) { if (rep_) { SEAM(0); } if (PHEN(13) && IN(pb + 13)) ph_gdn_out(C, p, lp); }
        SEAM(pb + 13);
        for (int rep_ = NREP(14) - 1; rep_ >= 0; --rep_) { if (PHEN(14) && IN(pb + 14)) {
            { pg8::Gemm g{MIX, (const gbf16*)(C.ws + WS_WOOUT) + (size_t)lp * 1024 * 1024, NLAT, D, D, 0}; pg8::StaticOrder S; S.init(NLAT, D, C.nblk, C.blk);
              EpiResid E{rep_ ? (gfloat*)(C.ws + WS_U + (size_t)200 * 1024 * 1024) : X, MOD + (size_t)lod * 5 * MODW + 2 * D}; pg8::gemm_phase<EpiResid, pg8::StaticOrder>(C.lds, g, S, E, C.tid); }
            if (lod < DEPTH - 1) { fresh(C); pg8::Gemm g{MIX + (size_t)NLAT * D, (const gbf16*)(C.ws + WS_WOOUT) + (size_t)lp * 1024 * 1024, NCTX, D, D, D / 4}; pg8::StaticOrder S; S.init(NCTX, D, C.nblk, C.blk); S.lim = S.nwg * 4; S.s = 4;
              EpiPart E{(gfloat*)(C.ws + WS_PART)}; pg8::gemm_phase<EpiPart, pg8::StaticOrder>(C.lds, g, S, E, C.tid); } } if (rep_) { SEAM(0); } }
        SEAM(pb + 14);
        if (PHEN(15) && IN(pb + 15)) ph_router(C, p, lod, ntok, (lod < DEPTH - 1) ? 4 : 0);
        SEAM(pb + 15);
        for (int rep_ = 0; rep_ < NREP(16); ++rep_) { if (rep_) { SEAM(0); } if (PHEN(16) && IN(pb + 16)) ph_gather(C, lod, ntok); }
        SEAM(pb + 16);
        for (int rep_ = 0; rep_ < NREP(17); ++rep_) { if (rep_) { SEAM(0); } if (PHEN(17) && IN(pb + 17)) { pg8::Gemm g{(const gbf16*)(C.ws + WS_XS), (const gbf16*)(C.ws + WS_WXIN) + (size_t)lp * 8 * 7168 * 1024, RMAX, 8 * 7168, D, 0}; MoeOrder S; S.initm((const guint*)(ctl + CW_CNT + lp * 64), 28, C.nblk, C.blk);
            EpiSwiglu E{(gbf16*)(C.ws + WS_HIDM), FFE, 28}; pg8::gemm_phase<EpiSwiglu, MoeOrder>(C.lds, g, S, E, C.tid); } }
        SEAM(pb + 17);
        for (int rep_ = 0; rep_ < NREP(18); ++rep_) { if (rep_) { SEAM(0); } if (PHEN(18) && IN(pb + 18)) {
            pg8::Gemm g{(const gbf16*)(C.ws + WS_HIDM), (const gbf16*)(C.ws + WS_WXOUT) + (size_t)lp * 8 * 1024 * 3584, RMAX, 8 * 1024, FFE, 0}; MoeOrder S; S.initm((const guint*)(ctl + CW_CNT + lp * 64), 4, C.nblk, C.blk);
            EpiF32 E{(gfloat*)(C.ws + WS_Y), D, 4}; pg8::gemm_phase<EpiF32, MoeOrder>(C.lds, g, S, E, C.tid); } }
        SEAM(pb + 18);
        if (PHEN(19) && IN(pb + 19)) ph_combine(C, p, lod, ntok, (const guint*)(ctl + CW_CNT + lp * 64));
        SEAM(pb + 19);
    }
#undef IN
#undef SEAM
#undef H
#undef MIX
#undef P
#undef X
#undef MOD
}

static int fused_setup() {
    static int grid = 0;
    if (grid == 0) {
        int dev = 0, cus = 0, per_cu = 0;
        if (hipGetDevice(&dev) != hipSuccess || hipDeviceGetAttribute(&cus, hipDeviceAttributeMultiprocessorCount, dev) != hipSuccess) { fprintf(stderr, "fused_setup: device query failed\n"); grid = -1; return grid; }
        if (hipFuncSetAttribute((const void*)fused_fwd, hipFuncAttributeMaxDynamicSharedMemorySize, LDS_BYTES) != hipSuccess) { fprintf(stderr, "fused_setup: hipFuncSetAttribute failed\n"); grid = -1; return grid; }
        if (hipOccupancyMaxActiveBlocksPerMultiprocessor(&per_cu, (const void*)fused_fwd, 512, LDS_BYTES) != hipSuccess || per_cu < 1) { fprintf(stderr, "fused_setup: occupancy query says %d blocks per CU\n", per_cu); (void)hipGetLastError(); }
        grid = cus;
    }
    return grid;
}
static void launch_fused(const Params& p0, int lo, int hi, hipStream_t s) {
    const int grid = fused_setup(); if (grid <= 0) return;
    Params p = p0; p.ph_lo = lo; p.ph_hi = hi;
    hipLaunchKernelGGL(fused_fwd, dim3(grid), dim3(512), LDS_BYTES, s, p);
}
}
#ifdef DEBUG_MODE
namespace dbg {
using namespace cfg;
__global__ void k_cmp_f32_bf16(const float* __restrict__ A, const unsigned short* __restrict__ R, size_t n, float* __restrict__ res) {
    float d2 = 0.f, r2 = 0.f;
    for (size_t i = (size_t)blockIdx.x * 256 + threadIdx.x; i < n; i += (size_t)gridDim.x * 256) { const float r = __uint_as_float((unsigned)R[i] << 16), a = A[i]; d2 += (a - r) * (a - r); r2 += r * r; }
    for (int o = 32; o >= 1; o >>= 1) { d2 += __shfl_xor(d2, o); r2 += __shfl_xor(r2, o); }
    if ((threadIdx.x & 63) == 0) { atomicAdd(res, d2); atomicAdd(res + 1, r2); }
}
__global__ void k_cmp_bf16_f32(const unsigned short* __restrict__ A, int fp, int fo, const float* __restrict__ R, int rp, int ro, int nrows, int ncols, float rscale, float* __restrict__ res) {
    float d2 = 0.f, r2 = 0.f;
    for (size_t i = (size_t)blockIdx.x * 256 + threadIdx.x; i < (size_t)nrows * ncols; i += (size_t)gridDim.x * 256) { const int row = (int)(i / ncols), c = (int)(i % ncols);
        const float a = __uint_as_float((unsigned)A[(size_t)row * fp + fo + c] << 16), r = R[(size_t)row * rp + ro + c] * rscale; d2 += (a - r) * (a - r); r2 += r * r; }
    for (int o = 32; o >= 1; o >>= 1) { d2 += __shfl_xor(d2, o); r2 += __shfl_xor(r2, o); }
    if ((threadIdx.x & 63) == 0) { atomicAdd(res, d2); atomicAdd(res + 1, r2); }
}
__global__ void k_cmp_f32_f32(const float* __restrict__ A, int fp, int fo, const float* __restrict__ R, int rp, int ro, int nrows, int ncols, float* __restrict__ res) {
    float d2 = 0.f, r2 = 0.f;
    for (size_t i = (size_t)blockIdx.x * 256 + threadIdx.x; i < (size_t)nrows * ncols; i += (size_t)gridDim.x * 256) { const int row = (int)(i / ncols), c = (int)(i % ncols);
        const float a = A[(size_t)row * fp + fo + c], r = R[(size_t)row * rp + ro + c]; d2 += (a - r) * (a - r); r2 += r * r; }
    for (int o = 32; o >= 1; o >>= 1) { d2 += __shfl_xor(d2, o); r2 += __shfl_xor(r2, o); }
    if ((threadIdx.x & 63) == 0) { atomicAdd(res, d2); atomicAdd(res + 1, r2); }
}
__global__ void k_decide(const float* __restrict__ res, int nchk, float tol, float* __restrict__ out, size_t nout) {
    int code = 0; float frac = 0.f;
    for (int k = 0; k < nchk; ++k) { const float err = res[2 * k] / res[2 * k + 1]; if (!(err <= tol)) { code = k + 1; float l = (err == err && err > 0.f) ? log10f(err) : 0.f; frac = fminf(fmaxf((l + 4.f) / 4.f * 0.9f, 0.f), 0.9f); break; } }
    if (code == 0) return;
    const float c = sqrtf((float)code + frac);
    for (size_t i = (size_t)blockIdx.x * 256 + threadIdx.x; i < nout; i += (size_t)gridDim.x * 256) out[i] = c;
}
}
#endif

static nv::NaiveWs carve_naive(char* base, size_t& off) {
    using namespace cfg;
    nv::NaiveWs w{};
    auto take = [&](size_t nfloats) { float* p = (float*)(base + off); off += ((nfloats * 4 + 255) / 256) * 256; return p; };
    w.MOD = take((size_t)DEPTH * 5 * MODW);
    w.X = take((size_t)NTOK * D); w.H = take((size_t)NTOK * D); w.P = take((size_t)NTOK * ODD_IN); w.MIX = take((size_t)NTOK * D);
    w.T0 = take((size_t)NTOK * 512); w.T1 = take((size_t)NTOK * 3072); w.T2 = take((size_t)NTOK * 2048);
    w.FOUT = take((size_t)NTOK * D); w.HID = take((size_t)NTOK * FFE);
    w.lam = take(64); w.cnt = (int*)take(64); w.list_tok = (int*)take((size_t)NEXP * NTOK); w.list_w = take((size_t)NEXP * NTOK);
    return w;
}
extern "C" void kernel_launch(void* const* d_in, const int* in_sizes, int n_in, void* d_out, int out_size, void* d_ws, size_t ws_size, hipStream_t stream) {
    using namespace cfg;
    if (n_in != 31 || out_size != NLAT * D) { fprintf(stderr, "kernel_launch: unexpected n_in %d / out_size %d\n", n_in, out_size); return; }
    fk::Params p{}; for (int i = 0; i < 31; ++i) p.in[i] = (const float*)d_in[i];
    p.out = (float*)d_out; p.ws = (unsigned char*)d_ws;
#ifdef DEBUG_MODE
    const size_t snap_bytes = (size_t)NTOK * D * 2, CK_BYTES = 8 * snap_bytes + (size_t)NLAT * D * 4 + 4096;
    if (ws_size < fk::WS_END + CK_BYTES) { fprintf(stderr, "kernel_launch(debug): workspace too small\n"); return; }
    char* ckb = (char*)d_ws + ws_size - CK_BYTES; ckb -= ((size_t)ckb & 255);
    unsigned short* snaps = (unsigned short*)ckb; float* nout = (float*)(ckb + 8 * snap_bytes); float* res = (float*)(ckb + 8 * snap_bytes + (size_t)NLAT * D * 4);
    {
        nv::Inputs in{}; for (int i = 0; i < 31; ++i) in.p[i] = (const float*)d_in[i];
        size_t off = 0; nv::NaiveWs w = carve_naive((char*)d_ws, off);
        if ((char*)d_ws + off > ckb) { fprintf(stderr, "kernel_launch(debug): oracle scratch overlaps snapshots\n"); return; }
        nv::run_naive(in, w, nout, snaps, stream);
    }
    (void)hipMemsetAsync(res, 0, 4096, stream);
    (void)hipMemsetAsync((char*)d_ws + fk::WS_CTL, 0, fk::CTL_BYTES, stream);
    int chk = 0;
    for (int ph = 0; ph < fk::NPHASE; ++ph) {
        fk::launch_fused(p, ph, ph + 1, stream);
        if (ph == 0) continue;
        const int lp = (ph - 1) / fk::NPH_PAIR, k = (ph - 1) % fk::NPH_PAIR;
        int snap = -1;
        if (k == 4) snap = 4 * lp + 0; else if (k == 7) snap = 4 * lp + 1; else if (k == 14) snap = 4 * lp + 2; else if (k == 19 && lp == 0) snap = 3;
        if (snap >= 0) { hipLaunchKernelGGL(dbg::k_cmp_f32_bf16, dim3(2048), dim3(256), 0, stream, (const float*)((char*)d_ws + fk::WS_X), snaps + (size_t)snap * NTOK * D, (size_t)NTOK * D, res + 2 * chk); ++chk; }
    }
    hipLaunchKernelGGL(dbg::k_cmp_f32_f32, dim3(2048), dim3(256), 0, stream, (const float*)d_out, D, 0, (const float*)nout, D, 0, NLAT, D, res + 2 * chk); ++chk;
    hipLaunchKernelGGL(dbg::k_decide, dim3(1024), dim3(256), 0, stream, (const float*)res, chk, DEBUG_TOL, (float*)d_out, (size_t)NLAT * D);
#else
    if (ws_size < fk::WS_END) { fprintf(stderr, "kernel_launch: workspace too small: need %zu have %zu\n", (size_t)fk::WS_END, ws_size); return; }
    (void)hipMemsetAsync((char*)d_ws + fk::WS_CTL, 0, fk::CTL_BYTES, stream);
    fk::launch_fused(p, 0, fk::NPHASE, stream);
#endif
}
```

```cpp
#include <hip/hip_runtime.h>
#include <cstdio>
#include <cstdint>
#include <cmath>
namespace cfg {
constexpr int D = 1024, B = 4, SEQ = 4096, CTX = 256, DEPTH = 4;
constexpr int NLAT = B * SEQ, NCTX = B * CTX, NTOK = NLAT + NCTX;
constexpr int NMOD = 6, MODW = NMOD * D;
constexpr int EVEN_IN = 2560, ODD_IN = 4128, FFN = 2816, FFE = 3584, NEXP = 8;
}
namespace nv {
using namespace cfg;
struct NaiveWs { float *MOD, *X, *H, *P, *MIX, *T0, *T1, *T2, *FOUT, *HID, *lam; int* cnt; int* list_tok; float* list_w; };
}
namespace pg8 {
#define PG8_LAS __attribute__((address_space(3)))
#define PG8_GAS __attribute__((address_space(1)))
typedef unsigned short bf16_t;
typedef short bf16x8 __attribute__((ext_vector_type(8)));
typedef float f32x4 __attribute__((ext_vector_type(4)));
typedef unsigned u32x4 __attribute__((ext_vector_type(4)));
constexpr int BM = 256, BK = 64, HALF = 128, HTB = HALF * BK * 2  , STAGE_BYTES = 8 * HTB, NXCD = 8, WGM = 8;

__host__ __device__ __forceinline__ int lds_byte(int r_, int c_) { const unsigned r = (unsigned)r_, c = (unsigned)c_; const unsigned st = (r >> 4) * 2u + (c >> 5), rr = r & 15u, cc = c & 31u, ob = rr * 64u + cc * 2u; return (int)(st * 1024u + (ob ^ (((ob >> 9) & 1u) << 5))); }
__host__ __device__ __forceinline__ void stage_rc(int b_, int& R, int& C) { const unsigned b = (unsigned)b_; const unsigned st = b >> 10, sb = b & 1023u, swz = sb ^ (((sb >> 9) & 1u) << 5); R = (int)((st >> 1) * 16u + (swz >> 6)); C = (int)((st & 1u) * 32u + ((swz & 63u) >> 1)); }
__host__ __device__ __forceinline__ int perm32(int rho_) { const unsigned rho = (unsigned)rho_; const unsigned n = rho >> 4, i = rho & 15u; return (int)(8u * (i >> 2) + 4u * n + (i & 3u)); }

struct Unit { int pm, pn, pk; };
struct Gemm { const PG8_GAS bf16_t* A; const PG8_GAS bf16_t* Bt; int M, N, K, Kh; };

struct StaticOrder {
    int nM, nN, nwg, G, c;
    int lim, L0, s;
    __host__ __device__ void init(int M, int N, int G_, int c_) { nM = M / BM; nN = N / BM; nwg = nM * nN; G = G_; c = c_; lim = nwg; L0 = 0; s = 1; }
    __host__ __device__ void decode(int wgid, Unit& u) const {
        { const int q = nwg / NXCD, r = nwg % NXCD, xcd = wgid % NXCD, off = wgid / NXCD; wgid = (xcd < r ? xcd * (q + 1) : r * (q + 1) + (xcd - r) * q) + off; }
        const int nig = WGM * nN, gid = wgid / nig, fm = gid * WGM, gsz = (nM - fm) < WGM ? (nM - fm) : WGM;
        u.pm = fm + ((wgid % nig) % gsz); u.pn = (wgid % nig) / gsz;
    }
    __host__ __device__ bool next(int i, Unit& u) const {
        const long j = (long)i * G + c; if (j >= lim) return false;
        u.pk = (int)(j % s); decode(L0 + (int)(j / s), u); return true;
    }
    __host__ __device__ void main_part() { lim = (nwg / G) * G; L0 = 0; s = 1; }
    __host__ __device__ void tail_part(int s_) { L0 = (nwg / G) * G; s = s_; lim = (nwg - L0) * s_; }
    __host__ __device__ int tail_tiles() const { return nwg - (nwg / G) * G; }
    __device__ __forceinline__ void a_ready(const Unit&) const {}
    __device__ __forceinline__ void done(const Unit&) const {}
};
template <class Epi, class Sched, bool ALIGN_EPI = true, bool SP2 = true>
__device__ __forceinline__ void gemm_phase(PG8_LAS unsigned char* lds, const Gemm g, const Sched& S, const Epi& E, const int tid) {
    const int wid = __builtin_amdgcn_readfirstlane(tid >> 6), lane = tid & 63, wr = wid >> 2, wc = wid & 3, fr = lane & 15, fq = lane >> 4;
    const int K = g.K, Kh = g.Kh ? g.Kh : g.K, nt = Kh / BK;
    unsigned voffA[2], voffB[2];
#pragma unroll
    for (int i = 0; i < 2; ++i) { int R, C; stage_rc(tid * 16 + i * 8192, R, C); const int Rb = Epi::PERM ? ((R & ~31) + perm32(R & 31)) : R;
        voffA[i] = (unsigned)(R * K + C) * 2u; voffB[i] = (unsigned)(Rb * K + C) * 2u; }
    const size_t kstep = (size_t)(BK * 2);
    const size_t hstep = (size_t)HALF * K * 2;
    const size_t tstep = 2 * hstep;
    const unsigned ldsw = (unsigned)wid * 1024u;
    const int aoff = lds_byte(wr * 64 + fr, fq * 8), boff = lds_byte(wc * 32 + fr, fq * 8);
#define PG8_SA(b, h) (((b) * 2 + (h)) * HTB)
#define PG8_SB(b, h) ((4 + (b) * 2 + (h)) * HTB)
#define PG8_STAGE(bufoff, gbase, voff) do { _Pragma("unroll") for (int _i = 0; _i < 2; ++_i) \
        __builtin_amdgcn_global_load_lds((const PG8_GAS unsigned*)((const PG8_GAS char*)(gbase) + (voff)[_i]), (PG8_LAS unsigned*)(lds + (bufoff) + ldsw + _i * 8192), 16, 0, 0); } while (0)
#define PG8_LDA(dst, b, h) do { _Pragma("unroll") for (int m = 0; m < 4; ++m) _Pragma("unroll") for (int k = 0; k < 2; ++k) dst[m][k] = *(const PG8_LAS bf16x8*)(lds + PG8_SA(b, h) + aoff + m * 2048 + k * 1024); } while (0)
#define PG8_LDB(dst, b, h) do { _Pragma("unroll") for (int n = 0; n < 2; ++n) _Pragma("unroll") for (int k = 0; k < 2; ++k) dst[n][k] = *(const PG8_LAS bf16x8*)(lds + PG8_SB(b, h) + boff + n * 2048 + k * 1024); } while (0)
#define PG8_MMA(ai, bj, At, Bt) do { __builtin_amdgcn_s_setprio(1); _Pragma("unroll") for (int m = 0; m < 4; ++m) _Pragma("unroll") for (int n = 0; n < 2; ++n) _Pragma("unroll") for (int k = 0; k < 2; ++k) \
        acc[ai][bj][m][n] = __builtin_amdgcn_mfma_f32_16x16x32_bf16(Bt[n][k], At[m][k], acc[ai][bj][m][n], 0, 0, 0); __builtin_amdgcn_s_setprio(0); } while (0)
#define PG8_WAIT_V(n) asm volatile("s_waitcnt vmcnt(" #n ")" ::: "memory")
#define PG8_WAIT_L(n) asm volatile("s_waitcnt lgkmcnt(" #n ")" ::: "memory")
#define PG8_BAR __builtin_amdgcn_s_barrier()
#define PG8_SCHED __builtin_amdgcn_sched_barrier(0)
    Unit cur, nxt; int ui = 0;
    if (!S.next(0, cur)) return;
    f32x4 acc[2][2][4][2];
#pragma unroll
    for (int a = 0; a < 2; ++a)
#pragma unroll
        for (int b = 0; b < 2; ++b)
#pragma unroll
            for (int m = 0; m < 4; ++m)
#pragma unroll
                for (int n = 0; n < 2; ++n) acc[a][b][m][n] = (f32x4){0.f, 0.f, 0.f, 0.f};
    bf16x8 At[4][2], B0[2][2], B1[2][2];
    const PG8_GAS char* cA = (const PG8_GAS char*)g.A + (size_t)cur.pm * tstep + (size_t)cur.pk * Kh * 2; const PG8_GAS char* cB = (const PG8_GAS char*)g.Bt + (size_t)cur.pn * tstep + (size_t)cur.pk * Kh * 2;
    S.a_ready(cur);
    if constexpr (SP2) {
        PG8_STAGE(PG8_SB(0, 0), cB, voffB); PG8_STAGE(PG8_SB(0, 1), cB + hstep, voffB); PG8_STAGE(PG8_SA(0, 0), cA, voffA); PG8_STAGE(PG8_SA(0, 1), cA + hstep, voffA);
        if (wr == 1) PG8_BAR;
        PG8_WAIT_V(2); PG8_BAR;
        PG8_STAGE(PG8_SB(1, 0), cB + kstep, voffB); PG8_STAGE(PG8_SA(1, 0), cA + kstep, voffA); PG8_STAGE(PG8_SB(1, 1), cB + hstep + kstep, voffB);
        PG8_WAIT_V(6); PG8_BAR;
    } else {
    PG8_STAGE(PG8_SB(0, 0), cB, voffB); PG8_STAGE(PG8_SA(0, 0), cA, voffA); PG8_STAGE(PG8_SB(0, 1), cB + hstep, voffB); PG8_STAGE(PG8_SA(0, 1), cA + hstep, voffA);
    if (wr == 1) PG8_BAR;
    PG8_WAIT_V(4); PG8_BAR;
    PG8_STAGE(PG8_SB(1, 0), cB + kstep, voffB); PG8_STAGE(PG8_SA(1, 0), cA + kstep, voffA); PG8_STAGE(PG8_SB(1, 1), cB + hstep + kstep, voffB);
    PG8_WAIT_V(6); PG8_BAR;
    }
    for (;;) {
        const bool has_next = S.next(ui + 1, nxt);
        const PG8_GAS char* nA = has_next ? (const PG8_GAS char*)g.A + (size_t)nxt.pm * tstep + (size_t)nxt.pk * Kh * 2 : cA; const PG8_GAS char* nB = has_next ? (const PG8_GAS char*)g.Bt + (size_t)nxt.pn * tstep + (size_t)nxt.pk * Kh * 2 : cB;
        for (int t = 0; t < nt; t += 2) {
            const bool last = (t == nt - 2);
            const PG8_GAS char* a1 = cA + (size_t)(t + 1) * kstep;
            const PG8_GAS char* a2 = last ? nA : cA + (size_t)(t + 2) * kstep; const PG8_GAS char* b2 = last ? nB : cB + (size_t)(t + 2) * kstep;
            const PG8_GAS char* a3 = a2 + kstep; const PG8_GAS char* b3 = b2 + kstep;
            if (last && has_next) S.a_ready(nxt);
            if constexpr (SP2) {
            PG8_LDB(B0, 0, 0); PG8_LDB(B1, 0, 1); PG8_SCHED; PG8_LDA(At, 0, 0); PG8_STAGE(PG8_SA(1, 1), a1 + hstep, voffA);
            PG8_WAIT_V(8); PG8_WAIT_L(0); PG8_BAR; PG8_MMA(0, 0, At, B0); PG8_MMA(0, 1, At, B1); PG8_BAR; PG8_SCHED;
            PG8_LDA(At, 0, 1); PG8_STAGE(PG8_SB(0, 0), b2, voffB); PG8_STAGE(PG8_SB(0, 1), b2 + hstep, voffB); PG8_STAGE(PG8_SA(0, 0), a2, voffA);
            PG8_WAIT_V(8); PG8_WAIT_L(0); PG8_BAR; PG8_MMA(1, 0, At, B0); PG8_MMA(1, 1, At, B1); PG8_BAR; PG8_SCHED;
            PG8_LDB(B0, 1, 0); PG8_LDB(B1, 1, 1); PG8_SCHED; PG8_LDA(At, 1, 0); PG8_STAGE(PG8_SA(0, 1), a2 + hstep, voffA);
            PG8_WAIT_V(8); PG8_WAIT_L(0); PG8_BAR; PG8_MMA(0, 0, At, B0); PG8_MMA(0, 1, At, B1); PG8_BAR; PG8_SCHED;
            PG8_LDA(At, 1, 1); PG8_STAGE(PG8_SB(1, 0), b3, voffB); PG8_STAGE(PG8_SB(1, 1), b3 + hstep, voffB); PG8_STAGE(PG8_SA(1, 0), a3, voffA);
            PG8_WAIT_V(8); PG8_WAIT_L(0); PG8_BAR; PG8_MMA(1, 0, At, B0); PG8_MMA(1, 1, At, B1); PG8_BAR; PG8_SCHED;
            } else {
            PG8_LDB(B0, 0, 0); PG8_SCHED; PG8_LDA(At, 0, 0); PG8_STAGE(PG8_SA(1, 1), a1 + hstep, voffA);
            PG8_WAIT_L(8); PG8_BAR; PG8_WAIT_L(0); PG8_MMA(0, 0, At, B0); PG8_BAR; PG8_SCHED;
            PG8_LDB(B1, 0, 1); PG8_STAGE(PG8_SB(0, 0), b2, voffB);
            PG8_BAR; PG8_WAIT_L(0); PG8_MMA(0, 1, At, B1); PG8_BAR;
            PG8_LDA(At, 0, 1); PG8_STAGE(PG8_SA(0, 0), a2, voffA);
            PG8_BAR; PG8_WAIT_L(0); PG8_MMA(1, 0, At, B0); PG8_BAR; PG8_SCHED;
            PG8_STAGE(PG8_SB(0, 1), b2 + hstep, voffB);
            PG8_WAIT_V(6); PG8_BAR; PG8_MMA(1, 1, At, B1); PG8_BAR;
            PG8_LDB(B0, 1, 0); PG8_SCHED; PG8_LDA(At, 1, 0); PG8_STAGE(PG8_SA(0, 1), a2 + hstep, voffA);
            PG8_WAIT_L(8); PG8_BAR; PG8_WAIT_L(0); PG8_MMA(0, 0, At, B0); PG8_BAR; PG8_SCHED;
            PG8_LDB(B1, 1, 1); PG8_STAGE(PG8_SB(1, 0), b3, voffB);
            PG8_BAR; PG8_WAIT_L(0); PG8_MMA(0, 1, At, B1); PG8_BAR;
            PG8_LDA(At, 1, 1); PG8_STAGE(PG8_SA(1, 0), a3, voffA);
            PG8_BAR; PG8_WAIT_L(0); PG8_MMA(1, 0, At, B0); PG8_BAR; PG8_SCHED;
            PG8_STAGE(PG8_SB(1, 1), b3 + hstep, voffB);
            PG8_WAIT_V(6); PG8_BAR; PG8_MMA(1, 1, At, B1); PG8_BAR;
            }
        }
        if constexpr (ALIGN_EPI) { if (wr == 0) PG8_BAR; }
        if constexpr (!Epi::AFTER_DRAIN) { E(acc, cur, wr, wc, fr, fq); S.done(cur); }
        if (!has_next) break;
#pragma unroll
        for (int a = 0; a < 2; ++a)
#pragma unroll
            for (int b = 0; b < 2; ++b)
#pragma unroll
                for (int m = 0; m < 4; ++m)
#pragma unroll
                    for (int n = 0; n < 2; ++n) acc[a][b][m][n] = (f32x4){0.f, 0.f, 0.f, 0.f};
        cur = nxt; cA = nA; cB = nB; ++ui;
        if constexpr (ALIGN_EPI) { if (wr == 1) PG8_BAR; }
    }
    PG8_WAIT_V(0);
    if constexpr (!ALIGN_EPI) { if (wr == 0) PG8_BAR; }
    PG8_BAR;
    if constexpr (Epi::AFTER_DRAIN) { E.fused(acc, cur, wr, wc, fr, fq, lds, wid, lane); S.done(cur); }
#undef PG8_SA
#undef PG8_SB
#undef PG8_STAGE
#undef PG8_LDA
#undef PG8_LDB
#undef PG8_MMA
#undef PG8_WAIT_V
#undef PG8_WAIT_L
#undef PG8_BAR
#undef PG8_SCHED
}
}
namespace fk {
using namespace cfg;
#define LAS __attribute__((address_space(3)))
typedef unsigned short bf16;
typedef short bf16x8 __attribute__((ext_vector_type(8)));
typedef short s16x4 __attribute__((ext_vector_type(4)));
typedef float f32x4 __attribute__((ext_vector_type(4)));
typedef float f32x2 __attribute__((ext_vector_type(2)));
typedef float f32x16 __attribute__((ext_vector_type(16)));
typedef unsigned u32x4 __attribute__((ext_vector_type(4)));
typedef unsigned u32x2 __attribute__((ext_vector_type(2)));
typedef __bf16 bf16x2_t __attribute__((ext_vector_type(2)));
#define DI __device__ __forceinline__
#define GAS __attribute__((address_space(1)))
typedef GAS float gfloat; typedef GAS unsigned short gbf16; typedef GAS unsigned guint; typedef GAS int gint; typedef GAS unsigned char guchar;
#define MFMA32(a, b, c) __builtin_amdgcn_mfma_f32_32x32x16_bf16((a), (b), (c), 0, 0, 0)

DI unsigned pk2(float a, float b) { f32x2 f = {a, b}; bf16x2_t r = __builtin_convertvector(f, bf16x2_t); return __builtin_bit_cast(unsigned, r); }
DI bf16 f2bf(float a) { return (bf16)(pk2(a, 0.f) & 0xffffu); }
DI float bf2f(bf16 v) { return __builtin_bit_cast(float, (unsigned)v << 16); }
DI float bflo(unsigned w) { return __builtin_bit_cast(float, w << 16); }
DI float bfhi(unsigned w) { return __builtin_bit_cast(float, w & 0xffff0000u); }
DI float sigmoid_(float x) { return __builtin_amdgcn_rcpf(1.f + __expf(-x)); }
DI float silu_(float x) { return x * __builtin_amdgcn_rcpf(1.f + __expf(-x)); }
DI float softplus_(float x) { return fmaxf(x, 0.f) + log1pf(expf(-fabsf(x))); }
DI float gelu_tanh_(float x) { const float u = 0.7978845608028654f * (x + 0.044715f * x * x * x); const float e = __expf(2.f * u); return x * (1.f - __builtin_amdgcn_rcpf(e + 1.f)); }
DI int crow(int reg, int h) { return (reg & 3) + 8 * (reg >> 2) + 4 * h; }
DI f32x16 zero16() { f32x16 z; for (int i = 0; i < 16; ++i) z[i] = 0.f; return z; }
DI bf16x8 pack_step(const f32x16& x, int s) {
    u32x4 p; p[0] = pk2(x[8 * s], x[8 * s + 1]); p[1] = pk2(x[8 * s + 2], x[8 * s + 3]); p[2] = pk2(x[8 * s + 4], x[8 * s + 5]); p[3] = pk2(x[8 * s + 6], x[8 * s + 7]);
    return __builtin_bit_cast(bf16x8, p);
}
DI bf16x8 ld_perm_frag(const LAS bf16* rowp, int kbase, int s, int h) {
    const s16x4 lo = *(const LAS s16x4*)(rowp + kbase + 16 * s + 4 * h);
    const s16x4 hi = *(const LAS s16x4*)(rowp + kbase + 16 * s + 8 + 4 * h);
    return __builtin_shufflevector(lo, hi, 0, 1, 2, 3, 4, 5, 6, 7);
}
DI float shx(float v, int o, int lane) { return __builtin_bit_cast(float, __builtin_amdgcn_ds_bpermute((lane ^ o) << 2, __builtin_bit_cast(int, v))); }
DI float wave_sum(float v, int lane) {
#pragma unroll
    for (int o = 1; o < 64; o <<= 1) v += shx(v, o, lane);
    return v;
}

constexpr size_t al256(size_t x) { return (x + 255) / 256 * 256; }
constexpr int RMAX = 36864;
constexpr int NCH = NTOK / 64;
constexpr int NCHD = NCH * 8 * 2;
constexpr size_t WS_CTL = 0, CTL_BYTES = 1u << 20;
constexpr size_t WS_MOD = CTL_BYTES;
constexpr size_t WS_COS = WS_MOD + al256((size_t)DEPTH * 5 * MODW * 4);
constexpr size_t WS_SIN = WS_COS + (size_t)SEQ * 32 * 4;
constexpr size_t WS_WEIN = WS_SIN + (size_t)SEQ * 32 * 4;
constexpr size_t WS_WEOUT = WS_WEIN + (size_t)2 * 2560 * 1024 * 2;
constexpr size_t WS_WEF1 = WS_WEOUT + (size_t)2 * 1024 * 1024 * 2;
constexpr size_t WS_WEF2 = WS_WEF1 + (size_t)2 * 5632 * 1024 * 2;
constexpr size_t WS_WOIN = WS_WEF2 + (size_t)2 * 1024 * 2816 * 2;
constexpr size_t WS_WOOUT = WS_WOIN + (size_t)2 * 4352 * 1024 * 2;
constexpr size_t WS_WXIN = WS_WOOUT + (size_t)2 * 1024 * 1024 * 2;
constexpr size_t WS_WXOUT = WS_WXIN + (size_t)2 * 8 * 7168 * 1024 * 2;
constexpr size_t WS_X = WS_WXOUT + (size_t)2 * 8 * 1024 * 3584 * 2;
constexpr size_t WS_H = WS_X + (size_t)NTOK * D * 4;
constexpr size_t WS_MIX = WS_H + (size_t)NTOK * D * 2;
constexpr size_t WS_P = WS_MIX + (size_t)NTOK * D * 2;
constexpr size_t WS_HS1 = WS_P + (size_t)NTOK * 4352 * 2;
constexpr size_t WS_U = WS_HS1 + (size_t)NTOK * 512 * 4;
constexpr size_t WS_PART = WS_U + (size_t)400 * 1024 * 1024;
constexpr size_t WS_RGA = WS_U;
constexpr size_t WS_RGU = WS_RGA + (size_t)2 * NTOK * 512 * 4;
constexpr size_t WS_QKVN = WS_U;
constexpr size_t WS_WG = WS_QKVN + (size_t)NTOK * 3072 * 2;
constexpr size_t WS_UG = WS_WG + (size_t)NCHD * 64 * 128 * 2;
constexpr size_t WS_QKD = WS_UG + (size_t)NCHD * 64 * 128 * 4;
constexpr size_t WS_SC = WS_QKD + (size_t)NCHD * 64 * 64 * 2;
constexpr size_t WS_KTG = WS_SC + (size_t)NCHD * 192 * 4;
constexpr size_t WS_OG = WS_KTG + (size_t)NCHD * 128 * 64 * 2;
constexpr size_t WS_U_END1 = WS_OG + (size_t)2 * NTOK * D * 4;
constexpr size_t WS_XS = WS_U;
constexpr size_t WS_HIDM = WS_XS + (size_t)RMAX * D * 2;
constexpr size_t WS_Y = WS_HIDM + (size_t)RMAX * FFE * 2;
constexpr size_t WS_YP = WS_Y + (size_t)RMAX * D * 4;
constexpr size_t WS_U_END2 = WS_YP + (size_t)64 * 256 * D * 4;
constexpr size_t WS_TOK = (WS_U_END1 > WS_U_END2 ? WS_U_END1 : WS_U_END2);
constexpr size_t WS_END = WS_TOK + (size_t)NTOK * 32;
constexpr size_t WS_AB = WS_HS1;
constexpr size_t WS_GB = WS_AB + (size_t)NTOK * 32 * 4;

constexpr int CW_BAR = 4096;
constexpr int CW_CNT = 8192;
constexpr int CW_Q = 8448;
constexpr int CW_BC = 16384;

constexpr int LDS_BYTES = 152 * 1024;
constexpr int LDS_MISC = LDS_BYTES - 256;

struct Params { const float* in[31]; float* out; unsigned char* ws; int ph_lo, ph_hi; int dbg0, dbg1; };

DI const gfloat* gin(const Params& p, int k) { return (const gfloat*)p.in[k]; }
struct Ctx {
    LAS unsigned char* lds;
    guchar* ws; guchar* ws0;
    int tid, lane, wave, nblk, blk, wave0;
};
#define XB_TMO      128
#define XB_XCNT(j)  (256  + 64 * (j))
#define XB_XSUB(j)  (1280 + 64 * (j))
#define XB_XGEN(j)  (2304 + 64 * (j))
#define XB_TOP      3328
#define XB_TOPGEN   3392
#define XCD_BAR_WORDS 3456
#define XB_SPIN_CAP (1u << 27)

__device__ __forceinline__ unsigned xb_ld(unsigned* p)              { return __hip_atomic_load(p, __ATOMIC_RELAXED, __HIP_MEMORY_SCOPE_AGENT); }
__device__ __forceinline__ unsigned xb_add(unsigned* p, unsigned v) { (void)v; unsigned one; asm volatile("v_mov_b32 %0, 1" : "=v"(one)); return __hip_atomic_fetch_add(p, one, __ATOMIC_RELAXED, __HIP_MEMORY_SCOPE_AGENT); }
__device__ __forceinline__ unsigned xb_xcc_id() { return (unsigned)__builtin_amdgcn_s_getreg((3 << 11) | 20) & 0xFu; }
#define XB_SPIN(cond, bar) do { unsigned _sp = 0; while (cond) { __builtin_amdgcn_s_sleep(1); \
    if ((++_sp & 255u) == 0u) { if (xb_ld(&(bar)[XB_TMO])) break; if (_sp > XB_SPIN_CAP) { (void)xb_add(&(bar)[XB_TMO], 1u); break; } } } } while (0)

struct XcdBarrier {
    unsigned* bar; unsigned x;
    volatile LAS unsigned* st;
};

__device__ __forceinline__ XcdBarrier xcd_barrier_post(unsigned* bar, volatile LAS unsigned* st) {
    XcdBarrier b; b.bar = bar; b.x = xb_xcc_id(); b.st = st;
    if (threadIdx.x == 0) (void)xb_add(&bar[XB_XCNT(b.x)], 1u);
    return b;
}
__device__ __forceinline__ void xcd_barrier_complete(unsigned* bar, unsigned x, unsigned& nloc, unsigned& nx) {
    const unsigned G = gridDim.x * gridDim.y * gridDim.z;
    unsigned sum, cnt, mine, sp = 0u;
    for (;;) {
        sum = 0u; cnt = 0u; mine = 0u;
#pragma unroll
        for (unsigned j = 0; j < 16; ++j) { const unsigned c = xb_ld(&bar[XB_XCNT(j)]); sum += c; cnt += (c > 0u) ? 1u : 0u; mine = (j == x) ? c : mine; }
        if (sum == G) break;
        __builtin_amdgcn_s_sleep(1);
        if ((++sp & 255u) == 0u) { if (xb_ld(&bar[XB_TMO])) break; if (sp > XB_SPIN_CAP) { (void)xb_add(&bar[XB_TMO], 1u); break; } }
    }
    nloc = mine > 0u ? mine : 1u; nx = cnt > 0u ? cnt : 1u;
}

__device__ __forceinline__ void xcd_barrier(const XcdBarrier& b) {
    asm volatile("s_waitcnt vmcnt(0)" ::: "memory");
    __syncthreads();
    if (threadIdx.x == 0) {
        unsigned* bar = b.bar;
        __builtin_amdgcn_s_waitcnt(0);
        unsigned nloc = b.st[0], nx = b.st[1];
        if (nloc == 0u) { xcd_barrier_complete(bar, b.x, nloc, nx); b.st[0] = nloc; b.st[1] = nx; }
        const unsigned old = xb_add(&bar[XB_XSUB(b.x)], 1u);
        const unsigned gen = old / nloc;
        if (old + 1u == (gen + 1u) * nloc) {
            __builtin_amdgcn_fence(__ATOMIC_RELEASE, "agent");
            asm volatile("s_waitcnt vmcnt(0)" ::: "memory");
            const unsigned og = xb_add(&bar[XB_TOP], 1u);
            const unsigned tg = og / nx;
            if (og + 1u == (tg + 1u) * nx) xb_add(&bar[XB_TOPGEN], 1u);
            else XB_SPIN(xb_ld(&bar[XB_TOPGEN]) == tg, bar);
            __builtin_amdgcn_fence(__ATOMIC_ACQUIRE, "agent");
            xb_add(&bar[XB_XGEN(b.x)], 1u);
            asm volatile("s_waitcnt vmcnt(0)" ::: "memory");
        } else {
            XB_SPIN(xb_ld(&bar[XB_XGEN(b.x)]) == gen, bar);
            __builtin_amdgcn_fence(__ATOMIC_ACQUIRE, "agent");
            asm volatile("s_waitcnt vmcnt(0)" ::: "memory");
        }
    }
    __syncthreads();
}

using pg8::Unit;
typedef pg8::f32x4 af4;

struct EpiEvenIn {
    static constexpr bool PERM = true, AFTER_DRAIN = false;
    gbf16* P; const gfloat* cosT; const gfloat* sinT;
    DI void operator()(const af4 (&acc)[2][2][4][2], const Unit& u, int wr, int wc, int fr, int fq) const {
        const int row0 = u.pm * 256 + wr * 64 + fr, col0 = u.pn * 256 + wc * 32 + 8 * fq;
        const bool rope = (u.pn < 4) && (u.pm < 64);
        const float qs = (u.pn < 2) ? 0.18033688011112042f : 1.f;
#pragma unroll
        for (int ai = 0; ai < 2; ++ai)
#pragma unroll
            for (int m = 0; m < 4; ++m) {
                const int row = row0 + ai * 128 + m * 16;
                gbf16* rowp = P + (size_t)row * EVEN_IN + col0;
#pragma unroll
                for (int bj = 0; bj < 2; ++bj) {
                    af4 v0 = acc[ai][bj][m][0], v1 = acc[ai][bj][m][1];
                    if (rope) {
                        const int t = row & 4095, i0 = ((col0 + bj * 128) & 63) >> 1;
                        const af4 cs = *(const GAS af4*)(cosT + t * 32 + i0), sn = *(const GAS af4*)(sinT + t * 32 + i0);
                        af4 o0, o1;
                        o0[0] = v0[0] * cs[0] - v0[1] * sn[0]; o0[1] = v0[0] * sn[0] + v0[1] * cs[0];
                        o0[2] = v0[2] * cs[1] - v0[3] * sn[1]; o0[3] = v0[2] * sn[1] + v0[3] * cs[1];
                        o1[0] = v1[0] * cs[2] - v1[1] * sn[2]; o1[1] = v1[0] * sn[2] + v1[1] * cs[2];
                        o1[2] = v1[2] * cs[3] - v1[3] * sn[3]; o1[3] = v1[2] * sn[3] + v1[3] * cs[3];
                        v0 = o0; v1 = o1;
                    }
                    v0 = v0 * qs; v1 = v1 * qs;
                    u32x4 w; w[0] = pk2(v0[0], v0[1]); w[1] = pk2(v0[2], v0[3]); w[2] = pk2(v1[0], v1[1]); w[3] = pk2(v1[2], v1[3]);
                    *(GAS u32x4*)(rowp + bj * 128) = w;
                }
            }
    }
};
struct EpiBf16Ab {
    static constexpr bool PERM = true, AFTER_DRAIN = false;
    gbf16* O; int ldc; gfloat* AB; int ab_pn;
    DI void operator()(const af4 (&acc)[2][2][4][2], const Unit& u, int wr, int wc, int fr, int fq) const {
        const int row0 = u.pm * 256 + wr * 64 + fr, col0 = u.pn * 256 + wc * 32 + 8 * fq;
        if (u.pn == ab_pn) {
            if (wc == 0) {
#pragma unroll
                for (int ai = 0; ai < 2; ++ai)
#pragma unroll
                    for (int m = 0; m < 4; ++m) { gfloat* ap = AB + (size_t)(row0 + ai * 128 + m * 16) * 32 + 8 * fq; *(GAS af4*)ap = acc[ai][0][m][0]; *(GAS af4*)(ap + 4) = acc[ai][0][m][1]; }
            }
            return;
        }
#pragma unroll
        for (int ai = 0; ai < 2; ++ai)
#pragma unroll
            for (int m = 0; m < 4; ++m) {
                gbf16* rowp = O + (size_t)(row0 + ai * 128 + m * 16) * ldc + col0;
#pragma unroll
                for (int bj = 0; bj < 2; ++bj) { const af4 v0 = acc[ai][bj][m][0], v1 = acc[ai][bj][m][1];
                    u32x4 w; w[0] = pk2(v0[0], v0[1]); w[1] = pk2(v0[2], v0[3]); w[2] = pk2(v1[0], v1[1]); w[3] = pk2(v1[2], v1[3]);
                    *(GAS u32x4*)(rowp + bj * 128) = w; }
            }
    }
};
struct EpiSwiglu {
    static constexpr bool PERM = true, AFTER_DRAIN = false;
    gbf16* O; int ldc; int nN;
    DI void operator()(const af4 (&acc)[2][2][4][2], const Unit& u, int wr, int wc, int fr, int fq) const {
        const int row0 = u.pm * 256 + wr * 64 + fr, col0 = (u.pn % nN) * 128 + wc * 32 + 8 * fq;
#pragma unroll
        for (int ai = 0; ai < 2; ++ai)
#pragma unroll
            for (int m = 0; m < 4; ++m) {
                const af4 g0 = acc[ai][0][m][0], g1 = acc[ai][0][m][1], u0 = acc[ai][1][m][0], u1 = acc[ai][1][m][1];
                float r[8];
#pragma unroll
                for (int j = 0; j < 4; ++j) { r[j] = silu_(g0[j]) * u0[j]; r[4 + j] = silu_(g1[j]) * u1[j]; }
                u32x4 w; w[0] = pk2(r[0], r[1]); w[1] = pk2(r[2], r[3]); w[2] = pk2(r[4], r[5]); w[3] = pk2(r[6], r[7]);
                *(GAS u32x4*)(O + (size_t)(row0 + ai * 128 + m * 16) * ldc + col0) = w;
            }
    }
};
struct EpiResid {
    static constexpr bool PERM = false, AFTER_DRAIN = false;
    gfloat* X; const gfloat* gate;
    DI void operator()(const af4 (&acc)[2][2][4][2], const Unit& u, int wr, int wc, int fr, int fq) const {
        const int row0 = u.pm * 256 + wr * 64 + fr, col0 = u.pn * 256 + wc * 32 + 4 * fq;
        const gfloat* gv = gate + (size_t)(u.pm < 64 ? (u.pm >> 4) : 4) * MODW + col0;
        af4 g[2][2];
#pragma unroll
        for (int bj = 0; bj < 2; ++bj)
#pragma unroll
            for (int n = 0; n < 2; ++n) g[bj][n] = *(const GAS af4*)(gv + bj * 128 + n * 16);
#pragma unroll
        for (int ai = 0; ai < 2; ++ai)
#pragma unroll
            for (int m = 0; m < 4; ++m) { gfloat* rowp = X + (size_t)(row0 + ai * 128 + m * 16) * D + col0;
#pragma unroll
                for (int bj = 0; bj < 2; ++bj)
#pragma unroll
                    for (int n = 0; n < 2; ++n) { GAS af4* p = (GAS af4*)(rowp + bj * 128 + n * 16); *p = *p + g[bj][n] * acc[ai][bj][m][n]; } }
    }
};
struct EpiPart {
    static constexpr bool PERM = false, AFTER_DRAIN = false;
    gfloat* PART;
    DI void operator()(const af4 (&acc)[2][2][4][2], const Unit& u, int wr, int wc, int fr, int fq) const {
        const int row0 = u.pm * 256 + wr * 64 + fr, col0 = u.pn * 256 + wc * 32 + 4 * fq;
        gfloat* base = PART + (size_t)u.pk * NCTX * D;
#pragma unroll
        for (int ai = 0; ai < 2; ++ai)
#pragma unroll
            for (int m = 0; m < 4; ++m) { gfloat* rowp = base + (size_t)(row0 + ai * 128 + m * 16) * D + col0;
#pragma unroll
                for (int bj = 0; bj < 2; ++bj)
#pragma unroll
                    for (int n = 0; n < 2; ++n) *(GAS af4*)(rowp + bj * 128 + n * 16) = acc[ai][bj][m][n]; }
    }
};
struct EpiF32 {
    static constexpr bool PERM = false, AFTER_DRAIN = false;
    gfloat* C; int ldc; int nN;
    DI void operator()(const af4 (&acc)[2][2][4][2], const Unit& u, int wr, int wc, int fr, int fq) const {
        const int row0 = u.pm * 256 + wr * 64 + fr, col0 = (u.pn % nN) * 256 + wc * 32 + 4 * fq;
#pragma unroll
        for (int ai = 0; ai < 2; ++ai)
#pragma unroll
            for (int m = 0; m < 4; ++m) { gfloat* rowp = C + (size_t)(row0 + ai * 128 + m * 16) * ldc + col0;
#pragma unroll
                for (int bj = 0; bj < 2; ++bj)
#pragma unroll
                    for (int n = 0; n < 2; ++n) *(GAS af4*)(rowp + bj * 128 + n * 16) = acc[ai][bj][m][n]; }
    }
};
struct MoeOrder : pg8::StaticOrder {
    int tend[8];
    __device__ void initm(const guint* cnt, int nN_, int G_, int c_) {
        int acc = 0;
#pragma unroll
        for (int e = 0; e < 8; ++e) { acc += ((int)cnt[e] + 255) >> 8; tend[e] = acc; }
        nM = acc; nN = nN_; nwg = nM * nN; G = G_; c = c_; lim = nwg; L0 = 0; s = 1;
    }
    __device__ bool next(int i, Unit& u) const {
        if (!pg8::StaticOrder::next(i, u)) return false;
        int e = 0;
#pragma unroll
        for (int k = 0; k < 7; ++k) e += (u.pm >= tend[k]) ? 1 : 0;
        u.pn += e * nN; return true;
    }
};

struct MoeOrder2 {
    int tend[8]; int nM, nwg, G, c, Lmain, r, s, tail;
    __device__ __forceinline__ void initm(const guint* cnt, int G_, int c_, int tail_) {
        int acc = 0;
#pragma unroll
        for (int e = 0; e < 8; ++e) { acc += ((int)cnt[e] + 255) >> 8; tend[e] = acc; }
        nM = acc; nwg = nM * 4; G = G_; c = c_; tail = tail_; Lmain = (nwg / G) * G; r = nwg - Lmain;
        s = 1; if (r > 0) { const int q = G / r; s = q >= 14 ? 14 : (q >= 7 ? 7 : (q >= 4 ? 4 : (q >= 2 ? 2 : 1))); }
    }
    __device__ __forceinline__ int tail_row0() const { return (Lmain >> 2) * 256; }
    __device__ __forceinline__ bool next(int i, Unit& u) const {
        const int j = i * G + c; int Lp;
        if (!tail) { if (j >= Lmain) return false; Lp = (j & 7) * (Lmain >> 3) + (j >> 3); u.pk = 0; }
        else { if (j >= r * s) return false; Lp = Lmain + j / s; u.pk = j % s; }
        u.pm = Lp >> 2; int e = 0;
#pragma unroll
        for (int k = 0; k < 7; ++k) e += (u.pm >= tend[k]) ? 1 : 0;
        u.pn = e * 4 + (Lp & 3); return true;
    }
    __device__ __forceinline__ void a_ready(const Unit&) const {}
    __device__ __forceinline__ void done(const Unit&) const {}
};
struct EpiPartY {
    static constexpr bool PERM = false, AFTER_DRAIN = false;
    gfloat* YP; int pm0, tail_rows;
    DI void operator()(const af4 (&acc)[2][2][4][2], const Unit& u, int wr, int wc, int fr, int fq) const {
        const int row0 = (u.pm - pm0) * 256 + wr * 64 + fr, col0 = (u.pn & 3) * 256 + wc * 32 + 4 * fq;
        gfloat* base = YP + (size_t)u.pk * tail_rows * D;
#pragma unroll
        for (int ai = 0; ai < 2; ++ai)
#pragma unroll
            for (int m = 0; m < 4; ++m) { gfloat* rowp = base + (size_t)(row0 + ai * 128 + m * 16) * D + col0;
#pragma unroll
                for (int bj = 0; bj < 2; ++bj)
#pragma unroll
                    for (int n = 0; n < 2; ++n) *(GAS af4*)(rowp + bj * 128 + n * 16) = acc[ai][bj][m][n]; }
    }
};
DI void transpose_load(f32x4 (&v)[8], const gfloat* W, int ldw, int k0, int n0, int lane) {
#pragma unroll
    for (int i = 0; i < 8; ++i) v[i] = *(const GAS f32x4*)(W + (size_t)(k0 + 8 * i + (lane >> 3)) * ldw + n0 + 4 * (lane & 7));
}
DI void transpose_store(const f32x4 (&v)[8], int K, gbf16* WT, int k0, int drow0, LAS float* scr, int lane) {
#pragma unroll
    for (int i = 0; i < 8; ++i) { LAS float* d = scr + (8 * i + (lane >> 3)) * 33 + 4 * (lane & 7); d[0] = v[i][0]; d[1] = v[i][1]; d[2] = v[i][2]; d[3] = v[i][3]; }
    asm volatile("s_waitcnt lgkmcnt(0)" ::: "memory");
    const int c = lane & 7;
#pragma unroll
    for (int j = 0; j < 4; ++j) { const int n = (lane >> 3) + 8 * j; const LAS float* s = scr + (8 * c) * 33 + n;
        u32x4 o; o[0] = pk2(s[0 * 33], s[1 * 33]); o[1] = pk2(s[2 * 33], s[3 * 33]); o[2] = pk2(s[4 * 33], s[5 * 33]); o[3] = pk2(s[6 * 33], s[7 * 33]);
        *(GAS u32x4*)(WT + (size_t)(drow0 + n) * K + k0 + 8 * c) = o; }
    asm volatile("s_waitcnt lgkmcnt(0)" ::: "memory");
}
struct TJob { const gfloat* W; gbf16* WT; int ldw, K, N, F; };
DI int tjob_items(const TJob& j) { return (j.K / 64) * (j.N / 32); }
DI TJob get_tjob(const Params& p, int j) {
    const int i = j / 22, r = j % 22; unsigned char* ws = p.ws; TJob t;
    if (r == 0) t = TJob{gin(p, 9) + (size_t)i * D * EVEN_IN, (gbf16*)(ws + WS_WEIN) + (size_t)i * 2560 * 1024, EVEN_IN, D, EVEN_IN, 0};
    else if (r == 1) t = TJob{gin(p, 10) + (size_t)i * D * D, (gbf16*)(ws + WS_WEOUT) + (size_t)i * 1024 * 1024, D, D, D, 0};
    else if (r == 2) t = TJob{gin(p, 20) + (size_t)i * D * 2 * FFN, (gbf16*)(ws + WS_WEF1) + (size_t)i * 5632 * 1024, 2 * FFN, D, 2 * FFN, FFN};
    else if (r == 3) t = TJob{gin(p, 21) + (size_t)i * FFN * D, (gbf16*)(ws + WS_WEF2) + (size_t)i * 1024 * 2816, D, FFN, D, 0};
    else if (r == 4) t = TJob{gin(p, 22) + (size_t)i * D * ODD_IN, (gbf16*)(ws + WS_WOIN) + (size_t)i * 4352 * 1024, ODD_IN, D, ODD_IN, 0};
    else if (r == 5) t = TJob{gin(p, 27) + (size_t)i * D * D, (gbf16*)(ws + WS_WOOUT) + (size_t)i * 1024 * 1024, D, D, D, 0};
    else if (r < 14) { const int e = r - 6; t = TJob{gin(p, 29) + ((size_t)i * 8 + e) * D * 2 * FFE, (gbf16*)(ws + WS_WXIN) + ((size_t)i * 8 + e) * 7168 * 1024, 2 * FFE, D, 2 * FFE, FFE}; }
    else { const int e = r - 14; t = TJob{gin(p, 30) + ((size_t)i * 8 + e) * FFE * D, (gbf16*)(ws + WS_WXOUT) + ((size_t)i * 8 + e) * 1024 * 3584, D, FFE, D, 0}; }
    return t;
}
#ifndef CONV_DEFER
#define CONV_DEFER 1
#endif
DI void convert_weights(const Ctx& C, const Params& p, int group, int gw, int NGW) {
    LAS float* scr = (LAS float*)(C.lds + 32768 + C.wave * 8704);
    int jstart = 0;
    for (int j = 0; j < 44; ++j) {
        const int gj = j < 6 ? 0 : (j < 28 ? 1 : 2);
        if (gj != group) continue;
        const TJob t = get_tjob(p, j); const int ni = tjob_items(t), nblkN = t.N / 32;
        const int first = (gw - jstart % NGW + NGW) % NGW;
        auto item_geom = [&](int it, int& k0, int& n0, int& drow0) { const int kb = it / nblkN, nb = it % nblkN; k0 = kb * 64; n0 = nb * 32; drow0 = n0;
            if (t.F > 0) drow0 = (n0 < t.F) ? ((n0 / 128) * 256 + (n0 % 128)) : (((n0 - t.F) / 128) * 256 + 128 + ((n0 - t.F) % 128)); };
        f32x4 va[8], vb[8], vc[8]; int k0 = 0, n0 = 0, d0 = 0, k1 = 0, n1 = 0, d1 = 0;
        if (first < ni) { item_geom(first, k0, n0, d0); transpose_load(va, t.W, t.ldw, k0, n0, C.lane); }
        if (first + NGW < ni) { item_geom(first + NGW, k1, n1, d1); transpose_load(vb, t.W, t.ldw, k1, n1, C.lane); }
        for (int it = first; it < ni; it += NGW) {
            const int nx = it + 2 * NGW; int k2 = 0, n2 = 0, d2 = 0;
            if (nx < ni) { item_geom(nx, k2, n2, d2); transpose_load(vc, t.W, t.ldw, k2, n2, C.lane); }
            transpose_store(va, t.K, t.WT, k0, d0, scr, C.lane);
#pragma unroll
            for (int q = 0; q < 8; ++q) { va[q] = vb[q]; vb[q] = vc[q]; }
            k0 = k1; n0 = n1; d0 = d1; k1 = k2; n1 = n2; d1 = d2;
        }
        jstart += ni;
    }
}
DI void ph_prologue(const Ctx& C, const Params& p) {
    LAS float* sil = (LAS float*)(C.lds);
    for (int i = C.tid; i < 5 * 1024; i += 512) { const int v = i >> 10, k = i & 1023; const float x = v < 4 ? gin(p, 1)[v * 1024 + k] : gin(p, 3)[k]; sil[i] = x / (1.f + expf(-x)); }
    __syncthreads();
    const int gw = C.blk * 8 + C.wave, NGW = C.nblk * 8;
    gfloat* MOD = (gfloat*)(C.ws + WS_MOD);
    for (int it = gw; it < DEPTH * (MODW / 64); it += NGW) {
        const int l = it / (MODW / 64), n = (it % (MODW / 64)) * 64 + C.lane;
        const gfloat* w = gin(p, 4) + (size_t)l * 1024 * MODW + n;
        float a0 = 0.f, a1 = 0.f, a2 = 0.f, a3 = 0.f, a4 = 0.f;
#pragma unroll 8
        for (int k = 0; k < 1024; ++k) { const float wv = w[(size_t)k * MODW]; a0 += sil[k] * wv; a1 += sil[1024 + k] * wv; a2 += sil[2048 + k] * wv; a3 += sil[3072 + k] * wv; a4 += sil[4096 + k] * wv; }
        const float bb = gin(p, 5)[l * MODW + n];
        MOD[(size_t)(l * 5 + 0) * MODW + n] = a0 + bb; MOD[(size_t)(l * 5 + 1) * MODW + n] = a1 + bb; MOD[(size_t)(l * 5 + 2) * MODW + n] = a2 + bb;
        MOD[(size_t)(l * 5 + 3) * MODW + n] = a3 + bb; MOD[(size_t)(l * 5 + 4) * MODW + n] = a4 + bb;
    }
    { gfloat* cosT = (gfloat*)(C.ws + WS_COS); gfloat* sinT = (gfloat*)(C.ws + WS_SIN);
      for (int idx = C.blk * 512 + C.tid; idx < SEQ * 32; idx += C.nblk * 512) { const int t = idx >> 5, i = idx & 31;
          const float invf = powf(10000.f, -(float)(i & 15) / 16.f); const float ang = (i < 16 ? (float)(t >> 6) : (float)(t & 63)) * invf;
          cosT[idx] = cosf(ang); sinT[idx] = sinf(ang); } }
    { for (int i = 0; i < 2; ++i) { GAS u32x4* z = (GAS u32x4*)((gbf16*)(C.ws + WS_WOIN) + (size_t)i * 4352 * 1024 + (size_t)4128 * 1024);
          for (int idx = C.blk * 512 + C.tid; idx < 224 * 1024 / 8; idx += C.nblk * 512) z[idx] = (u32x4){0u, 0u, 0u, 0u}; } }
    convert_weights(C, p, 0, gw, NGW);
#if CONV_DEFER == 0
    convert_weights(C, p, 1, gw, NGW); convert_weights(C, p, 2, gw, NGW);
#endif
}

DI void normmod_regs(f32x4 (&v)[4], const gfloat* g, const gfloat* shift, const gfloat* scale, int lane) {
    float ss = 0.f;
#pragma unroll
    for (int j = 0; j < 4; ++j) ss += (v[j][0] * v[j][0] + v[j][1] * v[j][1]) + (v[j][2] * v[j][2] + v[j][3] * v[j][3]);
    const float rs = rsqrtf(wave_sum(ss, lane) * (1.f / D) + 1e-6f);
#pragma unroll
    for (int j = 0; j < 4; ++j) { const f32x4 gg = ((const GAS f32x4*)g)[lane + 64 * j], sh = ((const GAS f32x4*)shift)[lane + 64 * j], sc = ((const GAS f32x4*)scale)[lane + 64 * j];
        v[j] = v[j] * rs * gg * (sc + 1.f) + sh; }
}
DI void store_row_bf16(gbf16* orow, const f32x4 (&v)[4], int lane) {
#pragma unroll
    for (int j = 0; j < 4; ++j) { u32x2 w; w[0] = pk2(v[j][0], v[j][1]); w[1] = pk2(v[j][2], v[j][3]); ((GAS u32x2*)orow)[lane + 64 * j] = w; }
}
DI void add_ctx_partials(const Ctx& C, f32x4 (&v)[4], int r, int npart, const gfloat* gate_ctx, gfloat* Xrow) {
    const gfloat* PART = (const gfloat*)(C.ws + WS_PART) + (size_t)(r - NLAT) * D;
#pragma unroll
    for (int j = 0; j < 4; ++j) { f32x4 a = (f32x4){0.f, 0.f, 0.f, 0.f};
        for (int pk = 0; pk < npart; ++pk) a = a + ((const GAS f32x4*)(PART + (size_t)pk * NCTX * D))[C.lane + 64 * j];
        v[j] = v[j] + ((const GAS f32x4*)gate_ctx)[C.lane + 64 * j] * a; ((GAS f32x4*)Xrow)[C.lane + 64 * j] = v[j]; }
}
DI void ph_normmod(const Ctx& C, const Params& p, int layer, bool second, bool from_input, int npart, int gate_off) {
    const int gw = C.blk * 8 + C.wave, NGW = C.nblk * 8;
    gfloat* X = (gfloat*)(C.ws + WS_X); gbf16* H = (gbf16*)(C.ws + WS_H);
    const gfloat* MODl = (const gfloat*)(C.ws + WS_MOD) + (size_t)layer * 5 * MODW;
    const gfloat* g = (second ? gin(p, 7) : gin(p, 6)) + layer * D;
    auto srcrow = [&](int r) { return from_input ? (r < NLAT ? gin(p, 0) + (size_t)r * D : gin(p, 2) + (size_t)(r - NLAT) * D) : (const gfloat*)X + (size_t)r * D; };
    f32x4 v[4], vn[4];
    if (gw < NTOK) { const gfloat* src = srcrow(gw);
#pragma unroll
        for (int j = 0; j < 4; ++j) v[j] = ((const GAS f32x4*)src)[C.lane + 64 * j]; }
    for (int r = gw; r < NTOK; r += NGW) {
        const int rn = r + NGW;
        if (rn < NTOK) { const gfloat* src = srcrow(rn);
#pragma unroll
            for (int j = 0; j < 4; ++j) vn[j] = ((const GAS f32x4*)src)[C.lane + 64 * j]; }
        if (from_input) {
#pragma unroll
            for (int j = 0; j < 4; ++j) ((GAS f32x4*)(X + (size_t)r * D))[C.lane + 64 * j] = v[j]; }
        if (npart > 0 && r >= NLAT) add_ctx_partials(C, v, r, npart, (const gfloat*)(C.ws + WS_MOD) + gate_off + 4 * MODW, X + (size_t)r * D);
        const gfloat* mv = MODl + (size_t)(r < NLAT ? (r >> 12) : 4) * MODW + (second ? 3 * D : 0);
        normmod_regs(v, g, mv, mv + D, C.lane);
        store_row_bf16(H + (size_t)r * D, v, C.lane);
#pragma unroll
        for (int j = 0; j < 4; ++j) v[j] = vn[j];
    }
}

DI void seq_bounds(int r, int& s0, int& s1) { if (r < NLAT) { s0 = r & ~4095; s1 = s0 + 4096; } else { s0 = NLAT + ((r - NLAT) & ~255); s1 = s0 + 256; } }

DI void ph_odd_conv(const Ctx& C, const Params& p, int i) {
    const int gw = C.blk * 8 + C.wave, NGW = C.nblk * 8;
    const gbf16* PO = (const gbf16*)(C.ws + WS_P); gbf16* QKVN = (gbf16*)(C.ws + WS_QKVN);
    const gfloat* AB = (const gfloat*)(C.ws + WS_AB); gfloat* Gd = (gfloat*)(C.ws + WS_GB); gfloat* Bd = Gd + (size_t)2 * NTOK * 8;
    const gfloat* cw = gin(p, 23) + (size_t)i * 4 * 3072;
    for (int u = gw; u < NCH * 6; u += NGW) {
        const int strip = u / 6, cgp = u % 6, r0 = strip * 64, c = cgp * 512 + 8 * C.lane;
        int s0, s1; seq_bounds(r0, s0, s1);
        float w[4][8];
#pragma unroll
        for (int tp = 0; tp < 4; ++tp) { const f32x4 w0 = *(const GAS f32x4*)(cw + tp * 3072 + c), w1 = *(const GAS f32x4*)(cw + tp * 3072 + c + 4);
#pragma unroll
            for (int e = 0; e < 4; ++e) { w[tp][e] = w0[e]; w[tp][4 + e] = w1[e]; } }
        u32x4 win[4];
        const u32x4 zz = (u32x4){0u, 0u, 0u, 0u};
        win[1] = (r0 - 2 >= s0) ? *(const GAS u32x4*)(PO + (size_t)(r0 - 2) * 4352 + c) : zz;
        win[2] = (r0 - 1 >= s0) ? *(const GAS u32x4*)(PO + (size_t)(r0 - 1) * 4352 + c) : zz;
        win[3] = *(const GAS u32x4*)(PO + (size_t)r0 * 4352 + c);
#pragma unroll 4
        for (int rr = 0; rr < 64; ++rr) {
            const int r = r0 + rr;
            win[0] = win[1]; win[1] = win[2]; win[2] = win[3];
            win[3] = (r + 1 < s1) ? *(const GAS u32x4*)(PO + (size_t)(r + 1) * 4352 + c) : zz;
            float a[8] = {0.f, 0.f, 0.f, 0.f, 0.f, 0.f, 0.f, 0.f};
#pragma unroll
            for (int tp = 0; tp < 4; ++tp) { const u32x4 x = win[tp];
                a[0] += w[tp][0] * bflo(x[0]); a[1] += w[tp][1] * bfhi(x[0]); a[2] += w[tp][2] * bflo(x[1]); a[3] += w[tp][3] * bfhi(x[1]);
                a[4] += w[tp][4] * bflo(x[2]); a[5] += w[tp][5] * bfhi(x[2]); a[6] += w[tp][6] * bflo(x[3]); a[7] += w[tp][7] * bfhi(x[3]); }
            float ss = 0.f;
#pragma unroll
            for (int e = 0; e < 8; ++e) { a[e] = silu_(a[e]); ss += a[e] * a[e]; }
            if (cgp < 4) {
                ss += shx(ss, 1, C.lane); ss += shx(ss, 2, C.lane); ss += shx(ss, 4, C.lane); ss += shx(ss, 8, C.lane);
                const float rn = rsqrtf(ss + 1e-6f);
#pragma unroll
                for (int e = 0; e < 8; ++e) a[e] *= rn;
            }
            u32x4 o; o[0] = pk2(a[0], a[1]); o[1] = pk2(a[2], a[3]); o[2] = pk2(a[4], a[5]); o[3] = pk2(a[6], a[7]);
            *(GAS u32x4*)(QKVN + (size_t)r * 3072 + c) = o;
        }
    }
    for (int r = gw * 4 + (C.lane >> 4); r < NTOK; r += NGW * 4) { const int l16 = C.lane & 15, d = l16 >> 3, h = l16 & 7;
        const float x0 = AB[(size_t)r * 32 + d * 16 + h], x1 = AB[(size_t)r * 32 + d * 16 + 8 + h];
        Gd[((size_t)d * NTOK + r) * 8 + h] = -expf(gin(p, 24)[i * 16 + d * 8 + h]) * softplus_(x0 + gin(p, 25)[i * 16 + d * 8 + h]);
        Bd[((size_t)d * NTOK + r) * 8 + h] = 1.f / (1.f + expf(-x1)); }
}
DI void ph_gdn_out(const Ctx& C, const Params& p, int i) {
    const int gw = C.blk * 8 + C.wave, NGW = C.nblk * 8;
    const gfloat* OG = (const gfloat*)(C.ws + WS_OG); const gbf16* PO = (const gbf16*)(C.ws + WS_P); gbf16* MIX = (gbf16*)(C.ws + WS_MIX);
    const f32x4 go = ((const GAS f32x4*)(gin(p, 26) + i * 128))[C.lane & 31];
    f32x4 ca[4], cb[4], na[4], nb[4]; u32x2 cz[4], nz[4];
#define GO_LOAD(r_, A_, B_, Z_) do { _Pragma("unroll") for (int j = 0; j < 4; ++j) { A_[j] = ((const GAS f32x4*)(OG + (size_t)(r_) * D))[C.lane + 64 * j]; B_[j] = ((const GAS f32x4*)(OG + ((size_t)NTOK + (r_)) * D))[C.lane + 64 * j]; \
        Z_[j] = *(const GAS u32x2*)(PO + (size_t)(r_) * 4352 + 3072 + 4 * C.lane + 256 * j); } } while (0)
    if (gw < NTOK) GO_LOAD(gw, ca, cb, cz);
    for (int r = gw; r < NTOK; r += NGW) {
        const int rn = r + NGW;
        if (rn < NTOK) GO_LOAD(rn, na, nb, nz);
#pragma unroll
        for (int j = 0; j < 4; ++j) {
            f32x4 o = ca[j] + cb[j];
            float ss = (o[0] * o[0] + o[1] * o[1]) + (o[2] * o[2] + o[3] * o[3]);
            ss += shx(ss, 1, C.lane); ss += shx(ss, 2, C.lane); ss += shx(ss, 4, C.lane); ss += shx(ss, 8, C.lane); ss += shx(ss, 16, C.lane);
            const float rs = rsqrtf(ss * (1.f / 128.f) + 1e-6f);
            const u32x2 z = cz[j];
            o[0] *= rs * go[0] * silu_(bflo(z[0])); o[1] *= rs * go[1] * silu_(bfhi(z[0])); o[2] *= rs * go[2] * silu_(bflo(z[1])); o[3] *= rs * go[3] * silu_(bfhi(z[1]));
            u32x2 w; w[0] = pk2(o[0], o[1]); w[1] = pk2(o[2], o[3]);
            ((GAS u32x2*)(MIX + (size_t)r * D))[C.lane + 64 * j] = w;
        }
#pragma unroll
        for (int j = 0; j < 4; ++j) { ca[j] = na[j]; cb[j] = nb[j]; cz[j] = nz[j]; }
    }
#undef GO_LOAD
}
struct TokInfo { int e0, p0, e1, p1; float w0, w1; int r0, r1; };
DI void ti_store(GAS TokInfo* q, const TokInfo& t) { u32x4 a, b; a[0] = (unsigned)t.e0; a[1] = (unsigned)t.p0; a[2] = (unsigned)t.e1; a[3] = (unsigned)t.p1; b[0] = __float_as_uint(t.w0); b[1] = __float_as_uint(t.w1); b[2] = (unsigned)t.r0; b[3] = (unsigned)t.r1;
    ((GAS u32x4*)q)[0] = a; ((GAS u32x4*)q)[1] = b; }
DI TokInfo ti_load(const GAS TokInfo* q) { const u32x4 a = ((const GAS u32x4*)q)[0], b = ((const GAS u32x4*)q)[1]; TokInfo t; t.e0 = (int)a[0]; t.p0 = (int)a[1]; t.e1 = (int)a[2]; t.p1 = (int)a[3]; t.w0 = __uint_as_float(b[0]); t.w1 = __uint_as_float(b[1]); t.r0 = (int)b[2]; t.r1 = (int)b[3]; return t; }
DI void ph_router(const Ctx& C, const Params& p, int layer, int ntok, int npart) {
    const int gw = C.blk * 8 + C.wave, NGW = C.nblk * 8, i = layer >> 1;
    gfloat* X = (gfloat*)(C.ws + WS_X); gbf16* H = (gbf16*)(C.ws + WS_H);
    const gfloat* MODl = (const gfloat*)(C.ws + WS_MOD) + (size_t)layer * 5 * MODW;
    const gfloat* g = gin(p, 7) + layer * D; const gfloat* wr = gin(p, 28) + (size_t)i * D * 8;
    guint* bc = (guint*)(C.ws + WS_CTL) + CW_BC + (i * 1024 + C.blk) * 8; GAS TokInfo* TI = (GAS TokInfo*)(C.ws + WS_TOK);
    LAS int* sl = (LAS int*)(C.lds + 64);
    for (int q = C.tid; q < 96 * 6; q += 512) sl[q] = -1;
    __syncthreads();
    int k = 0;
    for (int r = gw; r < NTOK; r += NGW, ++k) {
        f32x4 v[4];
#pragma unroll
        for (int j = 0; j < 4; ++j) v[j] = ((const GAS f32x4*)(X + (size_t)r * D))[C.lane + 64 * j];
        if (npart > 0 && r >= NLAT) add_ctx_partials(C, v, r, npart, MODl + 4 * MODW + 2 * D, X + (size_t)r * D);
        const gfloat* mv = MODl + (size_t)(r < NLAT ? (r >> 12) : 4) * MODW + 3 * D;
        normmod_regs(v, g, mv, mv + D, C.lane);
        store_row_bf16(H + (size_t)r * D, v, C.lane);
        if (r >= ntok) continue;
        float lg[8] = {0.f, 0.f, 0.f, 0.f, 0.f, 0.f, 0.f, 0.f};
#pragma unroll
        for (int j = 0; j < 4; ++j)
#pragma unroll
            for (int q = 0; q < 4; ++q) { const int kk = 4 * C.lane + 256 * j + q; const f32x4 w0 = *(const GAS f32x4*)(wr + kk * 8), w1 = *(const GAS f32x4*)(wr + kk * 8 + 4); const float x = v[j][q];
                lg[0] += x * w0[0]; lg[1] += x * w0[1]; lg[2] += x * w0[2]; lg[3] += x * w0[3]; lg[4] += x * w1[0]; lg[5] += x * w1[1]; lg[6] += x * w1[2]; lg[7] += x * w1[3]; }
#pragma unroll
        for (int e = 0; e < 8; ++e) lg[e] = wave_sum(lg[e], C.lane);
        if (C.lane == 0) {
            int e0 = 0; float b0 = lg[0];
#pragma unroll
            for (int e = 1; e < 8; ++e) if (lg[e] > b0) { e0 = e; b0 = lg[e]; }
            int e1 = -1; float b1 = -INFINITY;
#pragma unroll
            for (int e = 0; e < 8; ++e) if (e != e0 && lg[e] > b1) { e1 = e; b1 = lg[e]; }
            const float w1 = 1.f / (1.f + expf(b0 - b1)), w0 = 1.f - w1;
            LAS int* s = sl + (k * 8 + C.wave) * 6;
            s[0] = e0; s[1] = e1; s[2] = __float_as_int(w0); s[3] = __float_as_int(w1);
        }
    }
    __syncthreads();
    if (C.tid < 192) { const int q = C.tid, sq = q >> 1, wq = q & 1, e = sl[sq * 6 + wq]; int rk = 0;
        if (e >= 0) {
#pragma clang loop vectorize(disable) unroll(disable)
            for (int q2 = 0; q2 < q; ++q2) rk += (sl[(q2 >> 1) * 6 + (q2 & 1)] == e) ? 1 : 0; sl[sq * 6 + 4 + wq] = rk; } }
    if (C.tid < 8) { int c8 = 0;
#pragma clang loop vectorize(disable) unroll(disable)
        for (int q2 = 0; q2 < 192; ++q2) c8 += (sl[(q2 >> 1) * 6 + (q2 & 1)] == C.tid) ? 1 : 0; bc[C.tid] = (unsigned)c8; }
    __syncthreads();
    if (C.lane == 0) { int k2 = 0;
        for (int r = gw; r < ntok; r += NGW, ++k2) { const LAS int* s = sl + (k2 * 8 + C.wave) * 6;
            TokInfo t; t.e0 = s[0]; t.e1 = s[1]; t.p0 = s[4]; t.p1 = s[5]; t.w0 = __int_as_float(s[2]); t.w1 = __int_as_float(s[3]); t.r0 = 0; t.r1 = 0;
            ti_store(TI + r, t); } }
    __syncthreads();
}
DI void ph_gather(const Ctx& C, int layer, int ntok) {
    const int gw = C.blk * 8 + C.wave, NGW = C.nblk * 8, i = layer >> 1;
    GAS TokInfo* TI = (GAS TokInfo*)(C.ws + WS_TOK);
    const gbf16* H = (const gbf16*)(C.ws + WS_H); gbf16* XS = (gbf16*)(C.ws + WS_XS);
    LAS int* red = (LAS int*)C.lds;
    if (C.tid < 16) red[C.tid] = 0;
    __syncthreads();
    { const guint* bcb = (const guint*)(C.ws + WS_CTL) + CW_BC + (size_t)i * 1024 * 8; int tot[8] = {0, 0, 0, 0, 0, 0, 0, 0}, pre[8] = {0, 0, 0, 0, 0, 0, 0, 0};
#pragma clang loop vectorize(disable) unroll(disable)
      for (int t = C.tid; t < C.nblk; t += 512) { const u32x4 a = *(const GAS u32x4*)(bcb + t * 8), b2 = *(const GAS u32x4*)(bcb + t * 8 + 4);
#pragma unroll
          for (int e = 0; e < 4; ++e) { tot[e] += (int)a[e]; tot[4 + e] += (int)b2[e]; if (t < C.blk) { pre[e] += (int)a[e]; pre[4 + e] += (int)b2[e]; } } }
#pragma unroll
      for (int e = 0; e < 8; ++e) { const int ts = (int)wave_sum((float)tot[e], C.lane), ps = (int)wave_sum((float)pre[e], C.lane);
          if (C.lane == 0) { (void)__hip_atomic_fetch_add(red + e, ts, __ATOMIC_RELAXED, __HIP_MEMORY_SCOPE_WORKGROUP); (void)__hip_atomic_fetch_add(red + 8 + e, ps, __ATOMIC_RELAXED, __HIP_MEMORY_SCOPE_WORKGROUP); } } }
    __syncthreads();
    int base[8], cn[8], pref[8]; { int acc = 0;
#pragma unroll
        for (int e = 0; e < 8; ++e) { cn[e] = red[e]; pref[e] = red[8 + e]; base[e] = acc * 256 + pref[e]; acc += (cn[e] + 255) >> 8; } }
    if (C.blk == 0 && C.tid < 8) ((guint*)(C.ws + WS_CTL) + CW_CNT + i * 64)[C.tid] = (unsigned)red[C.tid];
    for (int r = gw; r < ntok; r += NGW) {
        const TokInfo t = ti_load(TI + r);
        int b0 = 0, b1 = 0;
#pragma unroll
        for (int e = 0; e < 8; ++e) { b0 = (t.e0 == e) ? base[e] : b0; b1 = (t.e1 == e) ? base[e] : b1; }
        const int r0 = b0 + t.p0, r1 = b1 + t.p1;
        const u32x4 a = ((const GAS u32x4*)(H + (size_t)r * D))[C.lane], b = ((const GAS u32x4*)(H + (size_t)r * D))[C.lane + 64];
        ((GAS u32x4*)(XS + (size_t)r0 * D))[C.lane] = a; ((GAS u32x4*)(XS + (size_t)r0 * D))[C.lane + 64] = b;
        ((GAS u32x4*)(XS + (size_t)r1 * D))[C.lane] = a; ((GAS u32x4*)(XS + (size_t)r1 * D))[C.lane + 64] = b;
        if (C.lane == 0) { ((GAS int*)(TI + r))[6] = r0; ((GAS int*)(TI + r))[7] = r1; }
    }
    for (int pr = gw; pr < 8 * 256; pr += NGW) {
        const int e = pr >> 8, j = pr & 255; int be = 0, ce = 0;
#pragma unroll
        for (int k = 0; k < 8; ++k) { be = (e == k) ? base[k] - pref[k] : be; ce = (e == k) ? cn[k] : ce; }
        const int lim = ((ce + 255) >> 8) << 8;
        if (ce + j < lim) { GAS u32x4* z = (GAS u32x4*)(XS + (size_t)(be + ce + j) * D); z[C.lane] = (u32x4){0u, 0u, 0u, 0u}; z[C.lane + 64] = (u32x4){0u, 0u, 0u, 0u}; }
    }
}
DI void ph_combine(const Ctx& C, const Params& p, int layer, int ntok, const guint* cnt) {
    int nM_ = 0;
#pragma unroll
    for (int e = 0; e < 8; ++e) nM_ += ((int)cnt[e] + 255) >> 8;
    const int nwg_ = nM_ * 4, Lm_ = (nwg_ / C.nblk) * C.nblk, r_ = nwg_ - Lm_; int ts = 1;
    if (r_ > 0) { const int q = C.nblk / r_; ts = q >= 14 ? 14 : (q >= 7 ? 7 : (q >= 4 ? 4 : (q >= 2 ? 2 : 1))); }
    const int trow0 = (Lm_ >> 2) * 256, trows = (r_ >> 2) * 256; const gfloat* YP = (const gfloat*)(C.ws + WS_YP);
    const int gw = C.blk * 8 + C.wave, NGW = C.nblk * 8;
    gfloat* X = (gfloat*)(C.ws + WS_X); gbf16* H = (gbf16*)(C.ws + WS_H); const gfloat* Y = (const gfloat*)(C.ws + WS_Y); const GAS TokInfo* TI = (const GAS TokInfo*)(C.ws + WS_TOK);
    const gfloat* MODl = (const gfloat*)(C.ws + WS_MOD) + (size_t)layer * 5 * MODW;
    const bool last = (layer == DEPTH - 1);
    const int nrows = last ? NLAT : NTOK;
    for (int r = gw; r < nrows; r += NGW) {
        f32x4 v[4];
#pragma unroll
        for (int j = 0; j < 4; ++j) v[j] = ((const GAS f32x4*)(X + (size_t)r * D))[C.lane + 64 * j];
        if (r < ntok) {
            const TokInfo t = ti_load(TI + r);
            const gfloat* ga = MODl + (size_t)(r < NLAT ? (r >> 12) : 4) * MODW + 5 * D;
#pragma unroll
            for (int j = 0; j < 4; ++j) { f32x4 y0, y1; const f32x4 gg = ((const GAS f32x4*)ga)[C.lane + 64 * j];
                if (t.r0 < trow0) y0 = ((const GAS f32x4*)(Y + (size_t)t.r0 * D))[C.lane + 64 * j];
                else { y0 = (f32x4){0.f, 0.f, 0.f, 0.f}; for (int pk = 0; pk < ts; ++pk) y0 = y0 + ((const GAS f32x4*)(YP + ((size_t)pk * trows + (t.r0 - trow0)) * D))[C.lane + 64 * j]; }
                if (t.r1 < trow0) y1 = ((const GAS f32x4*)(Y + (size_t)t.r1 * D))[C.lane + 64 * j];
                else { y1 = (f32x4){0.f, 0.f, 0.f, 0.f}; for (int pk = 0; pk < ts; ++pk) y1 = y1 + ((const GAS f32x4*)(YP + ((size_t)pk * trows + (t.r1 - trow0)) * D))[C.lane + 64 * j]; }
                v[j] = v[j] + gg * (y0 * t.w0 + y1 * t.w1); }
        }
        if (!last) {
#pragma unroll
            for (int j = 0; j < 4; ++j) ((GAS f32x4*)(X + (size_t)r * D))[C.lane + 64 * j] = v[j];
            const gfloat* MODn = (const gfloat*)(C.ws + WS_MOD) + (size_t)(layer + 1) * 5 * MODW;
            const gfloat* mv = MODn + (size_t)(r < NLAT ? (r >> 12) : 4) * MODW;
            normmod_regs(v, gin(p, 6) + (layer + 1) * D, mv, mv + D, C.lane);
            store_row_bf16(H + (size_t)r * D, v, C.lane);
        } else {
            float ss = 0.f;
#pragma unroll
            for (int j = 0; j < 4; ++j) ss += (v[j][0] * v[j][0] + v[j][1] * v[j][1]) + (v[j][2] * v[j][2] + v[j][3] * v[j][3]);
            const float rs = rsqrtf(wave_sum(ss, C.lane) * (1.f / D) + 1e-6f);
#pragma unroll
            for (int j = 0; j < 4; ++j) { const f32x4 gg = ((const GAS f32x4*)gin(p, 8))[C.lane + 64 * j]; ((GAS f32x4*)(((gfloat*)p.out) + (size_t)r * D))[C.lane + 64 * j] = v[j] * rs * gg; }
        }
    }
}
constexpr int AT_KB = 0, AT_KB_SZ = 64 * 136 * 2, AT_VT = 2 * AT_KB_SZ, AT_VT_SZ = 128 * 68 * 2, AT_QL = AT_VT + 2 * AT_VT_SZ, AT_END = AT_QL + 256 * 136 * 2;
static_assert(AT_END <= LDS_MISC, "attention LDS");
DI void attn_unit(const Ctx& C, const gbf16* PE, gbf16* MIX, const gfloat* gsub, float lam, float mul, int b, int h, int qb, bool ctxq) {
    LAS unsigned char* ldsb = C.lds; asm volatile("" : "+v"(ldsb));
    int tid = C.tid; asm volatile("" : "+v"(tid));
    const int lane = tid & 63, wave = __builtin_amdgcn_readfirstlane(tid >> 6), r = lane & 31, hh = lane >> 5;
    const int qrow0 = (ctxq ? NLAT + b * CTX : b * SEQ) + qb * 256;
    const int ntile = ctxq ? CTX / 64 : (CTX + SEQ) / 64;
    LAS bf16* QL = (LAS bf16*)(ldsb + AT_QL);
#pragma unroll
    for (int i = 0; i < 8; ++i) { const int c = tid + 512 * i, row = c >> 4, part = c & 15; *(LAS u32x4*)(QL + row * 136 + part * 8) = *(const GAS u32x4*)(PE + (size_t)(qrow0 + row) * EVEN_IN + h * 128 + part * 8); }
    f32x16 O[2][4];
#pragma unroll
    for (int mp = 0; mp < 2; ++mp)
#pragma unroll
        for (int k = 0; k < 4; ++k) O[mp][k] = zero16();
    float m[2] = {-1e30f, -1e30f}, l[2] = {0.f, 0.f};
    u32x4 vA[2];
    const int skey = tid & 63, spart = tid >> 6;
#define AT_LOAD(t, kr, vr) do { \
        { const int kidx_ = (t) * 64 + skey; const int krow_ = kidx_ < CTX ? NLAT + b * CTX + kidx_ : b * SEQ + kidx_ - CTX; \
          _Pragma("unroll") for (int i_ = 0; i_ < 2; ++i_) { const gbf16* src_ = PE + (size_t)krow_ * EVEN_IN + h * 128 + (spart + 8 * i_) * 8; vr[i_] = *(const GAS u32x4*)(src_ + 1024); } } \
        { LAS unsigned char* kd_ = ldsb + AT_KB + (((t) & 1)) * AT_KB_SZ; \
          _Pragma("unroll") for (int i_ = 0; i_ < 8; ++i_) { const int key_ = wave * 8 + i_, kidx_ = (t) * 64 + key_; const int krow_ = kidx_ < CTX ? NLAT + b * CTX + kidx_ : b * SEQ + kidx_ - CTX; \
              __builtin_amdgcn_global_load_lds((const GAS unsigned*)(PE + (size_t)krow_ * EVEN_IN + 512 + h * 128) + lane, (LAS unsigned*)(kd_ + key_ * 272), 4, 0, 0); } } } while (0)
#define AT_STORE(buf, kr, vr) do { LAS bf16* vt_ = (LAS bf16*)(ldsb + AT_VT + (buf) * AT_VT_SZ); \
        _Pragma("unroll") for (int i_ = 0; i_ < 2; ++i_) { const int part_ = spart + 8 * i_; \
            _Pragma("unroll") for (int e_ = 0; e_ < 4; ++e_) { vt_[(part_ * 8 + 2 * e_) * 68 + skey] = (bf16)(vr[i_][e_] & 0xffffu); vt_[(part_ * 8 + 2 * e_ + 1) * 68 + skey] = (bf16)(vr[i_][e_] >> 16); } } } while (0)
#define AT_TILE(t) do { const int buf = (t) & 1; \
        int tl_ = tid; asm volatile("" : "+v"(tl_)); const int lane = tl_ & 63, r = lane & 31, hh = lane >> 5, skey = lane, spart = tl_ >> 6;     \
        if ((t) + 1 < ntile) AT_LOAD((t) + 1, vA, vA); \
        const LAS bf16* kb = (const LAS bf16*)(ldsb + AT_KB + buf * AT_KB_SZ); const LAS bf16* vt = (const LAS bf16*)(ldsb + AT_VT + buf * AT_VT_SZ); \
        _Pragma("unroll") for (int ks2 = 0; ks2 < 2; ++ks2) {             \
            bf16x8 pf[2][2]; \
            _Pragma("unroll") for (int mp = 0; mp < 2; ++mp) { \
                f32x16 S = zero16(); \
                _Pragma("unroll") for (int ks = 0; ks < 4; ++ks) { const bf16x8 a = *(const LAS bf16x8*)(kb + (ks2 * 32 + r) * 136 + mp * 64 + 16 * ks + 8 * hh); const bf16x8 qf = *(const LAS bf16x8*)(QL + (wave * 32 + r) * 136 + mp * 64 + 16 * ks + 8 * hh); S = MFMA32(a, qf, S); } \
                float mx = S[0]; \
                _Pragma("unroll") for (int i = 1; i < 16; ++i) mx = fmaxf(mx, S[i]); \
                mx = fmaxf(mx, shx(mx, 32, lane)); \
                if (__any(mx > m[mp] + 8.f)) { const float mnew = fmaxf(m[mp], mx), corr = __builtin_amdgcn_exp2f(m[mp] - mnew); m[mp] = mnew; l[mp] *= corr; \
                    _Pragma("unroll") for (int k = 0; k < 4; ++k) O[mp][k] = O[mp][k] * corr; } \
                float ls = 0.f; const float mu = m[mp]; \
                _Pragma("unroll") for (int i = 0; i < 16; ++i) { S[i] = __builtin_amdgcn_exp2f(S[i] - mu); ls += S[i]; } \
                l[mp] += ls; \
                pf[mp][0] = pack_step(S, 0); pf[mp][1] = pack_step(S, 1); } \
            _Pragma("unroll") for (int s = 0; s < 2; ++s) \
                _Pragma("unroll") for (int k = 0; k < 4; ++k) { const bf16x8 a = ld_perm_frag(vt + (k * 32 + r) * 68, ks2 * 32, s, hh); O[0][k] = MFMA32(a, pf[0][s], O[0][k]); O[1][k] = MFMA32(a, pf[1][s], O[1][k]); } \
            } \
        if ((t) + 1 < ntile) AT_STORE(buf ^ 1, vA, vA); \
        __syncthreads(); } while (0)
    AT_LOAD(0, vA, vA); AT_STORE(0, vA, vA);
    __syncthreads();
    for (int t = 0; t < ntile; ++t) AT_TILE(t);
#undef AT_TILE
#undef AT_LOAD
#undef AT_STORE
    {
        const float i0 = 1.f / (l[0] + shx(l[0], 32, lane)), i1 = lam / (l[1] + shx(l[1], 32, lane));
        float ss = 0.f;
#pragma unroll
        for (int k = 0; k < 4; ++k)
#pragma unroll
            for (int i = 0; i < 16; ++i) { const float o = O[0][k][i] * i0 - O[1][k][i] * i1; O[0][k][i] = o; ss += o * o; }
        ss += shx(ss, 32, lane);
        const float rs = rsqrtf(ss * (1.f / 128.f) + 1e-6f) * mul;
        const int qrow = qrow0 + wave * 32 + r;
#pragma unroll
        for (int k = 0; k < 4; ++k)
#pragma unroll
            for (int g4 = 0; g4 < 4; ++g4) { const int dv0 = k * 32 + 8 * g4 + 4 * hh; const f32x4 gg = *(const GAS f32x4*)(gsub + dv0);
                u32x2 w; w[0] = pk2(O[0][k][4 * g4] * rs * gg[0], O[0][k][4 * g4 + 1] * rs * gg[1]); w[1] = pk2(O[0][k][4 * g4 + 2] * rs * gg[2], O[0][k][4 * g4 + 3] * rs * gg[3]);
                *(GAS u32x2*)(MIX + (size_t)qrow * D + h * 128 + dv0) = w; }
    }
    __syncthreads();
}

constexpr int RGG_WT = 0, RGG_XR = 36864, RGG_XB = RGG_XR + 17408, RGG_XF = RGG_XB + 18432, RGG_END = RGG_XF + 128 * 65 * 4;
static_assert(RGG_END <= LDS_MISC && 131 * 66 * 2 <= 17408, "rg gates LDS");
DI void ph_rg_gates(const Ctx& C, const Params& p, int i) {
    const gbf16* PE = (const gbf16*)(C.ws + WS_P); gfloat* RGA = (gfloat*)(C.ws + WS_RGA); gfloat* RGU = (gfloat*)(C.ws + WS_RGU);
    const gfloat* w_a = gin(p, 15) + (size_t)i * 2 * 8 * 64 * 64; const gfloat* w_x = gin(p, 17) + (size_t)i * 2 * 8 * 64 * 64;
    const gfloat* b_a = gin(p, 16) + i * 1024; const gfloat* b_x = gin(p, 18) + i * 1024; const gfloat* lamv = gin(p, 19) + i * 1024;
    const gfloat* cw = gin(p, 13) + i * 4 * 512; const gfloat* cb = gin(p, 14) + i * 512;
    int ncur = -1;
    for (int unit = C.blk; unit < (NTOK / 128) * 8; unit += C.nblk) {
        LAS unsigned char* ldsb = C.lds; asm volatile("" : "+v"(ldsb));
        int tid = C.tid; asm volatile("" : "+v"(tid));
        const int lane = tid & 63, wave = __builtin_amdgcn_readfirstlane(tid >> 6), r = lane & 31, hh = lane >> 5;
        const int n = unit & 7, tile = unit >> 3, r0 = tile * 128;
        LAS bf16* WT = (LAS bf16*)(ldsb + RGG_WT); LAS bf16* xraw = (LAS bf16*)(ldsb + RGG_XR); LAS bf16* XB = (LAS bf16*)(ldsb + RGG_XB); LAS float* XF = (LAS float*)(ldsb + RGG_XF);
        if (n != ncur) {
            __syncthreads();
            for (int idx = tid; idx < 16384; idx += 512) { const int ch = idx & 63, ci = (idx >> 6) & 63, g = (idx >> 12) & 1, d = idx >> 13;
                const float v = (g ? w_x : w_a)[((size_t)(d * 8 + n) * 64 + ci) * 64 + ch];
                WT[(((d * 2 + g) * 2 + (ch >> 5)) * 32 + (ch & 31)) * 72 + ci] = f2bf(v); }
            ncur = n;
        }
        int s0, s1; seq_bounds(r0, s0, s1);
        for (int idx = tid; idx < 131 * 8; idx += 512) { const int ri = idx >> 3, part = idx & 7, row = r0 - 2 + ri;
            u32x4 v = (u32x4){0u, 0u, 0u, 0u};
            if (row >= s0 && row < s1) v = *(const GAS u32x4*)(PE + (size_t)row * EVEN_IN + 1536 + n * 64 + part * 8);
            LAS unsigned* dst = (LAS unsigned*)(xraw + ri * 66 + part * 8); dst[0] = v[0]; dst[1] = v[1]; dst[2] = v[2]; dst[3] = v[3]; }
        __syncthreads();
        { const int cc = tid & 63; float tap[4];
#pragma unroll
          for (int tp = 0; tp < 4; ++tp) tap[tp] = cw[tp * 512 + n * 64 + cc];
          const float cbias = cb[n * 64 + cc];
#pragma unroll 4
          for (int it = 0; it < 16; ++it) { const int tok = (tid >> 6) + 8 * it; float a = cbias;
#pragma unroll
              for (int tp = 0; tp < 4; ++tp) a += tap[tp] * bf2f(xraw[(tok + tp) * 66 + cc]);
              XF[tok * 65 + cc] = a; XB[tok * 72 + cc] = f2bf(a); } }
        __syncthreads();
        { const int ti = wave & 3, d = wave >> 2;
#pragma unroll
          for (int chblk = 0; chblk < 2; ++chblk) {
              f32x16 aa = zero16(), ax = zero16();
#pragma unroll
              for (int ks = 0; ks < 4; ++ks) { const bf16x8 xa = *(const LAS bf16x8*)(XB + (ti * 32 + r) * 72 + 16 * ks + 8 * hh);
                  const bf16x8 ba = *(const LAS bf16x8*)(WT + (((d * 2 + 0) * 2 + chblk) * 32 + r) * 72 + 16 * ks + 8 * hh), bx = *(const LAS bf16x8*)(WT + (((d * 2 + 1) * 2 + chblk) * 32 + r) * 72 + 16 * ks + 8 * hh);
                  aa = MFMA32(xa, ba, aa); ax = MFMA32(xa, bx, ax); }
              const int ch = n * 64 + chblk * 32 + r;
              const float ba_ = b_a[d * 512 + ch], bx_ = b_x[d * 512 + ch], sp = softplus_(-lamv[d * 512 + ch]);
#pragma unroll
              for (int q = 0; q < 16; ++q) { const int tok = ti * 32 + crow(q, hh);
                  const float rr = sigmoid_(aa[q] + ba_), ii = sigmoid_(ax[q] + bx_);
                  const float log_a = -8.f * rr * sp; const float a = __expf(log_a), u = sqrtf(fmaxf(1.f - a * a, 0.f)) * (ii * XF[tok * 65 + chblk * 32 + r]);
                  const size_t o = ((size_t)d * NTOK + r0 + tok) * 512 + ch; RGA[o] = a; RGU[o] = u; }
          } }
        __syncthreads();
    }
}
DI int rg_row(int b, int d, int pp) { return pp < CTX ? NLAT + b * CTX + (d ? CTX - 1 - pp : pp) : b * SEQ + (d ? SEQ - 1 - (pp - CTX) : (pp - CTX)); }
DI void rgscan_unit(const Ctx& C, int b, int cg) {
    LAS unsigned char* ldsb = C.lds; asm volatile("" : "+v"(ldsb));
    int tid = C.tid; asm volatile("" : "+v"(tid));
    const gfloat* RGA = (const gfloat*)(C.ws + WS_RGA); const gfloat* RGU = (const gfloat*)(C.ws + WS_RGU); gfloat* HS1 = (gfloat*)(C.ws + WS_HS1);
    const gbf16* PE = (const gbf16*)(C.ws + WS_P); gbf16* MIX = (gbf16*)(C.ws + WS_MIX);
    LAS float* sb = (LAS float*)ldsb;
    const int ch = cg * 16 + (tid & 15), chunk = tid >> 4, p0 = chunk * 136;
    for (int pass = 0; pass < 2; ++pass) {
        const int d = 1 - pass;
        const gfloat* Ad = RGA + (size_t)d * NTOK * 512 + ch; const gfloat* Ud = RGU + (size_t)d * NTOK * 512 + ch;
        float av[17], uv[17], an[17], un[17];
        float A = 1.f, H = 0.f;
#pragma unroll
        for (int k = 0; k < 17; ++k) { const size_t o = (size_t)rg_row(b, d, p0 + k) * 512; av[k] = Ad[o]; uv[k] = Ud[o]; }
        for (int g8 = 0; g8 < 8; ++g8) {
            if (g8 < 7) {
#pragma unroll
                for (int k = 0; k < 17; ++k) { const size_t o = (size_t)rg_row(b, d, p0 + (g8 + 1) * 17 + k) * 512; an[k] = Ad[o]; un[k] = Ud[o]; } }
#pragma unroll
            for (int k = 0; k < 17; ++k) { H = av[k] * H + uv[k]; A *= av[k]; }
#pragma unroll
            for (int k = 0; k < 17; ++k) { av[k] = an[k]; uv[k] = un[k]; }
        }
        sb[(chunk * 16 + (tid & 15)) * 2] = A; sb[(chunk * 16 + (tid & 15)) * 2 + 1] = H;
        __syncthreads();
        float h = 0.f;
        for (int k = 0; k < chunk; ++k) h = sb[(k * 16 + (tid & 15)) * 2] * h + sb[(k * 16 + (tid & 15)) * 2 + 1];
#pragma unroll
        for (int k = 0; k < 17; ++k) { const size_t o = (size_t)rg_row(b, d, p0 + k) * 512; av[k] = Ad[o]; uv[k] = Ud[o]; }
        for (int g8 = 0; g8 < 8; ++g8) {
            if (g8 < 7) {
#pragma unroll
                for (int k = 0; k < 17; ++k) { const size_t o = (size_t)rg_row(b, d, p0 + (g8 + 1) * 17 + k) * 512; an[k] = Ad[o]; un[k] = Ud[o]; } }
#pragma unroll
            for (int k = 0; k < 17; ++k) { h = av[k] * h + uv[k]; const int row = rg_row(b, d, p0 + g8 * 17 + k);
                if (pass == 0) HS1[(size_t)row * 512 + ch] = h;
                else { const float y = h + HS1[(size_t)row * 512 + ch]; MIX[(size_t)row * D + 512 + ch] = f2bf(y * gelu_tanh_(bf2f(PE[(size_t)row * EVEN_IN + 2048 + ch]))); } }
#pragma unroll
            for (int k = 0; k < 17; ++k) { av[k] = an[k]; uv[k] = un[k]; }
        }
        __syncthreads();
    }
}
DI void ph_even_mix(const Ctx& C, const Params& p, int layer, int rep) {
    const int i = layer >> 1;
    volatile LAS unsigned* misc = (volatile LAS unsigned*)(C.lds + LDS_MISC);
    guint* q = (guint*)(C.ws + WS_CTL) + CW_Q + (i + 2 * rep) * 64;
    const float lam_init = 0.8f - 0.6f * expf(-0.3f * (float)layer);
    if (C.wave == 0) { const gfloat* lq = gin(p, 11) + i * 256; const float a = wave_sum(lq[C.lane] * lq[64 + C.lane], C.lane), b2 = wave_sum(lq[128 + C.lane] * lq[192 + C.lane], C.lane);
        if (C.lane == 0) ((volatile LAS float*)misc)[4] = expf(a) - expf(b2) + lam_init; }
    __syncthreads();
    const float lam = ((volatile LAS float*)misc)[4];
    const gbf16* PE = (const gbf16*)(C.ws + WS_P); gbf16* MIX = (gbf16*)(C.ws + WS_MIX);
    for (;;) {
        if (C.tid == 0) misc[8] = __hip_atomic_fetch_add(q, 1u, __ATOMIC_RELAXED, __HIP_MEMORY_SCOPE_AGENT);
        __syncthreads();
        const int u = (int)misc[8];
        __syncthreads();
#ifndef MIX_RG_REP
#define MIX_RG_REP 1
#endif
#ifndef MIX_AT_REP
#define MIX_AT_REP 1
#endif
        if (u >= 128 * MIX_RG_REP + 272 * MIX_AT_REP) break;
        if (u < 128 * MIX_RG_REP) { const int x = u & 127; rgscan_unit(C, x >> 5, x & 31); }
        else { const int y = (u - 128 * MIX_RG_REP) % 272;
            if (y < 256) attn_unit(C, PE, MIX, gin(p, 12) + i * 128, lam, 1.f - lam_init, y >> 6, (y >> 4) & 3, y & 15, false);
            else { const int x = y - 256; attn_unit(C, PE, MIX, gin(p, 12) + i * 128, lam, 1.f - lam_init, x >> 2, x & 3, 0, true); } }
    }
}
DI int chunk_row0(int cidx) { return cidx < 256 ? (cidx >> 6) * SEQ + (cidx & 63) * 64 : NLAT + (cidx - 256) * 64; }
constexpr int GA_RA = 0, GA_RB = 18432, GA_KT0 = 2 * 18432, GA_KT1 = 3 * 18432, GA_VT0 = 4 * 18432, GA_VT1 = 5 * 18432, GA_KK = 6 * 18432, GA_QK = GA_KK + 16640, GA_GC = GA_QK + 16640, GA_END = GA_GC + 1024;
static_assert(GA_END <= LDS_MISC, "GA LDS");
struct GaRegs { u32x4 q[2], k[2], v[2]; float g, be; };
DI void ga_load(const Ctx& C, int unit, GaRegs& R, int tid) {
    const int h = unit & 7, cidx = unit >> 3, row0 = chunk_row0(cidx), lane = tid & 63, wave = tid >> 6;
    const gbf16* QKVN = (const gbf16*)(C.ws + WS_QKVN); const gfloat* Gd = (const gfloat*)(C.ws + WS_GB); const gfloat* Bd = Gd + (size_t)2 * NTOK * 8;
#pragma unroll
    for (int i2 = 0; i2 < 2; ++i2) { const int c = tid + 512 * i2, pos = c & 63, part = c >> 6; const gbf16* src = QKVN + (size_t)(row0 + pos) * 3072 + h * 128 + part * 8;
        R.q[i2] = *(const GAS u32x4*)src; R.k[i2] = *(const GAS u32x4*)(src + 1024); R.v[i2] = *(const GAS u32x4*)(src + 2048); }
    R.g = 0.f; R.be = 0.f;
    if (wave < 2) { const int d = wave, row = row0 + (d ? 63 - lane : lane); R.g = Gd[((size_t)d * NTOK + row) * 8 + h]; R.be = Bd[((size_t)d * NTOK + row) * 8 + h]; }
}
DI void gdn_ga_unit(const Ctx& C, int unit, int next_unit, GaRegs& R) {
    LAS unsigned char* ldsb = C.lds; asm volatile("" : "+v"(ldsb));
    const int h = unit & 7, cidx = unit >> 3;
    const int row0 = chunk_row0(cidx);
    const gbf16* QKVN = (const gbf16*)(C.ws + WS_QKVN); const gfloat* Gd = (const gfloat*)(C.ws + WS_GB); const gfloat* Bd = Gd + (size_t)2 * NTOK * 8;
    const size_t ud0 = (size_t)(cidx * 8 + h) * 2;
    gbf16* WG = (gbf16*)(C.ws + WS_WG) + ud0 * 8192; gfloat* UG = (gfloat*)(C.ws + WS_UG) + ud0 * 8192; gbf16* QKD = (gbf16*)(C.ws + WS_QKD) + ud0 * 4096; gfloat* SC = (gfloat*)(C.ws + WS_SC) + ud0 * 192;
    gbf16* KTG = (gbf16*)(C.ws + WS_KTG) + ud0 * 8192;
    LAS bf16* Kc = (LAS bf16*)(ldsb + GA_RA); LAS bf16* Qc = (LAS bf16*)(ldsb + GA_RB);
    LAS float* KKm = (LAS float*)(ldsb + GA_KK); LAS float* QKm = (LAS float*)(ldsb + GA_QK);
    LAS float* gc = (LAS float*)(ldsb + GA_GC); LAS float* be = gc + 128;
    int tid = C.tid; asm volatile("" : "+v"(tid));
    const int lane = tid & 63, wave = __builtin_amdgcn_readfirstlane(tid >> 6), r = lane & 31, hh = lane >> 5;
#pragma unroll
    for (int i2 = 0; i2 < 2; ++i2) { const int c = tid + 512 * i2, pos = c & 63, part = c >> 6;
        const u32x4 q = R.q[i2], k = R.k[i2], v = R.v[i2];
        *(LAS u32x4*)(Qc + pos * 136 + part * 8) = q; *(LAS u32x4*)(Kc + pos * 136 + part * 8) = k;
        LAS bf16* kt0 = (LAS bf16*)(ldsb + GA_KT0) + (part * 8) * 72; LAS bf16* kt1 = (LAS bf16*)(ldsb + GA_KT1) + (part * 8) * 72;
        LAS bf16* vt0 = (LAS bf16*)(ldsb + GA_VT0) + (part * 8) * 72; LAS bf16* vt1 = (LAS bf16*)(ldsb + GA_VT1) + (part * 8) * 72;
#pragma unroll
        for (int e = 0; e < 4; ++e) { const bf16 k0 = (bf16)(k[e] & 0xffffu), k1 = (bf16)(k[e] >> 16), v0 = (bf16)(v[e] & 0xffffu), v1 = (bf16)(v[e] >> 16);
            kt0[(2 * e) * 72 + pos] = k0; kt0[(2 * e + 1) * 72 + pos] = k1; kt1[(2 * e) * 72 + 63 - pos] = k0; kt1[(2 * e + 1) * 72 + 63 - pos] = k1;
            vt0[(2 * e) * 72 + pos] = v0; vt0[(2 * e + 1) * 72 + pos] = v1; vt1[(2 * e) * 72 + 63 - pos] = v0; vt1[(2 * e + 1) * 72 + 63 - pos] = v1; } }
    if (wave < 2) {
        const int d = wave;
        float g = R.g;
#pragma unroll
        for (int o = 1; o < 64; o <<= 1) { const float t = __builtin_bit_cast(float, __builtin_amdgcn_ds_bpermute((lane - o) << 2, __builtin_bit_cast(int, g))); if (lane >= o) g += t; }
        gc[d * 64 + lane] = g; be[d * 64 + lane] = R.be;
    }
    if (next_unit >= 0) ga_load(C, next_unit, R, tid);
    __syncthreads();
    { const int ti = (wave & 3) >> 1, tj = wave & 1; const LAS bf16* Arows = (wave < 4 ? Kc : Qc);
      f32x16 acc = zero16();
#pragma unroll
      for (int ks = 0; ks < 8; ++ks) { const bf16x8 a = *(const LAS bf16x8*)(Arows + (ti * 32 + r) * 136 + 16 * ks + 8 * hh), bb = *(const LAS bf16x8*)(Kc + (tj * 32 + r) * 136 + 16 * ks + 8 * hh); acc = MFMA32(a, bb, acc); }
      LAS float* dst = (wave < 4 ? KKm : QKm);
#pragma unroll
      for (int i = 0; i < 16; ++i) dst[(ti * 32 + crow(i, hh)) * 65 + tj * 32 + r] = acc[i]; }
    __syncthreads();
    const float qscale = 0.08838834764831845f;
#pragma unroll
    for (int e = 0; e < 16; ++e) { const int idx = tid + 512 * e, d = idx >> 12, i = (idx >> 6) & 63, j = idx & 63, ti = d ? 63 - i : i, tj = d ? 63 - j : j;
        const float dec = (j <= i) ? __expf(gc[d * 64 + i] - gc[d * 64 + j]) : 0.f;
        ((LAS float*)(ldsb + (d ? GA_RB : GA_RA)))[i * 68 + j] = (j < i) ? KKm[ti * 65 + tj] * be[d * 64 + i] * dec : 0.f;
        QKD[idx] = f2bf(QKm[ti * 65 + tj] * qscale * dec); }
    if (tid < 128) { const int d = tid >> 6, i = tid & 63; SC[d * 192 + i] = qscale * __expf(gc[d * 64 + i]); SC[d * 192 + 64 + i] = __expf(gc[d * 64 + 63] - gc[d * 64 + i]); if (i == 0) SC[d * 192 + 128] = __expf(gc[d * 64 + 63]); }
    __syncthreads();
    if (wave < 2) {
        const int d = wave, c = lane; LAS float* Lm = (LAS float*)(ldsb + (d ? GA_RB : GA_RA)); float T[64];
#pragma unroll
        for (int i = 0; i < 64; ++i) { float a0 = (i == c) ? 1.f : 0.f, a1 = 0.f, a2 = 0.f, a3 = 0.f;
#pragma unroll
            for (int j4 = 0; j4 < (i + 3) / 4; ++j4) { const f32x4 l4 = *(const LAS f32x4*)(Lm + i * 68 + 4 * j4);
                a0 -= l4[0] * T[4 * j4]; if (4 * j4 + 1 < i) a1 -= l4[1] * T[4 * j4 + 1]; if (4 * j4 + 2 < i) a2 -= l4[2] * T[4 * j4 + 2]; if (4 * j4 + 3 < i) a3 -= l4[3] * T[4 * j4 + 3]; }
            T[i] = (a0 + a1) + (a2 + a3); asm volatile("" ::: "memory"); }
        const float s2 = be[d * 64 + c], s1 = s2 * __expf(gc[d * 64 + c]);
        LAS bf16* T1 = (LAS bf16*)Lm; LAS bf16* T2 = T1 + 64 * 72;
#pragma unroll
        for (int i = 0; i < 64; ++i) { T1[i * 72 + c] = f2bf(T[i] * s1); T2[i * 72 + c] = f2bf(T[i] * s2); }
    }
    __syncthreads();
#pragma unroll
    for (int d = 0; d < 2; ++d) {
        const LAS bf16* T1 = (const LAS bf16*)(ldsb + (d ? GA_RB : GA_RA)); const LAS bf16* T2 = T1 + 64 * 72;
        const LAS bf16* Kt = (const LAS bf16*)(ldsb + (d ? GA_KT1 : GA_KT0)); const LAS bf16* Vt = (const LAS bf16*)(ldsb + (d ? GA_VT1 : GA_VT0));
        const int ti = wave >> 2, tn = wave & 3; f32x16 aw = zero16(), au = zero16();
#pragma unroll
        for (int ks = 0; ks < 4; ++ks) { const bf16x8 a1 = *(const LAS bf16x8*)(T1 + (ti * 32 + r) * 72 + 16 * ks + 8 * hh), a2 = *(const LAS bf16x8*)(T2 + (ti * 32 + r) * 72 + 16 * ks + 8 * hh);
            const bf16x8 bk = *(const LAS bf16x8*)(Kt + (tn * 32 + r) * 72 + 16 * ks + 8 * hh), bv = *(const LAS bf16x8*)(Vt + (tn * 32 + r) * 72 + 16 * ks + 8 * hh);
            aw = MFMA32(a1, bk, aw); au = MFMA32(a2, bv, au); }
#pragma unroll
        for (int i = 0; i < 16; ++i) { const int pos = ti * 32 + crow(i, hh); WG[d * 8192 + pos * 128 + tn * 32 + r] = f2bf(aw[i]); UG[d * 8192 + pos * 128 + tn * 32 + r] = au[i]; }
#pragma unroll
        for (int i2 = 0; i2 < 2; ++i2) { const int c = tid + 512 * i2, row = c >> 3, part = c & 7; *(GAS u32x4*)(KTG + d * 8192 + row * 64 + part * 8) = *(const LAS u32x4*)(Kt + row * 72 + part * 8); }
    }
    __syncthreads();
}
DI void ph_gdn_ga(const Ctx& C) {
    GaRegs R; if (C.blk < NCH * 8) ga_load(C, C.blk, R, C.tid);
    for (int u = C.blk; u < NCH * 8; u += C.nblk) gdn_ga_unit(C, u, (u + C.nblk < NCH * 8) ? u + C.nblk : -1, R);
}

constexpr int GB_NSL = 2;
constexpr int GB_W = 0, GB_Q = GB_W + 64 * 136 * 2, GB_KT = GB_Q + 64 * 136 * 2, GB_QK = GB_KT + 128 * 72 * 2, GB_SC = GB_QK + 64 * 72 * 2, GB_BUF = GB_SC + 1024;
static_assert(2 * GB_BUF <= LDS_MISC, "GB LDS");
template <int VAR> DI void gdn_gb_unit(const Ctx& C, int unit) {
    LAS unsigned char* ldsb = C.lds; asm volatile("" : "+v"(ldsb));
    constexpr int NGRP = 4 / GB_NSL;
    const int grp = unit % NGRP, bhd = unit / NGRP, d = bhd & 1, h = (bhd >> 1) & 7, b = bhd >> 4;
    const gbf16* QKVN = (const gbf16*)(C.ws + WS_QKVN);
    const gbf16* WGb = (const gbf16*)(C.ws + WS_WG); const gfloat* UGb = (const gfloat*)(C.ws + WS_UG); const gbf16* QKDb = (const gbf16*)(C.ws + WS_QKD); const gbf16* KTGb = (const gbf16*)(C.ws + WS_KTG); const gfloat* SCb = (const gfloat*)(C.ws + WS_SC);
    gfloat* OG = (gfloat*)(C.ws + (VAR ? WS_XS : WS_OG)) + (size_t)d * NTOK * D;
    int tid = C.tid; asm volatile("" : "+v"(tid));
    const int lane = tid & 63, wave = __builtin_amdgcn_readfirstlane(tid >> 6), r = lane & 31, hh = lane >> 5;
    const bool comp = wave < GB_NSL; const int dv0 = (grp * GB_NSL + wave) * 32;
    f32x16 S[4];
#pragma unroll
    for (int k = 0; k < 4; ++k) S[k] = zero16();
    constexpr int NSW = 8 - GB_NSL, NIT = (56 + NSW - 1) / NSW, NRD = 1;
    const int wv = wave - GB_NSL, st = tid - GB_NSL * 64;
    u32x4 sreg[NIT], sreg2[NIT]; float rsc = 0.f, rsc2 = 0.f;
    auto chunk_of = [&](int step) { return step < 4 ? 256 + b * 4 + (d ? 3 - step : step) : b * 64 + (d ? 63 - (step - 4) : (step - 4)); };
#define GB_LOAD(step, rd, SR, RS) do { if (!comp) { int ln2_ = lane; asm volatile("" : "+v"(ln2_)); const int cidx_ = chunk_of(step), un_ = (cidx_ * 8 + h) * 2 + d, row0_ = chunk_row0(cidx_); \
        _Pragma("unroll") for (int i_ = 0; i_ < NIT; ++i_) { const int blk_ = wv + NSW * i_; if (blk_ < 56) { const gbf16* src_; \
            if (blk_ < 16) { const int c_ = blk_ * 64 + ln2_; src_ = WGb + (size_t)un_ * 8192 + c_ * 8; } \
            else if (blk_ < 32) { const int c_ = (blk_ - 16) * 64 + ln2_, pos_ = c_ >> 4, part_ = c_ & 15, row_ = row0_ + (d ? 63 - pos_ : pos_); src_ = QKVN + (size_t)row_ * 3072 + h * 128 + part_ * 8; } \
            else if (blk_ < 48) { const int c_ = (blk_ - 32) * 64 + ln2_; src_ = KTGb + (size_t)un_ * 8192 + c_ * 8; } \
            else { const int c_ = (blk_ - 48) * 64 + ln2_; src_ = QKDb + (size_t)un_ * 4096 + c_ * 8; } \
            SR[i_] = *(const GAS u32x4*)src_; } } \
        if (st < 192) RS = SCb[(size_t)un_ * 192 + st]; } } while (0)
#define GB_STORE(buf, rd, SR, RS) do { if (!comp) { int ln2_ = lane; asm volatile("" : "+v"(ln2_)); LAS unsigned char* B_ = ldsb + (buf) * GB_BUF; \
        _Pragma("unroll") for (int i_ = 0; i_ < NIT; ++i_) { const int blk_ = wv + NSW * i_; if (blk_ < 56) { \
            if (blk_ < 16) { const int c_ = blk_ * 64 + ln2_; *(LAS u32x4*)((LAS bf16*)(B_ + GB_W) + (c_ >> 4) * 136 + (c_ & 15) * 8) = SR[i_]; } \
            else if (blk_ < 32) { const int c_ = (blk_ - 16) * 64 + ln2_; *(LAS u32x4*)((LAS bf16*)(B_ + GB_Q) + (c_ >> 4) * 136 + (c_ & 15) * 8) = SR[i_]; } \
            else if (blk_ < 48) { const int c_ = (blk_ - 32) * 64 + ln2_; *(LAS u32x4*)((LAS bf16*)(B_ + GB_KT) + (c_ >> 3) * 72 + (c_ & 7) * 8) = SR[i_]; } \
            else { const int c_ = (blk_ - 48) * 64 + ln2_; *(LAS u32x4*)((LAS bf16*)(B_ + GB_QK) + (c_ >> 3) * 72 + (c_ & 7) * 8) = SR[i_]; } } } \
        if (st < 192) ((LAS float*)(B_ + GB_SC))[st] = RS; } } while (0)
    static_assert(NRD == 1, "two-steps-ahead staging is written for one round per step");
    GB_LOAD(0, 0, sreg, rsc); GB_STORE(0, 0, sreg, rsc); GB_LOAD(1, 0, sreg, rsc);
    f32x16 Un[2];
    Un[0] = zero16(); Un[1] = zero16();
    if (comp) { const int cidx = chunk_of(0), un = (cidx * 8 + h) * 2 + d; const gfloat* Uu = UGb + (size_t)un * 8192 + dv0 + r;
#pragma unroll
        for (int tt = 0; tt < 2; ++tt)
#pragma unroll
            for (int i = 0; i < 16; ++i) Un[tt][i] = Uu[(tt * 32 + crow(i, hh)) * 128]; }
    __syncthreads();
    if (!comp) {
        for (int step = 0; step < 68; ++step) {
            const int buf = step & 1;
            if (VAR != 2) { if (step + 2 < 68) GB_LOAD(step + 2, 0, sreg2, rsc2);
            if (step + 1 < 68) GB_STORE(buf ^ 1, 0, sreg, rsc); }
#pragma unroll
            for (int i_ = 0; i_ < NIT; ++i_) sreg[i_] = sreg2[i_];
            rsc = rsc2;
            asm volatile("s_waitcnt lgkmcnt(0)\n\ts_barrier" ::: "memory");
        }
    } else {
        for (int step = 0; step < 68; ++step) {
            const int buf = step & 1;
            if (VAR != 1) {
            int ln_ = lane; asm volatile("" : "+v"(ln_)); const int r = ln_ & 31, hh = ln_ >> 5;
            const int cidx = chunk_of(step), un = (cidx * 8 + h) * 2 + d, row0 = chunk_row0(cidx);
            const LAS unsigned char* Bp = ldsb + buf * GB_BUF; const LAS bf16* Wl = (const LAS bf16*)(Bp + GB_W); const LAS bf16* Ql = (const LAS bf16*)(Bp + GB_Q);
            const LAS bf16* KTl = (const LAS bf16*)(Bp + GB_KT); const LAS bf16* QKl = (const LAS bf16*)(Bp + GB_QK); const LAS float* scl = (const LAS float*)(Bp + GB_SC);
            bf16x8 sp[4][2];
#pragma unroll
            for (int kb = 0; kb < 4; ++kb) { sp[kb][0] = pack_step(S[kb], 0); sp[kb][1] = pack_step(S[kb], 1); }
            f32x16 aw0 = zero16(), aw1 = zero16();
#pragma unroll
            for (int kb = 0; kb < 4; ++kb)
#pragma unroll
                for (int s = 0; s < 2; ++s) { aw0 = MFMA32(ld_perm_frag(Wl + r * 136, kb * 32, s, hh), sp[kb][s], aw0); aw1 = MFMA32(ld_perm_frag(Wl + (32 + r) * 136, kb * 32, s, hh), sp[kb][s], aw1); }
#pragma unroll
            for (int i = 0; i < 16; ++i) { Un[0][i] -= aw0[i]; Un[1][i] -= aw1[i]; }
            f32x16 aq0 = zero16(), aq1 = zero16();
#pragma unroll
            for (int kb = 0; kb < 4; ++kb)
#pragma unroll
                for (int s = 0; s < 2; ++s) { aq0 = MFMA32(ld_perm_frag(Ql + r * 136, kb * 32, s, hh), sp[kb][s], aq0); aq1 = MFMA32(ld_perm_frag(Ql + (32 + r) * 136, kb * 32, s, hh), sp[kb][s], aq1); }
            bf16x8 vp[2][2];
#pragma unroll
            for (int jt = 0; jt < 2; ++jt) { vp[jt][0] = pack_step(Un[jt], 0); vp[jt][1] = pack_step(Un[jt], 1); }
#pragma unroll
            for (int i = 0; i < 16; ++i) { aq0[i] *= scl[crow(i, hh)]; aq1[i] *= scl[32 + crow(i, hh)]; }
#pragma unroll
            for (int jt = 0; jt < 2; ++jt)
#pragma unroll
                for (int s = 0; s < 2; ++s) { aq0 = MFMA32(ld_perm_frag(QKl + r * 72, jt * 32, s, hh), vp[jt][s], aq0); aq1 = MFMA32(ld_perm_frag(QKl + (32 + r) * 72, jt * 32, s, hh), vp[jt][s], aq1); }
#pragma unroll
            for (int jt = 0; jt < 2; ++jt) {
#pragma unroll
                for (int i = 0; i < 16; ++i) Un[jt][i] *= scl[64 + jt * 32 + crow(i, hh)];
                vp[jt][0] = pack_step(Un[jt], 0); vp[jt][1] = pack_step(Un[jt], 1); }
            if (step + 1 < 68) { const int cn = chunk_of(step + 1), unn = (cn * 8 + h) * 2 + d; const gfloat* Uu = UGb + (size_t)unn * 8192 + dv0 + r;
#pragma unroll
                for (int tt = 0; tt < 2; ++tt)
#pragma unroll
                    for (int i = 0; i < 16; ++i) Un[tt][i] = Uu[(tt * 32 + crow(i, hh)) * 128]; }
            const float gtot = scl[128];
#pragma unroll
            for (int kb = 0; kb < 4; ++kb) S[kb] = S[kb] * gtot;
#pragma unroll
            for (int jt = 0; jt < 2; ++jt)
#pragma unroll
                for (int s = 0; s < 2; ++s)
#pragma unroll
                    for (int kb = 0; kb < 4; ++kb) S[kb] = MFMA32(ld_perm_frag(KTl + (kb * 32 + r) * 72, jt * 32, s, hh), vp[jt][s], S[kb]);
#pragma unroll
            for (int i = 0; i < 16; ++i) { const int pos = crow(i, hh), row = row0 + (d ? 63 - pos : pos); OG[(size_t)row * D + h * 128 + dv0 + r] = aq0[i]; }
#pragma unroll
            for (int i = 0; i < 16; ++i) { const int pos = 32 + crow(i, hh), row = row0 + (d ? 63 - pos : pos); OG[(size_t)row * D + h * 128 + dv0 + r] = aq1[i]; }
            }
            asm volatile("s_waitcnt lgkmcnt(0)\n\ts_barrier" ::: "memory");
        }
    }
#undef GB_LOAD
#undef GB_STORE
}
DI void ph_gdn_gb(const Ctx& C, const Params& p, int lp, int rep) {
    constexpr int NU = 64 * (4 / GB_NSL);
#ifndef GB_PROBE_VAR
    for (int u = C.blk; u < NU; u += C.nblk) gdn_gb_unit<0>(C, u);
#else
    if (rep) { for (int u = C.blk; u < NU; u += C.nblk) gdn_gb_unit<GB_PROBE_VAR>(C, u); return; }
    for (int u = C.blk; u < NU; u += C.nblk) gdn_gb_unit<0>(C, u);
#endif
#if CONV_DEFER
    if (C.nblk > NU) { if (C.blk >= NU) convert_weights(C, p, 1 + lp, (C.blk - NU) * 8 + C.wave, (C.nblk - NU) * 8); }
    else convert_weights(C, p, 1 + lp, C.blk * 8 + C.wave, C.nblk * 8);
#endif
}
constexpr int NPH_PAIR = 20, NPHASE = 1 + 2 * NPH_PAIR;
DI void fresh(Ctx& C) { int t = C.wave0 * 64 + (int)__builtin_amdgcn_mbcnt_hi(~0u, __builtin_amdgcn_mbcnt_lo(~0u, 0u)); asm volatile("" : "+v"(t));     int b = blockIdx.x; asm volatile("" : "+s"(b)); guchar* w_ = C.ws0; asm volatile("" : "+s"(w_)); C.ws = w_; C.tid = t; C.lane = t & 63; C.wave = __builtin_amdgcn_readfirstlane(t >> 6); C.blk = b; }
__global__ void __launch_bounds__(512, 2) fused_fwd(Params p) {
    extern __shared__ __attribute__((aligned(16))) unsigned char lds_raw[];
    Ctx C; C.lds = (LAS unsigned char*)lds_raw; C.ws = (guchar*)p.ws; C.ws0 = (guchar*)p.ws; C.tid = threadIdx.x; C.lane = C.tid & 63; C.wave = __builtin_amdgcn_readfirstlane(C.tid >> 6); C.wave0 = C.wave; C.nblk = gridDim.x; C.blk = blockIdx.x;
    volatile LAS unsigned* misc = (volatile LAS unsigned*)(C.lds + LDS_MISC);
    if (C.tid < 16) misc[C.tid] = 0u;
    __syncthreads();
    unsigned* ctl = (unsigned*)(p.ws + WS_CTL);
    const bool single = (p.ph_lo == 0 && p.ph_hi == NPHASE);
    XcdBarrier bar; bar.bar = ctl + CW_BAR; bar.x = 0; bar.st = misc;
    if (single) bar = xcd_barrier_post(ctl + CW_BAR, misc);
    const int lo = p.ph_lo, hi = p.ph_hi;
#ifndef PH_MASK
#define PH_MASK 0x1FFFFFu
#endif
#define PHEN(k) (((PH_MASK) >> (k)) & 1u)
#ifndef XTRA_BAR
#define XTRA_BAR 0
#endif
#ifndef REP_MASK
#define REP_MASK 0u
#endif
#define NREP(k) (1 + (int)(((REP_MASK) >> (k)) & 1u))
#define IN(k) (fresh(C), lo <= (k) && (k) < hi)
#define SEAM(k) do { if (single) { unsigned* bp_ = ctl + CW_BAR; asm volatile("" : "+s"(bp_)); bar.bar = bp_; xcd_barrier(bar); for (int xb_ = 0; xb_ < XTRA_BAR; ++xb_) xcd_barrier(bar); } } while (0)
#define H ((gbf16*)(C.ws + WS_H))
#define MIX ((gbf16*)(C.ws + WS_MIX))
#define P ((gbf16*)(C.ws + WS_P))
#define X ((gfloat*)(C.ws + WS_X))
#define MOD ((const gfloat*)(C.ws + WS_MOD))
    for (int rep_ = 0; rep_ < NREP(0); ++rep_) { if (rep_) { SEAM(0); } if (PHEN(0) && IN(0)) ph_prologue(C, p); }
    SEAM(0);
    for (int lp = 0; lp < 2; ++lp) {
        const int pb = 1 + lp * NPH_PAIR, le = 2 * lp, lod = 2 * lp + 1;
        for (int rep_ = 0; rep_ < NREP(1); ++rep_) { if (rep_) { SEAM(0); } if (PHEN(1) && IN(pb + 0)) { if (lp == 0) ph_normmod(C, p, 0, false, true, 0, 0); } }
        SEAM(pb + 0);
        for (int rep_ = 0; rep_ < NREP(2); ++rep_) { if (rep_) { SEAM(0); } if (PHEN(2) && IN(pb + 1)) { pg8::Gemm g{H, (const gbf16*)(C.ws + WS_WEIN) + (size_t)lp * 2560 * 1024, NTOK, EVEN_IN, D, 0}; pg8::StaticOrder S; S.init(NTOK, EVEN_IN, C.nblk, C.blk);
            EpiEvenIn E{P, (const gfloat*)(C.ws + WS_COS), (const gfloat*)(C.ws + WS_SIN)}; pg8::gemm_phase<EpiEvenIn, pg8::StaticOrder>(C.lds, g, S, E, C.tid); } }
        SEAM(pb + 1);
        for (int rep_ = 0; rep_ < NREP(20); ++rep_) { if (rep_) { SEAM(0); } if (PHEN(20) && IN(pb + 2)) ph_rg_gates(C, p, lp); }
        SEAM(pb + 2);
        for (int rep_ = 0; rep_ < NREP(3); ++rep_) { if (rep_) { SEAM(0); } if (PHEN(3) && IN(pb + 3)) ph_even_mix(C, p, le, rep_); }
        SEAM(pb + 3);
        for (int rep_ = NREP(4) - 1; rep_ >= 0; --rep_) { if (PHEN(4) && IN(pb + 4)) {
            { pg8::Gemm g{MIX, (const gbf16*)(C.ws + WS_WEOUT) + (size_t)lp * 1024 * 1024, NLAT, D, D, 0}; pg8::StaticOrder S; S.init(NLAT, D, C.nblk, C.blk);
              EpiResid E{rep_ ? (gfloat*)(C.ws + WS_U + (size_t)200 * 1024 * 1024) : X, MOD + (size_t)le * 5 * MODW + 2 * D}; pg8::gemm_phase<EpiResid, pg8::StaticOrder>(C.lds, g, S, E, C.tid); }
            { fresh(C); pg8::Gemm g{MIX + (size_t)NLAT * D, (const gbf16*)(C.ws + WS_WEOUT) + (size_t)lp * 1024 * 1024, NCTX, D, D, D / 4}; pg8::StaticOrder S; S.init(NCTX, D, C.nblk, C.blk); S.lim = S.nwg * 4; S.s = 4;
              EpiPart E{(gfloat*)(C.ws + WS_PART)}; pg8::gemm_phase<EpiPart, pg8::StaticOrder>(C.lds, g, S, E, C.tid); } } if (rep_) { SEAM(0); } }
        SEAM(pb + 4);
        for (int rep_ = 0; rep_ < NREP(5); ++rep_) { if (rep_) { SEAM(0); } if (PHEN(5) && IN(pb + 5)) ph_normmod(C, p, le, true, false, 4, le * 5 * MODW + 2 * D); }
        SEAM(pb + 5);
        for (int rep_ = 0; rep_ < NREP(6); ++rep_) { if (rep_) { SEAM(0); } if (PHEN(6) && IN(pb + 6)) { pg8::Gemm g{H, (const gbf16*)(C.ws + WS_WEF1) + (size_t)lp * 5632 * 1024, NTOK, 2 * FFN, D, 0}; pg8::StaticOrder S; S.init(NTOK, 2 * FFN, C.nblk, C.blk);
            EpiSwiglu E{P, FFN, 2 * FFN / 256}; pg8::gemm_phase<EpiSwiglu, pg8::StaticOrder>(C.lds, g, S, E, C.tid); } }
        SEAM(pb + 6);
        for (int rep_ = NREP(7) - 1; rep_ >= 0; --rep_) { if (PHEN(7) && IN(pb + 7)) {
            { pg8::Gemm g{P, (const gbf16*)(C.ws + WS_WEF2) + (size_t)lp * 1024 * 2816, NLAT, D, FFN, 0}; pg8::StaticOrder S; S.init(NLAT, D, C.nblk, C.blk);
              EpiResid E{rep_ ? (gfloat*)(C.ws + WS_U + (size_t)200 * 1024 * 1024) : X, MOD + (size_t)le * 5 * MODW + 5 * D}; pg8::gemm_phase<EpiResid, pg8::StaticOrder>(C.lds, g, S, E, C.tid); }
            { fresh(C); pg8::Gemm g{P + (size_t)NLAT * FFN, (const gbf16*)(C.ws + WS_WEF2) + (size_t)lp * 1024 * 2816, NCTX, D, FFN, FFN / 11}; pg8::StaticOrder S; S.init(NCTX, D, C.nblk, C.blk); S.lim = S.nwg * 11; S.s = 11;
              EpiPart E{(gfloat*)(C.ws + WS_PART)}; pg8::gemm_phase<EpiPart, pg8::StaticOrder>(C.lds, g, S, E, C.tid); } } if (rep_) { SEAM(0); } }
        SEAM(pb + 7);
        const int ntok = (lod < DEPTH - 1) ? NTOK : NLAT;
        for (int rep_ = 0; rep_ < NREP(8); ++rep_) { if (rep_) { SEAM(0); } if (PHEN(8) && IN(pb + 8)) ph_normmod(C, p, lod, false, false, 11, le * 5 * MODW + 5 * D); }
        SEAM(pb + 8);
        for (int rep_ = 0; rep_ < NREP(9); ++rep_) { if (rep_) { SEAM(0); } if (PHEN(9) && IN(pb + 9)) { pg8::Gemm g{H, (const gbf16*)(C.ws + WS_WOIN) + (size_t)lp * 4352 * 1024, NTOK, 4352, D, 0}; pg8::StaticOrder S; S.init(NTOK, 4352, C.nblk, C.blk);
            EpiBf16Ab E{P, 4352, (gfloat*)(C.ws + WS_AB), 16}; pg8::gemm_phase<EpiBf16Ab, pg8::StaticOrder>(C.lds, g, S, E, C.tid); } }
        SEAM(pb + 9);
        for (int rep_ = 0; rep_ < NREP(10); ++rep_) { if (rep_) { SEAM(0); } if (PHEN(10) && IN(pb + 10)) ph_odd_conv(C, p, lp); }
        SEAM(pb + 10);
        for (int rep_ = 0; rep_ < NREP(11); ++rep_) { if (rep_) { SEAM(0); } if (PHEN(11) && IN(pb + 11)) ph_gdn_ga(C); }
        SEAM(pb + 11);
        for (int rep_ = 0; rep_ < NREP(12); ++rep_) { if (rep_) { SEAM(0); } if (PHEN(12) && IN(pb + 12)) ph_gdn_gb(C, p, lp, rep_); }
        SEAM(pb + 12);
        for (int rep_ = 0; rep_ < NREP(13); ++rep_) { if (rep_) { SEAM(0); } if (PHEN(13) && IN(pb + 13)) ph_gdn_out(C, p, lp); }
        SEAM(pb + 13);
        for (int rep_ = NREP(14) - 1; rep_ >= 0; --rep_) { if (PHEN(14) && IN(pb + 14)) {
            { pg8::Gemm g{MIX, (const gbf16*)(C.ws + WS_WOOUT) + (size_t)lp * 1024 * 1024, NLAT, D, D, 0}; pg8::StaticOrder S; S.init(NLAT, D, C.nblk, C.blk);
              EpiResid E{rep_ ? (gfloat*)(C.ws + WS_U + (size_t)200 * 1024 * 1024) : X, MOD + (size_t)lod * 5 * MODW + 2 * D}; pg8::gemm_phase<EpiResid, pg8::StaticOrder>(C.lds, g, S, E, C.tid); }
            if (lod < DEPTH - 1) { fresh(C); pg8::Gemm g{MIX + (size_t)NLAT * D, (const gbf16*)(C.ws + WS_WOOUT) + (size_t)lp * 1024 * 1024, NCTX, D, D, D / 4}; pg8::StaticOrder S; S.init(NCTX, D, C.nblk, C.blk); S.lim = S.nwg * 4; S.s = 4;
              EpiPart E{(gfloat*)(C.ws + WS_PART)}; pg8::gemm_phase<EpiPart, pg8::StaticOrder>(C.lds, g, S, E, C.tid); } } if (rep_) { SEAM(0); } }
        SEAM(pb + 14);
        if (PHEN(15) && IN(pb + 15)) ph_router(C, p, lod, ntok, (lod < DEPTH - 1) ? 4 : 0);
        SEAM(pb + 15);
        for (int rep_ = 0; rep_ < NREP(16); ++rep_) { if (rep_) { SEAM(0); } if (PHEN(16) && IN(pb + 16)) ph_gather(C, lod, ntok); }
        SEAM(pb + 16);
        for (int rep_ = 0; rep_ < NREP(17); ++rep_) { if (rep_) { SEAM(0); } if (PHEN(17) && IN(pb + 17)) { pg8::Gemm g{(const gbf16*)(C.ws + WS_XS), (const gbf16*)(C.ws + WS_WXIN) + (size_t)lp * 8 * 7168 * 1024, RMAX, 8 * 7168, D, 0}; MoeOrder S; S.initm((const guint*)(ctl + CW_CNT + lp * 64), 28, C.nblk, C.blk);
            EpiSwiglu E{(gbf16*)(C.ws + WS_HIDM), FFE, 28}; pg8::gemm_phase<EpiSwiglu, MoeOrder>(C.lds, g, S, E, C.tid); } }
        SEAM(pb + 17);
        for (int rep_ = 0; rep_ < NREP(18); ++rep_) { if (rep_) { SEAM(0); } if (PHEN(18) && IN(pb + 18)) {
            { pg8::Gemm g{(const gbf16*)(C.ws + WS_HIDM), (const gbf16*)(C.ws + WS_WXOUT) + (size_t)lp * 8 * 1024 * 3584, RMAX, 8 * 1024, FFE, 0}; MoeOrder2 S; S.initm((const guint*)(ctl + CW_CNT + lp * 64), C.nblk, C.blk, 0);
              EpiF32 E{(gfloat*)(C.ws + WS_Y), D, 4}; pg8::gemm_phase<EpiF32, MoeOrder2>(C.lds, g, S, E, C.tid); }
            { fresh(C); MoeOrder2 S; S.initm((const guint*)(ctl + CW_CNT + lp * 64), C.nblk, C.blk, 1);
              pg8::Gemm g{(const gbf16*)(C.ws + WS_HIDM), (const gbf16*)(C.ws + WS_WXOUT) + (size_t)lp * 8 * 1024 * 3584, RMAX, 8 * 1024, FFE, FFE / S.s};
              EpiPartY E{(gfloat*)(C.ws + WS_YP), S.Lmain >> 2, (S.r >> 2) * 256}; pg8::gemm_phase<EpiPartY, MoeOrder2>(C.lds, g, S, E, C.tid); } } }
        SEAM(pb + 18);
        if (PHEN(19) && IN(pb + 19)) ph_combine(C, p, lod, ntok, (const guint*)(ctl + CW_CNT + lp * 64));
        SEAM(pb + 19);
    }
#undef IN
#undef SEAM
#undef H
#undef MIX
#undef P
#undef X
#undef MOD
}

static int fused_setup() {
    static int grid = 0;
    if (grid == 0) {
        int dev = 0, cus = 0, per_cu = 0;
        if (hipGetDevice(&dev) != hipSuccess || hipDeviceGetAttribute(&cus, hipDeviceAttributeMultiprocessorCount, dev) != hipSuccess) { fprintf(stderr, "fused_setup: device query failed\n"); grid = -1; return grid; }
        if (hipFuncSetAttribute((const void*)fused_fwd, hipFuncAttributeMaxDynamicSharedMemorySize, LDS_BYTES) != hipSuccess) { fprintf(stderr, "fused_setup: hipFuncSetAttribute failed\n"); grid = -1; return grid; }
        if (hipOccupancyMaxActiveBlocksPerMultiprocessor(&per_cu, (const void*)fused_fwd, 512, LDS_BYTES) != hipSuccess || per_cu < 1) { fprintf(stderr, "fused_setup: occupancy query says %d blocks per CU\n", per_cu); (void)hipGetLastError(); }
        grid = cus;
    }
    return grid;
}
static void launch_fused(const Params& p0, int lo, int hi, hipStream_t s) {
    const int grid = fused_setup(); if (grid <= 0) return;
    Params p = p0; p.ph_lo = lo; p.ph_hi = hi;
    hipLaunchKernelGGL(fused_fwd, dim3(grid), dim3(512), LDS_BYTES, s, p);
}
}
#ifdef DEBUG_MODE
namespace dbg {
using namespace cfg;
__global__ void k_cmp_f32_bf16(const float* __restrict__ A, const unsigned short* __restrict__ R, size_t n, float* __restrict__ res) {
    float d2 = 0.f, r2 = 0.f;
    for (size_t i = (size_t)blockIdx.x * 256 + threadIdx.x; i < n; i += (size_t)gridDim.x * 256) { const float r = __uint_as_float((unsigned)R[i] << 16), a = A[i]; d2 += (a - r) * (a - r); r2 += r * r; }
    for (int o = 32; o >= 1; o >>= 1) { d2 += __shfl_xor(d2, o); r2 += __shfl_xor(r2, o); }
    if ((threadIdx.x & 63) == 0) { atomicAdd(res, d2); atomicAdd(res + 1, r2); }
}
__global__ void k_cmp_bf16_f32(const unsigned short* __restrict__ A, int fp, int fo, const float* __restrict__ R, int rp, int ro, int nrows, int ncols, float rscale, float* __restrict__ res) {
    float d2 = 0.f, r2 = 0.f;
    for (size_t i = (size_t)blockIdx.x * 256 + threadIdx.x; i < (size_t)nrows * ncols; i += (size_t)gridDim.x * 256) { const int row = (int)(i / ncols), c = (int)(i % ncols);
        const float a = __uint_as_float((unsigned)A[(size_t)row * fp + fo + c] << 16), r = R[(size_t)row * rp + ro + c] * rscale; d2 += (a - r) * (a - r); r2 += r * r; }
    for (int o = 32; o >= 1; o >>= 1) { d2 += __shfl_xor(d2, o); r2 += __shfl_xor(r2, o); }
    if ((threadIdx.x & 63) == 0) { atomicAdd(res, d2); atomicAdd(res + 1, r2); }
}
__global__ void k_cmp_f32_f32(const float* __restrict__ A, int fp, int fo, const float* __restrict__ R, int rp, int ro, int nrows, int ncols, float* __restrict__ res) {
    float d2 = 0.f, r2 = 0.f;
    for (size_t i = (size_t)blockIdx.x * 256 + threadIdx.x; i < (size_t)nrows * ncols; i += (size_t)gridDim.x * 256) { const int row = (int)(i / ncols), c = (int)(i % ncols);
        const float a = A[(size_t)row * fp + fo + c], r = R[(size_t)row * rp + ro + c]; d2 += (a - r) * (a - r); r2 += r * r; }
    for (int o = 32; o >= 1; o >>= 1) { d2 += __shfl_xor(d2, o); r2 += __shfl_xor(r2, o); }
    if ((threadIdx.x & 63) == 0) { atomicAdd(res, d2); atomicAdd(res + 1, r2); }
}
__global__ void k_decide(const float* __restrict__ res, int nchk, float tol, float* __restrict__ out, size_t nout) {
    int code = 0; float frac = 0.f;
    for (int k = 0; k < nchk; ++k) { const float err = res[2 * k] / res[2 * k + 1]; if (!(err <= tol)) { code = k + 1; float l = (err == err && err > 0.f) ? log10f(err) : 0.f; frac = fminf(fmaxf((l + 4.f) / 4.f * 0.9f, 0.f), 0.9f); break; } }
    if (code == 0) return;
    const float c = sqrtf((float)code + frac);
    for (size_t i = (size_t)blockIdx.x * 256 + threadIdx.x; i < nout; i += (size_t)gridDim.x * 256) out[i] = c;
}
}
#endif

static nv::NaiveWs carve_naive(char* base, size_t& off) {
    using namespace cfg;
    nv::NaiveWs w{};
    auto take = [&](size_t nfloats) { float* p = (float*)(base + off); off += ((nfloats * 4 + 255) / 256) * 256; return p; };
    w.MOD = take((size_t)DEPTH * 5 * MODW);
    w.X = take((size_t)NTOK * D); w.H = take((size_t)NTOK * D); w.P = take((size_t)NTOK * ODD_IN); w.MIX = take((size_t)NTOK * D);
    w.T0 = take((size_t)NTOK * 512); w.T1 = take((size_t)NTOK * 3072); w.T2 = take((size_t)NTOK * 2048);
    w.FOUT = take((size_t)NTOK * D); w.HID = take((size_t)NTOK * FFE);
    w.lam = take(64); w.cnt = (int*)take(64); w.list_tok = (int*)take((size_t)NEXP * NTOK); w.list_w = take((size_t)NEXP * NTOK);
    return w;
}
extern "C" void kernel_launch(void* const* d_in, const int* in_sizes, int n_in, void* d_out, int out_size, void* d_ws, size_t ws_size, hipStream_t stream) {
    using namespace cfg;
    if (n_in != 31 || out_size != NLAT * D) { fprintf(stderr, "kernel_launch: unexpected n_in %d / out_size %d\n", n_in, out_size); return; }
    fk::Params p{}; for (int i = 0; i < 31; ++i) p.in[i] = (const float*)d_in[i];
    p.out = (float*)d_out; p.ws = (unsigned char*)d_ws;
#ifdef DEBUG_MODE
    const size_t snap_bytes = (size_t)NTOK * D * 2, CK_BYTES = 8 * snap_bytes + (size_t)NLAT * D * 4 + 4096;
    if (ws_size < fk::WS_END + CK_BYTES) { fprintf(stderr, "kernel_launch(debug): workspace too small\n"); return; }
    char* ckb = (char*)d_ws + ws_size - CK_BYTES; ckb -= ((size_t)ckb & 255);
    unsigned short* snaps = (unsigned short*)ckb; float* nout = (float*)(ckb + 8 * snap_bytes); float* res = (float*)(ckb + 8 * snap_bytes + (size_t)NLAT * D * 4);
    {
        nv::Inputs in{}; for (int i = 0; i < 31; ++i) in.p[i] = (const float*)d_in[i];
        size_t off = 0; nv::NaiveWs w = carve_naive((char*)d_ws, off);
        if ((char*)d_ws + off > ckb) { fprintf(stderr, "kernel_launch(debug): oracle scratch overlaps snapshots\n"); return; }
        nv::run_naive(in, w, nout, snaps, stream);
    }
    (void)hipMemsetAsync(res, 0, 4096, stream);
    (void)hipMemsetAsync((char*)d_ws + fk::WS_CTL, 0, fk::CTL_BYTES, stream);
    int chk = 0;
    for (int ph = 0; ph < fk::NPHASE; ++ph) {
        fk::launch_fused(p, ph, ph + 1, stream);
        if (ph == 0) continue;
        const int lp = (ph - 1) / fk::NPH_PAIR, k = (ph - 1) % fk::NPH_PAIR;
        int snap = -1;
        if (k == 4) snap = 4 * lp + 0; else if (k == 7) snap = 4 * lp + 1; else if (k == 14) snap = 4 * lp + 2; else if (k == 19 && lp == 0) snap = 3;
        if (snap >= 0) { hipLaunchKernelGGL(dbg::k_cmp_f32_bf16, dim3(2048), dim3(256), 0, stream, (const float*)((char*)d_ws + fk::WS_X), snaps + (size_t)snap * NTOK * D, (size_t)NTOK * D, res + 2 * chk); ++chk; }
    }
    hipLaunchKernelGGL(dbg::k_cmp_f32_f32, dim3(2048), dim3(256), 0, stream, (const float*)d_out, D, 0, (const float*)nout, D, 0, NLAT, D, res + 2 * chk); ++chk;
    hipLaunchKernelGGL(dbg::k_decide, dim3(1024), dim3(256), 0, stream, (const float*)res, chk, DEBUG_TOL, (float*)d_out, (size_t)NLAT * D);
#else
    if (ws_size < fk::WS_END) { fprintf(stderr, "kernel_launch: workspace too small: need %zu have %zu\n", (size_t)fk::WS_END, ws_size); return; }
    (void)hipMemsetAsync((char*)d_ws + fk::WS_CTL, 0, fk::CTL_BYTES, stream);
    fk::launch_fused(p, 0, fk::NPHASE, stream);
#endif
}
```

```cpp
#include <hip/hip_runtime.h>
#include <cstdio>
#include <cstdint>
#include <cmath>
namespace cfg {
constexpr int D = 1024, B = 4, SEQ = 4096, CTX = 256, DEPTH = 4;
constexpr int NLAT = B * SEQ, NCTX = B * CTX, NTOK = NLAT + NCTX;
constexpr int NMOD = 6, MODW = NMOD * D;
constexpr int EVEN_IN = 2560, ODD_IN = 4128, FFN = 2816, FFE = 3584, NEXP = 8;
}
namespace nv {
using namespace cfg;
struct NaiveWs { float *MOD, *X, *H, *P, *MIX, *T0, *T1, *T2, *FOUT, *HID, *lam; int* cnt; int* list_tok; float* list_w; };
}
namespace pg8 {
#define PG8_LAS __attribute__((address_space(3)))
#define PG8_GAS __attribute__((address_space(1)))
typedef unsigned short bf16_t;
typedef short bf16x8 __attribute__((ext_vector_type(8)));
typedef float f32x4 __attribute__((ext_vector_type(4)));
typedef unsigned u32x4 __attribute__((ext_vector_type(4)));
constexpr int BM = 256, BK = 64, HALF = 128, HTB = HALF * BK * 2  , STAGE_BYTES = 8 * HTB, NXCD = 8, WGM = 8;

__host__ __device__ __forceinline__ int lds_byte(int r_, int c_) { const unsigned r = (unsigned)r_, c = (unsigned)c_; const unsigned st = (r >> 4) * 2u + (c >> 5), rr = r & 15u, cc = c & 31u, ob = rr * 64u + cc * 2u; return (int)(st * 1024u + (ob ^ (((ob >> 9) & 1u) << 5))); }
__host__ __device__ __forceinline__ void stage_rc(int b_, int& R, int& C) { const unsigned b = (unsigned)b_; const unsigned st = b >> 10, sb = b & 1023u, swz = sb ^ (((sb >> 9) & 1u) << 5); R = (int)((st >> 1) * 16u + (swz >> 6)); C = (int)((st & 1u) * 32u + ((swz & 63u) >> 1)); }
__host__ __device__ __forceinline__ int perm32(int rho_) { const unsigned rho = (unsigned)rho_; const unsigned n = rho >> 4, i = rho & 15u; return (int)(8u * (i >> 2) + 4u * n + (i & 3u)); }

struct Unit { int pm, pn, pk; };
struct Gemm { const PG8_GAS bf16_t* A; const PG8_GAS bf16_t* Bt; int M, N, K, Kh; };

struct StaticOrder {
    int nM, nN, nwg, G, c;
    int lim, L0, s;
    __host__ __device__ void init(int M, int N, int G_, int c_) { nM = M / BM; nN = N / BM; nwg = nM * nN; G = G_; c = c_; lim = nwg; L0 = 0; s = 1; }
    __host__ __device__ void decode(int wgid, Unit& u) const {
        { const int q = nwg / NXCD, r = nwg % NXCD, xcd = wgid % NXCD, off = wgid / NXCD; wgid = (xcd < r ? xcd * (q + 1) : r * (q + 1) + (xcd - r) * q) + off; }
        const int nig = WGM * nN, gid = wgid / nig, fm = gid * WGM, gsz = (nM - fm) < WGM ? (nM - fm) : WGM;
        u.pm = fm + ((wgid % nig) % gsz); u.pn = (wgid % nig) / gsz;
    }
    __host__ __device__ bool next(int i, Unit& u) const {
        const long j = (long)i * G + c; if (j >= lim) return false;
        u.pk = (int)(j % s); decode(L0 + (int)(j / s), u); return true;
    }
    __host__ __device__ void main_part() { lim = (nwg / G) * G; L0 = 0; s = 1; }
    __host__ __device__ void tail_part(int s_) { L0 = (nwg / G) * G; s = s_; lim = (nwg - L0) * s_; }
    __host__ __device__ int tail_tiles() const { return nwg - (nwg / G) * G; }
    __device__ __forceinline__ void a_ready(const Unit&) const {}
    __device__ __forceinline__ void done(const Unit&) const {}
};
template <class Epi, class Sched, bool ALIGN_EPI = true, bool SP2 = true>
__device__ __forceinline__ void gemm_phase(PG8_LAS unsigned char* lds, const Gemm g, const Sched& S, const Epi& E, const int tid) {
    const int wid = __builtin_amdgcn_readfirstlane(tid >> 6), lane = tid & 63, wr = wid >> 2, wc = wid & 3, fr = lane & 15, fq = lane >> 4;
    const int K = g.K, Kh = g.Kh ? g.Kh : g.K, nt = Kh / BK;
    unsigned voffA[2], voffB[2];
#pragma unroll
    for (int i = 0; i < 2; ++i) { int R, C; stage_rc(tid * 16 + i * 8192, R, C); const int Rb = Epi::PERM ? ((R & ~31) + perm32(R & 31)) : R;
        voffA[i] = (unsigned)(R * K + C) * 2u; voffB[i] = (unsigned)(Rb * K + C) * 2u; }
    const size_t kstep = (size_t)(BK * 2);
    const size_t hstep = (size_t)HALF * K * 2;
    const size_t tstep = 2 * hstep;
    const unsigned ldsw = (unsigned)wid * 1024u;
    const int aoff = lds_byte(wr * 64 + fr, fq * 8), boff = lds_byte(wc * 32 + fr, fq * 8);
#define PG8_SA(b, h) (((b) * 2 + (h)) * HTB)
#define PG8_SB(b, h) ((4 + (b) * 2 + (h)) * HTB)
#define PG8_STAGE(bufoff, gbase, voff) do { _Pragma("unroll") for (int _i = 0; _i < 2; ++_i) \
        __builtin_amdgcn_global_load_lds((const PG8_GAS unsigned*)((const PG8_GAS char*)(gbase) + (voff)[_i]), (PG8_LAS unsigned*)(lds + (bufoff) + ldsw + _i * 8192), 16, 0, 0); } while (0)
#define PG8_LDA(dst, b, h) do { _Pragma("unroll") for (int m = 0; m < 4; ++m) _Pragma("unroll") for (int k = 0; k < 2; ++k) dst[m][k] = *(const PG8_LAS bf16x8*)(lds + PG8_SA(b, h) + aoff + m * 2048 + k * 1024); } while (0)
#define PG8_LDB(dst, b, h) do { _Pragma("unroll") for (int n = 0; n < 2; ++n) _Pragma("unroll") for (int k = 0; k < 2; ++k) dst[n][k] = *(const PG8_LAS bf16x8*)(lds + PG8_SB(b, h) + boff + n * 2048 + k * 1024); } while (0)
#define PG8_MMA(ai, bj, At, Bt) do { __builtin_amdgcn_s_setprio(1); _Pragma("unroll") for (int m = 0; m < 4; ++m) _Pragma("unroll") for (int n = 0; n < 2; ++n) _Pragma("unroll") for (int k = 0; k < 2; ++k) \
        acc[ai][bj][m][n] = __builtin_amdgcn_mfma_f32_16x16x32_bf16(Bt[n][k], At[m][k], acc[ai][bj][m][n], 0, 0, 0); __builtin_amdgcn_s_setprio(0); } while (0)
#define PG8_WAIT_V(n) asm volatile("s_waitcnt vmcnt(" #n ")" ::: "memory")
#define PG8_WAIT_L(n) asm volatile("s_waitcnt lgkmcnt(" #n ")" ::: "memory")
#define PG8_BAR __builtin_amdgcn_s_barrier()
#define PG8_SCHED __builtin_amdgcn_sched_barrier(0)
    Unit cur, nxt; int ui = 0;
    if (!S.next(0, cur)) return;
    f32x4 acc[2][2][4][2];
#pragma unroll
    for (int a = 0; a < 2; ++a)
#pragma unroll
        for (int b = 0; b < 2; ++b)
#pragma unroll
            for (int m = 0; m < 4; ++m)
#pragma unroll
                for (int n = 0; n < 2; ++n) acc[a][b][m][n] = (f32x4){0.f, 0.f, 0.f, 0.f};
    bf16x8 At[4][2], B0[2][2], B1[2][2];
    const PG8_GAS char* cA = (const PG8_GAS char*)g.A + (size_t)cur.pm * tstep + (size_t)cur.pk * Kh * 2; const PG8_GAS char* cB = (const PG8_GAS char*)g.Bt + (size_t)cur.pn * tstep + (size_t)cur.pk * Kh * 2;
    S.a_ready(cur);
    if constexpr (SP2) {
        PG8_STAGE(PG8_SB(0, 0), cB, voffB); PG8_STAGE(PG8_SB(0, 1), cB + hstep, voffB); PG8_STAGE(PG8_SA(0, 0), cA, voffA); PG8_STAGE(PG8_SA(0, 1), cA + hstep, voffA);
        if (wr == 1) PG8_BAR;
        PG8_WAIT_V(2); PG8_BAR;
        PG8_STAGE(PG8_SB(1, 0), cB + kstep, voffB); PG8_STAGE(PG8_SA(1, 0), cA + kstep, voffA); PG8_STAGE(PG8_SB(1, 1), cB + hstep + kstep, voffB);
        PG8_WAIT_V(6); PG8_BAR;
    } else {
    PG8_STAGE(PG8_SB(0, 0), cB, voffB); PG8_STAGE(PG8_SA(0, 0), cA, voffA); PG8_STAGE(PG8_SB(0, 1), cB + hstep, voffB); PG8_STAGE(PG8_SA(0, 1), cA + hstep, voffA);
    if (wr == 1) PG8_BAR;
    PG8_WAIT_V(4); PG8_BAR;
    PG8_STAGE(PG8_SB(1, 0), cB + kstep, voffB); PG8_STAGE(PG8_SA(1, 0), cA + kstep, voffA); PG8_STAGE(PG8_SB(1, 1), cB + hstep + kstep, voffB);
    PG8_WAIT_V(6); PG8_BAR;
    }
    for (;;) {
        const bool has_next = S.next(ui + 1, nxt);
        const PG8_GAS char* nA = has_next ? (const PG8_GAS char*)g.A + (size_t)nxt.pm * tstep + (size_t)nxt.pk * Kh * 2 : cA; const PG8_GAS char* nB = has_next ? (const PG8_GAS char*)g.Bt + (size_t)nxt.pn * tstep + (size_t)nxt.pk * Kh * 2 : cB;
        for (int t = 0; t < nt; t += 2) {
            const bool last = (t == nt - 2);
            const PG8_GAS char* a1 = cA + (size_t)(t + 1) * kstep;
            const PG8_GAS char* a2 = last ? nA : cA + (size_t)(t + 2) * kstep; const PG8_GAS char* b2 = last ? nB : cB + (size_t)(t + 2) * kstep;
            const PG8_GAS char* a3 = a2 + kstep; const PG8_GAS char* b3 = b2 + kstep;
            if (last && has_next) S.a_ready(nxt);
            if constexpr (SP2) {
            PG8_LDB(B0, 0, 0); PG8_LDB(B1, 0, 1); PG8_SCHED; PG8_LDA(At, 0, 0); PG8_STAGE(PG8_SA(1, 1), a1 + hstep, voffA);
            PG8_WAIT_V(8); PG8_WAIT_L(0); PG8_BAR; PG8_MMA(0, 0, At, B0); PG8_MMA(0, 1, At, B1); PG8_BAR; PG8_SCHED;
            PG8_LDA(At, 0, 1); PG8_STAGE(PG8_SB(0, 0), b2, voffB); PG8_STAGE(PG8_SB(0, 1), b2 + hstep, voffB); PG8_STAGE(PG8_SA(0, 0), a2, voffA);
            PG8_WAIT_V(8); PG8_WAIT_L(0); PG8_BAR; PG8_MMA(1, 0, At, B0); PG8_MMA(1, 1, At, B1); PG8_BAR; PG8_SCHED;
            PG8_LDB(B0, 1, 0); PG8_LDB(B1, 1, 1); PG8_SCHED; PG8_LDA(At, 1, 0); PG8_STAGE(PG8_SA(0, 1), a2 + hstep, voffA);
            PG8_WAIT_V(8); PG8_WAIT_L(0); PG8_BAR; PG8_MMA(0, 0, At, B0); PG8_MMA(0, 1, At, B1); PG8_BAR; PG8_SCHED;
            PG8_LDA(At, 1, 1); PG8_STAGE(PG8_SB(1, 0), b3, voffB); PG8_STAGE(PG8_SB(1, 1), b3 + hstep, voffB); PG8_STAGE(PG8_SA(1, 0), a3, voffA);
            PG8_WAIT_V(8); PG8_WAIT_L(0); PG8_BAR; PG8_MMA(1, 0, At, B0); PG8_MMA(1, 1, At, B1); PG8_BAR; PG8_SCHED;
            } else {
            PG8_LDB(B0, 0, 0); PG8_SCHED; PG8_LDA(At, 0, 0); PG8_STAGE(PG8_SA(1, 1), a1 + hstep, voffA);
            PG8_WAIT_L(8); PG8_BAR; PG8_WAIT_L(0); PG8_MMA(0, 0, At, B0); PG8_BAR; PG8_SCHED;
            PG8_LDB(B1, 0, 1); PG8_STAGE(PG8_SB(0, 0), b2, voffB);
            PG8_BAR; PG8_WAIT_L(0); PG8_MMA(0, 1, At, B1); PG8_BAR;
            PG8_LDA(At, 0, 1); PG8_STAGE(PG8_SA(0, 0), a2, voffA);
            PG8_BAR; PG8_WAIT_L(0); PG8_MMA(1, 0, At, B0); PG8_BAR; PG8_SCHED;
            PG8_STAGE(PG8_SB(0, 1), b2 + hstep, voffB);
            PG8_WAIT_V(6); PG8_BAR; PG8_MMA(1, 1, At, B1); PG8_BAR;
            PG8_LDB(B0, 1, 0); PG8_SCHED; PG8_LDA(At, 1, 0); PG8_STAGE(PG8_SA(0, 1), a2 + hstep, voffA);
            PG8_WAIT_L(8); PG8_BAR; PG8_WAIT_L(0); PG8_MMA(0, 0, At, B0); PG8_BAR; PG8_SCHED;
            PG8_LDB(B1, 1, 1); PG8_STAGE(PG8_SB(1, 0), b3, voffB);
            PG8_BAR; PG8_WAIT_L(0); PG8_MMA(0, 1, At, B1); PG8_BAR;
            PG8_LDA(At, 1, 1); PG8_STAGE(PG8_SA(1, 0), a3, voffA);
            PG8_BAR; PG8_WAIT_L(0); PG8_MMA(1, 0, At, B0); PG8_BAR; PG8_SCHED;
            PG8_STAGE(PG8_SB(1, 1), b3 + hstep, voffB);
            PG8_WAIT_V(6); PG8_BAR; PG8_MMA(1, 1, At, B1); PG8_BAR;
            }
        }
        if constexpr (ALIGN_EPI) { if (wr == 0) PG8_BAR; }
        if constexpr (!Epi::AFTER_DRAIN) { E(acc, cur, wr, wc, fr, fq); S.done(cur); }
        if (!has_next) break;
#pragma unroll
        for (int a = 0; a < 2; ++a)
#pragma unroll
            for (int b = 0; b < 2; ++b)
#pragma unroll
                for (int m = 0; m < 4; ++m)
#pragma unroll
                    for (int n = 0; n < 2; ++n) acc[a][b][m][n] = (f32x4){0.f, 0.f, 0.f, 0.f};
        cur = nxt; cA = nA; cB = nB; ++ui;
        if constexpr (ALIGN_EPI) { if (wr == 1) PG8_BAR; }
    }
    PG8_WAIT_V(0);
    if constexpr (!ALIGN_EPI) { if (wr == 0) PG8_BAR; }
    PG8_BAR;
    if constexpr (Epi::AFTER_DRAIN) { E.fused(acc, cur, wr, wc, fr, fq, lds, wid, lane); S.done(cur); }
#undef PG8_SA
#undef PG8_SB
#undef PG8_STAGE
#undef PG8_LDA
#undef PG8_LDB
#undef PG8_MMA
#undef PG8_WAIT_V
#undef PG8_WAIT_L
#undef PG8_BAR
#undef PG8_SCHED
}
}
namespace fk {
using namespace cfg;
#define LAS __attribute__((address_space(3)))
typedef unsigned short bf16;
typedef short bf16x8 __attribute__((ext_vector_type(8)));
typedef short s16x4 __attribute__((ext_vector_type(4)));
typedef float f32x4 __attribute__((ext_vector_type(4)));
typedef float f32x2 __attribute__((ext_vector_type(2)));
typedef float f32x16 __attribute__((ext_vector_type(16)));
typedef unsigned u32x4 __attribute__((ext_vector_type(4)));
typedef unsigned u32x2 __attribute__((ext_vector_type(2)));
typedef __bf16 bf16x2_t __attribute__((ext_vector_type(2)));
#define DI __device__ __forceinline__
#define GAS __attribute__((address_space(1)))
typedef GAS float gfloat; typedef GAS unsigned short gbf16; typedef GAS unsigned guint; typedef GAS int gint; typedef GAS unsigned char guchar;
#define MFMA32(a, b, c) __builtin_amdgcn_mfma_f32_32x32x16_bf16((a), (b), (c), 0, 0, 0)

DI unsigned pk2(float a, float b) { f32x2 f = {a, b}; bf16x2_t r = __builtin_convertvector(f, bf16x2_t); return __builtin_bit_cast(unsigned, r); }
DI bf16 f2bf(float a) { return (bf16)(pk2(a, 0.f) & 0xffffu); }
DI float bf2f(bf16 v) { return __builtin_bit_cast(float, (unsigned)v << 16); }
DI float bflo(unsigned w) { return __builtin_bit_cast(float, w << 16); }
DI float bfhi(unsigned w) { return __builtin_bit_cast(float, w & 0xffff0000u); }
DI float sigmoid_(float x) { return __builtin_amdgcn_rcpf(1.f + __expf(-x)); }
DI float silu_(float x) { return x * __builtin_amdgcn_rcpf(1.f + __expf(-x)); }
DI float softplus_(float x) { return fmaxf(x, 0.f) + log1pf(expf(-fabsf(x))); }
DI float gelu_tanh_(float x) { const float u = 0.7978845608028654f * (x + 0.044715f * x * x * x); const float e = __expf(2.f * u); return x * (1.f - __builtin_amdgcn_rcpf(e + 1.f)); }
DI int crow(int reg, int h) { return (reg & 3) + 8 * (reg >> 2) + 4 * h; }
DI f32x16 zero16() { f32x16 z; for (int i = 0; i < 16; ++i) z[i] = 0.f; return z; }
DI bf16x8 pack_step(const f32x16& x, int s) {
    u32x4 p; p[0] = pk2(x[8 * s], x[8 * s + 1]); p[1] = pk2(x[8 * s + 2], x[8 * s + 3]); p[2] = pk2(x[8 * s + 4], x[8 * s + 5]); p[3] = pk2(x[8 * s + 6], x[8 * s + 7]);
    return __builtin_bit_cast(bf16x8, p);
}
DI bf16x8 ld_perm_frag(const LAS bf16* rowp, int kbase, int s, int h) {
    const s16x4 lo = *(const LAS s16x4*)(rowp + kbase + 16 * s + 4 * h);
    const s16x4 hi = *(const LAS s16x4*)(rowp + kbase + 16 * s + 8 + 4 * h);
    return __builtin_shufflevector(lo, hi, 0, 1, 2, 3, 4, 5, 6, 7);
}
DI float shx(float v, int o, int lane) { return __builtin_bit_cast(float, __builtin_amdgcn_ds_bpermute((lane ^ o) << 2, __builtin_bit_cast(int, v))); }
DI float wave_sum(float v, int lane) {
#pragma unroll
    for (int o = 1; o < 64; o <<= 1) v += shx(v, o, lane);
    return v;
}

constexpr size_t al256(size_t x) { return (x + 255) / 256 * 256; }
constexpr int RMAX = 36864;
constexpr int NCH = NTOK / 64;
constexpr int NCHD = NCH * 8 * 2;
constexpr size_t WS_CTL = 0, CTL_BYTES = 1u << 20;
constexpr size_t WS_MOD = CTL_BYTES;
constexpr size_t WS_COS = WS_MOD + al256((size_t)DEPTH * 5 * MODW * 4);
constexpr size_t WS_SIN = WS_COS + (size_t)SEQ * 32 * 4;
constexpr size_t WS_WEIN = WS_SIN + (size_t)SEQ * 32 * 4;
constexpr size_t WS_WEOUT = WS_WEIN + (size_t)2 * 2560 * 1024 * 2;
constexpr size_t WS_WEF1 = WS_WEOUT + (size_t)2 * 1024 * 1024 * 2;
constexpr size_t WS_WEF2 = WS_WEF1 + (size_t)2 * 5632 * 1024 * 2;
constexpr size_t WS_WOIN = WS_WEF2 + (size_t)2 * 1024 * 2816 * 2;
constexpr size_t WS_WOOUT = WS_WOIN + (size_t)2 * 4352 * 1024 * 2;
constexpr size_t WS_WXIN = WS_WOOUT + (size_t)2 * 1024 * 1024 * 2;
constexpr size_t WS_WXOUT = WS_WXIN + (size_t)2 * 8 * 7168 * 1024 * 2;
constexpr size_t WS_X = WS_WXOUT + (size_t)2 * 8 * 1024 * 3584 * 2;
constexpr size_t WS_H = WS_X + (size_t)NTOK * D * 4;
constexpr size_t WS_MIX = WS_H + (size_t)NTOK * D * 2;
constexpr size_t WS_P = WS_MIX + (size_t)NTOK * D * 2;
constexpr size_t WS_HS1 = WS_P + (size_t)NTOK * 4352 * 2;
constexpr size_t WS_U = WS_HS1 + (size_t)NTOK * 512 * 4;
constexpr size_t WS_PART = WS_U + (size_t)400 * 1024 * 1024;
constexpr size_t WS_RGA = WS_U;
constexpr size_t WS_RGU = WS_RGA + (size_t)2 * NTOK * 512 * 4;
constexpr size_t WS_QKVN = WS_U;
constexpr size_t WS_WG = WS_QKVN + (size_t)NTOK * 3072 * 2;
constexpr size_t WS_UG = WS_WG + (size_t)NCHD * 64 * 128 * 2;
constexpr size_t WS_QKD = WS_UG + (size_t)NCHD * 64 * 128 * 4;
constexpr size_t WS_SC = WS_QKD + (size_t)NCHD * 64 * 64 * 2;
constexpr size_t WS_KTG = WS_SC + (size_t)NCHD * 192 * 4;
constexpr size_t WS_OG = WS_KTG + (size_t)NCHD * 128 * 64 * 2;
constexpr size_t WS_U_END1 = WS_OG + (size_t)2 * NTOK * D * 4;
constexpr size_t WS_XS = WS_U;
constexpr size_t WS_HIDM = WS_XS + (size_t)RMAX * D * 2;
constexpr size_t WS_Y = WS_HIDM + (size_t)RMAX * FFE * 2;
constexpr size_t WS_YP = WS_Y + (size_t)RMAX * D * 4;
constexpr size_t WS_U_END2 = WS_YP + (size_t)64 * 256 * D * 4;
constexpr size_t WS_TOK = (WS_U_END1 > WS_U_END2 ? WS_U_END1 : WS_U_END2);
constexpr size_t WS_END = WS_TOK + (size_t)NTOK * 32;
constexpr size_t WS_AB = WS_HS1;
constexpr size_t WS_GB = WS_AB + (size_t)NTOK * 32 * 4;

constexpr int CW_BAR = 4096;
constexpr int CW_CNT = 8192;
constexpr int CW_Q = 8448;
constexpr int CW_BC = 16384;

constexpr int LDS_BYTES = 152 * 1024;
constexpr int LDS_MISC = LDS_BYTES - 256;

struct Params { const float* in[31]; float* out; unsigned char* ws; int ph_lo, ph_hi; int dbg0, dbg1; };

DI const gfloat* gin(const Params& p, int k) { return (const gfloat*)p.in[k]; }
struct Ctx {
    LAS unsigned char* lds;
    guchar* ws; guchar* ws0;
    int tid, lane, wave, nblk, blk, wave0;
};
#define XB_TMO      128
#define XB_XCNT(j)  (256  + 64 * (j))
#define XB_XSUB(j)  (1280 + 64 * (j))
#define XB_XGEN(j)  (2304 + 64 * (j))
#define XB_TOP      3328
#define XB_TOPGEN   3392
#define XCD_BAR_WORDS 3456
#define XB_SPIN_CAP (1u << 27)

__device__ __forceinline__ unsigned xb_ld(unsigned* p)              { return __hip_atomic_load(p, __ATOMIC_RELAXED, __HIP_MEMORY_SCOPE_AGENT); }
__device__ __forceinline__ unsigned xb_add(unsigned* p, unsigned v) { (void)v; unsigned one; asm volatile("v_mov_b32 %0, 1" : "=v"(one)); return __hip_atomic_fetch_add(p, one, __ATOMIC_RELAXED, __HIP_MEMORY_SCOPE_AGENT); }
__device__ __forceinline__ unsigned xb_xcc_id() { return (unsigned)__builtin_amdgcn_s_getreg((3 << 11) | 20) & 0xFu; }
#define XB_SPIN(cond, bar) do { unsigned _sp = 0; while (cond) { __builtin_amdgcn_s_sleep(1); \
    if ((++_sp & 255u) == 0u) { if (xb_ld(&(bar)[XB_TMO])) break; if (_sp > XB_SPIN_CAP) { (void)xb_add(&(bar)[XB_TMO], 1u); break; } } } } while (0)

struct XcdBarrier {
    unsigned* bar; unsigned x;
    volatile LAS unsigned* st;
};

__device__ __forceinline__ XcdBarrier xcd_barrier_post(unsigned* bar, volatile LAS unsigned* st) {
    XcdBarrier b; b.bar = bar; b.x = xb_xcc_id(); b.st = st;
    if (threadIdx.x == 0) (void)xb_add(&bar[XB_XCNT(b.x)], 1u);
    return b;
}
__device__ __forceinline__ void xcd_barrier_complete(unsigned* bar, unsigned x, unsigned& nloc, unsigned& nx) {
    const unsigned G = gridDim.x * gridDim.y * gridDim.z;
    unsigned sum, cnt, mine, sp = 0u;
    for (;;) {
        sum = 0u; cnt = 0u; mine = 0u;
#pragma unroll
        for (unsigned j = 0; j < 16; ++j) { const unsigned c = xb_ld(&bar[XB_XCNT(j)]); sum += c; cnt += (c > 0u) ? 1u : 0u; mine = (j == x) ? c : mine; }
        if (sum == G) break;
        __builtin_amdgcn_s_sleep(1);
        if ((++sp & 255u) == 0u) { if (xb_ld(&bar[XB_TMO])) break; if (sp > XB_SPIN_CAP) { (void)xb_add(&bar[XB_TMO], 1u); break; } }
    }
    nloc = mine > 0u ? mine : 1u; nx = cnt > 0u ? cnt : 1u;
}

__device__ __forceinline__ void xcd_barrier(const XcdBarrier& b) {
    asm volatile("s_waitcnt vmcnt(0)" ::: "memory");
    __syncthreads();
    if (threadIdx.x == 0) {
        unsigned* bar = b.bar;
        __builtin_amdgcn_s_waitcnt(0);
        unsigned nloc = b.st[0], nx = b.st[1];
        if (nloc == 0u) { xcd_barrier_complete(bar, b.x, nloc, nx); b.st[0] = nloc; b.st[1] = nx; }
        const unsigned old = xb_add(&bar[XB_XSUB(b.x)], 1u);
        const unsigned gen = old / nloc;
        if (old + 1u == (gen + 1u) * nloc) {
            __builtin_amdgcn_fence(__ATOMIC_RELEASE, "agent");
            asm volatile("s_waitcnt vmcnt(0)" ::: "memory");
            const unsigned og = xb_add(&bar[XB_TOP], 1u);
            const unsigned tg = og / nx;
            if (og + 1u == (tg + 1u) * nx) xb_add(&bar[XB_TOPGEN], 1u);
            else XB_SPIN(xb_ld(&bar[XB_TOPGEN]) == tg, bar);
            __builtin_amdgcn_fence(__ATOMIC_ACQUIRE, "agent");
            xb_add(&bar[XB_XGEN(b.x)], 1u);
            asm volatile("s_waitcnt vmcnt(0)" ::: "memory");
        } else {
            XB_SPIN(xb_ld(&bar[XB_XGEN(b.x)]) == gen, bar);
            __builtin_amdgcn_fence(__ATOMIC_ACQUIRE, "agent");
            asm volatile("s_waitcnt vmcnt(0)" ::: "memory");
        }
    }
    __syncthreads();
}

using pg8::Unit;
typedef pg8::f32x4 af4;

struct EpiEvenIn {
    static constexpr bool PERM = true, AFTER_DRAIN = false;
    gbf16* P; const gfloat* cosT; const gfloat* sinT;
    DI void operator()(const af4 (&acc)[2][2][4][2], const Unit& u, int wr, int wc, int fr, int fq) const {
        const int row0 = u.pm * 256 + wr * 64 + fr, col0 = u.pn * 256 + wc * 32 + 8 * fq;
        const bool rope = (u.pn < 4) && (u.pm < 64);
        const float qs = (u.pn < 2) ? 0.18033688011112042f : 1.f;
#pragma unroll
        for (int ai = 0; ai < 2; ++ai)
#pragma unroll
            for (int m = 0; m < 4; ++m) {
                const int row = row0 + ai * 128 + m * 16;
                gbf16* rowp = P + (size_t)row * EVEN_IN + col0;
#pragma unroll
                for (int bj = 0; bj < 2; ++bj) {
                    af4 v0 = acc[ai][bj][m][0], v1 = acc[ai][bj][m][1];
                    if (rope) {
                        const int t = row & 4095, i0 = ((col0 + bj * 128) & 63) >> 1;
                        const af4 cs = *(const GAS af4*)(cosT + t * 32 + i0), sn = *(const GAS af4*)(sinT + t * 32 + i0);
                        af4 o0, o1;
                        o0[0] = v0[0] * cs[0] - v0[1] * sn[0]; o0[1] = v0[0] * sn[0] + v0[1] * cs[0];
                        o0[2] = v0[2] * cs[1] - v0[3] * sn[1]; o0[3] = v0[2] * sn[1] + v0[3] * cs[1];
                        o1[0] = v1[0] * cs[2] - v1[1] * sn[2]; o1[1] = v1[0] * sn[2] + v1[1] * cs[2];
                        o1[2] = v1[2] * cs[3] - v1[3] * sn[3]; o1[3] = v1[2] * sn[3] + v1[3] * cs[3];
                        v0 = o0; v1 = o1;
                    }
                    v0 = v0 * qs; v1 = v1 * qs;
                    u32x4 w; w[0] = pk2(v0[0], v0[1]); w[1] = pk2(v0[2], v0[3]); w[2] = pk2(v1[0], v1[1]); w[3] = pk2(v1[2], v1[3]);
                    *(GAS u32x4*)(rowp + bj * 128) = w;
                }
            }
    }
};
struct EpiBf16Ab {
    static constexpr bool PERM = true, AFTER_DRAIN = false;
    gbf16* O; int ldc; gfloat* AB; int ab_pn;
    DI void operator()(const af4 (&acc)[2][2][4][2], const Unit& u, int wr, int wc, int fr, int fq) const {
        const int row0 = u.pm * 256 + wr * 64 + fr, col0 = u.pn * 256 + wc * 32 + 8 * fq;
        if (u.pn == ab_pn) {
            if (wc == 0) {
#pragma unroll
                for (int ai = 0; ai < 2; ++ai)
#pragma unroll
                    for (int m = 0; m < 4; ++m) { gfloat* ap = AB + (size_t)(row0 + ai * 128 + m * 16) * 32 + 8 * fq; *(GAS af4*)ap = acc[ai][0][m][0]; *(GAS af4*)(ap + 4) = acc[ai][0][m][1]; }
            }
            return;
        }
#pragma unroll
        for (int ai = 0; ai < 2; ++ai)
#pragma unroll
            for (int m = 0; m < 4; ++m) {
                gbf16* rowp = O + (size_t)(row0 + ai * 128 + m * 16) * ldc + col0;
#pragma unroll
                for (int bj = 0; bj < 2; ++bj) { const af4 v0 = acc[ai][bj][m][0], v1 = acc[ai][bj][m][1];
                    u32x4 w; w[0] = pk2(v0[0], v0[1]); w[1] = pk2(v0[2], v0[3]); w[2] = pk2(v1[0], v1[1]); w[3] = pk2(v1[2], v1[3]);
                    *(GAS u32x4*)(rowp + bj * 128) = w; }
            }
    }
};
struct EpiSwiglu {
    static constexpr bool PERM = true, AFTER_DRAIN = false;
    gbf16* O; int ldc; int nN;
    DI void operator()(const af4 (&acc)[2][2][4][2], const Unit& u, int wr, int wc, int fr, int fq) const {
        const int row0 = u.pm * 256 + wr * 64 + fr, col0 = (u.pn % nN) * 128 + wc * 32 + 8 * fq;
#pragma unroll
        for (int ai = 0; ai < 2; ++ai)
#pragma unroll
            for (int m = 0; m < 4; ++m) {
                const af4 g0 = acc[ai][0][m][0], g1 = acc[ai][0][m][1], u0 = acc[ai][1][m][0], u1 = acc[ai][1][m][1];
                float r[8];
#pragma unroll
                for (int j = 0; j < 4; ++j) { r[j] = silu_(g0[j]) * u0[j]; r[4 + j] = silu_(g1[j]) * u1[j]; }
                u32x4 w; w[0] = pk2(r[0], r[1]); w[1] = pk2(r[2], r[3]); w[2] = pk2(r[4], r[5]); w[3] = pk2(r[6], r[7]);
                *(GAS u32x4*)(O + (size_t)(row0 + ai * 128 + m * 16) * ldc + col0) = w;
            }
    }
};
struct EpiResid {
    static constexpr bool PERM = false, AFTER_DRAIN = false;
    gfloat* X; const gfloat* gate;
    DI void operator()(const af4 (&acc)[2][2][4][2], const Unit& u, int wr, int wc, int fr, int fq) const {
        const int row0 = u.pm * 256 + wr * 64 + fr, col0 = u.pn * 256 + wc * 32 + 4 * fq;
        const gfloat* gv = gate + (size_t)(u.pm < 64 ? (u.pm >> 4) : 4) * MODW + col0;
        af4 g[2][2];
#pragma unroll
        for (int bj = 0; bj < 2; ++bj)
#pragma unroll
            for (int n = 0; n < 2; ++n) g[bj][n] = *(const GAS af4*)(gv + bj * 128 + n * 16);
#pragma unroll
        for (int ai = 0; ai < 2; ++ai)
#pragma unroll
            for (int m = 0; m < 4; ++m) { gfloat* rowp = X + (size_t)(row0 + ai * 128 + m * 16) * D + col0;
#pragma unroll
                for (int bj = 0; bj < 2; ++bj)
#pragma unroll
                    for (int n = 0; n < 2; ++n) { GAS af4* p = (GAS af4*)(rowp + bj * 128 + n * 16); *p = *p + g[bj][n] * acc[ai][bj][m][n]; } }
    }
};
struct EpiPart {
    static constexpr bool PERM = false, AFTER_DRAIN = false;
    gfloat* PART;
    DI void operator()(const af4 (&acc)[2][2][4][2], const Unit& u, int wr, int wc, int fr, int fq) const {
        const int row0 = u.pm * 256 + wr * 64 + fr, col0 = u.pn * 256 + wc * 32 + 4 * fq;
        gfloat* base = PART + (size_t)u.pk * NCTX * D;
#pragma unroll
        for (int ai = 0; ai < 2; ++ai)
#pragma unroll
            for (int m = 0; m < 4; ++m) { gfloat* rowp = base + (size_t)(row0 + ai * 128 + m * 16) * D + col0;
#pragma unroll
                for (int bj = 0; bj < 2; ++bj)
#pragma unroll
                    for (int n = 0; n < 2; ++n) *(GAS af4*)(rowp + bj * 128 + n * 16) = acc[ai][bj][m][n]; }
    }
};
struct EpiF32 {
    static constexpr bool PERM = false, AFTER_DRAIN = false;
    gfloat* C; int ldc; int nN;
    DI void operator()(const af4 (&acc)[2][2][4][2], const Unit& u, int wr, int wc, int fr, int fq) const {
        const int row0 = u.pm * 256 + wr * 64 + fr, col0 = (u.pn % nN) * 256 + wc * 32 + 4 * fq;
#pragma unroll
        for (int ai = 0; ai < 2; ++ai)
#pragma unroll
            for (int m = 0; m < 4; ++m) { gfloat* rowp = C + (size_t)(row0 + ai * 128 + m * 16) * ldc + col0;
#pragma unroll
                for (int bj = 0; bj < 2; ++bj)
#pragma unroll
                    for (int n = 0; n < 2; ++n) *(GAS af4*)(rowp + bj * 128 + n * 16) = acc[ai][bj][m][n]; }
    }
};
struct MoeOrder : pg8::StaticOrder {
    int tend[8];
    __device__ void initm(const guint* cnt, int nN_, int G_, int c_) {
        int acc = 0;
#pragma unroll
        for (int e = 0; e < 8; ++e) { acc += ((int)cnt[e] + 255) >> 8; tend[e] = acc; }
        nM = acc; nN = nN_; nwg = nM * nN; G = G_; c = c_; lim = nwg; L0 = 0; s = 1;
    }
    __device__ bool next(int i, Unit& u) const {
        if (!pg8::StaticOrder::next(i, u)) return false;
        int e = 0;
#pragma unroll
        for (int k = 0; k < 7; ++k) e += (u.pm >= tend[k]) ? 1 : 0;
        u.pn += e * nN; return true;
    }
};

struct MoeOrder2 {
    int tend[8]; int nM, nwg, G, c, Lmain, r, s, tail;
    __device__ __forceinline__ void initm(const guint* cnt, int G_, int c_, int tail_) {
        int acc = 0;
#pragma unroll
        for (int e = 0; e < 8; ++e) { acc += ((int)cnt[e] + 255) >> 8; tend[e] = acc; }
        nM = acc; nwg = nM * 4; G = G_; c = c_; tail = tail_; Lmain = (nwg / G) * G; r = nwg - Lmain;
        s = 1; if (r > 0) { const int q = G / r; s = q >= 14 ? 14 : (q >= 7 ? 7 : (q >= 4 ? 4 : (q >= 2 ? 2 : 1))); }
    }
    __device__ __forceinline__ int tail_row0() const { return (Lmain >> 2) * 256; }
    __device__ __forceinline__ bool next(int i, Unit& u) const {
        const int j = i * G + c; int Lp;
        if (!tail) { if (j >= Lmain) return false; Lp = (j & 7) * (Lmain >> 3) + (j >> 3); u.pk = 0; }
        else { if (j >= r * s) return false; Lp = Lmain + j / s; u.pk = j % s; }
        u.pm = Lp >> 2; int e = 0;
#pragma unroll
        for (int k = 0; k < 7; ++k) e += (u.pm >= tend[k]) ? 1 : 0;
        u.pn = e * 4 + (Lp & 3); return true;
    }
    __device__ __forceinline__ void a_ready(const Unit&) const {}
    __device__ __forceinline__ void done(const Unit&) const {}
};
struct EpiPartY {
    static constexpr bool PERM = false, AFTER_DRAIN = false;
    gfloat* YP; int pm0, tail_rows;
    DI void operator()(const af4 (&acc)[2][2][4][2], const Unit& u, int wr, int wc, int fr, int fq) const {
        const int row0 = (u.pm - pm0) * 256 + wr * 64 + fr, col0 = (u.pn & 3) * 256 + wc * 32 + 4 * fq;
        gfloat* base = YP + (size_t)u.pk * tail_rows * D;
#pragma unroll
        for (int ai = 0; ai < 2; ++ai)
#pragma unroll
            for (int m = 0; m < 4; ++m) { gfloat* rowp = base + (size_t)(row0 + ai * 128 + m * 16) * D + col0;
#pragma unroll
                for (int bj = 0; bj < 2; ++bj)
#pragma unroll
                    for (int n = 0; n < 2; ++n) *(GAS af4*)(rowp + bj * 128 + n * 16) = acc[ai][bj][m][n]; }
    }
};
DI void transpose_load(f32x4 (&v)[8], const gfloat* W, int ldw, int k0, int n0, int lane) {
#pragma unroll
    for (int i = 0; i < 8; ++i) v[i] = *(const GAS f32x4*)(W + (size_t)(k0 + 8 * i + (lane >> 3)) * ldw + n0 + 4 * (lane & 7));
}
DI void transpose_store(const f32x4 (&v)[8], int K, gbf16* WT, int k0, int drow0, LAS float* scr, int lane) {
#pragma unroll
    for (int i = 0; i < 8; ++i) { LAS float* d = scr + (8 * i + (lane >> 3)) * 33 + 4 * (lane & 7); d[0] = v[i][0]; d[1] = v[i][1]; d[2] = v[i][2]; d[3] = v[i][3]; }
    asm volatile("s_waitcnt lgkmcnt(0)" ::: "memory");
    const int c = lane & 7;
#pragma unroll
    for (int j = 0; j < 4; ++j) { const int n = (lane >> 3) + 8 * j; const LAS float* s = scr + (8 * c) * 33 + n;
        u32x4 o; o[0] = pk2(s[0 * 33], s[1 * 33]); o[1] = pk2(s[2 * 33], s[3 * 33]); o[2] = pk2(s[4 * 33], s[5 * 33]); o[3] = pk2(s[6 * 33], s[7 * 33]);
        *(GAS u32x4*)(WT + (size_t)(drow0 + n) * K + k0 + 8 * c) = o; }
    asm volatile("s_waitcnt lgkmcnt(0)" ::: "memory");
}
struct TJob { const gfloat* W; gbf16* WT; int ldw, K, N, F; };
DI int tjob_items(const TJob& j) { return (j.K / 64) * (j.N / 32); }
DI TJob get_tjob(const Params& p, int j) {
    const int i = j / 22, r = j % 22; unsigned char* ws = p.ws; TJob t;
    if (r == 0) t = TJob{gin(p, 9) + (size_t)i * D * EVEN_IN, (gbf16*)(ws + WS_WEIN) + (size_t)i * 2560 * 1024, EVEN_IN, D, EVEN_IN, 0};
    else if (r == 1) t = TJob{gin(p, 10) + (size_t)i * D * D, (gbf16*)(ws + WS_WEOUT) + (size_t)i * 1024 * 1024, D, D, D, 0};
    else if (r == 2) t = TJob{gin(p, 20) + (size_t)i * D * 2 * FFN, (gbf16*)(ws + WS_WEF1) + (size_t)i * 5632 * 1024, 2 * FFN, D, 2 * FFN, FFN};
    else if (r == 3) t = TJob{gin(p, 21) + (size_t)i * FFN * D, (gbf16*)(ws + WS_WEF2) + (size_t)i * 1024 * 2816, D, FFN, D, 0};
    else if (r == 4) t = TJob{gin(p, 22) + (size_t)i * D * ODD_IN, (gbf16*)(ws + WS_WOIN) + (size_t)i * 4352 * 1024, ODD_IN, D, ODD_IN, 0};
    else if (r == 5) t = TJob{gin(p, 27) + (size_t)i * D * D, (gbf16*)(ws + WS_WOOUT) + (size_t)i * 1024 * 1024, D, D, D, 0};
    else if (r < 14) { const int e = r - 6; t = TJob{gin(p, 29) + ((size_t)i * 8 + e) * D * 2 * FFE, (gbf16*)(ws + WS_WXIN) + ((size_t)i * 8 + e) * 7168 * 1024, 2 * FFE, D, 2 * FFE, FFE}; }
    else { const int e = r - 14; t = TJob{gin(p, 30) + ((size_t)i * 8 + e) * FFE * D, (gbf16*)(ws + WS_WXOUT) + ((size_t)i * 8 + e) * 1024 * 3584, D, FFE, D, 0}; }
    return t;
}
#ifndef CONV_DEFER
#define CONV_DEFER 1
#endif
DI void convert_weights(const Ctx& C, const Params& p, int group, int gw, int NGW) {
    LAS float* scr = (LAS float*)(C.lds + 32768 + C.wave * 8704);
    int jstart = 0;
    for (int j = 0; j < 44; ++j) {
        const int gj = j < 6 ? 0 : (j < 28 ? 1 : 2);
        if (gj != group) continue;
        const TJob t = get_tjob(p, j); const int ni = tjob_items(t), nblkN = t.N / 32;
        const int first = (gw - jstart % NGW + NGW) % NGW;
        auto item_geom = [&](int it, int& k0, int& n0, int& drow0) { const int kb = it / nblkN, nb = it % nblkN; k0 = kb * 64; n0 = nb * 32; drow0 = n0;
            if (t.F > 0) drow0 = (n0 < t.F) ? ((n0 / 128) * 256 + (n0 % 128)) : (((n0 - t.F) / 128) * 256 + 128 + ((n0 - t.F) % 128)); };
        f32x4 va[8], vb[8], vc[8]; int k0 = 0, n0 = 0, d0 = 0, k1 = 0, n1 = 0, d1 = 0;
        if (first < ni) { item_geom(first, k0, n0, d0); transpose_load(va, t.W, t.ldw, k0, n0, C.lane); }
        if (first + NGW < ni) { item_geom(first + NGW, k1, n1, d1); transpose_load(vb, t.W, t.ldw, k1, n1, C.lane); }
        for (int it = first; it < ni; it += NGW) {
            const int nx = it + 2 * NGW; int k2 = 0, n2 = 0, d2 = 0;
            if (nx < ni) { item_geom(nx, k2, n2, d2); transpose_load(vc, t.W, t.ldw, k2, n2, C.lane); }
            transpose_store(va, t.K, t.WT, k0, d0, scr, C.lane);
#pragma unroll
            for (int q = 0; q < 8; ++q) { va[q] = vb[q]; vb[q] = vc[q]; }
            k0 = k1; n0 = n1; d0 = d1; k1 = k2; n1 = n2; d1 = d2;
        }
        jstart += ni;
    }
}
DI void ph_prologue(const Ctx& C, const Params& p) {
    LAS float* sil = (LAS float*)(C.lds);
    for (int i = C.tid; i < 5 * 1024; i += 512) { const int v = i >> 10, k = i & 1023; const float x = v < 4 ? gin(p, 1)[v * 1024 + k] : gin(p, 3)[k]; sil[i] = x / (1.f + expf(-x)); }
    __syncthreads();
    const int gw = C.blk * 8 + C.wave, NGW = C.nblk * 8;
    gfloat* MOD = (gfloat*)(C.ws + WS_MOD);
    for (int it = gw; it < DEPTH * (MODW / 64); it += NGW) {
        const int l = it / (MODW / 64), n = (it % (MODW / 64)) * 64 + C.lane;
        const gfloat* w = gin(p, 4) + (size_t)l * 1024 * MODW + n;
        float a0 = 0.f, a1 = 0.f, a2 = 0.f, a3 = 0.f, a4 = 0.f;
#pragma unroll 8
        for (int k = 0; k < 1024; ++k) { const float wv = w[(size_t)k * MODW]; a0 += sil[k] * wv; a1 += sil[1024 + k] * wv; a2 += sil[2048 + k] * wv; a3 += sil[3072 + k] * wv; a4 += sil[4096 + k] * wv; }
        const float bb = gin(p, 5)[l * MODW + n];
        MOD[(size_t)(l * 5 + 0) * MODW + n] = a0 + bb; MOD[(size_t)(l * 5 + 1) * MODW + n] = a1 + bb; MOD[(size_t)(l * 5 + 2) * MODW + n] = a2 + bb;
        MOD[(size_t)(l * 5 + 3) * MODW + n] = a3 + bb; MOD[(size_t)(l * 5 + 4) * MODW + n] = a4 + bb;
    }
    { gfloat* cosT = (gfloat*)(C.ws + WS_COS); gfloat* sinT = (gfloat*)(C.ws + WS_SIN);
      for (int idx = C.blk * 512 + C.tid; idx < SEQ * 32; idx += C.nblk * 512) { const int t = idx >> 5, i = idx & 31;
          const float invf = powf(10000.f, -(float)(i & 15) / 16.f); const float ang = (i < 16 ? (float)(t >> 6) : (float)(t & 63)) * invf;
          cosT[idx] = cosf(ang); sinT[idx] = sinf(ang); } }
    { for (int i = 0; i < 2; ++i) { GAS u32x4* z = (GAS u32x4*)((gbf16*)(C.ws + WS_WOIN) + (size_t)i * 4352 * 1024 + (size_t)4128 * 1024);
          for (int idx = C.blk * 512 + C.tid; idx < 224 * 1024 / 8; idx += C.nblk * 512) z[idx] = (u32x4){0u, 0u, 0u, 0u}; } }
    convert_weights(C, p, 0, gw, NGW);
#if CONV_DEFER == 0
    convert_weights(C, p, 1, gw, NGW); convert_weights(C, p, 2, gw, NGW);
#endif
}

DI void normmod_regs(f32x4 (&v)[4], const gfloat* g, const gfloat* shift, const gfloat* scale, int lane) {
    float ss = 0.f;
#pragma unroll
    for (int j = 0; j < 4; ++j) ss += (v[j][0] * v[j][0] + v[j][1] * v[j][1]) + (v[j][2] * v[j][2] + v[j][3] * v[j][3]);
    const float rs = rsqrtf(wave_sum(ss, lane) * (1.f / D) + 1e-6f);
#pragma unroll
    for (int j = 0; j < 4; ++j) { const f32x4 gg = ((const GAS f32x4*)g)[lane + 64 * j], sh = ((const GAS f32x4*)shift)[lane + 64 * j], sc = ((const GAS f32x4*)scale)[lane + 64 * j];
        v[j] = v[j] * rs * gg * (sc + 1.f) + sh; }
}
DI void store_row_bf16(gbf16* orow, const f32x4 (&v)[4], int lane) {
#pragma unroll
    for (int j = 0; j < 4; ++j) { u32x2 w; w[0] = pk2(v[j][0], v[j][1]); w[1] = pk2(v[j][2], v[j][3]); ((GAS u32x2*)orow)[lane + 64 * j] = w; }
}
DI void add_ctx_partials(const Ctx& C, f32x4 (&v)[4], int r, int npart, const gfloat* gate_ctx, gfloat* Xrow) {
    const gfloat* PART = (const gfloat*)(C.ws + WS_PART) + (size_t)(r - NLAT) * D;
#pragma unroll
    for (int j = 0; j < 4; ++j) { f32x4 a = (f32x4){0.f, 0.f, 0.f, 0.f};
        for (int pk = 0; pk < npart; ++pk) a = a + ((const GAS f32x4*)(PART + (size_t)pk * NCTX * D))[C.lane + 64 * j];
        v[j] = v[j] + ((const GAS f32x4*)gate_ctx)[C.lane + 64 * j] * a; ((GAS f32x4*)Xrow)[C.lane + 64 * j] = v[j]; }
}
DI void ph_normmod(const Ctx& C, const Params& p, int layer, bool second, bool from_input, int npart, int gate_off) {
    const int gw = C.blk * 8 + C.wave, NGW = C.nblk * 8;
    gfloat* X = (gfloat*)(C.ws + WS_X); gbf16* H = (gbf16*)(C.ws + WS_H);
    const gfloat* MODl = (const gfloat*)(C.ws + WS_MOD) + (size_t)layer * 5 * MODW;
    const gfloat* g = (second ? gin(p, 7) : gin(p, 6)) + layer * D;
    auto srcrow = [&](int r) { return from_input ? (r < NLAT ? gin(p, 0) + (size_t)r * D : gin(p, 2) + (size_t)(r - NLAT) * D) : (const gfloat*)X + (size_t)r * D; };
    f32x4 v[4], vn[4];
    if (gw < NTOK) { const gfloat* src = srcrow(gw);
#pragma unroll
        for (int j = 0; j < 4; ++j) v[j] = ((const GAS f32x4*)src)[C.lane + 64 * j]; }
    for (int r = gw; r < NTOK; r += NGW) {
        const int rn = r + NGW;
        if (rn < NTOK) { const gfloat* src = srcrow(rn);
#pragma unroll
            for (int j = 0; j < 4; ++j) vn[j] = ((const GAS f32x4*)src)[C.lane + 64 * j]; }
        if (from_input) {
#pragma unroll
            for (int j = 0; j < 4; ++j) ((GAS f32x4*)(X + (size_t)r * D))[C.lane + 64 * j] = v[j]; }
        if (npart > 0 && r >= NLAT) add_ctx_partials(C, v, r, npart, (const gfloat*)(C.ws + WS_MOD) + gate_off + 4 * MODW, X + (size_t)r * D);
        const gfloat* mv = MODl + (size_t)(r < NLAT ? (r >> 12) : 4) * MODW + (second ? 3 * D : 0);
        normmod_regs(v, g, mv, mv + D, C.lane);
        store_row_bf16(H + (size_t)r * D, v, C.lane);
#pragma unroll
        for (int j = 0; j < 4; ++j) v[j] = vn[j];
    }
}

DI void seq_bounds(int r, int& s0, int& s1) { if (r < NLAT) { s0 = r & ~4095; s1 = s0 + 4096; } else { s0 = NLAT + ((r - NLAT) & ~255); s1 = s0 + 256; } }

DI void ph_odd_conv(const Ctx& C, const Params& p, int i) {
    const int gw = C.blk * 8 + C.wave, NGW = C.nblk * 8;
    const gbf16* PO = (const gbf16*)(C.ws + WS_P); gbf16* QKVN = (gbf16*)(C.ws + WS_QKVN);
    const gfloat* AB = (const gfloat*)(C.ws + WS_AB); gfloat* Gd = (gfloat*)(C.ws + WS_GB); gfloat* Bd = Gd + (size_t)2 * NTOK * 8;
    const gfloat* cw = gin(p, 23) + (size_t)i * 4 * 3072;
    for (int u = gw; u < NCH * 6; u += NGW) {
        const int strip = u / 6, cgp = u % 6, r0 = strip * 64, c = cgp * 512 + 8 * C.lane;
        int s0, s1; seq_bounds(r0, s0, s1);
        float w[4][8];
#pragma unroll
        for (int tp = 0; tp < 4; ++tp) { const f32x4 w0 = *(const GAS f32x4*)(cw + tp * 3072 + c), w1 = *(const GAS f32x4*)(cw + tp * 3072 + c + 4);
#pragma unroll
            for (int e = 0; e < 4; ++e) { w[tp][e] = w0[e]; w[tp][4 + e] = w1[e]; } }
        u32x4 win[4];
        const u32x4 zz = (u32x4){0u, 0u, 0u, 0u};
        win[1] = (r0 - 2 >= s0) ? *(const GAS u32x4*)(PO + (size_t)(r0 - 2) * 4352 + c) : zz;
        win[2] = (r0 - 1 >= s0) ? *(const GAS u32x4*)(PO + (size_t)(r0 - 1) * 4352 + c) : zz;
        win[3] = *(const GAS u32x4*)(PO + (size_t)r0 * 4352 + c);
#pragma unroll 4
        for (int rr = 0; rr < 64; ++rr) {
            const int r = r0 + rr;
            win[0] = win[1]; win[1] = win[2]; win[2] = win[3];
            win[3] = (r + 1 < s1) ? *(const GAS u32x4*)(PO + (size_t)(r + 1) * 4352 + c) : zz;
            float a[8] = {0.f, 0.f, 0.f, 0.f, 0.f, 0.f, 0.f, 0.f};
#pragma unroll
            for (int tp = 0; tp < 4; ++tp) { const u32x4 x = win[tp];
                a[0] += w[tp][0] * bflo(x[0]); a[1] += w[tp][1] * bfhi(x[0]); a[2] += w[tp][2] * bflo(x[1]); a[3] += w[tp][3] * bfhi(x[1]);
                a[4] += w[tp][4] * bflo(x[2]); a[5] += w[tp][5] * bfhi(x[2]); a[6] += w[tp][6] * bflo(x[3]); a[7] += w[tp][7] * bfhi(x[3]); }
            float ss = 0.f;
#pragma unroll
            for (int e = 0; e < 8; ++e) { a[e] = silu_(a[e]); ss += a[e] * a[e]; }
            if (cgp < 4) {
                ss += shx(ss, 1, C.lane); ss += shx(ss, 2, C.lane); ss += shx(ss, 4, C.lane); ss += shx(ss, 8, C.lane);
                const float rn = rsqrtf(ss + 1e-6f);
#pragma unroll
                for (int e = 0; e < 8; ++e) a[e] *= rn;
            }
            u32x4 o; o[0] = pk2(a[0], a[1]); o[1] = pk2(a[2], a[3]); o[2] = pk2(a[4], a[5]); o[3] = pk2(a[6], a[7]);
            *(GAS u32x4*)(QKVN + (size_t)r * 3072 + c) = o;
        }
    }
    for (int r = gw * 4 + (C.lane >> 4); r < NTOK; r += NGW * 4) { const int l16 = C.lane & 15, d = l16 >> 3, h = l16 & 7;
        const float x0 = AB[(size_t)r * 32 + d * 16 + h], x1 = AB[(size_t)r * 32 + d * 16 + 8 + h];
        Gd[((size_t)d * NTOK + r) * 8 + h] = -expf(gin(p, 24)[i * 16 + d * 8 + h]) * softplus_(x0 + gin(p, 25)[i * 16 + d * 8 + h]);
        Bd[((size_t)d * NTOK + r) * 8 + h] = 1.f / (1.f + expf(-x1)); }
}
DI void ph_gdn_out(const Ctx& C, const Params& p, int i) {
    const int gw = C.blk * 8 + C.wave, NGW = C.nblk * 8;
    const gfloat* OG = (const gfloat*)(C.ws + WS_OG); const gbf16* PO = (const gbf16*)(C.ws + WS_P); gbf16* MIX = (gbf16*)(C.ws + WS_MIX);
    const f32x4 go = ((const GAS f32x4*)(gin(p, 26) + i * 128))[C.lane & 31];
    f32x4 ca[4], cb[4], na[4], nb[4]; u32x2 cz[4], nz[4];
#define GO_LOAD(r_, A_, B_, Z_) do { _Pragma("unroll") for (int j = 0; j < 4; ++j) { A_[j] = ((const GAS f32x4*)(OG + (size_t)(r_) * D))[C.lane + 64 * j]; B_[j] = ((const GAS f32x4*)(OG + ((size_t)NTOK + (r_)) * D))[C.lane + 64 * j]; \
        Z_[j] = *(const GAS u32x2*)(PO + (size_t)(r_) * 4352 + 3072 + 4 * C.lane + 256 * j); } } while (0)
    if (gw < NTOK) GO_LOAD(gw, ca, cb, cz);
    for (int r = gw; r < NTOK; r += NGW) {
        const int rn = r + NGW;
        if (rn < NTOK) GO_LOAD(rn, na, nb, nz);
#pragma unroll
        for (int j = 0; j < 4; ++j) {
            f32x4 o = ca[j] + cb[j];
            float ss = (o[0] * o[0] + o[1] * o[1]) + (o[2] * o[2] + o[3] * o[3]);
            ss += shx(ss, 1, C.lane); ss += shx(ss, 2, C.lane); ss += shx(ss, 4, C.lane); ss += shx(ss, 8, C.lane); ss += shx(ss, 16, C.lane);
            const float rs = rsqrtf(ss * (1.f / 128.f) + 1e-6f);
            const u32x2 z = cz[j];
            o[0] *= rs * go[0] * silu_(bflo(z[0])); o[1] *= rs * go[1] * silu_(bfhi(z[0])); o[2] *= rs * go[2] * silu_(bflo(z[1])); o[3] *= rs * go[3] * silu_(bfhi(z[1]));
            u32x2 w; w[0] = pk2(o[0], o[1]); w[1] = pk2(o[2], o[3]);
            ((GAS u32x2*)(MIX + (size_t)r * D))[C.lane + 64 * j] = w;
        }
#pragma unroll
        for (int j = 0; j < 4; ++j) { ca[j] = na[j]; cb[j] = nb[j]; cz[j] = nz[j]; }
    }
#undef GO_LOAD
}
struct TokInfo { int e0, p0, e1, p1; float w0, w1; int r0, r1; };
DI void ti_store(GAS TokInfo* q, const TokInfo& t) { u32x4 a, b; a[0] = (unsigned)t.e0; a[1] = (unsigned)t.p0; a[2] = (unsigned)t.e1; a[3] = (unsigned)t.p1; b[0] = __float_as_uint(t.w0); b[1] = __float_as_uint(t.w1); b[2] = (unsigned)t.r0; b[3] = (unsigned)t.r1;
    ((GAS u32x4*)q)[0] = a; ((GAS u32x4*)q)[1] = b; }
DI TokInfo ti_load(const GAS TokInfo* q) { const u32x4 a = ((const GAS u32x4*)q)[0], b = ((const GAS u32x4*)q)[1]; TokInfo t; t.e0 = (int)a[0]; t.p0 = (int)a[1]; t.e1 = (int)a[2]; t.p1 = (int)a[3]; t.w0 = __uint_as_float(b[0]); t.w1 = __uint_as_float(b[1]); t.r0 = (int)b[2]; t.r1 = (int)b[3]; return t; }
DI void ph_router(const Ctx& C, const Params& p, int layer, int ntok, int npart) {
    const int gw = C.blk * 8 + C.wave, NGW = C.nblk * 8, i = layer >> 1;
    gfloat* X = (gfloat*)(C.ws + WS_X); gbf16* H = (gbf16*)(C.ws + WS_H);
    const gfloat* MODl = (const gfloat*)(C.ws + WS_MOD) + (size_t)layer * 5 * MODW;
    const gfloat* g = gin(p, 7) + layer * D; const gfloat* wr = gin(p, 28) + (size_t)i * D * 8;
    guint* bc = (guint*)(C.ws + WS_CTL) + CW_BC + (i * 1024 + C.blk) * 8; GAS TokInfo* TI = (GAS TokInfo*)(C.ws + WS_TOK);
    LAS int* sl = (LAS int*)(C.lds + 64);
    for (int q = C.tid; q < 96 * 6; q += 512) sl[q] = -1;
    __syncthreads();
    int k = 0;
    for (int r = gw; r < NTOK; r += NGW, ++k) {
        f32x4 v[4];
#pragma unroll
        for (int j = 0; j < 4; ++j) v[j] = ((const GAS f32x4*)(X + (size_t)r * D))[C.lane + 64 * j];
        if (npart > 0 && r >= NLAT) add_ctx_partials(C, v, r, npart, MODl + 4 * MODW + 2 * D, X + (size_t)r * D);
        const gfloat* mv = MODl + (size_t)(r < NLAT ? (r >> 12) : 4) * MODW + 3 * D;
        normmod_regs(v, g, mv, mv + D, C.lane);
        store_row_bf16(H + (size_t)r * D, v, C.lane);
        if (r >= ntok) continue;
        float lg[8] = {0.f, 0.f, 0.f, 0.f, 0.f, 0.f, 0.f, 0.f};
#pragma unroll
        for (int j = 0; j < 4; ++j)
#pragma unroll
            for (int q = 0; q < 4; ++q) { const int kk = 4 * C.lane + 256 * j + q; const f32x4 w0 = *(const GAS f32x4*)(wr + kk * 8), w1 = *(const GAS f32x4*)(wr + kk * 8 + 4); const float x = v[j][q];
                lg[0] += x * w0[0]; lg[1] += x * w0[1]; lg[2] += x * w0[2]; lg[3] += x * w0[3]; lg[4] += x * w1[0]; lg[5] += x * w1[1]; lg[6] += x * w1[2]; lg[7] += x * w1[3]; }
#pragma unroll
        for (int e = 0; e < 8; ++e) lg[e] = wave_sum(lg[e], C.lane);
        if (C.lane == 0) {
            int e0 = 0; float b0 = lg[0];
#pragma unroll
            for (int e = 1; e < 8; ++e) if (lg[e] > b0) { e0 = e; b0 = lg[e]; }
            int e1 = -1; float b1 = -INFINITY;
#pragma unroll
            for (int e = 0; e < 8; ++e) if (e != e0 && lg[e] > b1) { e1 = e; b1 = lg[e]; }
            const float w1 = 1.f / (1.f + expf(b0 - b1)), w0 = 1.f - w1;
            LAS int* s = sl + (k * 8 + C.wave) * 6;
            s[0] = e0; s[1] = e1; s[2] = __float_as_int(w0); s[3] = __float_as_int(w1);
        }
    }
    __syncthreads();
    if (C.tid < 192) { const int q = C.tid, sq = q >> 1, wq = q & 1, e = sl[sq * 6 + wq]; int rk = 0;
        if (e >= 0) {
#pragma clang loop vectorize(disable) unroll(disable)
            for (int q2 = 0; q2 < q; ++q2) rk += (sl[(q2 >> 1) * 6 + (q2 & 1)] == e) ? 1 : 0; sl[sq * 6 + 4 + wq] = rk; } }
    if (C.tid < 8) { int c8 = 0;
#pragma clang loop vectorize(disable) unroll(disable)
        for (int q2 = 0; q2 < 192; ++q2) c8 += (sl[(q2 >> 1) * 6 + (q2 & 1)] == C.tid) ? 1 : 0; bc[C.tid] = (unsigned)c8; }
    __syncthreads();
    if (C.lane == 0) { int k2 = 0;
        for (int r = gw; r < ntok; r += NGW, ++k2) { const LAS int* s = sl + (k2 * 8 + C.wave) * 6;
            TokInfo t; t.e0 = s[0]; t.e1 = s[1]; t.p0 = s[4]; t.p1 = s[5]; t.w0 = __int_as_float(s[2]); t.w1 = __int_as_float(s[3]); t.r0 = 0; t.r1 = 0;
            ti_store(TI + r, t); } }
    __syncthreads();
}
DI void ph_gather(const Ctx& C, int layer, int ntok) {
    const int gw = C.blk * 8 + C.wave, NGW = C.nblk * 8, i = layer >> 1;
    GAS TokInfo* TI = (GAS TokInfo*)(C.ws + WS_TOK);
    const gbf16* H = (const gbf16*)(C.ws + WS_H); gbf16* XS = (gbf16*)(C.ws + WS_XS);
    LAS int* red = (LAS int*)C.lds;
    if (C.tid < 16) red[C.tid] = 0;
    __syncthreads();
    { const guint* bcb = (const guint*)(C.ws + WS_CTL) + CW_BC + (size_t)i * 1024 * 8; int tot[8] = {0, 0, 0, 0, 0, 0, 0, 0}, pre[8] = {0, 0, 0, 0, 0, 0, 0, 0};
#pragma clang loop vectorize(disable) unroll(disable)
      for (int t = C.tid; t < C.nblk; t += 512) { const u32x4 a = *(const GAS u32x4*)(bcb + t * 8), b2 = *(const GAS u32x4*)(bcb + t * 8 + 4);
#pragma unroll
          for (int e = 0; e < 4; ++e) { tot[e] += (int)a[e]; tot[4 + e] += (int)b2[e]; if (t < C.blk) { pre[e] += (int)a[e]; pre[4 + e] += (int)b2[e]; } } }
#pragma unroll
      for (int e = 0; e < 8; ++e) { const int ts = (int)wave_sum((float)tot[e], C.lane), ps = (int)wave_sum((float)pre[e], C.lane);
          if (C.lane == 0) { (void)__hip_atomic_fetch_add(red + e, ts, __ATOMIC_RELAXED, __HIP_MEMORY_SCOPE_WORKGROUP); (void)__hip_atomic_fetch_add(red + 8 + e, ps, __ATOMIC_RELAXED, __HIP_MEMORY_SCOPE_WORKGROUP); } } }
    __syncthreads();
    int base[8], cn[8], pref[8]; { int acc = 0;
#pragma unroll
        for (int e = 0; e < 8; ++e) { cn[e] = red[e]; pref[e] = red[8 + e]; base[e] = acc * 256 + pref[e]; acc += (cn[e] + 255) >> 8; } }
    if (C.blk == 0 && C.tid < 8) ((guint*)(C.ws + WS_CTL) + CW_CNT + i * 64)[C.tid] = (unsigned)red[C.tid];
    for (int r = gw; r < ntok; r += NGW) {
        const TokInfo t = ti_load(TI + r);
        int b0 = 0, b1 = 0;
#pragma unroll
        for (int e = 0; e < 8; ++e) { b0 = (t.e0 == e) ? base[e] : b0; b1 = (t.e1 == e) ? base[e] : b1; }
        const int r0 = b0 + t.p0, r1 = b1 + t.p1;
        const u32x4 a = ((const GAS u32x4*)(H + (size_t)r * D))[C.lane], b = ((const GAS u32x4*)(H + (size_t)r * D))[C.lane + 64];
        ((GAS u32x4*)(XS + (size_t)r0 * D))[C.lane] = a; ((GAS u32x4*)(XS + (size_t)r0 * D))[C.lane + 64] = b;
        ((GAS u32x4*)(XS + (size_t)r1 * D))[C.lane] = a; ((GAS u32x4*)(XS + (size_t)r1 * D))[C.lane + 64] = b;
        if (C.lane == 0) { ((GAS int*)(TI + r))[6] = r0; ((GAS int*)(TI + r))[7] = r1; }
    }
    for (int pr = gw; pr < 8 * 256; pr += NGW) {
        const int e = pr >> 8, j = pr & 255; int be = 0, ce = 0;
#pragma unroll
        for (int k = 0; k < 8; ++k) { be = (e == k) ? base[k] - pref[k] : be; ce = (e == k) ? cn[k] : ce; }
        const int lim = ((ce + 255) >> 8) << 8;
        if (ce + j < lim) { GAS u32x4* z = (GAS u32x4*)(XS + (size_t)(be + ce + j) * D); z[C.lane] = (u32x4){0u, 0u, 0u, 0u}; z[C.lane + 64] = (u32x4){0u, 0u, 0u, 0u}; }
    }
}
DI void ph_combine(const Ctx& C, const Params& p, int layer, int ntok, const guint* cnt) {
    int nM_ = 0;
#pragma unroll
    for (int e = 0; e < 8; ++e) nM_ += ((int)cnt[e] + 255) >> 8;
    const int nwg_ = nM_ * 4, Lm_ = (nwg_ / C.nblk) * C.nblk, r_ = nwg_ - Lm_; int ts = 1;
    if (r_ > 0) { const int q = C.nblk / r_; ts = q >= 14 ? 14 : (q >= 7 ? 7 : (q >= 4 ? 4 : (q >= 2 ? 2 : 1))); }
    const int trow0 = (Lm_ >> 2) * 256, trows = (r_ >> 2) * 256; const gfloat* YP = (const gfloat*)(C.ws + WS_YP);
    const int gw = C.blk * 8 + C.wave, NGW = C.nblk * 8;
    gfloat* X = (gfloat*)(C.ws + WS_X); gbf16* H = (gbf16*)(C.ws + WS_H); const gfloat* Y = (const gfloat*)(C.ws + WS_Y); const GAS TokInfo* TI = (const GAS TokInfo*)(C.ws + WS_TOK);
    const gfloat* MODl = (const gfloat*)(C.ws + WS_MOD) + (size_t)layer * 5 * MODW;
    const bool last = (layer == DEPTH - 1);
    const int nrows = last ? NLAT : NTOK;
    for (int r = gw; r < nrows; r += NGW) {
        f32x4 v[4];
#pragma unroll
        for (int j = 0; j < 4; ++j) v[j] = ((const GAS f32x4*)(X + (size_t)r * D))[C.lane + 64 * j];
        if (r < ntok) {
            const TokInfo t = ti_load(TI + r);
            const gfloat* ga = MODl + (size_t)(r < NLAT ? (r >> 12) : 4) * MODW + 5 * D;
#pragma unroll
            for (int j = 0; j < 4; ++j) { f32x4 y0, y1; const f32x4 gg = ((const GAS f32x4*)ga)[C.lane + 64 * j];
                if (t.r0 < trow0) y0 = ((const GAS f32x4*)(Y + (size_t)t.r0 * D))[C.lane + 64 * j];
                else { y0 = (f32x4){0.f, 0.f, 0.f, 0.f}; for (int pk = 0; pk < ts; ++pk) y0 = y0 + ((const GAS f32x4*)(YP + ((size_t)pk * trows + (t.r0 - trow0)) * D))[C.lane + 64 * j]; }
                if (t.r1 < trow0) y1 = ((const GAS f32x4*)(Y + (size_t)t.r1 * D))[C.lane + 64 * j];
                else { y1 = (f32x4){0.f, 0.f, 0.f, 0.f}; for (int pk = 0; pk < ts; ++pk) y1 = y1 + ((const GAS f32x4*)(YP + ((size_t)pk * trows + (t.r1 - trow0)) * D))[C.lane + 64 * j]; }
                v[j] = v[j] + gg * (y0 * t.w0 + y1 * t.w1); }
        }
        if (!last) {
#pragma unroll
            for (int j = 0; j < 4; ++j) ((GAS f32x4*)(X + (size_t)r * D))[C.lane + 64 * j] = v[j];
            const gfloat* MODn = (const gfloat*)(C.ws + WS_MOD) + (size_t)(layer + 1) * 5 * MODW;
            const gfloat* mv = MODn + (size_t)(r < NLAT ? (r >> 12) : 4) * MODW;
            normmod_regs(v, gin(p, 6) + (layer + 1) * D, mv, mv + D, C.lane);
            store_row_bf16(H + (size_t)r * D, v, C.lane);
        } else {
            float ss = 0.f;
#pragma unroll
            for (int j = 0; j < 4; ++j) ss += (v[j][0] * v[j][0] + v[j][1] * v[j][1]) + (v[j][2] * v[j][2] + v[j][3] * v[j][3]);
            const float rs = rsqrtf(wave_sum(ss, C.lane) * (1.f / D) + 1e-6f);
#pragma unroll
            for (int j = 0; j < 4; ++j) { const f32x4 gg = ((const GAS f32x4*)gin(p, 8))[C.lane + 64 * j]; ((GAS f32x4*)(((gfloat*)p.out) + (size_t)r * D))[C.lane + 64 * j] = v[j] * rs * gg; }
        }
    }
}
constexpr int AT_KB = 0, AT_KB_SZ = 64 * 136 * 2, AT_VT = 2 * AT_KB_SZ, AT_VT_SZ = 128 * 68 * 2, AT_QL = AT_VT + 2 * AT_VT_SZ, AT_END = AT_QL + 256 * 136 * 2;
static_assert(AT_END <= LDS_MISC, "attention LDS");
DI void attn_unit(const Ctx& C, const gbf16* PE, gbf16* MIX, const gfloat* gsub, float lam, float mul, int b, int h, int qb, bool ctxq) {
    LAS unsigned char* ldsb = C.lds; asm volatile("" : "+v"(ldsb));
    int tid = C.tid; asm volatile("" : "+v"(tid));
    const int lane = tid & 63, wave = __builtin_amdgcn_readfirstlane(tid >> 6), r = lane & 31, hh = lane >> 5;
    const int qrow0 = (ctxq ? NLAT + b * CTX : b * SEQ) + qb * 256;
    const int ntile = ctxq ? CTX / 64 : (CTX + SEQ) / 64;
    LAS bf16* QL = (LAS bf16*)(ldsb + AT_QL);
#pragma unroll
    for (int i = 0; i < 8; ++i) { const int c = tid + 512 * i, row = c >> 4, part = c & 15; *(LAS u32x4*)(QL + row * 136 + part * 8) = *(const GAS u32x4*)(PE + (size_t)(qrow0 + row) * EVEN_IN + h * 128 + part * 8); }
    f32x16 O[2][4];
#pragma unroll
    for (int mp = 0; mp < 2; ++mp)
#pragma unroll
        for (int k = 0; k < 4; ++k) O[mp][k] = zero16();
    float m[2] = {-1e30f, -1e30f}, l[2] = {0.f, 0.f};
    u32x4 vA[2];
    const int skey = tid & 63, spart = tid >> 6;
#define AT_LOAD(t, kr, vr) do { \
        { const int kidx_ = (t) * 64 + skey; const int krow_ = kidx_ < CTX ? NLAT + b * CTX + kidx_ : b * SEQ + kidx_ - CTX; \
          _Pragma("unroll") for (int i_ = 0; i_ < 2; ++i_) { const gbf16* src_ = PE + (size_t)krow_ * EVEN_IN + h * 128 + (spart + 8 * i_) * 8; vr[i_] = *(const GAS u32x4*)(src_ + 1024); } } \
        { LAS unsigned char* kd_ = ldsb + AT_KB + (((t) & 1)) * AT_KB_SZ; \
          _Pragma("unroll") for (int i_ = 0; i_ < 8; ++i_) { const int key_ = wave * 8 + i_, kidx_ = (t) * 64 + key_; const int krow_ = kidx_ < CTX ? NLAT + b * CTX + kidx_ : b * SEQ + kidx_ - CTX; \
              __builtin_amdgcn_global_load_lds((const GAS unsigned*)(PE + (size_t)krow_ * EVEN_IN + 512 + h * 128) + lane, (LAS unsigned*)(kd_ + key_ * 272), 4, 0, 0); } } } while (0)
#define AT_STORE(buf, kr, vr) do { LAS bf16* vt_ = (LAS bf16*)(ldsb + AT_VT + (buf) * AT_VT_SZ); \
        _Pragma("unroll") for (int i_ = 0; i_ < 2; ++i_) { const int part_ = spart + 8 * i_; \
            _Pragma("unroll") for (int e_ = 0; e_ < 4; ++e_) { vt_[(part_ * 8 + 2 * e_) * 68 + skey] = (bf16)(vr[i_][e_] & 0xffffu); vt_[(part_ * 8 + 2 * e_ + 1) * 68 + skey] = (bf16)(vr[i_][e_] >> 16); } } } while (0)
#define AT_TILE(t) do { const int buf = (t) & 1; \
        int tl_ = tid; asm volatile("" : "+v"(tl_)); const int lane = tl_ & 63, r = lane & 31, hh = lane >> 5, skey = lane, spart = tl_ >> 6;     \
        if ((t) + 1 < ntile) AT_LOAD((t) + 1, vA, vA); \
        const LAS bf16* kb = (const LAS bf16*)(ldsb + AT_KB + buf * AT_KB_SZ); const LAS bf16* vt = (const LAS bf16*)(ldsb + AT_VT + buf * AT_VT_SZ); \
        _Pragma("unroll") for (int ks2 = 0; ks2 < 2; ++ks2) {             \
            bf16x8 pf[2][2]; \
            _Pragma("unroll") for (int mp = 0; mp < 2; ++mp) { \
                f32x16 S = zero16(); \
                _Pragma("unroll") for (int ks = 0; ks < 4; ++ks) { const bf16x8 a = *(const LAS bf16x8*)(kb + (ks2 * 32 + r) * 136 + mp * 64 + 16 * ks + 8 * hh); const bf16x8 qf = *(const LAS bf16x8*)(QL + (wave * 32 + r) * 136 + mp * 64 + 16 * ks + 8 * hh); S = MFMA32(a, qf, S); } \
                float mx = S[0]; \
                _Pragma("unroll") for (int i = 1; i < 16; ++i) mx = fmaxf(mx, S[i]); \
                mx = fmaxf(mx, shx(mx, 32, lane)); \
                if (__any(mx > m[mp] + 8.f)) { const float mnew = fmaxf(m[mp], mx), corr = __builtin_amdgcn_exp2f(m[mp] - mnew); m[mp] = mnew; l[mp] *= corr; \
                    _Pragma("unroll") for (int k = 0; k < 4; ++k) O[mp][k] = O[mp][k] * corr; } \
                float ls = 0.f; const float mu = m[mp]; \
                _Pragma("unroll") for (int i = 0; i < 16; ++i) { S[i] = __builtin_amdgcn_exp2f(S[i] - mu); ls += S[i]; } \
                l[mp] += ls; \
                pf[mp][0] = pack_step(S, 0); pf[mp][1] = pack_step(S, 1); } \
            _Pragma("unroll") for (int s = 0; s < 2; ++s) \
                _Pragma("unroll") for (int k = 0; k < 4; ++k) { const bf16x8 a = ld_perm_frag(vt + (k * 32 + r) * 68, ks2 * 32, s, hh); O[0][k] = MFMA32(a, pf[0][s], O[0][k]); O[1][k] = MFMA32(a, pf[1][s], O[1][k]); } \
            } \
        if ((t) + 1 < ntile) AT_STORE(buf ^ 1, vA, vA); \
        __syncthreads(); } while (0)
    AT_LOAD(0, vA, vA); AT_STORE(0, vA, vA);
    __syncthreads();
    for (int t = 0; t < ntile; ++t) AT_TILE(t);
#undef AT_TILE
#undef AT_LOAD
#undef AT_STORE
    {
        const float i0 = 1.f / (l[0] + shx(l[0], 32, lane)), i1 = lam / (l[1] + shx(l[1], 32, lane));
        float ss = 0.f;
#pragma unroll
        for (int k = 0; k < 4; ++k)
#pragma unroll
            for (int i = 0; i < 16; ++i) { const float o = O[0][k][i] * i0 - O[1][k][i] * i1; O[0][k][i] = o; ss += o * o; }
        ss += shx(ss, 32, lane);
        const float rs = rsqrtf(ss * (1.f / 128.f) + 1e-6f) * mul;
        const int qrow = qrow0 + wave * 32 + r;
#pragma unroll
        for (int k = 0; k < 4; ++k)
#pragma unroll
            for (int g4 = 0; g4 < 4; ++g4) { const int dv0 = k * 32 + 8 * g4 + 4 * hh; const f32x4 gg = *(const GAS f32x4*)(gsub + dv0);
                u32x2 w; w[0] = pk2(O[0][k][4 * g4] * rs * gg[0], O[0][k][4 * g4 + 1] * rs * gg[1]); w[1] = pk2(O[0][k][4 * g4 + 2] * rs * gg[2], O[0][k][4 * g4 + 3] * rs * gg[3]);
                *(GAS u32x2*)(MIX + (size_t)qrow * D + h * 128 + dv0) = w; }
    }
    __syncthreads();
}

constexpr int RGG_WT = 0, RGG_XR = 36864, RGG_XB = RGG_XR + 17408, RGG_XF = RGG_XB + 18432, RGG_END = RGG_XF + 128 * 65 * 4;
static_assert(RGG_END <= LDS_MISC && 131 * 66 * 2 <= 17408, "rg gates LDS");
DI void ph_rg_gates(const Ctx& C, const Params& p, int i) {
    const gbf16* PE = (const gbf16*)(C.ws + WS_P); gfloat* RGA = (gfloat*)(C.ws + WS_RGA); gfloat* RGU = (gfloat*)(C.ws + WS_RGU);
    const gfloat* w_a = gin(p, 15) + (size_t)i * 2 * 8 * 64 * 64; const gfloat* w_x = gin(p, 17) + (size_t)i * 2 * 8 * 64 * 64;
    const gfloat* b_a = gin(p, 16) + i * 1024; const gfloat* b_x = gin(p, 18) + i * 1024; const gfloat* lamv = gin(p, 19) + i * 1024;
    const gfloat* cw = gin(p, 13) + i * 4 * 512; const gfloat* cb = gin(p, 14) + i * 512;
    int ncur = -1;
    for (int unit = C.blk; unit < (NTOK / 128) * 8; unit += C.nblk) {
        LAS unsigned char* ldsb = C.lds; asm volatile("" : "+v"(ldsb));
        int tid = C.tid; asm volatile("" : "+v"(tid));
        const int lane = tid & 63, wave = __builtin_amdgcn_readfirstlane(tid >> 6), r = lane & 31, hh = lane >> 5;
        const int n = unit & 7, tile = unit >> 3, r0 = tile * 128;
        LAS bf16* WT = (LAS bf16*)(ldsb + RGG_WT); LAS bf16* xraw = (LAS bf16*)(ldsb + RGG_XR); LAS bf16* XB = (LAS bf16*)(ldsb + RGG_XB); LAS float* XF = (LAS float*)(ldsb + RGG_XF);
        if (n != ncur) {
            __syncthreads();
            for (int idx = tid; idx < 16384; idx += 512) { const int ch = idx & 63, ci = (idx >> 6) & 63, g = (idx >> 12) & 1, d = idx >> 13;
                const float v = (g ? w_x : w_a)[((size_t)(d * 8 + n) * 64 + ci) * 64 + ch];
                WT[(((d * 2 + g) * 2 + (ch >> 5)) * 32 + (ch & 31)) * 72 + ci] = f2bf(v); }
            ncur = n;
        }
        int s0, s1; seq_bounds(r0, s0, s1);
        for (int idx = tid; idx < 131 * 8; idx += 512) { const int ri = idx >> 3, part = idx & 7, row = r0 - 2 + ri;
            u32x4 v = (u32x4){0u, 0u, 0u, 0u};
            if (row >= s0 && row < s1) v = *(const GAS u32x4*)(PE + (size_t)row * EVEN_IN + 1536 + n * 64 + part * 8);
            LAS unsigned* dst = (LAS unsigned*)(xraw + ri * 66 + part * 8); dst[0] = v[0]; dst[1] = v[1]; dst[2] = v[2]; dst[3] = v[3]; }
        __syncthreads();
        { const int cc = tid & 63; float tap[4];
#pragma unroll
          for (int tp = 0; tp < 4; ++tp) tap[tp] = cw[tp * 512 + n * 64 + cc];
          const float cbias = cb[n * 64 + cc];
#pragma unroll 4
          for (int it = 0; it < 16; ++it) { const int tok = (tid >> 6) + 8 * it; float a = cbias;
#pragma unroll
              for (int tp = 0; tp < 4; ++tp) a += tap[tp] * bf2f(xraw[(tok + tp) * 66 + cc]);
              XF[tok * 65 + cc] = a; XB[tok * 72 + cc] = f2bf(a); } }
        __syncthreads();
        { const int ti = wave & 3, d = wave >> 2;
#pragma unroll
          for (int chblk = 0; chblk < 2; ++chblk) {
              f32x16 aa = zero16(), ax = zero16();
#pragma unroll
              for (int ks = 0; ks < 4; ++ks) { const bf16x8 xa = *(const LAS bf16x8*)(XB + (ti * 32 + r) * 72 + 16 * ks + 8 * hh);
                  const bf16x8 ba = *(const LAS bf16x8*)(WT + (((d * 2 + 0) * 2 + chblk) * 32 + r) * 72 + 16 * ks + 8 * hh), bx = *(const LAS bf16x8*)(WT + (((d * 2 + 1) * 2 + chblk) * 32 + r) * 72 + 16 * ks + 8 * hh);
                  aa = MFMA32(xa, ba, aa); ax = MFMA32(xa, bx, ax); }
              const int ch = n * 64 + chblk * 32 + r;
              const float ba_ = b_a[d * 512 + ch], bx_ = b_x[d * 512 + ch], sp = softplus_(-lamv[d * 512 + ch]);
#pragma unroll
              for (int q = 0; q < 16; ++q) { const int tok = ti * 32 + crow(q, hh);
                  const float rr = sigmoid_(aa[q] + ba_), ii = sigmoid_(ax[q] + bx_);
                  const float log_a = -8.f * rr * sp; const float a = __expf(log_a), u = sqrtf(fmaxf(1.f - a * a, 0.f)) * (ii * XF[tok * 65 + chblk * 32 + r]);
                  const size_t o = ((size_t)d * NTOK + r0 + tok) * 512 + ch; RGA[o] = a; RGU[o] = u; }
          } }
        __syncthreads();
    }
}
DI int rg_row(int b, int d, int pp) { return pp < CTX ? NLAT + b * CTX + (d ? CTX - 1 - pp : pp) : b * SEQ + (d ? SEQ - 1 - (pp - CTX) : (pp - CTX)); }
DI void rgscan_unit(const Ctx& C, int b, int cg) {
    LAS unsigned char* ldsb = C.lds; asm volatile("" : "+v"(ldsb));
    int tid = C.tid; asm volatile("" : "+v"(tid));
    const gfloat* RGA = (const gfloat*)(C.ws + WS_RGA); const gfloat* RGU = (const gfloat*)(C.ws + WS_RGU); gfloat* HS1 = (gfloat*)(C.ws + WS_HS1);
    const gbf16* PE = (const gbf16*)(C.ws + WS_P); gbf16* MIX = (gbf16*)(C.ws + WS_MIX);
    LAS float* sb = (LAS float*)ldsb;
    const int ch = cg * 16 + (tid & 15), chunk = tid >> 4, p0 = chunk * 136;
    for (int pass = 0; pass < 2; ++pass) {
        const int d = 1 - pass;
        const gfloat* Ad = RGA + (size_t)d * NTOK * 512 + ch; const gfloat* Ud = RGU + (size_t)d * NTOK * 512 + ch;
        float av[17], uv[17], an[17], un[17];
        float A = 1.f, H = 0.f;
#pragma unroll
        for (int k = 0; k < 17; ++k) { const size_t o = (size_t)rg_row(b, d, p0 + k) * 512; av[k] = Ad[o]; uv[k] = Ud[o]; }
        for (int g8 = 0; g8 < 8; ++g8) {
            if (g8 < 7) {
#pragma unroll
                for (int k = 0; k < 17; ++k) { const size_t o = (size_t)rg_row(b, d, p0 + (g8 + 1) * 17 + k) * 512; an[k] = Ad[o]; un[k] = Ud[o]; } }
#pragma unroll
            for (int k = 0; k < 17; ++k) { H = av[k] * H + uv[k]; A *= av[k]; }
#pragma unroll
            for (int k = 0; k < 17; ++k) { av[k] = an[k]; uv[k] = un[k]; }
        }
        sb[(chunk * 16 + (tid & 15)) * 2] = A; sb[(chunk * 16 + (tid & 15)) * 2 + 1] = H;
        __syncthreads();
        float h = 0.f;
        for (int k = 0; k < chunk; ++k) h = sb[(k * 16 + (tid & 15)) * 2] * h + sb[(k * 16 + (tid & 15)) * 2 + 1];
#pragma unroll
        for (int k = 0; k < 17; ++k) { const size_t o = (size_t)rg_row(b, d, p0 + k) * 512; av[k] = Ad[o]; uv[k] = Ud[o]; }
        for (int g8 = 0; g8 < 8; ++g8) {
            if (g8 < 7) {
#pragma unroll
                for (int k = 0; k < 17; ++k) { const size_t o = (size_t)rg_row(b, d, p0 + (g8 + 1) * 17 + k) * 512; an[k] = Ad[o]; un[k] = Ud[o]; } }
#pragma unroll
            for (int k = 0; k < 17; ++k) { h = av[k] * h + uv[k]; const int row = rg_row(b, d, p0 + g8 * 17 + k);
                if (pass == 0) HS1[(size_t)row * 512 + ch] = h;
                else { const float y = h + HS1[(size_t)row * 512 + ch]; MIX[(size_t)row * D + 512 + ch] = f2bf(y * gelu_tanh_(bf2f(PE[(size_t)row * EVEN_IN + 2048 + ch]))); } }
#pragma unroll
            for (int k = 0; k < 17; ++k) { av[k] = an[k]; uv[k] = un[k]; }
        }
        __syncthreads();
    }
}
DI void ph_even_mix(const Ctx& C, const Params& p, int layer, int rep) {
    const int i = layer >> 1;
    volatile LAS unsigned* misc = (volatile LAS unsigned*)(C.lds + LDS_MISC);
    guint* q = (guint*)(C.ws + WS_CTL) + CW_Q + (i + 2 * rep) * 64;
    const float lam_init = 0.8f - 0.6f * expf(-0.3f * (float)layer);
    if (C.wave == 0) { const gfloat* lq = gin(p, 11) + i * 256; const float a = wave_sum(lq[C.lane] * lq[64 + C.lane], C.lane), b2 = wave_sum(lq[128 + C.lane] * lq[192 + C.lane], C.lane);
        if (C.lane == 0) ((volatile LAS float*)misc)[4] = expf(a) - expf(b2) + lam_init; }
    __syncthreads();
    const float lam = ((volatile LAS float*)misc)[4];
    const gbf16* PE = (const gbf16*)(C.ws + WS_P); gbf16* MIX = (gbf16*)(C.ws + WS_MIX);
    for (;;) {
        if (C.tid == 0) misc[8] = __hip_atomic_fetch_add(q, 1u, __ATOMIC_RELAXED, __HIP_MEMORY_SCOPE_AGENT);
        __syncthreads();
        const int u = (int)misc[8];
        __syncthreads();
#ifndef MIX_RG_REP
#define MIX_RG_REP 1
#endif
#ifndef MIX_AT_REP
#define MIX_AT_REP 1
#endif
        if (u >= 128 * MIX_RG_REP + 272 * MIX_AT_REP) break;
        if (u < 128 * MIX_RG_REP) { const int x = u & 127; rgscan_unit(C, x >> 5, x & 31); }
        else { const int y = (u - 128 * MIX_RG_REP) % 272;
            if (y < 256) attn_unit(C, PE, MIX, gin(p, 12) + i * 128, lam, 1.f - lam_init, y >> 6, (y >> 4) & 3, y & 15, false);
            else { const int x = y - 256; attn_unit(C, PE, MIX, gin(p, 12) + i * 128, lam, 1.f - lam_init, x >> 2, x & 3, 0, true); } }
    }
}
DI int chunk_row0(int cidx) { return cidx < 256 ? (cidx >> 6) * SEQ + (cidx & 63) * 64 : NLAT + (cidx - 256) * 64; }
constexpr int GA_RA = 0, GA_RB = 18432, GA_KT0 = 2 * 18432, GA_KT1 = 3 * 18432, GA_VT0 = 4 * 18432, GA_VT1 = 5 * 18432, GA_KK = 6 * 18432, GA_QK = GA_KK + 16640, GA_GC = GA_QK + 16640, GA_END = GA_GC + 1024;
static_assert(GA_END <= LDS_MISC, "GA LDS");
struct GaRegs { u32x4 q[2], k[2], v[2]; float g, be; };
DI void ga_load(const Ctx& C, int unit, GaRegs& R, int tid) {
    const int h = unit & 7, cidx = unit >> 3, row0 = chunk_row0(cidx), lane = tid & 63, wave = tid >> 6;
    const gbf16* QKVN = (const gbf16*)(C.ws + WS_QKVN); const gfloat* Gd = (const gfloat*)(C.ws + WS_GB); const gfloat* Bd = Gd + (size_t)2 * NTOK * 8;
#pragma unroll
    for (int i2 = 0; i2 < 2; ++i2) { const int c = tid + 512 * i2, pos = c & 63, part = c >> 6; const gbf16* src = QKVN + (size_t)(row0 + pos) * 3072 + h * 128 + part * 8;
        R.q[i2] = *(const GAS u32x4*)src; R.k[i2] = *(const GAS u32x4*)(src + 1024); R.v[i2] = *(const GAS u32x4*)(src + 2048); }
    R.g = 0.f; R.be = 0.f;
    if (wave < 2) { const int d = wave, row = row0 + (d ? 63 - lane : lane); R.g = Gd[((size_t)d * NTOK + row) * 8 + h]; R.be = Bd[((size_t)d * NTOK + row) * 8 + h]; }
}
DI void gdn_ga_unit(const Ctx& C, int unit, int next_unit, GaRegs& R) {
    LAS unsigned char* ldsb = C.lds; asm volatile("" : "+v"(ldsb));
    const int h = unit & 7, cidx = unit >> 3;
    const int row0 = chunk_row0(cidx);
    const gbf16* QKVN = (const gbf16*)(C.ws + WS_QKVN); const gfloat* Gd = (const gfloat*)(C.ws + WS_GB); const gfloat* Bd = Gd + (size_t)2 * NTOK * 8;
    const size_t ud0 = (size_t)(cidx * 8 + h) * 2;
    gbf16* WG = (gbf16*)(C.ws + WS_WG) + ud0 * 8192; gfloat* UG = (gfloat*)(C.ws + WS_UG) + ud0 * 8192; gbf16* QKD = (gbf16*)(C.ws + WS_QKD) + ud0 * 4096; gfloat* SC = (gfloat*)(C.ws + WS_SC) + ud0 * 192;
    gbf16* KTG = (gbf16*)(C.ws + WS_KTG) + ud0 * 8192;
    LAS bf16* Kc = (LAS bf16*)(ldsb + GA_RA); LAS bf16* Qc = (LAS bf16*)(ldsb + GA_RB);
    LAS float* KKm = (LAS float*)(ldsb + GA_KK); LAS float* QKm = (LAS float*)(ldsb + GA_QK);
    LAS float* gc = (LAS float*)(ldsb + GA_GC); LAS float* be = gc + 128;
    int tid = C.tid; asm volatile("" : "+v"(tid));
    const int lane = tid & 63, wave = __builtin_amdgcn_readfirstlane(tid >> 6), r = lane & 31, hh = lane >> 5;
#pragma unroll
    for (int i2 = 0; i2 < 2; ++i2) { const int c = tid + 512 * i2, pos = c & 63, part = c >> 6;
        const u32x4 q = R.q[i2], k = R.k[i2], v = R.v[i2];
        *(LAS u32x4*)(Qc + pos * 136 + part * 8) = q; *(LAS u32x4*)(Kc + pos * 136 + part * 8) = k;
        LAS bf16* kt0 = (LAS bf16*)(ldsb + GA_KT0) + (part * 8) * 72; LAS bf16* kt1 = (LAS bf16*)(ldsb + GA_KT1) + (part * 8) * 72;
        LAS bf16* vt0 = (LAS bf16*)(ldsb + GA_VT0) + (part * 8) * 72; LAS bf16* vt1 = (LAS bf16*)(ldsb + GA_VT1) + (part * 8) * 72;
#pragma unroll
        for (int e = 0; e < 4; ++e) { const bf16 k0 = (bf16)(k[e] & 0xffffu), k1 = (bf16)(k[e] >> 16), v0 = (bf16)(v[e] & 0xffffu), v1 = (bf16)(v[e] >> 16);
            kt0[(2 * e) * 72 + pos] = k0; kt0[(2 * e + 1) * 72 + pos] = k1; kt1[(2 * e) * 72 + 63 - pos] = k0; kt1[(2 * e + 1) * 72 + 63 - pos] = k1;
            vt0[(2 * e) * 72 + pos] = v0; vt0[(2 * e + 1) * 72 + pos] = v1; vt1[(2 * e) * 72 + 63 - pos] = v0; vt1[(2 * e + 1) * 72 + 63 - pos] = v1; } }
    if (wave < 2) {
        const int d = wave;
        float g = R.g;
#pragma unroll
        for (int o = 1; o < 64; o <<= 1) { const float t = __builtin_bit_cast(float, __builtin_amdgcn_ds_bpermute((lane - o) << 2, __builtin_bit_cast(int, g))); if (lane >= o) g += t; }
        gc[d * 64 + lane] = g; be[d * 64 + lane] = R.be;
    }
    if (next_unit >= 0) ga_load(C, next_unit, R, tid);
    __syncthreads();
    { const int ti = (wave & 3) >> 1, tj = wave & 1; const LAS bf16* Arows = (wave < 4 ? Kc : Qc);
      f32x16 acc = zero16();
#pragma unroll
      for (int ks = 0; ks < 8; ++ks) { const bf16x8 a = *(const LAS bf16x8*)(Arows + (ti * 32 + r) * 136 + 16 * ks + 8 * hh), bb = *(const LAS bf16x8*)(Kc + (tj * 32 + r) * 136 + 16 * ks + 8 * hh); acc = MFMA32(a, bb, acc); }
      LAS float* dst = (wave < 4 ? KKm : QKm);
#pragma unroll
      for (int i = 0; i < 16; ++i) dst[(ti * 32 + crow(i, hh)) * 65 + tj * 32 + r] = acc[i]; }
    __syncthreads();
    const float qscale = 0.08838834764831845f;
#pragma unroll
    for (int e = 0; e < 16; ++e) { const int idx = tid + 512 * e, d = idx >> 12, i = (idx >> 6) & 63, j = idx & 63, ti = d ? 63 - i : i, tj = d ? 63 - j : j;
        const float dec = (j <= i) ? __expf(gc[d * 64 + i] - gc[d * 64 + j]) : 0.f;
        ((LAS float*)(ldsb + (d ? GA_RB : GA_RA)))[i * 68 + j] = (j < i) ? KKm[ti * 65 + tj] * be[d * 64 + i] * dec : 0.f;
        QKD[idx] = f2bf(QKm[ti * 65 + tj] * qscale * dec); }
    if (tid < 128) { const int d = tid >> 6, i = tid & 63; SC[d * 192 + i] = qscale * __expf(gc[d * 64 + i]); SC[d * 192 + 64 + i] = __expf(gc[d * 64 + 63] - gc[d * 64 + i]); if (i == 0) SC[d * 192 + 128] = __expf(gc[d * 64 + 63]); }
    __syncthreads();
    if (wave < 2) {
        const int d = wave, c = lane; LAS float* Lm = (LAS float*)(ldsb + (d ? GA_RB : GA_RA)); float T[64];
#pragma unroll
        for (int i = 0; i < 64; ++i) { float a0 = (i == c) ? 1.f : 0.f, a1 = 0.f, a2 = 0.f, a3 = 0.f;
#pragma unroll
            for (int j4 = 0; j4 < (i + 3) / 4; ++j4) { const f32x4 l4 = *(const LAS f32x4*)(Lm + i * 68 + 4 * j4);
                a0 -= l4[0] * T[4 * j4]; if (4 * j4 + 1 < i) a1 -= l4[1] * T[4 * j4 + 1]; if (4 * j4 + 2 < i) a2 -= l4[2] * T[4 * j4 + 2]; if (4 * j4 + 3 < i) a3 -= l4[3] * T[4 * j4 + 3]; }
            T[i] = (a0 + a1) + (a2 + a3); if ((i & 1) == 1) asm volatile("" ::: "memory"); }
        const float s2 = be[d * 64 + c], s1 = s2 * __expf(gc[d * 64 + c]);
        LAS bf16* T1 = (LAS bf16*)Lm; LAS bf16* T2 = T1 + 64 * 72;
#pragma unroll
        for (int i = 0; i < 64; ++i) { T1[i * 72 + c] = f2bf(T[i] * s1); T2[i * 72 + c] = f2bf(T[i] * s2); }
    }
    __syncthreads();
#pragma unroll
    for (int d = 0; d < 2; ++d) {
        const LAS bf16* T1 = (const LAS bf16*)(ldsb + (d ? GA_RB : GA_RA)); const LAS bf16* T2 = T1 + 64 * 72;
        const LAS bf16* Kt = (const LAS bf16*)(ldsb + (d ? GA_KT1 : GA_KT0)); const LAS bf16* Vt = (const LAS bf16*)(ldsb + (d ? GA_VT1 : GA_VT0));
        const int ti = wave >> 2, tn = wave & 3; f32x16 aw = zero16(), au = zero16();
#pragma unroll
        for (int ks = 0; ks < 4; ++ks) { const bf16x8 a1 = *(const LAS bf16x8*)(T1 + (ti * 32 + r) * 72 + 16 * ks + 8 * hh), a2 = *(const LAS bf16x8*)(T2 + (ti * 32 + r) * 72 + 16 * ks + 8 * hh);
            const bf16x8 bk = *(const LAS bf16x8*)(Kt + (tn * 32 + r) * 72 + 16 * ks + 8 * hh), bv = *(const LAS bf16x8*)(Vt + (tn * 32 + r) * 72 + 16 * ks + 8 * hh);
            aw = MFMA32(a1, bk, aw); au = MFMA32(a2, bv, au); }
#pragma unroll
        for (int i = 0; i < 16; ++i) { const int pos = ti * 32 + crow(i, hh); WG[d * 8192 + pos * 128 + tn * 32 + r] = f2bf(aw[i]); UG[d * 8192 + pos * 128 + tn * 32 + r] = au[i]; }
#pragma unroll
        for (int i2 = 0; i2 < 2; ++i2) { const int c = tid + 512 * i2, row = c >> 3, part = c & 7; *(GAS u32x4*)(KTG + d * 8192 + row * 64 + part * 8) = *(const LAS u32x4*)(Kt + row * 72 + part * 8); }
    }
    __syncthreads();
}
DI void ph_gdn_ga(const Ctx& C) {
    GaRegs R; if (C.blk < NCH * 8) ga_load(C, C.blk, R, C.tid);
    for (int u = C.blk; u < NCH * 8; u += C.nblk) gdn_ga_unit(C, u, (u + C.nblk < NCH * 8) ? u + C.nblk : -1, R);
}

constexpr int GB_NSL = 2;
constexpr int GB_W = 0, GB_Q = GB_W + 64 * 136 * 2, GB_KT = GB_Q + 64 * 136 * 2, GB_QK = GB_KT + 128 * 72 * 2, GB_SC = GB_QK + 64 * 72 * 2, GB_BUF = GB_SC + 1024;
static_assert(2 * GB_BUF <= LDS_MISC, "GB LDS");
template <int VAR> DI void gdn_gb_unit(const Ctx& C, int unit) {
    LAS unsigned char* ldsb = C.lds; asm volatile("" : "+v"(ldsb));
    constexpr int NGRP = 4 / GB_NSL;
    const int grp = unit % NGRP, bhd = unit / NGRP, d = bhd & 1, h = (bhd >> 1) & 7, b = bhd >> 4;
    const gbf16* QKVN = (const gbf16*)(C.ws + WS_QKVN);
    const gbf16* WGb = (const gbf16*)(C.ws + WS_WG); const gfloat* UGb = (const gfloat*)(C.ws + WS_UG); const gbf16* QKDb = (const gbf16*)(C.ws + WS_QKD); const gbf16* KTGb = (const gbf16*)(C.ws + WS_KTG); const gfloat* SCb = (const gfloat*)(C.ws + WS_SC);
    gfloat* OG = (gfloat*)(C.ws + (VAR ? WS_XS : WS_OG)) + (size_t)d * NTOK * D;
    int tid = C.tid; asm volatile("" : "+v"(tid));
    const int lane = tid & 63, wave = __builtin_amdgcn_readfirstlane(tid >> 6), r = lane & 31, hh = lane >> 5;
    const bool comp = wave < GB_NSL; const int dv0 = (grp * GB_NSL + wave) * 32;
    f32x16 S[4];
#pragma unroll
    for (int k = 0; k < 4; ++k) S[k] = zero16();
    constexpr int NSW = 8 - GB_NSL, NIT = (56 + NSW - 1) / NSW, NRD = 1;
    const int wv = wave - GB_NSL, st = tid - GB_NSL * 64;
    u32x4 sreg[NIT], sreg2[NIT]; float rsc = 0.f, rsc2 = 0.f;
    auto chunk_of = [&](int step) { return step < 4 ? 256 + b * 4 + (d ? 3 - step : step) : b * 64 + (d ? 63 - (step - 4) : (step - 4)); };
#define GB_LOAD(step, rd, SR, RS) do { if (!comp) { int ln2_ = lane; asm volatile("" : "+v"(ln2_)); const int cidx_ = chunk_of(step), un_ = (cidx_ * 8 + h) * 2 + d, row0_ = chunk_row0(cidx_); \
        _Pragma("unroll") for (int i_ = 0; i_ < NIT; ++i_) { const int blk_ = wv + NSW * i_; if (blk_ < 56) { const gbf16* src_; \
            if (blk_ < 16) { const int c_ = blk_ * 64 + ln2_; src_ = WGb + (size_t)un_ * 8192 + c_ * 8; } \
            else if (blk_ < 32) { const int c_ = (blk_ - 16) * 64 + ln2_, pos_ = c_ >> 4, part_ = c_ & 15, row_ = row0_ + (d ? 63 - pos_ : pos_); src_ = QKVN + (size_t)row_ * 3072 + h * 128 + part_ * 8; } \
            else if (blk_ < 48) { const int c_ = (blk_ - 32) * 64 + ln2_; src_ = KTGb + (size_t)un_ * 8192 + c_ * 8; } \
            else { const int c_ = (blk_ - 48) * 64 + ln2_; src_ = QKDb + (size_t)un_ * 4096 + c_ * 8; } \
            SR[i_] = *(const GAS u32x4*)src_; } } \
        if (st < 192) RS = SCb[(size_t)un_ * 192 + st]; } } while (0)
#define GB_STORE(buf, rd, SR, RS) do { if (!comp) { int ln2_ = lane; asm volatile("" : "+v"(ln2_)); LAS unsigned char* B_ = ldsb + (buf) * GB_BUF; \
        _Pragma("unroll") for (int i_ = 0; i_ < NIT; ++i_) { const int blk_ = wv + NSW * i_; if (blk_ < 56) { \
            if (blk_ < 16) { const int c_ = blk_ * 64 + ln2_; *(LAS u32x4*)((LAS bf16*)(B_ + GB_W) + (c_ >> 4) * 136 + (c_ & 15) * 8) = SR[i_]; } \
            else if (blk_ < 32) { const int c_ = (blk_ - 16) * 64 + ln2_; *(LAS u32x4*)((LAS bf16*)(B_ + GB_Q) + (c_ >> 4) * 136 + (c_ & 15) * 8) = SR[i_]; } \
            else if (blk_ < 48) { const int c_ = (blk_ - 32) * 64 + ln2_; *(LAS u32x4*)((LAS bf16*)(B_ + GB_KT) + (c_ >> 3) * 72 + (c_ & 7) * 8) = SR[i_]; } \
            else { const int c_ = (blk_ - 48) * 64 + ln2_; *(LAS u32x4*)((LAS bf16*)(B_ + GB_QK) + (c_ >> 3) * 72 + (c_ & 7) * 8) = SR[i_]; } } } \
        if (st < 192) ((LAS float*)(B_ + GB_SC))[st] = RS; } } while (0)
    static_assert(NRD == 1, "two-steps-ahead staging is written for one round per step");
    GB_LOAD(0, 0, sreg, rsc); GB_STORE(0, 0, sreg, rsc); GB_LOAD(1, 0, sreg, rsc);
    f32x16 Un[2];
    Un[0] = zero16(); Un[1] = zero16();
    if (comp) { const int cidx = chunk_of(0), un = (cidx * 8 + h) * 2 + d; const gfloat* Uu = UGb + (size_t)un * 8192 + dv0 + r;
#pragma unroll
        for (int tt = 0; tt < 2; ++tt)
#pragma unroll
            for (int i = 0; i < 16; ++i) Un[tt][i] = Uu[(tt * 32 + crow(i, hh)) * 128]; }
    __syncthreads();
    if (!comp) {
        for (int step = 0; step < 68; ++step) {
            const int buf = step & 1;
            if (VAR != 2) { if (step + 2 < 68) GB_LOAD(step + 2, 0, sreg2, rsc2);
            if (step + 1 < 68) GB_STORE(buf ^ 1, 0, sreg, rsc); }
#pragma unroll
            for (int i_ = 0; i_ < NIT; ++i_) sreg[i_] = sreg2[i_];
            rsc = rsc2;
            asm volatile("s_waitcnt lgkmcnt(0)\n\ts_barrier" ::: "memory");
        }
    } else {
        for (int step = 0; step < 68; ++step) {
            const int buf = step & 1;
            if (VAR != 1) {
            int ln_ = lane; asm volatile("" : "+v"(ln_)); const int r = ln_ & 31, hh = ln_ >> 5;
            const int cidx = chunk_of(step), un = (cidx * 8 + h) * 2 + d, row0 = chunk_row0(cidx);
            const LAS unsigned char* Bp = ldsb + buf * GB_BUF; const LAS bf16* Wl = (const LAS bf16*)(Bp + GB_W); const LAS bf16* Ql = (const LAS bf16*)(Bp + GB_Q);
            const LAS bf16* KTl = (const LAS bf16*)(Bp + GB_KT); const LAS bf16* QKl = (const LAS bf16*)(Bp + GB_QK); const LAS float* scl = (const LAS float*)(Bp + GB_SC);
            bf16x8 sp[4][2];
#pragma unroll
            for (int kb = 0; kb < 4; ++kb) { sp[kb][0] = pack_step(S[kb], 0); sp[kb][1] = pack_step(S[kb], 1); }
            f32x16 aw0 = zero16(), aw1 = zero16();
#pragma unroll
            for (int kb = 0; kb < 4; ++kb)
#pragma unroll
                for (int s = 0; s < 2; ++s) { aw0 = MFMA32(ld_perm_frag(Wl + r * 136, kb * 32, s, hh), sp[kb][s], aw0); aw1 = MFMA32(ld_perm_frag(Wl + (32 + r) * 136, kb * 32, s, hh), sp[kb][s], aw1); }
#pragma unroll
            for (int i = 0; i < 16; ++i) { Un[0][i] -= aw0[i]; Un[1][i] -= aw1[i]; }
            f32x16 aq0 = zero16(), aq1 = zero16();
#pragma unroll
            for (int kb = 0; kb < 4; ++kb)
#pragma unroll
                for (int s = 0; s < 2; ++s) { aq0 = MFMA32(ld_perm_frag(Ql + r * 136, kb * 32, s, hh), sp[kb][s], aq0); aq1 = MFMA32(ld_perm_frag(Ql + (32 + r) * 136, kb * 32, s, hh), sp[kb][s], aq1); }
            bf16x8 vp[2][2];
#pragma unroll
            for (int jt = 0; jt < 2; ++jt) { vp[jt][0] = pack_step(Un[jt], 0); vp[jt][1] = pack_step(Un[jt], 1); }
#pragma unroll
            for (int i = 0; i < 16; ++i) { aq0[i] *= scl[crow(i, hh)]; aq1[i] *= scl[32 + crow(i, hh)]; }
#pragma unroll
            for (int jt = 0; jt < 2; ++jt)
#pragma unroll
                for (int s = 0; s < 2; ++s) { aq0 = MFMA32(ld_perm_frag(QKl + r * 72, jt * 32, s, hh), vp[jt][s], aq0); aq1 = MFMA32(ld_perm_frag(QKl + (32 + r) * 72, jt * 32, s, hh), vp[jt][s], aq1); }
#pragma unroll
            for (int jt = 0; jt < 2; ++jt) {
#pragma unroll
                for (int i = 0; i < 16; ++i) Un[jt][i] *= scl[64 + jt * 32 + crow(i, hh)];
                vp[jt][0] = pack_step(Un[jt], 0); vp[jt][1] = pack_step(Un[jt], 1); }
            if (step + 1 < 68) { const int cn = chunk_of(step + 1), unn = (cn * 8 + h) * 2 + d; const gfloat* Uu = UGb + (size_t)unn * 8192 + dv0 + r;
#pragma unroll
                for (int tt = 0; tt < 2; ++tt)
#pragma unroll
                    for (int i = 0; i < 16; ++i) Un[tt][i] = Uu[(tt * 32 + crow(i, hh)) * 128]; }
            const float gtot = scl[128];
#pragma unroll
            for (int kb = 0; kb < 4; ++kb) S[kb] = S[kb] * gtot;
#pragma unroll
            for (int jt = 0; jt < 2; ++jt)
#pragma unroll
                for (int s = 0; s < 2; ++s)
#pragma unroll
                    for (int kb = 0; kb < 4; ++kb) S[kb] = MFMA32(ld_perm_frag(KTl + (kb * 32 + r) * 72, jt * 32, s, hh), vp[jt][s], S[kb]);
#pragma unroll
            for (int i = 0; i < 16; ++i) { const int pos = crow(i, hh), row = row0 + (d ? 63 - pos : pos); OG[(size_t)row * D + h * 128 + dv0 + r] = aq0[i]; }
#pragma unroll
            for (int i = 0; i < 16; ++i) { const int pos = 32 + crow(i, hh), row = row0 + (d ? 63 - pos : pos); OG[(size_t)row * D + h * 128 + dv0 + r] = aq1[i]; }
            }
            asm volatile("s_waitcnt lgkmcnt(0)\n\ts_barrier" ::: "memory");
        }
    }
#undef GB_LOAD
#undef GB_STORE
}
DI void ph_gdn_gb(const Ctx& C, const Params& p, int lp, int rep) {
    constexpr int NU = 64 * (4 / GB_NSL);
#ifndef GB_PROBE_VAR
    for (int u = C.blk; u < NU; u += C.nblk) gdn_gb_unit<0>(C, u);
#else
    if (rep) { for (int u = C.blk; u < NU; u += C.nblk) gdn_gb_unit<GB_PROBE_VAR>(C, u); return; }
    for (int u = C.blk; u < NU; u += C.nblk) gdn_gb_unit<0>(C, u);
#endif
#if CONV_DEFER
    if (C.nblk > NU) { if (C.blk >= NU) convert_weights(C, p, 1 + lp, (C.blk - NU) * 8 + C.wave, (C.nblk - NU) * 8); }
    else convert_weights(C, p, 1 + lp, C.blk * 8 + C.wave, C.nblk * 8);
#endif
}
constexpr int NPH_PAIR = 20, NPHASE = 1 + 2 * NPH_PAIR;
DI void fresh(Ctx& C) { int t; asm volatile("v_mbcnt_lo_u32_b32 %0, -1, 0\n\tv_mbcnt_hi_u32_b32 %0, -1, %0" : "=v"(t)); t += C.wave0 * 64; asm volatile("" : "+v"(t));     int b = blockIdx.x; asm volatile("" : "+s"(b)); guchar* w_ = C.ws0; asm volatile("" : "+s"(w_)); C.ws = w_; C.tid = t; C.lane = t & 63; C.wave = __builtin_amdgcn_readfirstlane(t >> 6); C.blk = b; }
__global__ void __launch_bounds__(512, 2) fused_fwd(Params p) {
    extern __shared__ __attribute__((aligned(16))) unsigned char lds_raw[];
    Ctx C; C.lds = (LAS unsigned char*)lds_raw; C.ws = (guchar*)p.ws; C.ws0 = (guchar*)p.ws; C.tid = threadIdx.x; C.lane = C.tid & 63; C.wave = __builtin_amdgcn_readfirstlane(C.tid >> 6); C.wave0 = C.wave; C.nblk = gridDim.x; C.blk = blockIdx.x;
    volatile LAS unsigned* misc = (volatile LAS unsigned*)(C.lds + LDS_MISC);
    if (C.tid < 16) misc[C.tid] = 0u;
    __syncthreads();
    unsigned* ctl = (unsigned*)(p.ws + WS_CTL);
    const bool single = (p.ph_lo == 0 && p.ph_hi == NPHASE);
    XcdBarrier bar; bar.bar = ctl + CW_BAR; bar.x = 0; bar.st = misc;
    if (single) bar = xcd_barrier_post(ctl + CW_BAR, misc);
    const int lo = p.ph_lo, hi = p.ph_hi;
#ifndef PH_MASK
#define PH_MASK 0x1FFFFFu
#endif
#define PHEN(k) (((PH_MASK) >> (k)) & 1u)
#ifndef XTRA_BAR
#define XTRA_BAR 0
#endif
#ifndef REP_MASK
#define REP_MASK 0u
#endif
#define NREP(k) (1 + (int)(((REP_MASK) >> (k)) & 1u))
#define IN(k) (fresh(C), lo <= (k) && (k) < hi)
#define SEAM(k) do { if (single) { unsigned* bp_ = ctl + CW_BAR; asm volatile("" : "+s"(bp_)); bar.bar = bp_; xcd_barrier(bar); for (int xb_ = 0; xb_ < XTRA_BAR; ++xb_) xcd_barrier(bar); } } while (0)
#define H ((gbf16*)(C.ws + WS_H))
#define MIX ((gbf16*)(C.ws + WS_MIX))
#define P ((gbf16*)(C.ws + WS_P))
#define X ((gfloat*)(C.ws + WS_X))
#define MOD ((const gfloat*)(C.ws + WS_MOD))
    for (int rep_ = 0; rep_ < NREP(0); ++rep_) { if (rep_) { SEAM(0); } if (PHEN(0) && IN(0)) ph_prologue(C, p); }
    SEAM(0);
    for (int lp = 0; lp < 2; ++lp) {
        const int pb = 1 + lp * NPH_PAIR, le = 2 * lp, lod = 2 * lp + 1;
        for (int rep_ = 0; rep_ < NREP(1); ++rep_) { if (rep_) { SEAM(0); } if (PHEN(1) && IN(pb + 0)) { if (lp == 0) ph_normmod(C, p, 0, false, true, 0, 0); } }
        SEAM(pb + 0);
        for (int rep_ = 0; rep_ < NREP(2); ++rep_) { if (rep_) { SEAM(0); } if (PHEN(2) && IN(pb + 1)) { pg8::Gemm g{H, (const gbf16*)(C.ws + WS_WEIN) + (size_t)lp * 2560 * 1024, NTOK, EVEN_IN, D, 0}; pg8::StaticOrder S; S.init(NTOK, EVEN_IN, C.nblk, C.blk);
            EpiEvenIn E{P, (const gfloat*)(C.ws + WS_COS), (const gfloat*)(C.ws + WS_SIN)}; pg8::gemm_phase<EpiEvenIn, pg8::StaticOrder>(C.lds, g, S, E, C.tid); } }
        SEAM(pb + 1);
        for (int rep_ = 0; rep_ < NREP(20); ++rep_) { if (rep_) { SEAM(0); } if (PHEN(20) && IN(pb + 2)) ph_rg_gates(C, p, lp); }
        SEAM(pb + 2);
        for (int rep_ = 0; rep_ < NREP(3); ++rep_) { if (rep_) { SEAM(0); } if (PHEN(3) && IN(pb + 3)) ph_even_mix(C, p, le, rep_); }
        SEAM(pb + 3);
        for (int rep_ = NREP(4) - 1; rep_ >= 0; --rep_) { if (PHEN(4) && IN(pb + 4)) {
            { pg8::Gemm g{MIX, (const gbf16*)(C.ws + WS_WEOUT) + (size_t)lp * 1024 * 1024, NLAT, D, D, 0}; pg8::StaticOrder S; S.init(NLAT, D, C.nblk, C.blk);
              EpiResid E{rep_ ? (gfloat*)(C.ws + WS_U + (size_t)200 * 1024 * 1024) : X, MOD + (size_t)le * 5 * MODW + 2 * D}; pg8::gemm_phase<EpiResid, pg8::StaticOrder>(C.lds, g, S, E, C.tid); }
            { fresh(C); pg8::Gemm g{MIX + (size_t)NLAT * D, (const gbf16*)(C.ws + WS_WEOUT) + (size_t)lp * 1024 * 1024, NCTX, D, D, D / 4}; pg8::StaticOrder S; S.init(NCTX, D, C.nblk, C.blk); S.lim = S.nwg * 4; S.s = 4;
              EpiPart E{(gfloat*)(C.ws + WS_PART)}; pg8::gemm_phase<EpiPart, pg8::StaticOrder>(C.lds, g, S, E, C.tid); } } if (rep_) { SEAM(0); } }
        SEAM(pb + 4);
        for (int rep_ = 0; rep_ < NREP(5); ++rep_) { if (rep_) { SEAM(0); } if (PHEN(5) && IN(pb + 5)) ph_normmod(C, p, le, true, false, 4, le * 5 * MODW + 2 * D); }
        SEAM(pb + 5);
        for (int rep_ = 0; rep_ < NREP(6); ++rep_) { if (rep_) { SEAM(0); } if (PHEN(6) && IN(pb + 6)) { pg8::Gemm g{H, (const gbf16*)(C.ws + WS_WEF1) + (size_t)lp * 5632 * 1024, NTOK, 2 * FFN, D, 0}; pg8::StaticOrder S; S.init(NTOK, 2 * FFN, C.nblk, C.blk);
            EpiSwiglu E{P, FFN, 2 * FFN / 256}; pg8::gemm_phase<EpiSwiglu, pg8::StaticOrder>(C.lds, g, S, E, C.tid); } }
        SEAM(pb + 6);
        for (int rep_ = NREP(7) - 1; rep_ >= 0; --rep_) { if (PHEN(7) && IN(pb + 7)) {
            { pg8::Gemm g{P, (const gbf16*)(C.ws + WS_WEF2) + (size_t)lp * 1024 * 2816, NLAT, D, FFN, 0}; pg8::StaticOrder S; S.init(NLAT, D, C.nblk, C.blk);
              EpiResid E{rep_ ? (gfloat*)(C.ws + WS_U + (size_t)200 * 1024 * 1024) : X, MOD + (size_t)le * 5 * MODW + 5 * D}; pg8::gemm_phase<EpiResid, pg8::StaticOrder>(C.lds, g, S, E, C.tid); }
            { fresh(C); pg8::Gemm g{P + (size_t)NLAT * FFN, (const gbf16*)(C.ws + WS_WEF2) + (size_t)lp * 1024 * 2816, NCTX, D, FFN, FFN / 11}; pg8::StaticOrder S; S.init(NCTX, D, C.nblk, C.blk); S.lim = S.nwg * 11; S.s = 11;
              EpiPart E{(gfloat*)(C.ws + WS_PART)}; pg8::gemm_phase<EpiPart, pg8::StaticOrder>(C.lds, g, S, E, C.tid); } } if (rep_) { SEAM(0); } }
        SEAM(pb + 7);
        const int ntok = (lod < DEPTH - 1) ? NTOK : NLAT;
        for (int rep_ = 0; rep_ < NREP(8); ++rep_) { if (rep_) { SEAM(0); } if (PHEN(8) && IN(pb + 8)) ph_normmod(C, p, lod, false, false, 11, le * 5 * MODW + 5 * D); }
        SEAM(pb + 8);
        for (int rep_ = 0; rep_ < NREP(9); ++rep_) { if (rep_) { SEAM(0); } if (PHEN(9) && IN(pb + 9)) { pg8::Gemm g{H, (const gbf16*)(C.ws + WS_WOIN) + (size_t)lp * 4352 * 1024, NTOK, 4352, D, 0}; pg8::StaticOrder S; S.init(NTOK, 4352, C.nblk, C.blk);
            EpiBf16Ab E{P, 4352, (gfloat*)(C.ws + WS_AB), 16}; pg8::gemm_phase<EpiBf16Ab, pg8::StaticOrder>(C.lds, g, S, E, C.tid); } }
        SEAM(pb + 9);
        for (int rep_ = 0; rep_ < NREP(10); ++rep_) { if (rep_) { SEAM(0); } if (PHEN(10) && IN(pb + 10)) ph_odd_conv(C, p, lp); }
        SEAM(pb + 10);
        for (int rep_ = 0; rep_ < NREP(11); ++rep_) { if (rep_) { SEAM(0); } if (PHEN(11) && IN(pb + 11)) ph_gdn_ga(C); }
        SEAM(pb + 11);
        for (int rep_ = 0; rep_ < NREP(12); ++rep_) { if (rep_) { SEAM(0); } if (PHEN(12) && IN(pb + 12)) ph_gdn_gb(C, p, lp, rep_); }
        SEAM(pb + 12);
        for (int rep_ = 0; rep_ < NREP(13); ++rep_) { if (rep_) { SEAM(0); } if (PHEN(13) && IN(pb + 13)) ph_gdn_out(C, p, lp); }
        SEAM(pb + 13);
        for (int rep_ = NREP(14) - 1; rep_ >= 0; --rep_) { if (PHEN(14) && IN(pb + 14)) {
            { pg8::Gemm g{MIX, (const gbf16*)(C.ws + WS_WOOUT) + (size_t)lp * 1024 * 1024, NLAT, D, D, 0}; pg8::StaticOrder S; S.init(NLAT, D, C.nblk, C.blk);
              EpiResid E{rep_ ? (gfloat*)(C.ws + WS_U + (size_t)200 * 1024 * 1024) : X, MOD + (size_t)lod * 5 * MODW + 2 * D}; pg8::gemm_phase<EpiResid, pg8::StaticOrder>(C.lds, g, S, E, C.tid); }
            if (lod < DEPTH - 1) { fresh(C); pg8::Gemm g{MIX + (size_t)NLAT * D, (const gbf16*)(C.ws + WS_WOOUT) + (size_t)lp * 1024 * 1024, NCTX, D, D, D / 4}; pg8::StaticOrder S; S.init(NCTX, D, C.nblk, C.blk); S.lim = S.nwg * 4; S.s = 4;
              EpiPart E{(gfloat*)(C.ws + WS_PART)}; pg8::gemm_phase<EpiPart, pg8::StaticOrder>(C.lds, g, S, E, C.tid); } } if (rep_) { SEAM(0); } }
        SEAM(pb + 14);
        if (PHEN(15) && IN(pb + 15)) ph_router(C, p, lod, ntok, (lod < DEPTH - 1) ? 4 : 0);
        SEAM(pb + 15);
        for (int rep_ = 0; rep_ < NREP(16); ++rep_) { if (rep_) { SEAM(0); } if (PHEN(16) && IN(pb + 16)) ph_gather(C, lod, ntok); }
        SEAM(pb + 16);
        for (int rep_ = 0; rep_ < NREP(17); ++rep_) { if (rep_) { SEAM(0); } if (PHEN(17) && IN(pb + 17)) { pg8::Gemm g{(const gbf16*)(C.ws + WS_XS), (const gbf16*)(C.ws + WS_WXIN) + (size_t)lp * 8 * 7168 * 1024, RMAX, 8 * 7168, D, 0}; MoeOrder S; S.initm((const guint*)(ctl + CW_CNT + lp * 64), 28, C.nblk, C.blk);
            EpiSwiglu E{(gbf16*)(C.ws + WS_HIDM), FFE, 28}; pg8::gemm_phase<EpiSwiglu, MoeOrder>(C.lds, g, S, E, C.tid); } }
        SEAM(pb + 17);
        for (int rep_ = 0; rep_ < NREP(18); ++rep_) { if (rep_) { SEAM(0); } if (PHEN(18) && IN(pb + 18)) {
            { pg8::Gemm g{(const gbf16*)(C.ws + WS_HIDM), (const gbf16*)(C.ws + WS_WXOUT) + (size_t)lp * 8 * 1024 * 3584, RMAX, 8 * 1024, FFE, 0}; MoeOrder2 S; S.initm((const guint*)(ctl + CW_CNT + lp * 64), C.nblk, C.blk, 0);
              EpiF32 E{(gfloat*)(C.ws + WS_Y), D, 4}; pg8::gemm_phase<EpiF32, MoeOrder2>(C.lds, g, S, E, C.tid); }
            { fresh(C); MoeOrder2 S; S.initm((const guint*)(ctl + CW_CNT + lp * 64), C.nblk, C.blk, 1);
              pg8::Gemm g{(const gbf16*)(C.ws + WS_HIDM), (const gbf16*)(C.ws + WS_WXOUT) + (size_t)lp * 8 * 1024 * 3584, RMAX, 8 * 1024, FFE, FFE / S.s};
              EpiPartY E{(gfloat*)(C.ws + WS_YP), S.Lmain >> 2, (S.r >> 2) * 256}; pg8::gemm_phase<EpiPartY, MoeOrder2>(C.lds, g, S, E, C.tid); } } }
        SEAM(pb + 18);
        if (PHEN(19) && IN(pb + 19)) ph_combine(C, p, lod, ntok, (const guint*)(ctl + CW_CNT + lp * 64));
        SEAM(pb + 19);
    }
#undef IN
#undef SEAM
#undef H
#undef MIX
#undef P
#undef X
#undef MOD
}

static int fused_setup() {
    static int grid = 0;
    if (grid == 0) {
        int dev = 0, cus = 0, per_cu = 0;
        if (hipGetDevice(&dev) != hipSuccess || hipDeviceGetAttribute(&cus, hipDeviceAttributeMultiprocessorCount, dev) != hipSuccess) { fprintf(stderr, "fused_setup: device query failed\n"); grid = -1; return grid; }
        if (hipFuncSetAttribute((const void*)fused_fwd, hipFuncAttributeMaxDynamicSharedMemorySize, LDS_BYTES) != hipSuccess) { fprintf(stderr, "fused_setup: hipFuncSetAttribute failed\n"); grid = -1; return grid; }
        if (hipOccupancyMaxActiveBlocksPerMultiprocessor(&per_cu, (const void*)fused_fwd, 512, LDS_BYTES) != hipSuccess || per_cu < 1) { fprintf(stderr, "fused_setup: occupancy query says %d blocks per CU\n", per_cu); (void)hipGetLastError(); }
        grid = cus;
    }
    return grid;
}
static void launch_fused(const Params& p0, int lo, int hi, hipStream_t s) {
    const int grid = fused_setup(); if (grid <= 0) return;
    Params p = p0; p.ph_lo = lo; p.ph_hi = hi;
    hipLaunchKernelGGL(fused_fwd, dim3(grid), dim3(512), LDS_BYTES, s, p);
}
}
#ifdef DEBUG_MODE
namespace dbg {
using namespace cfg;
__global__ void k_cmp_f32_bf16(const float* __restrict__ A, const unsigned short* __restrict__ R, size_t n, float* __restrict__ res) {
    float d2 = 0.f, r2 = 0.f;
    for (size_t i = (size_t)blockIdx.x * 256 + threadIdx.x; i < n; i += (size_t)gridDim.x * 256) { const float r = __uint_as_float((unsigned)R[i] << 16), a = A[i]; d2 += (a - r) * (a - r); r2 += r * r; }
    for (int o = 32; o >= 1; o >>= 1) { d2 += __shfl_xor(d2, o); r2 += __shfl_xor(r2, o); }
    if ((threadIdx.x & 63) == 0) { atomicAdd(res, d2); atomicAdd(res + 1, r2); }
}
__global__ void k_cmp_bf16_f32(const unsigned short* __restrict__ A, int fp, int fo, const float* __restrict__ R, int rp, int ro, int nrows, int ncols, float rscale, float* __restrict__ res) {
    float d2 = 0.f, r2 = 0.f;
    for (size_t i = (size_t)blockIdx.x * 256 + threadIdx.x; i < (size_t)nrows * ncols; i += (size_t)gridDim.x * 256) { const int row = (int)(i / ncols), c = (int)(i % ncols);
        const float a = __uint_as_float((unsigned)A[(size_t)row * fp + fo + c] << 16), r = R[(size_t)row * rp + ro + c] * rscale; d2 += (a - r) * (a - r); r2 += r * r; }
    for (int o = 32; o >= 1; o >>= 1) { d2 += __shfl_xor(d2, o); r2 += __shfl_xor(r2, o); }
    if ((threadIdx.x & 63) == 0) { atomicAdd(res, d2); atomicAdd(res + 1, r2); }
}
__global__ void k_cmp_f32_f32(const float* __restrict__ A, int fp, int fo, const float* __restrict__ R, int rp, int ro, int nrows, int ncols, float* __restrict__ res) {
    float d2 = 0.f, r2 = 0.f;
    for (size_t i = (size_t)blockIdx.x * 256 + threadIdx.x; i < (size_t)nrows * ncols; i += (size_t)gridDim.x * 256) { const int row = (int)(i / ncols), c = (int)(i % ncols);
        const float a = A[(size_t)row * fp + fo + c], r = R[(size_t)row * rp + ro + c]; d2 += (a - r) * (a - r); r2 += r * r; }
    for (int o = 32; o >= 1; o >>= 1) { d2 += __shfl_xor(d2, o); r2 += __shfl_xor(r2, o); }
    if ((threadIdx.x & 63) == 0) { atomicAdd(res, d2); atomicAdd(res + 1, r2); }
}
__global__ void k_decide(const float* __restrict__ res, int nchk, float tol, float* __restrict__ out, size_t nout) {
    int code = 0; float frac = 0.f;
    for (int k = 0; k < nchk; ++k) { const float err = res[2 * k] / res[2 * k + 1]; if (!(err <= tol)) { code = k + 1; float l = (err == err && err > 0.f) ? log10f(err) : 0.f; frac = fminf(fmaxf((l + 4.f) / 4.f * 0.9f, 0.f), 0.9f); break; } }
    if (code == 0) return;
    const float c = sqrtf((float)code + frac);
    for (size_t i = (size_t)blockIdx.x * 256 + threadIdx.x; i < nout; i += (size_t)gridDim.x * 256) out[i] = c;
}
}
#endif

static nv::NaiveWs carve_naive(char* base, size_t& off) {
    using namespace cfg;
    nv::NaiveWs w{};
    auto take = [&](size_t nfloats) { float* p = (float*)(base + off); off += ((nfloats * 4 + 255) / 256) * 256; return p; };
    w.MOD = take((size_t)DEPTH * 5 * MODW);
    w.X = take((size_t)NTOK * D); w.H = take((size_t)NTOK * D); w.P = take((size_t)NTOK * ODD_IN); w.MIX = take((size_t)NTOK * D);
    w.T0 = take((size_t)NTOK * 512); w.T1 = take((size_t)NTOK * 3072); w.T2 = take((size_t)NTOK * 2048);
    w.FOUT = take((size_t)NTOK * D); w.HID = take((size_t)NTOK * FFE);
    w.lam = take(64); w.cnt = (int*)take(64); w.list_tok = (int*)take((size_t)NEXP * NTOK); w.list_w = take((size_t)NEXP * NTOK);
    return w;
}
extern "C" void kernel_launch(void* const* d_in, const int* in_sizes, int n_in, void* d_out, int out_size, void* d_ws, size_t ws_size, hipStream_t stream) {
    using namespace cfg;
    if (n_in != 31 || out_size != NLAT * D) { fprintf(stderr, "kernel_launch: unexpected n_in %d / out_size %d\n", n_in, out_size); return; }
    fk::Params p{}; for (int i = 0; i < 31; ++i) p.in[i] = (const float*)d_in[i];
    p.out = (float*)d_out; p.ws = (unsigned char*)d_ws;
#ifdef DEBUG_MODE
    const size_t snap_bytes = (size_t)NTOK * D * 2, CK_BYTES = 8 * snap_bytes + (size_t)NLAT * D * 4 + 4096;
    if (ws_size < fk::WS_END + CK_BYTES) { fprintf(stderr, "kernel_launch(debug): workspace too small\n"); return; }
    char* ckb = (char*)d_ws + ws_size - CK_BYTES; ckb -= ((size_t)ckb & 255);
    unsigned short* snaps = (unsigned short*)ckb; float* nout = (float*)(ckb + 8 * snap_bytes); float* res = (float*)(ckb + 8 * snap_bytes + (size_t)NLAT * D * 4);
    {
        nv::Inputs in{}; for (int i = 0; i < 31; ++i) in.p[i] = (const float*)d_in[i];
        size_t off = 0; nv::NaiveWs w = carve_naive((char*)d_ws, off);
        if ((char*)d_ws + off > ckb) { fprintf(stderr, "kernel_launch(debug): oracle scratch overlaps snapshots\n"); return; }
        nv::run_naive(in, w, nout, snaps, stream);
    }
    (void)hipMemsetAsync(res, 0, 4096, stream);
    (void)hipMemsetAsync((char*)d_ws + fk::WS_CTL, 0, fk::CTL_BYTES, stream);
    int chk = 0;
    for (int ph = 0; ph < fk::NPHASE; ++ph) {
        fk::launch_fused(p, ph, ph + 1, stream);
        if (ph == 0) continue;
        const int lp = (ph - 1) / fk::NPH_PAIR, k = (ph - 1) % fk::NPH_PAIR;
        int snap = -1;
        if (k == 5) snap = 4 * lp + 0; else if (k == 8) snap = 4 * lp + 1; else if (k == 15) snap = 4 * lp + 2; else if (k == 19 && lp == 0) snap = 3;
        if (snap >= 0) { hipLaunchKernelGGL(dbg::k_cmp_f32_bf16, dim3(2048), dim3(256), 0, stream, (const float*)((char*)d_ws + fk::WS_X), snaps + (size_t)snap * NTOK * D, (size_t)(snap == 6 ? NLAT : NTOK) * D, res + 2 * chk); ++chk; }
    }
    hipLaunchKernelGGL(dbg::k_cmp_f32_f32, dim3(2048), dim3(256), 0, stream, (const float*)d_out, D, 0, (const float*)nout, D, 0, NLAT, D, res + 2 * chk); ++chk;
    hipLaunchKernelGGL(dbg::k_decide, dim3(1024), dim3(256), 0, stream, (const float*)res, chk, DEBUG_TOL, (float*)d_out, (size_t)NLAT * D);
#else
    if (ws_size < fk::WS_END) { fprintf(stderr, "kernel_launch: workspace too small: need %zu have %zu\n", (size_t)fk::WS_END, ws_size); return; }
    (void)hipMemsetAsync((char*)d_ws + fk::WS_CTL, 0, fk::CTL_BYTES, stream);
    fk::launch_fused(p, 0, fk::NPHASE, stream);
#endif
}
```

```cpp
#include <hip/hip_runtime.h>
#include <cstdio>
#include <cstdint>
#include <cmath>
namespace cfg {
constexpr int D = 1024, B = 4, SEQ = 4096, CTX = 256, DEPTH = 4;
constexpr int NLAT = B * SEQ, NCTX = B * CTX, NTOK = NLAT + NCTX;
constexpr int NMOD = 6, MODW = NMOD * D;
constexpr int EVEN_IN = 2560, ODD_IN = 4128, FFN = 2816, FFE = 3584, NEXP = 8;
}
namespace nv {
using namespace cfg;
struct NaiveWs { float *MOD, *X, *H, *P, *MIX, *T0, *T1, *T2, *FOUT, *HID, *lam; int* cnt; int* list_tok; float* list_w; };
}
namespace pg8 {
#define PG8_LAS __attribute__((address_space(3)))
#define PG8_GAS __attribute__((address_space(1)))
typedef unsigned short bf16_t;
typedef short bf16x8 __attribute__((ext_vector_type(8)));
typedef float f32x4 __attribute__((ext_vector_type(4)));
typedef unsigned u32x4 __attribute__((ext_vector_type(4)));
constexpr int BM = 256, BK = 64, HALF = 128, HTB = HALF * BK * 2  , STAGE_BYTES = 8 * HTB, NXCD = 8, WGM = 8;

__host__ __device__ __forceinline__ int lds_byte(int r_, int c_) { const unsigned r = (unsigned)r_, c = (unsigned)c_; const unsigned st = (r >> 4) * 2u + (c >> 5), rr = r & 15u, cc = c & 31u, ob = rr * 64u + cc * 2u; return (int)(st * 1024u + (ob ^ (((ob >> 9) & 1u) << 5))); }
__host__ __device__ __forceinline__ void stage_rc(int b_, int& R, int& C) { const unsigned b = (unsigned)b_; const unsigned st = b >> 10, sb = b & 1023u, swz = sb ^ (((sb >> 9) & 1u) << 5); R = (int)((st >> 1) * 16u + (swz >> 6)); C = (int)((st & 1u) * 32u + ((swz & 63u) >> 1)); }
__host__ __device__ __forceinline__ int perm32(int rho_) { const unsigned rho = (unsigned)rho_; const unsigned n = rho >> 4, i = rho & 15u; return (int)(8u * (i >> 2) + 4u * n + (i & 3u)); }

struct Unit { int pm, pn, pk; };
struct Gemm { const PG8_GAS bf16_t* A; const PG8_GAS bf16_t* Bt; int M, N, K, Kh; };

struct StaticOrder {
    int nM, nN, nwg, G, c;
    int lim, L0, s;
    __host__ __device__ void init(int M, int N, int G_, int c_) { nM = M / BM; nN = N / BM; nwg = nM * nN; G = G_; c = c_; lim = nwg; L0 = 0; s = 1; }
    __host__ __device__ void decode(int wgid, Unit& u) const {
        { const int q = nwg / NXCD, r = nwg % NXCD, xcd = wgid % NXCD, off = wgid / NXCD; wgid = (xcd < r ? xcd * (q + 1) : r * (q + 1) + (xcd - r) * q) + off; }
        const int nig = WGM * nN, gid = wgid / nig, fm = gid * WGM, gsz = (nM - fm) < WGM ? (nM - fm) : WGM;
        u.pm = fm + ((wgid % nig) % gsz); u.pn = (wgid % nig) / gsz;
    }
    __host__ __device__ bool next(int i, Unit& u) const {
        const long j = (long)i * G + c; if (j >= lim) return false;
        u.pk = (int)(j % s); decode(L0 + (int)(j / s), u); return true;
    }
    __host__ __device__ void main_part() { lim = (nwg / G) * G; L0 = 0; s = 1; }
    __host__ __device__ void tail_part(int s_) { L0 = (nwg / G) * G; s = s_; lim = (nwg - L0) * s_; }
    __host__ __device__ int tail_tiles() const { return nwg - (nwg / G) * G; }
    __device__ __forceinline__ void a_ready(const Unit&) const {}
    __device__ __forceinline__ void done(const Unit&) const {}
};
template <class Epi, class Sched, bool ALIGN_EPI = true, bool SP2 = true>
__device__ __forceinline__ void gemm_phase(PG8_LAS unsigned char* lds, const Gemm g, const Sched& S, const Epi& E, const int tid) {
    const int wid = __builtin_amdgcn_readfirstlane(tid >> 6), lane = tid & 63, wr = wid >> 2, wc = wid & 3, fr = lane & 15, fq = lane >> 4;
    const int K = g.K, Kh = g.Kh ? g.Kh : g.K, nt = Kh / BK;
    unsigned voffA[2], voffB[2];
#pragma unroll
    for (int i = 0; i < 2; ++i) { int R, C; stage_rc(tid * 16 + i * 8192, R, C); const int Rb = Epi::PERM ? ((R & ~31) + perm32(R & 31)) : R;
        voffA[i] = (unsigned)(R * K + C) * 2u; voffB[i] = (unsigned)(Rb * K + C) * 2u; }
    const size_t kstep = (size_t)(BK * 2);
    const size_t hstep = (size_t)HALF * K * 2;
    const size_t tstep = 2 * hstep;
    const unsigned ldsw = (unsigned)wid * 1024u;
    const int aoff = lds_byte(wr * 64 + fr, fq * 8), boff = lds_byte(wc * 32 + fr, fq * 8);
#define PG8_SA(b, h) (((b) * 2 + (h)) * HTB)
#define PG8_SB(b, h) ((4 + (b) * 2 + (h)) * HTB)
#define PG8_STAGE(bufoff, gbase, voff) do { _Pragma("unroll") for (int _i = 0; _i < 2; ++_i) \
        __builtin_amdgcn_global_load_lds((const PG8_GAS unsigned*)((const PG8_GAS char*)(gbase) + (voff)[_i]), (PG8_LAS unsigned*)(lds + (bufoff) + ldsw + _i * 8192), 16, 0, 0); } while (0)
#define PG8_LDA(dst, b, h) do { _Pragma("unroll") for (int m = 0; m < 4; ++m) _Pragma("unroll") for (int k = 0; k < 2; ++k) dst[m][k] = *(const PG8_LAS bf16x8*)(lds + PG8_SA(b, h) + aoff + m * 2048 + k * 1024); } while (0)
#define PG8_LDB(dst, b, h) do { _Pragma("unroll") for (int n = 0; n < 2; ++n) _Pragma("unroll") for (int k = 0; k < 2; ++k) dst[n][k] = *(const PG8_LAS bf16x8*)(lds + PG8_SB(b, h) + boff + n * 2048 + k * 1024); } while (0)
#define PG8_MMA(ai, bj, At, Bt) do { __builtin_amdgcn_s_setprio(1); _Pragma("unroll") for (int m = 0; m < 4; ++m) _Pragma("unroll") for (int n = 0; n < 2; ++n) _Pragma("unroll") for (int k = 0; k < 2; ++k) \
        acc[ai][bj][m][n] = __builtin_amdgcn_mfma_f32_16x16x32_bf16(Bt[n][k], At[m][k], acc[ai][bj][m][n], 0, 0, 0); __builtin_amdgcn_s_setprio(0); } while (0)
#define PG8_WAIT_V(n) asm volatile("s_waitcnt vmcnt(" #n ")" ::: "memory")
#define PG8_WAIT_L(n) asm volatile("s_waitcnt lgkmcnt(" #n ")" ::: "memory")
#define PG8_BAR __builtin_amdgcn_s_barrier()
#define PG8_SCHED __builtin_amdgcn_sched_barrier(0)
    Unit cur, nxt; int ui = 0;
    if (!S.next(0, cur)) return;
    f32x4 acc[2][2][4][2];
#pragma unroll
    for (int a = 0; a < 2; ++a)
#pragma unroll
        for (int b = 0; b < 2; ++b)
#pragma unroll
            for (int m = 0; m < 4; ++m)
#pragma unroll
                for (int n = 0; n < 2; ++n) acc[a][b][m][n] = (f32x4){0.f, 0.f, 0.f, 0.f};
    bf16x8 At[4][2], B0[2][2], B1[2][2];
    const PG8_GAS char* cA = (const PG8_GAS char*)g.A + (size_t)cur.pm * tstep + (size_t)cur.pk * Kh * 2; const PG8_GAS char* cB = (const PG8_GAS char*)g.Bt + (size_t)cur.pn * tstep + (size_t)cur.pk * Kh * 2;
    S.a_ready(cur);
    if constexpr (SP2) {
        PG8_STAGE(PG8_SB(0, 0), cB, voffB); PG8_STAGE(PG8_SB(0, 1), cB + hstep, voffB); PG8_STAGE(PG8_SA(0, 0), cA, voffA); PG8_STAGE(PG8_SA(0, 1), cA + hstep, voffA);
        if (wr == 1) PG8_BAR;
        PG8_WAIT_V(2); PG8_BAR;
        PG8_STAGE(PG8_SB(1, 0), cB + kstep, voffB); PG8_STAGE(PG8_SA(1, 0), cA + kstep, voffA); PG8_STAGE(PG8_SB(1, 1), cB + hstep + kstep, voffB);
        PG8_WAIT_V(6); PG8_BAR;
    } else {
    PG8_STAGE(PG8_SB(0, 0), cB, voffB); PG8_STAGE(PG8_SA(0, 0), cA, voffA); PG8_STAGE(PG8_SB(0, 1), cB + hstep, voffB); PG8_STAGE(PG8_SA(0, 1), cA + hstep, voffA);
    if (wr == 1) PG8_BAR;
    PG8_WAIT_V(4); PG8_BAR;
    PG8_STAGE(PG8_SB(1, 0), cB + kstep, voffB); PG8_STAGE(PG8_SA(1, 0), cA + kstep, voffA); PG8_STAGE(PG8_SB(1, 1), cB + hstep + kstep, voffB);
    PG8_WAIT_V(6); PG8_BAR;
    }
    for (;;) {
        const bool has_next = S.next(ui + 1, nxt);
        const PG8_GAS char* nA = has_next ? (const PG8_GAS char*)g.A + (size_t)nxt.pm * tstep + (size_t)nxt.pk * Kh * 2 : cA; const PG8_GAS char* nB = has_next ? (const PG8_GAS char*)g.Bt + (size_t)nxt.pn * tstep + (size_t)nxt.pk * Kh * 2 : cB;
        for (int t = 0; t < nt; t += 2) {
            const bool last = (t == nt - 2);
            const PG8_GAS char* a1 = cA + (size_t)(t + 1) * kstep;
            const PG8_GAS char* a2 = last ? nA : cA + (size_t)(t + 2) * kstep; const PG8_GAS char* b2 = last ? nB : cB + (size_t)(t + 2) * kstep;
            const PG8_GAS char* a3 = a2 + kstep; const PG8_GAS char* b3 = b2 + kstep;
            if (last && has_next) S.a_ready(nxt);
            if constexpr (SP2) {
            PG8_LDB(B0, 0, 0); PG8_LDB(B1, 0, 1); PG8_SCHED; PG8_LDA(At, 0, 0); PG8_STAGE(PG8_SA(1, 1), a1 + hstep, voffA);
            PG8_WAIT_V(8); PG8_WAIT_L(0); PG8_BAR; PG8_MMA(0, 0, At, B0); PG8_MMA(0, 1, At, B1); PG8_BAR; PG8_SCHED;
            PG8_LDA(At, 0, 1); PG8_STAGE(PG8_SB(0, 0), b2, voffB); PG8_STAGE(PG8_SB(0, 1), b2 + hstep, voffB); PG8_STAGE(PG8_SA(0, 0), a2, voffA);
            PG8_WAIT_V(8); PG8_WAIT_L(0); PG8_BAR; PG8_MMA(1, 0, At, B0); PG8_MMA(1, 1, At, B1); PG8_BAR; PG8_SCHED;
            PG8_LDB(B0, 1, 0); PG8_LDB(B1, 1, 1); PG8_SCHED; PG8_LDA(At, 1, 0); PG8_STAGE(PG8_SA(0, 1), a2 + hstep, voffA);
            PG8_WAIT_V(8); PG8_WAIT_L(0); PG8_BAR; PG8_MMA(0, 0, At, B0); PG8_MMA(0, 1, At, B1); PG8_BAR; PG8_SCHED;
            PG8_LDA(At, 1, 1); PG8_STAGE(PG8_SB(1, 0), b3, voffB); PG8_STAGE(PG8_SB(1, 1), b3 + hstep, voffB); PG8_STAGE(PG8_SA(1, 0), a3, voffA);
            PG8_WAIT_V(8); PG8_WAIT_L(0); PG8_BAR; PG8_MMA(1, 0, At, B0); PG8_MMA(1, 1, At, B1); PG8_BAR; PG8_SCHED;
            } else {
            PG8_LDB(B0, 0, 0); PG8_SCHED; PG8_LDA(At, 0, 0); PG8_STAGE(PG8_SA(1, 1), a1 + hstep, voffA);
            PG8_WAIT_L(8); PG8_BAR; PG8_WAIT_L(0); PG8_MMA(0, 0, At, B0); PG8_BAR; PG8_SCHED;
            PG8_LDB(B1, 0, 1); PG8_STAGE(PG8_SB(0, 0), b2, voffB);
            PG8_BAR; PG8_WAIT_L(0); PG8_MMA(0, 1, At, B1); PG8_BAR;
            PG8_LDA(At, 0, 1); PG8_STAGE(PG8_SA(0, 0), a2, voffA);
            PG8_BAR; PG8_WAIT_L(0); PG8_MMA(1, 0, At, B0); PG8_BAR; PG8_SCHED;
            PG8_STAGE(PG8_SB(0, 1), b2 + hstep, voffB);
            PG8_WAIT_V(6); PG8_BAR; PG8_MMA(1, 1, At, B1); PG8_BAR;
            PG8_LDB(B0, 1, 0); PG8_SCHED; PG8_LDA(At, 1, 0); PG8_STAGE(PG8_SA(0, 1), a2 + hstep, voffA);
            PG8_WAIT_L(8); PG8_BAR; PG8_WAIT_L(0); PG8_MMA(0, 0, At, B0); PG8_BAR; PG8_SCHED;
            PG8_LDB(B1, 1, 1); PG8_STAGE(PG8_SB(1, 0), b3, voffB);
            PG8_BAR; PG8_WAIT_L(0); PG8_MMA(0, 1, At, B1); PG8_BAR;
            PG8_LDA(At, 1, 1); PG8_STAGE(PG8_SA(1, 0), a3, voffA);
            PG8_BAR; PG8_WAIT_L(0); PG8_MMA(1, 0, At, B0); PG8_BAR; PG8_SCHED;
            PG8_STAGE(PG8_SB(1, 1), b3 + hstep, voffB);
            PG8_WAIT_V(6); PG8_BAR; PG8_MMA(1, 1, At, B1); PG8_BAR;
            }
        }
        if constexpr (ALIGN_EPI) { if (wr == 0) PG8_BAR; }
        if constexpr (!Epi::AFTER_DRAIN) { E(acc, cur, wr, wc, fr, fq); S.done(cur); }
        if (!has_next) break;
#pragma unroll
        for (int a = 0; a < 2; ++a)
#pragma unroll
            for (int b = 0; b < 2; ++b)
#pragma unroll
                for (int m = 0; m < 4; ++m)
#pragma unroll
                    for (int n = 0; n < 2; ++n) acc[a][b][m][n] = (f32x4){0.f, 0.f, 0.f, 0.f};
        cur = nxt; cA = nA; cB = nB; ++ui;
        if constexpr (ALIGN_EPI) { if (wr == 1) PG8_BAR; }
    }
    PG8_WAIT_V(0);
    if constexpr (!ALIGN_EPI) { if (wr == 0) PG8_BAR; }
    PG8_BAR;
    if constexpr (Epi::AFTER_DRAIN) { E.fused(acc, cur, wr, wc, fr, fq, lds, wid, lane); S.done(cur); }
#undef PG8_SA
#undef PG8_SB
#undef PG8_STAGE
#undef PG8_LDA
#undef PG8_LDB
#undef PG8_MMA
#undef PG8_WAIT_V
#undef PG8_WAIT_L
#undef PG8_BAR
#undef PG8_SCHED
}
}
namespace fk {
using namespace cfg;
#define LAS __attribute__((address_space(3)))
typedef unsigned short bf16;
typedef short bf16x8 __attribute__((ext_vector_type(8)));
typedef short s16x4 __attribute__((ext_vector_type(4)));
typedef float f32x4 __attribute__((ext_vector_type(4)));
typedef float f32x2 __attribute__((ext_vector_type(2)));
typedef float f32x16 __attribute__((ext_vector_type(16)));
typedef unsigned u32x4 __attribute__((ext_vector_type(4)));
typedef unsigned u32x2 __attribute__((ext_vector_type(2)));
typedef __bf16 bf16x2_t __attribute__((ext_vector_type(2)));
#define DI __device__ __forceinline__
#define GAS __attribute__((address_space(1)))
typedef GAS float gfloat; typedef GAS unsigned short gbf16; typedef GAS unsigned guint; typedef GAS int gint; typedef GAS unsigned char guchar;
#define MFMA32(a, b, c) __builtin_amdgcn_mfma_f32_32x32x16_bf16((a), (b), (c), 0, 0, 0)

DI unsigned pk2(float a, float b) { f32x2 f = {a, b}; bf16x2_t r = __builtin_convertvector(f, bf16x2_t); return __builtin_bit_cast(unsigned, r); }
DI bf16 f2bf(float a) { return (bf16)(pk2(a, 0.f) & 0xffffu); }
DI float bf2f(bf16 v) { return __builtin_bit_cast(float, (unsigned)v << 16); }
DI float bflo(unsigned w) { return __builtin_bit_cast(float, w << 16); }
DI float bfhi(unsigned w) { return __builtin_bit_cast(float, w & 0xffff0000u); }
DI float sigmoid_(float x) { return __builtin_amdgcn_rcpf(1.f + __expf(-x)); }
DI float silu_(float x) { return x * __builtin_amdgcn_rcpf(1.f + __expf(-x)); }
DI float softplus_(float x) { return fmaxf(x, 0.f) + log1pf(expf(-fabsf(x))); }
DI float gelu_tanh_(float x) { const float u = 0.7978845608028654f * (x + 0.044715f * x * x * x); const float e = __expf(2.f * u); return x * (1.f - __builtin_amdgcn_rcpf(e + 1.f)); }
DI int crow(int reg, int h) { return (reg & 3) + 8 * (reg >> 2) + 4 * h; }
DI f32x16 zero16() { f32x16 z; for (int i = 0; i < 16; ++i) z[i] = 0.f; return z; }
DI bf16x8 pack_step(const f32x16& x, int s) {
    u32x4 p; p[0] = pk2(x[8 * s], x[8 * s + 1]); p[1] = pk2(x[8 * s + 2], x[8 * s + 3]); p[2] = pk2(x[8 * s + 4], x[8 * s + 5]); p[3] = pk2(x[8 * s + 6], x[8 * s + 7]);
    return __builtin_bit_cast(bf16x8, p);
}
DI bf16x8 ld_perm_frag(const LAS bf16* rowp, int kbase, int s, int h) {
    const s16x4 lo = *(const LAS s16x4*)(rowp + kbase + 16 * s + 4 * h);
    const s16x4 hi = *(const LAS s16x4*)(rowp + kbase + 16 * s + 8 + 4 * h);
    return __builtin_shufflevector(lo, hi, 0, 1, 2, 3, 4, 5, 6, 7);
}
DI float shx(float v, int o, int lane) { return __builtin_bit_cast(float, __builtin_amdgcn_ds_bpermute((lane ^ o) << 2, __builtin_bit_cast(int, v))); }
DI float wave_sum(float v, int lane) {
#pragma unroll
    for (int o = 1; o < 64; o <<= 1) v += shx(v, o, lane);
    return v;
}

constexpr size_t al256(size_t x) { return (x + 255) / 256 * 256; }
constexpr int RMAX = 36864;
constexpr int NCH = NTOK / 64;
constexpr int NCHD = NCH * 8 * 2;
constexpr size_t WS_CTL = 0, CTL_BYTES = 1u << 20;
constexpr size_t WS_MOD = CTL_BYTES;
constexpr size_t WS_COS = WS_MOD + al256((size_t)DEPTH * 5 * MODW * 4);
constexpr size_t WS_SIN = WS_COS + (size_t)SEQ * 32 * 4;
constexpr size_t WS_WEIN = WS_SIN + (size_t)SEQ * 32 * 4;
constexpr size_t WS_WEOUT = WS_WEIN + (size_t)2 * 2560 * 1024 * 2;
constexpr size_t WS_WEF1 = WS_WEOUT + (size_t)2 * 1024 * 1024 * 2;
constexpr size_t WS_WEF2 = WS_WEF1 + (size_t)2 * 5632 * 1024 * 2;
constexpr size_t WS_WOIN = WS_WEF2 + (size_t)2 * 1024 * 2816 * 2;
constexpr size_t WS_WOOUT = WS_WOIN + (size_t)2 * 4352 * 1024 * 2;
constexpr size_t WS_WXIN = WS_WOOUT + (size_t)2 * 1024 * 1024 * 2;
constexpr size_t WS_WXOUT = WS_WXIN + (size_t)2 * 8 * 7168 * 1024 * 2;
constexpr size_t WS_X = WS_WXOUT + (size_t)2 * 8 * 1024 * 3584 * 2;
constexpr size_t WS_H = WS_X + (size_t)NTOK * D * 4;
constexpr size_t WS_MIX = WS_H + (size_t)NTOK * D * 2;
constexpr size_t WS_P = WS_MIX + (size_t)NTOK * D * 2;
constexpr size_t WS_HS1 = WS_P + (size_t)NTOK * 4352 * 2;
constexpr size_t WS_U = WS_HS1 + (size_t)NTOK * 512 * 4;
constexpr size_t WS_PART = WS_U + (size_t)400 * 1024 * 1024;
constexpr size_t WS_RGA = WS_U;
constexpr size_t WS_RGU = WS_RGA + (size_t)2 * NTOK * 512 * 4;
constexpr size_t WS_QKVN = WS_U;
constexpr size_t WS_WG = WS_QKVN + (size_t)NTOK * 3072 * 2;
constexpr size_t WS_UG = WS_WG + (size_t)NCHD * 64 * 128 * 2;
constexpr size_t WS_QKD = WS_UG + (size_t)NCHD * 64 * 128 * 4;
constexpr size_t WS_SC = WS_QKD + (size_t)NCHD * 64 * 64 * 2;
constexpr size_t WS_KTG = WS_SC + (size_t)NCHD * 192 * 4;
constexpr size_t WS_OG = WS_KTG + (size_t)NCHD * 128 * 64 * 2;
constexpr size_t WS_U_END1 = WS_OG + (size_t)2 * NTOK * D * 4;
constexpr size_t WS_XS = WS_U;
constexpr size_t WS_HIDM = WS_XS + (size_t)RMAX * D * 2;
constexpr size_t WS_Y = WS_HIDM + (size_t)RMAX * FFE * 2;
constexpr size_t WS_YP = WS_Y + (size_t)RMAX * D * 4;
constexpr size_t WS_U_END2 = WS_YP + (size_t)64 * 256 * D * 4;
constexpr size_t WS_TOK = (WS_U_END1 > WS_U_END2 ? WS_U_END1 : WS_U_END2);
constexpr size_t WS_END = WS_TOK + (size_t)NTOK * 32;
constexpr size_t WS_AB = WS_HS1;
constexpr size_t WS_GB = WS_AB + (size_t)NTOK * 32 * 4;

constexpr int CW_BAR = 4096;
constexpr int CW_CNT = 8192;
constexpr int CW_Q = 8448;
constexpr int CW_BC = 16384;

constexpr int LDS_BYTES = 152 * 1024;
constexpr int LDS_MISC = LDS_BYTES - 256;

struct Params { const float* in[31]; float* out; unsigned char* ws; int ph_lo, ph_hi; int dbg0, dbg1; };

DI const gfloat* gin(const Params& p, int k) { return (const gfloat*)p.in[k]; }
struct Ctx {
    LAS unsigned char* lds;
    guchar* ws; guchar* ws0;
    int tid, lane, wave, nblk, blk, wave0;
};
#define XB_TMO      128
#define XB_XCNT(j)  (256  + 64 * (j))
#define XB_XSUB(j)  (1280 + 64 * (j))
#define XB_XGEN(j)  (2304 + 64 * (j))
#define XB_TOP      3328
#define XB_TOPGEN   3392
#define XCD_BAR_WORDS 3456
#define XB_SPIN_CAP (1u << 27)

__device__ __forceinline__ unsigned xb_ld(unsigned* p)              { return __hip_atomic_load(p, __ATOMIC_RELAXED, __HIP_MEMORY_SCOPE_AGENT); }
__device__ __forceinline__ unsigned xb_add(unsigned* p, unsigned v) { (void)v; unsigned one; asm volatile("v_mov_b32 %0, 1" : "=v"(one)); return __hip_atomic_fetch_add(p, one, __ATOMIC_RELAXED, __HIP_MEMORY_SCOPE_AGENT); }
__device__ __forceinline__ unsigned xb_xcc_id() { return (unsigned)__builtin_amdgcn_s_getreg((3 << 11) | 20) & 0xFu; }
#define XB_SPIN(cond, bar) do { unsigned _sp = 0; while (cond) { __builtin_amdgcn_s_sleep(1); \
    if ((++_sp & 255u) == 0u) { if (xb_ld(&(bar)[XB_TMO])) break; if (_sp > XB_SPIN_CAP) { (void)xb_add(&(bar)[XB_TMO], 1u); break; } } } } while (0)

struct XcdBarrier {
    unsigned* bar; unsigned x;
    volatile LAS unsigned* st;
};

__device__ __forceinline__ XcdBarrier xcd_barrier_post(unsigned* bar, volatile LAS unsigned* st) {
    XcdBarrier b; b.bar = bar; b.x = xb_xcc_id(); b.st = st;
    if (threadIdx.x == 0) (void)xb_add(&bar[XB_XCNT(b.x)], 1u);
    return b;
}
__device__ __forceinline__ void xcd_barrier_complete(unsigned* bar, unsigned x, unsigned& nloc, unsigned& nx) {
    const unsigned G = gridDim.x * gridDim.y * gridDim.z;
    unsigned sum, cnt, mine, sp = 0u;
    for (;;) {
        sum = 0u; cnt = 0u; mine = 0u;
#pragma unroll
        for (unsigned j = 0; j < 16; ++j) { const unsigned c = xb_ld(&bar[XB_XCNT(j)]); sum += c; cnt += (c > 0u) ? 1u : 0u; mine = (j == x) ? c : mine; }
        if (sum == G) break;
        __builtin_amdgcn_s_sleep(1);
        if ((++sp & 255u) == 0u) { if (xb_ld(&bar[XB_TMO])) break; if (sp > XB_SPIN_CAP) { (void)xb_add(&bar[XB_TMO], 1u); break; } }
    }
    nloc = mine > 0u ? mine : 1u; nx = cnt > 0u ? cnt : 1u;
}

__device__ __forceinline__ void xcd_barrier(const XcdBarrier& b) {
    asm volatile("s_waitcnt vmcnt(0)" ::: "memory");
    __syncthreads();
    if (threadIdx.x == 0) {
        unsigned* bar = b.bar;
        __builtin_amdgcn_s_waitcnt(0);
        unsigned nloc = b.st[0], nx = b.st[1];
        if (nloc == 0u) { xcd_barrier_complete(bar, b.x, nloc, nx); b.st[0] = nloc; b.st[1] = nx; }
        const unsigned old = xb_add(&bar[XB_XSUB(b.x)], 1u);
        const unsigned gen = old / nloc;
        if (old + 1u == (gen + 1u) * nloc) {
            __builtin_amdgcn_fence(__ATOMIC_RELEASE, "agent");
            asm volatile("s_waitcnt vmcnt(0)" ::: "memory");
            const unsigned og = xb_add(&bar[XB_TOP], 1u);
            const unsigned tg = og / nx;
            if (og + 1u == (tg + 1u) * nx) xb_add(&bar[XB_TOPGEN], 1u);
            else XB_SPIN(xb_ld(&bar[XB_TOPGEN]) == tg, bar);
            __builtin_amdgcn_fence(__ATOMIC_ACQUIRE, "agent");
            xb_add(&bar[XB_XGEN(b.x)], 1u);
            asm volatile("s_waitcnt vmcnt(0)" ::: "memory");
        } else {
            XB_SPIN(xb_ld(&bar[XB_XGEN(b.x)]) == gen, bar);
            __builtin_amdgcn_fence(__ATOMIC_ACQUIRE, "agent");
            asm volatile("s_waitcnt vmcnt(0)" ::: "memory");
        }
    }
    __syncthreads();
}

using pg8::Unit;
typedef pg8::f32x4 af4;

struct EpiEvenIn {
    static constexpr bool PERM = true, AFTER_DRAIN = false;
    gbf16* P; const gfloat* cosT; const gfloat* sinT;
    DI void operator()(const af4 (&acc)[2][2][4][2], const Unit& u, int wr, int wc, int fr, int fq) const {
        const int row0 = u.pm * 256 + wr * 64 + fr, col0 = u.pn * 256 + wc * 32 + 8 * fq;
        const bool rope = (u.pn < 4) && (u.pm < 64);
        const float qs = (u.pn < 2) ? 0.18033688011112042f : 1.f;
#pragma unroll
        for (int ai = 0; ai < 2; ++ai)
#pragma unroll
            for (int m = 0; m < 4; ++m) {
                const int row = row0 + ai * 128 + m * 16;
                gbf16* rowp = P + (size_t)row * EVEN_IN + col0;
#pragma unroll
                for (int bj = 0; bj < 2; ++bj) {
                    af4 v0 = acc[ai][bj][m][0], v1 = acc[ai][bj][m][1];
                    if (rope) {
                        const int t = row & 4095, i0 = ((col0 + bj * 128) & 63) >> 1;
                        const af4 cs = *(const GAS af4*)(cosT + t * 32 + i0), sn = *(const GAS af4*)(sinT + t * 32 + i0);
                        af4 o0, o1;
                        o0[0] = v0[0] * cs[0] - v0[1] * sn[0]; o0[1] = v0[0] * sn[0] + v0[1] * cs[0];
                        o0[2] = v0[2] * cs[1] - v0[3] * sn[1]; o0[3] = v0[2] * sn[1] + v0[3] * cs[1];
                        o1[0] = v1[0] * cs[2] - v1[1] * sn[2]; o1[1] = v1[0] * sn[2] + v1[1] * cs[2];
                        o1[2] = v1[2] * cs[3] - v1[3] * sn[3]; o1[3] = v1[2] * sn[3] + v1[3] * cs[3];
                        v0 = o0; v1 = o1;
                    }
                    v0 = v0 * qs; v1 = v1 * qs;
                    u32x4 w; w[0] = pk2(v0[0], v0[1]); w[1] = pk2(v0[2], v0[3]); w[2] = pk2(v1[0], v1[1]); w[3] = pk2(v1[2], v1[3]);
                    *(GAS u32x4*)(rowp + bj * 128) = w;
                }
            }
    }
};
struct EpiBf16Ab {
    static constexpr bool PERM = true, AFTER_DRAIN = false;
    gbf16* O; int ldc; gfloat* AB; int ab_pn;
    DI void operator()(const af4 (&acc)[2][2][4][2], const Unit& u, int wr, int wc, int fr, int fq) const {
        const int row0 = u.pm * 256 + wr * 64 + fr, col0 = u.pn * 256 + wc * 32 + 8 * fq;
        if (u.pn == ab_pn) {
            if (wc == 0) {
#pragma unroll
                for (int ai = 0; ai < 2; ++ai)
#pragma unroll
                    for (int m = 0; m < 4; ++m) { gfloat* ap = AB + (size_t)(row0 + ai * 128 + m * 16) * 32 + 8 * fq; *(GAS af4*)ap = acc[ai][0][m][0]; *(GAS af4*)(ap + 4) = acc[ai][0][m][1]; }
            }
            return;
        }
#pragma unroll
        for (int ai = 0; ai < 2; ++ai)
#pragma unroll
            for (int m = 0; m < 4; ++m) {
                gbf16* rowp = O + (size_t)(row0 + ai * 128 + m * 16) * ldc + col0;
#pragma unroll
                for (int bj = 0; bj < 2; ++bj) { const af4 v0 = acc[ai][bj][m][0], v1 = acc[ai][bj][m][1];
                    u32x4 w; w[0] = pk2(v0[0], v0[1]); w[1] = pk2(v0[2], v0[3]); w[2] = pk2(v1[0], v1[1]); w[3] = pk2(v1[2], v1[3]);
                    *(GAS u32x4*)(rowp + bj * 128) = w; }
            }
    }
};
struct EpiSwiglu {
    static constexpr bool PERM = true, AFTER_DRAIN = false;
    gbf16* O; int ldc; int nN;
    DI void operator()(const af4 (&acc)[2][2][4][2], const Unit& u, int wr, int wc, int fr, int fq) const {
        const int row0 = u.pm * 256 + wr * 64 + fr, col0 = (u.pn % nN) * 128 + wc * 32 + 8 * fq;
#pragma unroll
        for (int ai = 0; ai < 2; ++ai)
#pragma unroll
            for (int m = 0; m < 4; ++m) {
                const af4 g0 = acc[ai][0][m][0], g1 = acc[ai][0][m][1], u0 = acc[ai][1][m][0], u1 = acc[ai][1][m][1];
                float r[8];
#pragma unroll
                for (int j = 0; j < 4; ++j) { r[j] = silu_(g0[j]) * u0[j]; r[4 + j] = silu_(g1[j]) * u1[j]; }
                u32x4 w; w[0] = pk2(r[0], r[1]); w[1] = pk2(r[2], r[3]); w[2] = pk2(r[4], r[5]); w[3] = pk2(r[6], r[7]);
                *(GAS u32x4*)(O + (size_t)(row0 + ai * 128 + m * 16) * ldc + col0) = w;
            }
    }
};
struct EpiResid {
    static constexpr bool PERM = false, AFTER_DRAIN = false;
    gfloat* X; const gfloat* gate;
    DI void operator()(const af4 (&acc)[2][2][4][2], const Unit& u, int wr, int wc, int fr, int fq) const {
        const int row0 = u.pm * 256 + wr * 64 + fr, col0 = u.pn * 256 + wc * 32 + 4 * fq;
        const gfloat* gv = gate + (size_t)(u.pm < 64 ? (u.pm >> 4) : 4) * MODW + col0;
        af4 g[2][2];
#pragma unroll
        for (int bj = 0; bj < 2; ++bj)
#pragma unroll
            for (int n = 0; n < 2; ++n) g[bj][n] = *(const GAS af4*)(gv + bj * 128 + n * 16);
#pragma unroll
        for (int ai = 0; ai < 2; ++ai)
#pragma unroll
            for (int m = 0; m < 4; ++m) { gfloat* rowp = X + (size_t)(row0 + ai * 128 + m * 16) * D + col0;
#pragma unroll
                for (int bj = 0; bj < 2; ++bj)
#pragma unroll
                    for (int n = 0; n < 2; ++n) { GAS af4* p = (GAS af4*)(rowp + bj * 128 + n * 16); *p = *p + g[bj][n] * acc[ai][bj][m][n]; } }
    }
};
struct EpiPart {
    static constexpr bool PERM = false, AFTER_DRAIN = false;
    gfloat* PART;
    DI void operator()(const af4 (&acc)[2][2][4][2], const Unit& u, int wr, int wc, int fr, int fq) const {
        const int row0 = u.pm * 256 + wr * 64 + fr, col0 = u.pn * 256 + wc * 32 + 4 * fq;
        gfloat* base = PART + (size_t)u.pk * NCTX * D;
#pragma unroll
        for (int ai = 0; ai < 2; ++ai)
#pragma unroll
            for (int m = 0; m < 4; ++m) { gfloat* rowp = base + (size_t)(row0 + ai * 128 + m * 16) * D + col0;
#pragma unroll
                for (int bj = 0; bj < 2; ++bj)
#pragma unroll
                    for (int n = 0; n < 2; ++n) *(GAS af4*)(rowp + bj * 128 + n * 16) = acc[ai][bj][m][n]; }
    }
};
struct EpiF32 {
    static constexpr bool PERM = false, AFTER_DRAIN = false;
    gfloat* C; int ldc; int nN;
    DI void operator()(const af4 (&acc)[2][2][4][2], const Unit& u, int wr, int wc, int fr, int fq) const {
        const int row0 = u.pm * 256 + wr * 64 + fr, col0 = (u.pn % nN) * 256 + wc * 32 + 4 * fq;
#pragma unroll
        for (int ai = 0; ai < 2; ++ai)
#pragma unroll
            for (int m = 0; m < 4; ++m) { gfloat* rowp = C + (size_t)(row0 + ai * 128 + m * 16) * ldc + col0;
#pragma unroll
                for (int bj = 0; bj < 2; ++bj)
#pragma unroll
                    for (int n = 0; n < 2; ++n) *(GAS af4*)(rowp + bj * 128 + n * 16) = acc[ai][bj][m][n]; }
    }
};
struct MoeOrder : pg8::StaticOrder {
    int tend[8];
    __device__ void initm(const guint* cnt, int nN_, int G_, int c_) {
        int acc = 0;
#pragma unroll
        for (int e = 0; e < 8; ++e) { acc += ((int)cnt[e] + 255) >> 8; tend[e] = acc; }
        nM = acc; nN = nN_; nwg = nM * nN; G = G_; c = c_; lim = nwg; L0 = 0; s = 1;
    }
    __device__ bool next(int i, Unit& u) const {
        if (!pg8::StaticOrder::next(i, u)) return false;
        int e = 0;
#pragma unroll
        for (int k = 0; k < 7; ++k) e += (u.pm >= tend[k]) ? 1 : 0;
        u.pn += e * nN; return true;
    }
};

struct MoeOrder2 {
    int tend[8]; int nM, nwg, G, c, Lmain, r, s, tail;
    __device__ __forceinline__ void initm(const guint* cnt, int G_, int c_, int tail_) {
        int acc = 0;
#pragma unroll
        for (int e = 0; e < 8; ++e) { acc += ((int)cnt[e] + 255) >> 8; tend[e] = acc; }
        nM = acc; nwg = nM * 4; G = G_; c = c_; tail = tail_; Lmain = (nwg / G) * G; r = nwg - Lmain;
        s = 1; if (r > 0) { const int q = G / r; s = q >= 14 ? 14 : (q >= 7 ? 7 : (q >= 4 ? 4 : (q >= 2 ? 2 : 1))); }
    }
    __device__ __forceinline__ int tail_row0() const { return (Lmain >> 2) * 256; }
    __device__ __forceinline__ bool next(int i, Unit& u) const {
        const int j = i * G + c; int Lp;
        if (!tail) { if (j >= Lmain) return false; Lp = (j & 7) * (Lmain >> 3) + (j >> 3); u.pk = 0; }
        else { if (j >= r * s) return false; Lp = Lmain + j / s; u.pk = j % s; }
        u.pm = Lp >> 2; int e = 0;
#pragma unroll
        for (int k = 0; k < 7; ++k) e += (u.pm >= tend[k]) ? 1 : 0;
        u.pn = e * 4 + (Lp & 3); return true;
    }
    __device__ __forceinline__ void a_ready(const Unit&) const {}
    __device__ __forceinline__ void done(const Unit&) const {}
};
struct EpiPartY {
    static constexpr bool PERM = false, AFTER_DRAIN = false;
    gfloat* YP; int pm0, tail_rows;
    DI void operator()(const af4 (&acc)[2][2][4][2], const Unit& u, int wr, int wc, int fr, int fq) const {
        const int row0 = (u.pm - pm0) * 256 + wr * 64 + fr, col0 = (u.pn & 3) * 256 + wc * 32 + 4 * fq;
        gfloat* base = YP + (size_t)u.pk * tail_rows * D;
#pragma unroll
        for (int ai = 0; ai < 2; ++ai)
#pragma unroll
            for (int m = 0; m < 4; ++m) { gfloat* rowp = base + (size_t)(row0 + ai * 128 + m * 16) * D + col0;
#pragma unroll
                for (int bj = 0; bj < 2; ++bj)
#pragma unroll
                    for (int n = 0; n < 2; ++n) *(GAS af4*)(rowp + bj * 128 + n * 16) = acc[ai][bj][m][n]; }
    }
};
DI void transpose_load(f32x4 (&v)[8], const gfloat* W, int ldw, int k0, int n0, int lane) {
#pragma unroll
    for (int i = 0; i < 8; ++i) v[i] = *(const GAS f32x4*)(W + (size_t)(k0 + 8 * i + (lane >> 3)) * ldw + n0 + 4 * (lane & 7));
}
DI void transpose_store(const f32x4 (&v)[8], int K, gbf16* WT, int k0, int drow0, LAS float* scr, int lane) {
#pragma unroll
    for (int i = 0; i < 8; ++i) { LAS float* d = scr + (8 * i + (lane >> 3)) * 33 + 4 * (lane & 7); d[0] = v[i][0]; d[1] = v[i][1]; d[2] = v[i][2]; d[3] = v[i][3]; }
    asm volatile("s_waitcnt lgkmcnt(0)" ::: "memory");
    const int c = lane & 7;
#pragma unroll
    for (int j = 0; j < 4; ++j) { const int n = (lane >> 3) + 8 * j; const LAS float* s = scr + (8 * c) * 33 + n;
        u32x4 o; o[0] = pk2(s[0 * 33], s[1 * 33]); o[1] = pk2(s[2 * 33], s[3 * 33]); o[2] = pk2(s[4 * 33], s[5 * 33]); o[3] = pk2(s[6 * 33], s[7 * 33]);
        *(GAS u32x4*)(WT + (size_t)(drow0 + n) * K + k0 + 8 * c) = o; }
    asm volatile("s_waitcnt lgkmcnt(0)" ::: "memory");
}
struct TJob { const gfloat* W; gbf16* WT; int ldw, K, N, F; };
DI int tjob_items(const TJob& j) { return (j.K / 64) * (j.N / 32); }
DI TJob get_tjob(const Params& p, int j) {
    const int i = j / 22, r = j % 22; unsigned char* ws = p.ws; TJob t;
    if (r == 0) t = TJob{gin(p, 9) + (size_t)i * D * EVEN_IN, (gbf16*)(ws + WS_WEIN) + (size_t)i * 2560 * 1024, EVEN_IN, D, EVEN_IN, 0};
    else if (r == 1) t = TJob{gin(p, 10) + (size_t)i * D * D, (gbf16*)(ws + WS_WEOUT) + (size_t)i * 1024 * 1024, D, D, D, 0};
    else if (r == 2) t = TJob{gin(p, 20) + (size_t)i * D * 2 * FFN, (gbf16*)(ws + WS_WEF1) + (size_t)i * 5632 * 1024, 2 * FFN, D, 2 * FFN, FFN};
    else if (r == 3) t = TJob{gin(p, 21) + (size_t)i * FFN * D, (gbf16*)(ws + WS_WEF2) + (size_t)i * 1024 * 2816, D, FFN, D, 0};
    else if (r == 4) t = TJob{gin(p, 22) + (size_t)i * D * ODD_IN, (gbf16*)(ws + WS_WOIN) + (size_t)i * 4352 * 1024, ODD_IN, D, ODD_IN, 0};
    else if (r == 5) t = TJob{gin(p, 27) + (size_t)i * D * D, (gbf16*)(ws + WS_WOOUT) + (size_t)i * 1024 * 1024, D, D, D, 0};
    else if (r < 14) { const int e = r - 6; t = TJob{gin(p, 29) + ((size_t)i * 8 + e) * D * 2 * FFE, (gbf16*)(ws + WS_WXIN) + ((size_t)i * 8 + e) * 7168 * 1024, 2 * FFE, D, 2 * FFE, FFE}; }
    else { const int e = r - 14; t = TJob{gin(p, 30) + ((size_t)i * 8 + e) * FFE * D, (gbf16*)(ws + WS_WXOUT) + ((size_t)i * 8 + e) * 1024 * 3584, D, FFE, D, 0}; }
    return t;
}
#ifndef CONV_DEFER
#define CONV_DEFER 1
#endif
DI void convert_weights(const Ctx& C, const Params& p, int group, int gw, int NGW) {
    LAS float* scr = (LAS float*)(C.lds + 32768 + C.wave * 8704);
    int jstart = 0;
    for (int j = 0; j < 44; ++j) {
        const int gj = j < 6 ? 0 : (j < 28 ? 1 : 2);
        if (gj != group) continue;
        const TJob t = get_tjob(p, j); const int ni = tjob_items(t), nblkN = t.N / 32;
        const int first = (gw - jstart % NGW + NGW) % NGW;
        auto item_geom = [&](int it, int& k0, int& n0, int& drow0) { const int kb = it / nblkN, nb = it % nblkN; k0 = kb * 64; n0 = nb * 32; drow0 = n0;
            if (t.F > 0) drow0 = (n0 < t.F) ? ((n0 / 128) * 256 + (n0 % 128)) : (((n0 - t.F) / 128) * 256 + 128 + ((n0 - t.F) % 128)); };
        f32x4 va[8], vb[8], vc[8]; int k0 = 0, n0 = 0, d0 = 0, k1 = 0, n1 = 0, d1 = 0;
        if (first < ni) { item_geom(first, k0, n0, d0); transpose_load(va, t.W, t.ldw, k0, n0, C.lane); }
        if (first + NGW < ni) { item_geom(first + NGW, k1, n1, d1); transpose_load(vb, t.W, t.ldw, k1, n1, C.lane); }
        for (int it = first; it < ni; it += NGW) {
            const int nx = it + 2 * NGW; int k2 = 0, n2 = 0, d2 = 0;
            if (nx < ni) { item_geom(nx, k2, n2, d2); transpose_load(vc, t.W, t.ldw, k2, n2, C.lane); }
            transpose_store(va, t.K, t.WT, k0, d0, scr, C.lane);
#pragma unroll
            for (int q = 0; q < 8; ++q) { va[q] = vb[q]; vb[q] = vc[q]; }
            k0 = k1; n0 = n1; d0 = d1; k1 = k2; n1 = n2; d1 = d2;
        }
        jstart += ni;
    }
}
DI void ph_prologue(const Ctx& C, const Params& p) {
    LAS float* sil = (LAS float*)(C.lds);
    for (int i = C.tid; i < 5 * 1024; i += 512) { const int v = i >> 10, k = i & 1023; const float x = v < 4 ? gin(p, 1)[v * 1024 + k] : gin(p, 3)[k]; sil[i] = x / (1.f + expf(-x)); }
    __syncthreads();
    const int gw = C.blk * 8 + C.wave, NGW = C.nblk * 8;
    gfloat* MOD = (gfloat*)(C.ws + WS_MOD);
    for (int it = gw; it < DEPTH * (MODW / 64); it += NGW) {
        const int l = it / (MODW / 64), n = (it % (MODW / 64)) * 64 + C.lane;
        const gfloat* w = gin(p, 4) + (size_t)l * 1024 * MODW + n;
        float a0 = 0.f, a1 = 0.f, a2 = 0.f, a3 = 0.f, a4 = 0.f;
#pragma unroll 8
        for (int k = 0; k < 1024; ++k) { const float wv = w[(size_t)k * MODW]; a0 += sil[k] * wv; a1 += sil[1024 + k] * wv; a2 += sil[2048 + k] * wv; a3 += sil[3072 + k] * wv; a4 += sil[4096 + k] * wv; }
        const float bb = gin(p, 5)[l * MODW + n];
        MOD[(size_t)(l * 5 + 0) * MODW + n] = a0 + bb; MOD[(size_t)(l * 5 + 1) * MODW + n] = a1 + bb; MOD[(size_t)(l * 5 + 2) * MODW + n] = a2 + bb;
        MOD[(size_t)(l * 5 + 3) * MODW + n] = a3 + bb; MOD[(size_t)(l * 5 + 4) * MODW + n] = a4 + bb;
    }
    { gfloat* cosT = (gfloat*)(C.ws + WS_COS); gfloat* sinT = (gfloat*)(C.ws + WS_SIN);
      for (int idx = C.blk * 512 + C.tid; idx < SEQ * 32; idx += C.nblk * 512) { const int t = idx >> 5, i = idx & 31;
          const float invf = powf(10000.f, -(float)(i & 15) / 16.f); const float ang = (i < 16 ? (float)(t >> 6) : (float)(t & 63)) * invf;
          cosT[idx] = cosf(ang); sinT[idx] = sinf(ang); } }
    { for (int i = 0; i < 2; ++i) { GAS u32x4* z = (GAS u32x4*)((gbf16*)(C.ws + WS_WOIN) + (size_t)i * 4352 * 1024 + (size_t)4128 * 1024);
          for (int idx = C.blk * 512 + C.tid; idx < 224 * 1024 / 8; idx += C.nblk * 512) z[idx] = (u32x4){0u, 0u, 0u, 0u}; } }
    convert_weights(C, p, 0, gw, NGW);
#if CONV_DEFER == 0
    convert_weights(C, p, 1, gw, NGW); convert_weights(C, p, 2, gw, NGW);
#endif
}

DI void normmod_regs(f32x4 (&v)[4], const gfloat* g, const gfloat* shift, const gfloat* scale, int lane) {
    float ss = 0.f;
#pragma unroll
    for (int j = 0; j < 4; ++j) ss += (v[j][0] * v[j][0] + v[j][1] * v[j][1]) + (v[j][2] * v[j][2] + v[j][3] * v[j][3]);
    const float rs = rsqrtf(wave_sum(ss, lane) * (1.f / D) + 1e-6f);
#pragma unroll
    for (int j = 0; j < 4; ++j) { const f32x4 gg = ((const GAS f32x4*)g)[lane + 64 * j], sh = ((const GAS f32x4*)shift)[lane + 64 * j], sc = ((const GAS f32x4*)scale)[lane + 64 * j];
        v[j] = v[j] * rs * gg * (sc + 1.f) + sh; }
}
DI void store_row_bf16(gbf16* orow, const f32x4 (&v)[4], int lane) {
#pragma unroll
    for (int j = 0; j < 4; ++j) { u32x2 w; w[0] = pk2(v[j][0], v[j][1]); w[1] = pk2(v[j][2], v[j][3]); ((GAS u32x2*)orow)[lane + 64 * j] = w; }
}
DI void add_ctx_partials(const Ctx& C, f32x4 (&v)[4], int r, int npart, const gfloat* gate_ctx, gfloat* Xrow) {
    const gfloat* PART = (const gfloat*)(C.ws + WS_PART) + (size_t)(r - NLAT) * D;
#pragma unroll
    for (int j = 0; j < 4; ++j) { f32x4 a = (f32x4){0.f, 0.f, 0.f, 0.f};
        for (int pk = 0; pk < npart; ++pk) a = a + ((const GAS f32x4*)(PART + (size_t)pk * NCTX * D))[C.lane + 64 * j];
        v[j] = v[j] + ((const GAS f32x4*)gate_ctx)[C.lane + 64 * j] * a; ((GAS f32x4*)Xrow)[C.lane + 64 * j] = v[j]; }
}
DI void ph_normmod(const Ctx& C, const Params& p, int layer, bool second, bool from_input, int npart, int gate_off) {
    const int gw = C.blk * 8 + C.wave, NGW = C.nblk * 8;
    gfloat* X = (gfloat*)(C.ws + WS_X); gbf16* H = (gbf16*)(C.ws + WS_H);
    const gfloat* MODl = (const gfloat*)(C.ws + WS_MOD) + (size_t)layer * 5 * MODW;
    const gfloat* g = (second ? gin(p, 7) : gin(p, 6)) + layer * D;
    auto srcrow = [&](int r) { return from_input ? (r < NLAT ? gin(p, 0) + (size_t)r * D : gin(p, 2) + (size_t)(r - NLAT) * D) : (const gfloat*)X + (size_t)r * D; };
    f32x4 v[4], vn[4];
    if (gw < NTOK) { const gfloat* src = srcrow(gw);
#pragma unroll
        for (int j = 0; j < 4; ++j) v[j] = ((const GAS f32x4*)src)[C.lane + 64 * j]; }
    for (int r = gw; r < NTOK; r += NGW) {
        const int rn = r + NGW;
        if (rn < NTOK) { const gfloat* src = srcrow(rn);
#pragma unroll
            for (int j = 0; j < 4; ++j) vn[j] = ((const GAS f32x4*)src)[C.lane + 64 * j]; }
        if (from_input) {
#pragma unroll
            for (int j = 0; j < 4; ++j) ((GAS f32x4*)(X + (size_t)r * D))[C.lane + 64 * j] = v[j]; }
        if (npart > 0 && r >= NLAT) add_ctx_partials(C, v, r, npart, (const gfloat*)(C.ws + WS_MOD) + gate_off + 4 * MODW, X + (size_t)r * D);
        const gfloat* mv = MODl + (size_t)(r < NLAT ? (r >> 12) : 4) * MODW + (second ? 3 * D : 0);
        normmod_regs(v, g, mv, mv + D, C.lane);
        store_row_bf16(H + (size_t)r * D, v, C.lane);
#pragma unroll
        for (int j = 0; j < 4; ++j) v[j] = vn[j];
    }
}

DI void seq_bounds(int r, int& s0, int& s1) { if (r < NLAT) { s0 = r & ~4095; s1 = s0 + 4096; } else { s0 = NLAT + ((r - NLAT) & ~255); s1 = s0 + 256; } }

DI void ph_odd_conv(const Ctx& C, const Params& p, int i) {
    const int gw = C.blk * 8 + C.wave, NGW = C.nblk * 8;
    const gbf16* PO = (const gbf16*)(C.ws + WS_P); gbf16* QKVN = (gbf16*)(C.ws + WS_QKVN);
    const gfloat* AB = (const gfloat*)(C.ws + WS_AB); gfloat* Gd = (gfloat*)(C.ws + WS_GB); gfloat* Bd = Gd + (size_t)2 * NTOK * 8;
    const gfloat* cw = gin(p, 23) + (size_t)i * 4 * 3072;
    for (int u = gw; u < NCH * 6; u += NGW) {
        const int strip = u / 6, cgp = u % 6, r0 = strip * 64, c = cgp * 512 + 8 * C.lane;
        int s0, s1; seq_bounds(r0, s0, s1);
        float w[4][8];
#pragma unroll
        for (int tp = 0; tp < 4; ++tp) { const f32x4 w0 = *(const GAS f32x4*)(cw + tp * 3072 + c), w1 = *(const GAS f32x4*)(cw + tp * 3072 + c + 4);
#pragma unroll
            for (int e = 0; e < 4; ++e) { w[tp][e] = w0[e]; w[tp][4 + e] = w1[e]; } }
        u32x4 win[4];
        const u32x4 zz = (u32x4){0u, 0u, 0u, 0u};
        win[1] = (r0 - 2 >= s0) ? *(const GAS u32x4*)(PO + (size_t)(r0 - 2) * 4352 + c) : zz;
        win[2] = (r0 - 1 >= s0) ? *(const GAS u32x4*)(PO + (size_t)(r0 - 1) * 4352 + c) : zz;
        win[3] = *(const GAS u32x4*)(PO + (size_t)r0 * 4352 + c);
#pragma unroll 4
        for (int rr = 0; rr < 64; ++rr) {
            const int r = r0 + rr;
            win[0] = win[1]; win[1] = win[2]; win[2] = win[3];
            win[3] = (r + 1 < s1) ? *(const GAS u32x4*)(PO + (size_t)(r + 1) * 4352 + c) : zz;
            float a[8] = {0.f, 0.f, 0.f, 0.f, 0.f, 0.f, 0.f, 0.f};
#pragma unroll
            for (int tp = 0; tp < 4; ++tp) { const u32x4 x = win[tp];
                a[0] += w[tp][0] * bflo(x[0]); a[1] += w[tp][1] * bfhi(x[0]); a[2] += w[tp][2] * bflo(x[1]); a[3] += w[tp][3] * bfhi(x[1]);
                a[4] += w[tp][4] * bflo(x[2]); a[5] += w[tp][5] * bfhi(x[2]); a[6] += w[tp][6] * bflo(x[3]); a[7] += w[tp][7] * bfhi(x[3]); }
            float ss = 0.f;
#pragma unroll
            for (int e = 0; e < 8; ++e) { a[e] = silu_(a[e]); ss += a[e] * a[e]; }
            if (cgp < 4) {
                ss += shx(ss, 1, C.lane); ss += shx(ss, 2, C.lane); ss += shx(ss, 4, C.lane); ss += shx(ss, 8, C.lane);
                const float rn = rsqrtf(ss + 1e-6f);
#pragma unroll
                for (int e = 0; e < 8; ++e) a[e] *= rn;
            }
            u32x4 o; o[0] = pk2(a[0], a[1]); o[1] = pk2(a[2], a[3]); o[2] = pk2(a[4], a[5]); o[3] = pk2(a[6], a[7]);
            *(GAS u32x4*)(QKVN + (size_t)r * 3072 + c) = o;
        }
    }
    for (int r = gw * 4 + (C.lane >> 4); r < NTOK; r += NGW * 4) { const int l16 = C.lane & 15, d = l16 >> 3, h = l16 & 7;
        const float x0 = AB[(size_t)r * 32 + d * 16 + h], x1 = AB[(size_t)r * 32 + d * 16 + 8 + h];
        Gd[((size_t)d * NTOK + r) * 8 + h] = -expf(gin(p, 24)[i * 16 + d * 8 + h]) * softplus_(x0 + gin(p, 25)[i * 16 + d * 8 + h]);
        Bd[((size_t)d * NTOK + r) * 8 + h] = 1.f / (1.f + expf(-x1)); }
}
DI void ph_gdn_out(const Ctx& C, const Params& p, int i) {
    const int gw = C.blk * 8 + C.wave, NGW = C.nblk * 8;
    const gfloat* OG = (const gfloat*)(C.ws + WS_OG); const gbf16* PO = (const gbf16*)(C.ws + WS_P); gbf16* MIX = (gbf16*)(C.ws + WS_MIX);
    const f32x4 go = ((const GAS f32x4*)(gin(p, 26) + i * 128))[C.lane & 31];
    f32x4 ca[4], cb[4], na[4], nb[4]; u32x2 cz[4], nz[4];
#define GO_LOAD(r_, A_, B_, Z_) do { _Pragma("unroll") for (int j = 0; j < 4; ++j) { A_[j] = ((const GAS f32x4*)(OG + (size_t)(r_) * D))[C.lane + 64 * j]; B_[j] = ((const GAS f32x4*)(OG + ((size_t)NTOK + (r_)) * D))[C.lane + 64 * j]; \
        Z_[j] = *(const GAS u32x2*)(PO + (size_t)(r_) * 4352 + 3072 + 4 * C.lane + 256 * j); } } while (0)
    if (gw < NTOK) GO_LOAD(gw, ca, cb, cz);
    for (int r = gw; r < NTOK; r += NGW) {
        const int rn = r + NGW;
        if (rn < NTOK) GO_LOAD(rn, na, nb, nz);
#pragma unroll
        for (int j = 0; j < 4; ++j) {
            f32x4 o = ca[j] + cb[j];
            float ss = (o[0] * o[0] + o[1] * o[1]) + (o[2] * o[2] + o[3] * o[3]);
            ss += shx(ss, 1, C.lane); ss += shx(ss, 2, C.lane); ss += shx(ss, 4, C.lane); ss += shx(ss, 8, C.lane); ss += shx(ss, 16, C.lane);
            const float rs = rsqrtf(ss * (1.f / 128.f) + 1e-6f);
            const u32x2 z = cz[j];
            o[0] *= rs * go[0] * silu_(bflo(z[0])); o[1] *= rs * go[1] * silu_(bfhi(z[0])); o[2] *= rs * go[2] * silu_(bflo(z[1])); o[3] *= rs * go[3] * silu_(bfhi(z[1]));
            u32x2 w; w[0] = pk2(o[0], o[1]); w[1] = pk2(o[2], o[3]);
            ((GAS u32x2*)(MIX + (size_t)r * D))[C.lane + 64 * j] = w;
        }
#pragma unroll
        for (int j = 0; j < 4; ++j) { ca[j] = na[j]; cb[j] = nb[j]; cz[j] = nz[j]; }
    }
#undef GO_LOAD
}
struct TokInfo { int e0, p0, e1, p1; float w0, w1; int r0, r1; };
DI void ti_store(GAS TokInfo* q, const TokInfo& t) { u32x4 a, b; a[0] = (unsigned)t.e0; a[1] = (unsigned)t.p0; a[2] = (unsigned)t.e1; a[3] = (unsigned)t.p1; b[0] = __float_as_uint(t.w0); b[1] = __float_as_uint(t.w1); b[2] = (unsigned)t.r0; b[3] = (unsigned)t.r1;
    ((GAS u32x4*)q)[0] = a; ((GAS u32x4*)q)[1] = b; }
DI TokInfo ti_load(const GAS TokInfo* q) { const u32x4 a = ((const GAS u32x4*)q)[0], b = ((const GAS u32x4*)q)[1]; TokInfo t; t.e0 = (int)a[0]; t.p0 = (int)a[1]; t.e1 = (int)a[2]; t.p1 = (int)a[3]; t.w0 = __uint_as_float(b[0]); t.w1 = __uint_as_float(b[1]); t.r0 = (int)b[2]; t.r1 = (int)b[3]; return t; }
DI void ph_router(const Ctx& C, const Params& p, int layer, int ntok, int npart) {
    const int gw = C.blk * 8 + C.wave, NGW = C.nblk * 8, i = layer >> 1;
    gfloat* X = (gfloat*)(C.ws + WS_X); gbf16* H = (gbf16*)(C.ws + WS_H);
    const gfloat* MODl = (const gfloat*)(C.ws + WS_MOD) + (size_t)layer * 5 * MODW;
    const gfloat* g = gin(p, 7) + layer * D; const gfloat* wr = gin(p, 28) + (size_t)i * D * 8;
    guint* bc = (guint*)(C.ws + WS_CTL) + CW_BC + (i * 1024 + C.blk) * 8; GAS TokInfo* TI = (GAS TokInfo*)(C.ws + WS_TOK);
    LAS int* sl = (LAS int*)(C.lds + 64);
    for (int q = C.tid; q < 96 * 6; q += 512) sl[q] = -1;
    __syncthreads();
    int k = 0;
    for (int r = gw; r < NTOK; r += NGW, ++k) {
        f32x4 v[4];
#pragma unroll
        for (int j = 0; j < 4; ++j) v[j] = ((const GAS f32x4*)(X + (size_t)r * D))[C.lane + 64 * j];
        if (npart > 0 && r >= NLAT) add_ctx_partials(C, v, r, npart, MODl + 4 * MODW + 2 * D, X + (size_t)r * D);
        const gfloat* mv = MODl + (size_t)(r < NLAT ? (r >> 12) : 4) * MODW + 3 * D;
        normmod_regs(v, g, mv, mv + D, C.lane);
        store_row_bf16(H + (size_t)r * D, v, C.lane);
        if (r >= ntok) continue;
        float lg[8] = {0.f, 0.f, 0.f, 0.f, 0.f, 0.f, 0.f, 0.f};
#pragma unroll
        for (int j = 0; j < 4; ++j)
#pragma unroll
            for (int q = 0; q < 4; ++q) { const int kk = 4 * C.lane + 256 * j + q; const f32x4 w0 = *(const GAS f32x4*)(wr + kk * 8), w1 = *(const GAS f32x4*)(wr + kk * 8 + 4); const float x = v[j][q];
                lg[0] += x * w0[0]; lg[1] += x * w0[1]; lg[2] += x * w0[2]; lg[3] += x * w0[3]; lg[4] += x * w1[0]; lg[5] += x * w1[1]; lg[6] += x * w1[2]; lg[7] += x * w1[3]; }
#pragma unroll
        for (int e = 0; e < 8; ++e) lg[e] = wave_sum(lg[e], C.lane);
        if (C.lane == 0) {
            int e0 = 0; float b0 = lg[0];
#pragma unroll
            for (int e = 1; e < 8; ++e) if (lg[e] > b0) { e0 = e; b0 = lg[e]; }
            int e1 = -1; float b1 = -INFINITY;
#pragma unroll
            for (int e = 0; e < 8; ++e) if (e != e0 && lg[e] > b1) { e1 = e; b1 = lg[e]; }
            const float w1 = 1.f / (1.f + expf(b0 - b1)), w0 = 1.f - w1;
            LAS int* s = sl + (k * 8 + C.wave) * 6;
            s[0] = e0; s[1] = e1; s[2] = __float_as_int(w0); s[3] = __float_as_int(w1);
        }
    }
    __syncthreads();
    if (C.tid < 192) { const int q = C.tid, sq = q >> 1, wq = q & 1, e = sl[sq * 6 + wq]; int rk = 0;
        if (e >= 0) {
#pragma clang loop vectorize(disable) unroll(disable)
            for (int q2 = 0; q2 < q; ++q2) rk += (sl[(q2 >> 1) * 6 + (q2 & 1)] == e) ? 1 : 0; sl[sq * 6 + 4 + wq] = rk; } }
    if (C.tid < 8) { int c8 = 0;
#pragma clang loop vectorize(disable) unroll(disable)
        for (int q2 = 0; q2 < 192; ++q2) c8 += (sl[(q2 >> 1) * 6 + (q2 & 1)] == C.tid) ? 1 : 0; bc[C.tid] = (unsigned)c8; }
    __syncthreads();
    if (C.lane == 0) { int k2 = 0;
        for (int r = gw; r < ntok; r += NGW, ++k2) { const LAS int* s = sl + (k2 * 8 + C.wave) * 6;
            TokInfo t; t.e0 = s[0]; t.e1 = s[1]; t.p0 = s[4]; t.p1 = s[5]; t.w0 = __int_as_float(s[2]); t.w1 = __int_as_float(s[3]); t.r0 = 0; t.r1 = 0;
            ti_store(TI + r, t); } }
    __syncthreads();
}
DI void ph_gather(const Ctx& C, int layer, int ntok) {
    const int gw = C.blk * 8 + C.wave, NGW = C.nblk * 8, i = layer >> 1;
    GAS TokInfo* TI = (GAS TokInfo*)(C.ws + WS_TOK);
    const gbf16* H = (const gbf16*)(C.ws + WS_H); gbf16* XS = (gbf16*)(C.ws + WS_XS);
    LAS int* red = (LAS int*)C.lds;
    if (C.tid < 16) red[C.tid] = 0;
    __syncthreads();
    { const guint* bcb = (const guint*)(C.ws + WS_CTL) + CW_BC + (size_t)i * 1024 * 8; int tot[8] = {0, 0, 0, 0, 0, 0, 0, 0}, pre[8] = {0, 0, 0, 0, 0, 0, 0, 0};
#pragma clang loop vectorize(disable) unroll(disable)
      for (int t = C.tid; t < C.nblk; t += 512) { const u32x4 a = *(const GAS u32x4*)(bcb + t * 8), b2 = *(const GAS u32x4*)(bcb + t * 8 + 4);
#pragma unroll
          for (int e = 0; e < 4; ++e) { tot[e] += (int)a[e]; tot[4 + e] += (int)b2[e]; if (t < C.blk) { pre[e] += (int)a[e]; pre[4 + e] += (int)b2[e]; } } }
#pragma unroll
      for (int e = 0; e < 8; ++e) { const int ts = (int)wave_sum((float)tot[e], C.lane), ps = (int)wave_sum((float)pre[e], C.lane);
          if (C.lane == 0) { (void)__hip_atomic_fetch_add(red + e, ts, __ATOMIC_RELAXED, __HIP_MEMORY_SCOPE_WORKGROUP); (void)__hip_atomic_fetch_add(red + 8 + e, ps, __ATOMIC_RELAXED, __HIP_MEMORY_SCOPE_WORKGROUP); } } }
    __syncthreads();
    int base[8], cn[8], pref[8]; { int acc = 0;
#pragma unroll
        for (int e = 0; e < 8; ++e) { cn[e] = red[e]; pref[e] = red[8 + e]; base[e] = acc * 256 + pref[e]; acc += (cn[e] + 255) >> 8; } }
    if (C.blk == 0 && C.tid < 8) ((guint*)(C.ws + WS_CTL) + CW_CNT + i * 64)[C.tid] = (unsigned)red[C.tid];
    for (int r = gw; r < ntok; r += NGW) {
        const TokInfo t = ti_load(TI + r);
        int b0 = 0, b1 = 0;
#pragma unroll
        for (int e = 0; e < 8; ++e) { b0 = (t.e0 == e) ? base[e] : b0; b1 = (t.e1 == e) ? base[e] : b1; }
        const int r0 = b0 + t.p0, r1 = b1 + t.p1;
        const u32x4 a = ((const GAS u32x4*)(H + (size_t)r * D))[C.lane], b = ((const GAS u32x4*)(H + (size_t)r * D))[C.lane + 64];
        ((GAS u32x4*)(XS + (size_t)r0 * D))[C.lane] = a; ((GAS u32x4*)(XS + (size_t)r0 * D))[C.lane + 64] = b;
        ((GAS u32x4*)(XS + (size_t)r1 * D))[C.lane] = a; ((GAS u32x4*)(XS + (size_t)r1 * D))[C.lane + 64] = b;
        if (C.lane == 0) { ((GAS int*)(TI + r))[6] = r0; ((GAS int*)(TI + r))[7] = r1; }
    }
    for (int pr = gw; pr < 8 * 256; pr += NGW) {
        const int e = pr >> 8, j = pr & 255; int be = 0, ce = 0;
#pragma unroll
        for (int k = 0; k < 8; ++k) { be = (e == k) ? base[k] - pref[k] : be; ce = (e == k) ? cn[k] : ce; }
        const int lim = ((ce + 255) >> 8) << 8;
        if (ce + j < lim) { GAS u32x4* z = (GAS u32x4*)(XS + (size_t)(be + ce + j) * D); z[C.lane] = (u32x4){0u, 0u, 0u, 0u}; z[C.lane + 64] = (u32x4){0u, 0u, 0u, 0u}; }
    }
}
DI void ph_combine(const Ctx& C, const Params& p, int layer, int ntok, const guint* cnt) {
    int nM_ = 0;
#pragma unroll
    for (int e = 0; e < 8; ++e) nM_ += ((int)cnt[e] + 255) >> 8;
    const int nwg_ = nM_ * 4, Lm_ = (nwg_ / C.nblk) * C.nblk, r_ = nwg_ - Lm_; int ts = 1;
    if (r_ > 0) { const int q = C.nblk / r_; ts = q >= 14 ? 14 : (q >= 7 ? 7 : (q >= 4 ? 4 : (q >= 2 ? 2 : 1))); }
    const int trow0 = (Lm_ >> 2) * 256, trows = (r_ >> 2) * 256; const gfloat* YP = (const gfloat*)(C.ws + WS_YP);
    const int gw = C.blk * 8 + C.wave, NGW = C.nblk * 8;
    gfloat* X = (gfloat*)(C.ws + WS_X); gbf16* H = (gbf16*)(C.ws + WS_H); const gfloat* Y = (const gfloat*)(C.ws + WS_Y); const GAS TokInfo* TI = (const GAS TokInfo*)(C.ws + WS_TOK);
    const gfloat* MODl = (const gfloat*)(C.ws + WS_MOD) + (size_t)layer * 5 * MODW;
    const bool last = (layer == DEPTH - 1);
    const int nrows = last ? NLAT : NTOK;
    for (int r = gw; r < nrows; r += NGW) {
        f32x4 v[4];
#pragma unroll
        for (int j = 0; j < 4; ++j) v[j] = ((const GAS f32x4*)(X + (size_t)r * D))[C.lane + 64 * j];
        if (r < ntok) {
            const TokInfo t = ti_load(TI + r);
            const gfloat* ga = MODl + (size_t)(r < NLAT ? (r >> 12) : 4) * MODW + 5 * D;
#pragma unroll
            for (int j = 0; j < 4; ++j) { f32x4 y0, y1; const f32x4 gg = ((const GAS f32x4*)ga)[C.lane + 64 * j];
                if (t.r0 < trow0) y0 = ((const GAS f32x4*)(Y + (size_t)t.r0 * D))[C.lane + 64 * j];
                else { y0 = (f32x4){0.f, 0.f, 0.f, 0.f}; for (int pk = 0; pk < ts; ++pk) y0 = y0 + ((const GAS f32x4*)(YP + ((size_t)pk * trows + (t.r0 - trow0)) * D))[C.lane + 64 * j]; }
                if (t.r1 < trow0) y1 = ((const GAS f32x4*)(Y + (size_t)t.r1 * D))[C.lane + 64 * j];
                else { y1 = (f32x4){0.f, 0.f, 0.f, 0.f}; for (int pk = 0; pk < ts; ++pk) y1 = y1 + ((const GAS f32x4*)(YP + ((size_t)pk * trows + (t.r1 - trow0)) * D))[C.lane + 64 * j]; }
                v[j] = v[j] + gg * (y0 * t.w0 + y1 * t.w1); }
        }
        if (!last) {
#pragma unroll
            for (int j = 0; j < 4; ++j) ((GAS f32x4*)(X + (size_t)r * D))[C.lane + 64 * j] = v[j];
            const gfloat* MODn = (const gfloat*)(C.ws + WS_MOD) + (size_t)(layer + 1) * 5 * MODW;
            const gfloat* mv = MODn + (size_t)(r < NLAT ? (r >> 12) : 4) * MODW;
            normmod_regs(v, gin(p, 6) + (layer + 1) * D, mv, mv + D, C.lane);
            store_row_bf16(H + (size_t)r * D, v, C.lane);
        } else {
            float ss = 0.f;
#pragma unroll
            for (int j = 0; j < 4; ++j) ss += (v[j][0] * v[j][0] + v[j][1] * v[j][1]) + (v[j][2] * v[j][2] + v[j][3] * v[j][3]);
            const float rs = rsqrtf(wave_sum(ss, C.lane) * (1.f / D) + 1e-6f);
#pragma unroll
            for (int j = 0; j < 4; ++j) { const f32x4 gg = ((const GAS f32x4*)gin(p, 8))[C.lane + 64 * j]; ((GAS f32x4*)(((gfloat*)p.out) + (size_t)r * D))[C.lane + 64 * j] = v[j] * rs * gg; }
        }
    }
}
constexpr int AT_KB = 0, AT_KB_SZ = 64 * 136 * 2, AT_VT = 2 * AT_KB_SZ, AT_VT_SZ = 128 * 72 * 2, AT_QL = AT_VT + 2 * AT_VT_SZ, AT_END = AT_QL + 256 * 136 * 2;
static_assert(AT_END <= LDS_MISC, "attention LDS");
DI void attn_unit(const Ctx& C, const gbf16* PE, gbf16* MIX, const gfloat* gsub, float lam, float mul, int b, int h, int qb, bool ctxq) {
    LAS unsigned char* ldsb = C.lds; asm volatile("" : "+v"(ldsb));
    int tid = C.tid; asm volatile("" : "+v"(tid));
    const int lane = tid & 63, wave = __builtin_amdgcn_readfirstlane(tid >> 6), r = lane & 31, hh = lane >> 5;
    const int qrow0 = (ctxq ? NLAT + b * CTX : b * SEQ) + qb * 256;
    const int ntile = ctxq ? CTX / 64 : (CTX + SEQ) / 64;
    LAS bf16* QL = (LAS bf16*)(ldsb + AT_QL);
#pragma unroll
    for (int i = 0; i < 8; ++i) { const int c = tid + 512 * i, row = c >> 4, part = c & 15; *(LAS u32x4*)(QL + row * 136 + part * 8) = *(const GAS u32x4*)(PE + (size_t)(qrow0 + row) * EVEN_IN + h * 128 + part * 8); }
    f32x16 O[2][4];
#pragma unroll
    for (int mp = 0; mp < 2; ++mp)
#pragma unroll
        for (int k = 0; k < 4; ++k) O[mp][k] = zero16();
    float m[2] = {-1e30f, -1e30f}, l[2] = {0.f, 0.f};
    u32x4 vA[2];
    const int skey = tid & 63, spart = tid >> 6;
#define AT_LOAD(t, kr, vr) do { \
        { const int kidx_ = (t) * 64 + skey; const int krow_ = kidx_ < CTX ? NLAT + b * CTX + kidx_ : b * SEQ + kidx_ - CTX; \
          _Pragma("unroll") for (int i_ = 0; i_ < 2; ++i_) { const gbf16* src_ = PE + (size_t)krow_ * EVEN_IN + h * 128 + (spart + 8 * i_) * 8; vr[i_] = *(const GAS u32x4*)(src_ + 1024); } } \
        { LAS unsigned char* kd_ = ldsb + AT_KB + (((t) & 1)) * AT_KB_SZ; \
          _Pragma("unroll") for (int i_ = 0; i_ < 8; ++i_) { const int key_ = wave * 8 + i_, kidx_ = (t) * 64 + key_; const int krow_ = kidx_ < CTX ? NLAT + b * CTX + kidx_ : b * SEQ + kidx_ - CTX; \
              __builtin_amdgcn_global_load_lds((const GAS unsigned*)(PE + (size_t)krow_ * EVEN_IN + 512 + h * 128) + lane, (LAS unsigned*)(kd_ + key_ * 272), 4, 0, 0); } } } while (0)
#define AT_STORE(buf, kr, vr) do { LAS bf16* vt_ = (LAS bf16*)(ldsb + AT_VT + (buf) * AT_VT_SZ); const int j16_ = skey & 15, pkey_ = (skey & ~15) | ((j16_ & 3) | (((j16_ >> 2) == 1) ? 8 : (((j16_ >> 2) == 2) ? 4 : (j16_ & 12))));   \
        _Pragma("unroll") for (int i_ = 0; i_ < 2; ++i_) { const int part_ = spart + 8 * i_; \
            _Pragma("unroll") for (int e_ = 0; e_ < 4; ++e_) { vt_[(part_ * 8 + 2 * e_) * 72 + pkey_] = (bf16)(vr[i_][e_] & 0xffffu); vt_[(part_ * 8 + 2 * e_ + 1) * 72 + pkey_] = (bf16)(vr[i_][e_] >> 16); } } } while (0)
#define AT_TILE(t) do { const int buf = (t) & 1; \
        int tl_ = tid; asm volatile("" : "+v"(tl_)); const int lane = tl_ & 63, r = lane & 31, hh = lane >> 5, skey = lane, spart = tl_ >> 6;     \
        if ((t) + 1 < ntile) AT_LOAD((t) + 1, vA, vA); \
        const LAS bf16* kb = (const LAS bf16*)(ldsb + AT_KB + buf * AT_KB_SZ); const LAS bf16* vt = (const LAS bf16*)(ldsb + AT_VT + buf * AT_VT_SZ); \
        _Pragma("unroll") for (int ks2 = 0; ks2 < 2; ++ks2) {             \
            bf16x8 pf[2][2]; \
            _Pragma("unroll") for (int mp = 0; mp < 2; ++mp) { \
                f32x16 S = zero16(); \
                _Pragma("unroll") for (int ks = 0; ks < 4; ++ks) { const bf16x8 a = *(const LAS bf16x8*)(kb + (ks2 * 32 + r) * 136 + mp * 64 + 16 * ks + 8 * hh); const bf16x8 qf = *(const LAS bf16x8*)(QL + (wave * 32 + r) * 136 + mp * 64 + 16 * ks + 8 * hh); S = MFMA32(a, qf, S); } \
                float mx = S[0]; \
                _Pragma("unroll") for (int i = 1; i < 16; ++i) mx = fmaxf(mx, S[i]); \
                mx = fmaxf(mx, shx(mx, 32, lane)); \
                if (__any(mx > m[mp] + 8.f)) { const float mnew = fmaxf(m[mp], mx), corr = __builtin_amdgcn_exp2f(m[mp] - mnew); m[mp] = mnew; l[mp] *= corr; \
                    _Pragma("unroll") for (int k = 0; k < 4; ++k) O[mp][k] = O[mp][k] * corr; } \
                float ls = 0.f; const float mu = m[mp]; \
                _Pragma("unroll") for (int i = 0; i < 16; ++i) { S[i] = __builtin_amdgcn_exp2f(S[i] - mu); ls += S[i]; } \
                l[mp] += ls; \
                pf[mp][0] = pack_step(S, 0); pf[mp][1] = pack_step(S, 1); } \
            _Pragma("unroll") for (int s = 0; s < 2; ++s) \
                _Pragma("unroll") for (int k = 0; k < 4; ++k) { const bf16x8 a = *(const LAS bf16x8*)(vt + (k * 32 + r) * 72 + ks2 * 32 + 16 * s + 8 * hh); O[0][k] = MFMA32(a, pf[0][s], O[0][k]); O[1][k] = MFMA32(a, pf[1][s], O[1][k]); } \
            } \
        if ((t) + 1 < ntile) AT_STORE(buf ^ 1, vA, vA); \
        __syncthreads(); } while (0)
    AT_LOAD(0, vA, vA); AT_STORE(0, vA, vA);
    __syncthreads();
    for (int t = 0; t < ntile; ++t) AT_TILE(t);
#undef AT_TILE
#undef AT_LOAD
#undef AT_STORE
    {
        const float i0 = 1.f / (l[0] + shx(l[0], 32, lane)), i1 = lam / (l[1] + shx(l[1], 32, lane));
        float ss = 0.f;
#pragma unroll
        for (int k = 0; k < 4; ++k)
#pragma unroll
            for (int i = 0; i < 16; ++i) { const float o = O[0][k][i] * i0 - O[1][k][i] * i1; O[0][k][i] = o; ss += o * o; }
        ss += shx(ss, 32, lane);
        const float rs = rsqrtf(ss * (1.f / 128.f) + 1e-6f) * mul;
        const int qrow = qrow0 + wave * 32 + r;
#pragma unroll
        for (int k = 0; k < 4; ++k)
#pragma unroll
            for (int g4 = 0; g4 < 4; ++g4) { const int dv0 = k * 32 + 8 * g4 + 4 * hh; const f32x4 gg = *(const GAS f32x4*)(gsub + dv0);
                u32x2 w; w[0] = pk2(O[0][k][4 * g4] * rs * gg[0], O[0][k][4 * g4 + 1] * rs * gg[1]); w[1] = pk2(O[0][k][4 * g4 + 2] * rs * gg[2], O[0][k][4 * g4 + 3] * rs * gg[3]);
                *(GAS u32x2*)(MIX + (size_t)qrow * D + h * 128 + dv0) = w; }
    }
    __syncthreads();
}

constexpr int RGG_WT = 0, RGG_XR = 36864, RGG_XB = RGG_XR + 17408, RGG_XF = RGG_XB + 18432, RGG_END = RGG_XF + 128 * 65 * 4;
static_assert(RGG_END <= LDS_MISC && 131 * 66 * 2 <= 17408, "rg gates LDS");
DI void ph_rg_gates(const Ctx& C, const Params& p, int i) {
    const gbf16* PE = (const gbf16*)(C.ws + WS_P); gfloat* RGA = (gfloat*)(C.ws + WS_RGA); gfloat* RGU = (gfloat*)(C.ws + WS_RGU);
    const gfloat* w_a = gin(p, 15) + (size_t)i * 2 * 8 * 64 * 64; const gfloat* w_x = gin(p, 17) + (size_t)i * 2 * 8 * 64 * 64;
    const gfloat* b_a = gin(p, 16) + i * 1024; const gfloat* b_x = gin(p, 18) + i * 1024; const gfloat* lamv = gin(p, 19) + i * 1024;
    const gfloat* cw = gin(p, 13) + i * 4 * 512; const gfloat* cb = gin(p, 14) + i * 512;
    int ncur = -1;
    for (int unit = C.blk; unit < (NTOK / 128) * 8; unit += C.nblk) {
        LAS unsigned char* ldsb = C.lds; asm volatile("" : "+v"(ldsb));
        int tid = C.tid; asm volatile("" : "+v"(tid));
        const int lane = tid & 63, wave = __builtin_amdgcn_readfirstlane(tid >> 6), r = lane & 31, hh = lane >> 5;
        const int n = unit & 7, tile = unit >> 3, r0 = tile * 128;
        LAS bf16* WT = (LAS bf16*)(ldsb + RGG_WT); LAS bf16* xraw = (LAS bf16*)(ldsb + RGG_XR); LAS bf16* XB = (LAS bf16*)(ldsb + RGG_XB); LAS float* XF = (LAS float*)(ldsb + RGG_XF);
        if (n != ncur) {
            __syncthreads();
            for (int idx = tid; idx < 16384; idx += 512) { const int ch = idx & 63, ci = (idx >> 6) & 63, g = (idx >> 12) & 1, d = idx >> 13;
                const float v = (g ? w_x : w_a)[((size_t)(d * 8 + n) * 64 + ci) * 64 + ch];
                WT[(((d * 2 + g) * 2 + (ch >> 5)) * 32 + (ch & 31)) * 72 + ci] = f2bf(v); }
            ncur = n;
        }
        int s0, s1; seq_bounds(r0, s0, s1);
        for (int idx = tid; idx < 131 * 8; idx += 512) { const int ri = idx >> 3, part = idx & 7, row = r0 - 2 + ri;
            u32x4 v = (u32x4){0u, 0u, 0u, 0u};
            if (row >= s0 && row < s1) v = *(const GAS u32x4*)(PE + (size_t)row * EVEN_IN + 1536 + n * 64 + part * 8);
            LAS unsigned* dst = (LAS unsigned*)(xraw + ri * 66 + part * 8); dst[0] = v[0]; dst[1] = v[1]; dst[2] = v[2]; dst[3] = v[3]; }
        __syncthreads();
        { const int cc = tid & 63; float tap[4];
#pragma unroll
          for (int tp = 0; tp < 4; ++tp) tap[tp] = cw[tp * 512 + n * 64 + cc];
          const float cbias = cb[n * 64 + cc];
#pragma unroll 4
          for (int it = 0; it < 16; ++it) { const int tok = (tid >> 6) + 8 * it; float a = cbias;
#pragma unroll
              for (int tp = 0; tp < 4; ++tp) a += tap[tp] * bf2f(xraw[(tok + tp) * 66 + cc]);
              XF[tok * 65 + cc] = a; XB[tok * 72 + cc] = f2bf(a); } }
        __syncthreads();
        { const int ti = wave & 3, d = wave >> 2;
#pragma unroll
          for (int chblk = 0; chblk < 2; ++chblk) {
              f32x16 aa = zero16(), ax = zero16();
#pragma unroll
              for (int ks = 0; ks < 4; ++ks) { const bf16x8 xa = *(const LAS bf16x8*)(XB + (ti * 32 + r) * 72 + 16 * ks + 8 * hh);
                  const bf16x8 ba = *(const LAS bf16x8*)(WT + (((d * 2 + 0) * 2 + chblk) * 32 + r) * 72 + 16 * ks + 8 * hh), bx = *(const LAS bf16x8*)(WT + (((d * 2 + 1) * 2 + chblk) * 32 + r) * 72 + 16 * ks + 8 * hh);
                  aa = MFMA32(xa, ba, aa); ax = MFMA32(xa, bx, ax); }
              const int ch = n * 64 + chblk * 32 + r;
              const float ba_ = b_a[d * 512 + ch], bx_ = b_x[d * 512 + ch], sp = softplus_(-lamv[d * 512 + ch]);
#pragma unroll
              for (int q = 0; q < 16; ++q) { const int tok = ti * 32 + crow(q, hh);
                  const float rr = sigmoid_(aa[q] + ba_), ii = sigmoid_(ax[q] + bx_);
                  const float log_a = -8.f * rr * sp; const float a = __expf(log_a), u = sqrtf(fmaxf(1.f - a * a, 0.f)) * (ii * XF[tok * 65 + chblk * 32 + r]);
                  const size_t o = ((size_t)d * NTOK + r0 + tok) * 512 + ch; RGA[o] = a; RGU[o] = u; }
          } }
        __syncthreads();
    }
}
DI int rg_row(int b, int d, int pp) { return pp < CTX ? NLAT + b * CTX + (d ? CTX - 1 - pp : pp) : b * SEQ + (d ? SEQ - 1 - (pp - CTX) : (pp - CTX)); }
DI void rgscan_unit(const Ctx& C, int b, int cg) {
    LAS unsigned char* ldsb = C.lds; asm volatile("" : "+v"(ldsb));
    int tid = C.tid; asm volatile("" : "+v"(tid));
    const gfloat* RGA = (const gfloat*)(C.ws + WS_RGA); const gfloat* RGU = (const gfloat*)(C.ws + WS_RGU); gfloat* HS1 = (gfloat*)(C.ws + WS_HS1);
    const gbf16* PE = (const gbf16*)(C.ws + WS_P); gbf16* MIX = (gbf16*)(C.ws + WS_MIX);
    LAS float* sb = (LAS float*)ldsb;
    const int ch = cg * 16 + (tid & 15), chunk = tid >> 4, p0 = chunk * 136;
    for (int pass = 0; pass < 2; ++pass) {
        const int d = 1 - pass;
        const gfloat* Ad = RGA + (size_t)d * NTOK * 512 + ch; const gfloat* Ud = RGU + (size_t)d * NTOK * 512 + ch;
        float av[17], uv[17], an[17], un[17];
        float A = 1.f, H = 0.f;
#pragma unroll
        for (int k = 0; k < 17; ++k) { const size_t o = (size_t)rg_row(b, d, p0 + k) * 512; av[k] = Ad[o]; uv[k] = Ud[o]; }
        for (int g8 = 0; g8 < 8; ++g8) {
            if (g8 < 7) {
#pragma unroll
                for (int k = 0; k < 17; ++k) { const size_t o = (size_t)rg_row(b, d, p0 + (g8 + 1) * 17 + k) * 512; an[k] = Ad[o]; un[k] = Ud[o]; } }
#pragma unroll
            for (int k = 0; k < 17; ++k) { H = av[k] * H + uv[k]; A *= av[k]; }
#pragma unroll
            for (int k = 0; k < 17; ++k) { av[k] = an[k]; uv[k] = un[k]; }
        }
        sb[(chunk * 16 + (tid & 15)) * 2] = A; sb[(chunk * 16 + (tid & 15)) * 2 + 1] = H;
        __syncthreads();
        float h = 0.f;
        for (int k = 0; k < chunk; ++k) h = sb[(k * 16 + (tid & 15)) * 2] * h + sb[(k * 16 + (tid & 15)) * 2 + 1];
#pragma unroll
        for (int k = 0; k < 17; ++k) { const size_t o = (size_t)rg_row(b, d, p0 + k) * 512; av[k] = Ad[o]; uv[k] = Ud[o]; }
        for (int g8 = 0; g8 < 8; ++g8) {
            if (g8 < 7) {
#pragma unroll
                for (int k = 0; k < 17; ++k) { const size_t o = (size_t)rg_row(b, d, p0 + (g8 + 1) * 17 + k) * 512; an[k] = Ad[o]; un[k] = Ud[o]; } }
#pragma unroll
            for (int k = 0; k < 17; ++k) { h = av[k] * h + uv[k]; const int row = rg_row(b, d, p0 + g8 * 17 + k);
                if (pass == 0) HS1[(size_t)row * 512 + ch] = h;
                else { const float y = h + HS1[(size_t)row * 512 + ch]; MIX[(size_t)row * D + 512 + ch] = f2bf(y * gelu_tanh_(bf2f(PE[(size_t)row * EVEN_IN + 2048 + ch]))); } }
#pragma unroll
            for (int k = 0; k < 17; ++k) { av[k] = an[k]; uv[k] = un[k]; }
        }
        __syncthreads();
    }
}
DI void ph_even_mix(const Ctx& C, const Params& p, int layer, int rep) {
    const int i = layer >> 1;
    volatile LAS unsigned* misc = (volatile LAS unsigned*)(C.lds + LDS_MISC);
    guint* q = (guint*)(C.ws + WS_CTL) + CW_Q + (i + 2 * rep) * 64;
    const float lam_init = 0.8f - 0.6f * expf(-0.3f * (float)layer);
    if (C.wave == 0) { const gfloat* lq = gin(p, 11) + i * 256; const float a = wave_sum(lq[C.lane] * lq[64 + C.lane], C.lane), b2 = wave_sum(lq[128 + C.lane] * lq[192 + C.lane], C.lane);
        if (C.lane == 0) ((volatile LAS float*)misc)[4] = expf(a) - expf(b2) + lam_init; }
    __syncthreads();
    const float lam = ((volatile LAS float*)misc)[4];
    const gbf16* PE = (const gbf16*)(C.ws + WS_P); gbf16* MIX = (gbf16*)(C.ws + WS_MIX);
    for (;;) {
        if (C.tid == 0) misc[8] = __hip_atomic_fetch_add(q, 1u, __ATOMIC_RELAXED, __HIP_MEMORY_SCOPE_AGENT);
        __syncthreads();
        const int u = (int)misc[8];
        __syncthreads();
#ifndef MIX_RG_REP
#define MIX_RG_REP 1
#endif
#ifndef MIX_AT_REP
#define MIX_AT_REP 1
#endif
        if (u >= 128 * MIX_RG_REP + 272 * MIX_AT_REP) break;
        if (u < 128 * MIX_RG_REP) { const int x = u & 127; rgscan_unit(C, x >> 5, x & 31); }
        else { const int y = (u - 128 * MIX_RG_REP) % 272;
            if (y < 256) attn_unit(C, PE, MIX, gin(p, 12) + i * 128, lam, 1.f - lam_init, y >> 6, (y >> 4) & 3, y & 15, false);
            else { const int x = y - 256; attn_unit(C, PE, MIX, gin(p, 12) + i * 128, lam, 1.f - lam_init, x >> 2, x & 3, 0, true); } }
    }
}
DI int chunk_row0(int cidx) { return cidx < 256 ? (cidx >> 6) * SEQ + (cidx & 63) * 64 : NLAT + (cidx - 256) * 64; }
constexpr int GA_RA = 0, GA_RB = 18432, GA_KT0 = 2 * 18432, GA_KT1 = 3 * 18432, GA_VT0 = 4 * 18432, GA_VT1 = 5 * 18432, GA_KK = 6 * 18432, GA_QK = GA_KK + 16640, GA_GC = GA_QK + 16640, GA_END = GA_GC + 1024;
static_assert(GA_END <= LDS_MISC, "GA LDS");
struct GaRegs { u32x4 q[2], k[2], v[2]; float g, be; };
DI void ga_load(const Ctx& C, int unit, GaRegs& R, int tid) {
    const int h = unit & 7, cidx = unit >> 3, row0 = chunk_row0(cidx), lane = tid & 63, wave = tid >> 6;
    const gbf16* QKVN = (const gbf16*)(C.ws + WS_QKVN); const gfloat* Gd = (const gfloat*)(C.ws + WS_GB); const gfloat* Bd = Gd + (size_t)2 * NTOK * 8;
#pragma unroll
    for (int i2 = 0; i2 < 2; ++i2) { const int c = tid + 512 * i2, pos = c & 63, part = c >> 6; const gbf16* src = QKVN + (size_t)(row0 + pos) * 3072 + h * 128 + part * 8;
        R.q[i2] = *(const GAS u32x4*)src; R.k[i2] = *(const GAS u32x4*)(src + 1024); R.v[i2] = *(const GAS u32x4*)(src + 2048); }
    R.g = 0.f; R.be = 0.f;
    if (wave < 2) { const int d = wave, row = row0 + (d ? 63 - lane : lane); R.g = Gd[((size_t)d * NTOK + row) * 8 + h]; R.be = Bd[((size_t)d * NTOK + row) * 8 + h]; }
}
DI void gdn_ga_unit(const Ctx& C, int unit, int next_unit, GaRegs& R) {
    LAS unsigned char* ldsb = C.lds; asm volatile("" : "+v"(ldsb));
    const int h = unit & 7, cidx = unit >> 3;
    const int row0 = chunk_row0(cidx);
    const gbf16* QKVN = (const gbf16*)(C.ws + WS_QKVN); const gfloat* Gd = (const gfloat*)(C.ws + WS_GB); const gfloat* Bd = Gd + (size_t)2 * NTOK * 8;
    const size_t ud0 = (size_t)(cidx * 8 + h) * 2;
    gbf16* WG = (gbf16*)(C.ws + WS_WG) + ud0 * 8192; gfloat* UG = (gfloat*)(C.ws + WS_UG) + ud0 * 8192; gbf16* QKD = (gbf16*)(C.ws + WS_QKD) + ud0 * 4096; gfloat* SC = (gfloat*)(C.ws + WS_SC) + ud0 * 192;
    gbf16* KTG = (gbf16*)(C.ws + WS_KTG) + ud0 * 8192;
    LAS bf16* Kc = (LAS bf16*)(ldsb + GA_RA); LAS bf16* Qc = (LAS bf16*)(ldsb + GA_RB);
    LAS float* KKm = (LAS float*)(ldsb + GA_KK); LAS float* QKm = (LAS float*)(ldsb + GA_QK);
    LAS float* gc = (LAS float*)(ldsb + GA_GC); LAS float* be = gc + 128;
    int tid = C.tid; asm volatile("" : "+v"(tid));
    const int lane = tid & 63, wave = __builtin_amdgcn_readfirstlane(tid >> 6), r = lane & 31, hh = lane >> 5;
#pragma unroll
    for (int i2 = 0; i2 < 2; ++i2) { const int c = tid + 512 * i2, pos = c & 63, part = c >> 6;
        const u32x4 q = R.q[i2], k = R.k[i2], v = R.v[i2];
        *(LAS u32x4*)(Qc + pos * 136 + part * 8) = q; *(LAS u32x4*)(Kc + pos * 136 + part * 8) = k;
        LAS bf16* kt0 = (LAS bf16*)(ldsb + GA_KT0) + (part * 8) * 72; LAS bf16* kt1 = (LAS bf16*)(ldsb + GA_KT1) + (part * 8) * 72;
        LAS bf16* vt0 = (LAS bf16*)(ldsb + GA_VT0) + (part * 8) * 72; LAS bf16* vt1 = (LAS bf16*)(ldsb + GA_VT1) + (part * 8) * 72;
#pragma unroll
        for (int e = 0; e < 4; ++e) { const bf16 k0 = (bf16)(k[e] & 0xffffu), k1 = (bf16)(k[e] >> 16), v0 = (bf16)(v[e] & 0xffffu), v1 = (bf16)(v[e] >> 16);
            kt0[(2 * e) * 72 + pos] = k0; kt0[(2 * e + 1) * 72 + pos] = k1; kt1[(2 * e) * 72 + 63 - pos] = k0; kt1[(2 * e + 1) * 72 + 63 - pos] = k1;
            vt0[(2 * e) * 72 + pos] = v0; vt0[(2 * e + 1) * 72 + pos] = v1; vt1[(2 * e) * 72 + 63 - pos] = v0; vt1[(2 * e + 1) * 72 + 63 - pos] = v1; } }
    if (wave < 2) {
        const int d = wave;
        float g = R.g;
#pragma unroll
        for (int o = 1; o < 64; o <<= 1) { const float t = __builtin_bit_cast(float, __builtin_amdgcn_ds_bpermute((lane - o) << 2, __builtin_bit_cast(int, g))); if (lane >= o) g += t; }
        gc[d * 64 + lane] = g; be[d * 64 + lane] = R.be;
    }
    if (next_unit >= 0) ga_load(C, next_unit, R, tid);
    __syncthreads();
    { const int ti = (wave & 3) >> 1, tj = wave & 1; const LAS bf16* Arows = (wave < 4 ? Kc : Qc);
      f32x16 acc = zero16();
#pragma unroll
      for (int ks = 0; ks < 8; ++ks) { const bf16x8 a = *(const LAS bf16x8*)(Arows + (ti * 32 + r) * 136 + 16 * ks + 8 * hh), bb = *(const LAS bf16x8*)(Kc + (tj * 32 + r) * 136 + 16 * ks + 8 * hh); acc = MFMA32(a, bb, acc); }
      LAS float* dst = (wave < 4 ? KKm : QKm);
#pragma unroll
      for (int i = 0; i < 16; ++i) dst[(ti * 32 + crow(i, hh)) * 65 + tj * 32 + r] = acc[i]; }
    __syncthreads();
    const float qscale = 0.08838834764831845f;
#pragma unroll
    for (int e = 0; e < 16; ++e) { const int idx = tid + 512 * e, d = idx >> 12, i = (idx >> 6) & 63, j = idx & 63, ti = d ? 63 - i : i, tj = d ? 63 - j : j;
        const float dec = (j <= i) ? __expf(gc[d * 64 + i] - gc[d * 64 + j]) : 0.f;
        ((LAS float*)(ldsb + (d ? GA_RB : GA_RA)))[i * 68 + j] = (j < i) ? KKm[ti * 65 + tj] * be[d * 64 + i] * dec : 0.f;
        QKD[idx] = f2bf(QKm[ti * 65 + tj] * qscale * dec); }
    if (tid < 128) { const int d = tid >> 6, i = tid & 63; SC[d * 192 + i] = qscale * __expf(gc[d * 64 + i]); SC[d * 192 + 64 + i] = __expf(gc[d * 64 + 63] - gc[d * 64 + i]); if (i == 0) SC[d * 192 + 128] = __expf(gc[d * 64 + 63]); }
    __syncthreads();
    if (wave < 2) {
        const int d = wave, c = lane; LAS float* Lm = (LAS float*)(ldsb + (d ? GA_RB : GA_RA)); float T[64];
#pragma unroll
        for (int i = 0; i < 64; ++i) { float a0 = (i == c) ? 1.f : 0.f, a1 = 0.f, a2 = 0.f, a3 = 0.f;
#pragma unroll
            for (int j4 = 0; j4 < (i + 3) / 4; ++j4) { const f32x4 l4 = *(const LAS f32x4*)(Lm + i * 68 + 4 * j4);
                a0 -= l4[0] * T[4 * j4]; if (4 * j4 + 1 < i) a1 -= l4[1] * T[4 * j4 + 1]; if (4 * j4 + 2 < i) a2 -= l4[2] * T[4 * j4 + 2]; if (4 * j4 + 3 < i) a3 -= l4[3] * T[4 * j4 + 3]; }
            T[i] = (a0 + a1) + (a2 + a3); if ((i & 1) == 1) asm volatile("" ::: "memory"); }
        const float s2 = be[d * 64 + c], s1 = s2 * __expf(gc[d * 64 + c]);
        LAS bf16* T1 = (LAS bf16*)Lm; LAS bf16* T2 = T1 + 64 * 72;
#pragma unroll
        for (int i = 0; i < 64; ++i) { T1[i * 72 + c] = f2bf(T[i] * s1); T2[i * 72 + c] = f2bf(T[i] * s2); }
    }
    __syncthreads();
#pragma unroll
    for (int d = 0; d < 2; ++d) {
        const LAS bf16* T1 = (const LAS bf16*)(ldsb + (d ? GA_RB : GA_RA)); const LAS bf16* T2 = T1 + 64 * 72;
        const LAS bf16* Kt = (const LAS bf16*)(ldsb + (d ? GA_KT1 : GA_KT0)); const LAS bf16* Vt = (const LAS bf16*)(ldsb + (d ? GA_VT1 : GA_VT0));
        const int ti = wave >> 2, tn = wave & 3; f32x16 aw = zero16(), au = zero16();
#pragma unroll
        for (int ks = 0; ks < 4; ++ks) { const bf16x8 a1 = *(const LAS bf16x8*)(T1 + (ti * 32 + r) * 72 + 16 * ks + 8 * hh), a2 = *(const LAS bf16x8*)(T2 + (ti * 32 + r) * 72 + 16 * ks + 8 * hh);
            const bf16x8 bk = *(const LAS bf16x8*)(Kt + (tn * 32 + r) * 72 + 16 * ks + 8 * hh), bv = *(const LAS bf16x8*)(Vt + (tn * 32 + r) * 72 + 16 * ks + 8 * hh);
            aw = MFMA32(a1, bk, aw); au = MFMA32(a2, bv, au); }
#pragma unroll
        for (int i = 0; i < 16; ++i) { const int pos = ti * 32 + crow(i, hh); WG[d * 8192 + pos * 128 + tn * 32 + r] = f2bf(aw[i]); UG[d * 8192 + pos * 128 + tn * 32 + r] = au[i]; }
#pragma unroll
        for (int i2 = 0; i2 < 2; ++i2) { const int c = tid + 512 * i2, row = c >> 3, part = c & 7; *(GAS u32x4*)(KTG + d * 8192 + row * 64 + part * 8) = *(const LAS u32x4*)(Kt + row * 72 + part * 8); }
    }
    __syncthreads();
}
DI void ph_gdn_ga(const Ctx& C) {
    GaRegs R; if (C.blk < NCH * 8) ga_load(C, C.blk, R, C.tid);
    for (int u = C.blk; u < NCH * 8; u += C.nblk) gdn_ga_unit(C, u, (u + C.nblk < NCH * 8) ? u + C.nblk : -1, R);
}

constexpr int GB_NSL = 2;
constexpr int GB_W = 0, GB_Q = GB_W + 64 * 136 * 2, GB_KT = GB_Q + 64 * 136 * 2, GB_QK = GB_KT + 128 * 72 * 2, GB_SC = GB_QK + 64 * 72 * 2, GB_BUF = GB_SC + 1024;
static_assert(2 * GB_BUF <= LDS_MISC, "GB LDS");
template <int VAR> DI void gdn_gb_unit(const Ctx& C, int unit) {
    LAS unsigned char* ldsb = C.lds; asm volatile("" : "+v"(ldsb));
    constexpr int NGRP = 4 / GB_NSL;
    const int grp = unit % NGRP, bhd = unit / NGRP, d = bhd & 1, h = (bhd >> 1) & 7, b = bhd >> 4;
    const gbf16* QKVN = (const gbf16*)(C.ws + WS_QKVN);
    const gbf16* WGb = (const gbf16*)(C.ws + WS_WG); const gfloat* UGb = (const gfloat*)(C.ws + WS_UG); const gbf16* QKDb = (const gbf16*)(C.ws + WS_QKD); const gbf16* KTGb = (const gbf16*)(C.ws + WS_KTG); const gfloat* SCb = (const gfloat*)(C.ws + WS_SC);
    gfloat* OG = (gfloat*)(C.ws + (VAR ? WS_XS : WS_OG)) + (size_t)d * NTOK * D;
    int tid = C.tid; asm volatile("" : "+v"(tid));
    const int lane = tid & 63, wave = __builtin_amdgcn_readfirstlane(tid >> 6), r = lane & 31, hh = lane >> 5;
    const bool comp = wave < GB_NSL; const int dv0 = (grp * GB_NSL + wave) * 32;
    f32x16 S[4];
#pragma unroll
    for (int k = 0; k < 4; ++k) S[k] = zero16();
    constexpr int NSW = 8 - GB_NSL, NIT = (56 + NSW - 1) / NSW, NRD = 1;
    const int wv = wave - GB_NSL, st = tid - GB_NSL * 64;
    u32x4 sreg[NIT], sreg2[NIT]; float rsc = 0.f, rsc2 = 0.f;
    auto chunk_of = [&](int step) { return step < 4 ? 256 + b * 4 + (d ? 3 - step : step) : b * 64 + (d ? 63 - (step - 4) : (step - 4)); };
#define GB_LOAD(step, rd, SR, RS) do { if (!comp) { int ln2_ = lane; asm volatile("" : "+v"(ln2_)); const int cidx_ = chunk_of(step), un_ = (cidx_ * 8 + h) * 2 + d, row0_ = chunk_row0(cidx_); \
        _Pragma("unroll") for (int i_ = 0; i_ < NIT; ++i_) { const int blk_ = wv + NSW * i_; if (blk_ < 56) { const gbf16* src_; \
            if (blk_ < 16) { const int c_ = blk_ * 64 + ln2_; src_ = WGb + (size_t)un_ * 8192 + c_ * 8; } \
            else if (blk_ < 32) { const int c_ = (blk_ - 16) * 64 + ln2_, pos_ = c_ >> 4, part_ = c_ & 15, row_ = row0_ + (d ? 63 - pos_ : pos_); src_ = QKVN + (size_t)row_ * 3072 + h * 128 + part_ * 8; } \
            else if (blk_ < 48) { const int c_ = (blk_ - 32) * 64 + ln2_; src_ = KTGb + (size_t)un_ * 8192 + c_ * 8; } \
            else { const int c_ = (blk_ - 48) * 64 + ln2_; src_ = QKDb + (size_t)un_ * 4096 + c_ * 8; } \
            SR[i_] = *(const GAS u32x4*)src_; } } \
        if (st < 192) RS = SCb[(size_t)un_ * 192 + st]; } } while (0)
#define GB_STORE(buf, rd, SR, RS) do { if (!comp) { int ln2_ = lane; asm volatile("" : "+v"(ln2_)); LAS unsigned char* B_ = ldsb + (buf) * GB_BUF; \
        _Pragma("unroll") for (int i_ = 0; i_ < NIT; ++i_) { const int blk_ = wv + NSW * i_; if (blk_ < 56) { \
            if (blk_ < 16) { const int c_ = blk_ * 64 + ln2_; *(LAS u32x4*)((LAS bf16*)(B_ + GB_W) + (c_ >> 4) * 136 + (c_ & 15) * 8) = SR[i_]; } \
            else if (blk_ < 32) { const int c_ = (blk_ - 16) * 64 + ln2_; *(LAS u32x4*)((LAS bf16*)(B_ + GB_Q) + (c_ >> 4) * 136 + (c_ & 15) * 8) = SR[i_]; } \
            else if (blk_ < 48) { const int c_ = (blk_ - 32) * 64 + ln2_; *(LAS u32x4*)((LAS bf16*)(B_ + GB_KT) + (c_ >> 3) * 72 + (c_ & 7) * 8) = SR[i_]; } \
            else { const int c_ = (blk_ - 48) * 64 + ln2_; *(LAS u32x4*)((LAS bf16*)(B_ + GB_QK) + (c_ >> 3) * 72 + (c_ & 7) * 8) = SR[i_]; } } } \
        if (st < 192) ((LAS float*)(B_ + GB_SC))[st] = RS; } } while (0)
    static_assert(NRD == 1, "two-steps-ahead staging is written for one round per step");
    GB_LOAD(0, 0, sreg, rsc); GB_STORE(0, 0, sreg, rsc); GB_LOAD(1, 0, sreg, rsc);
    f32x16 Un[2];
    Un[0] = zero16(); Un[1] = zero16();
    if (comp) { const int cidx = chunk_of(0), un = (cidx * 8 + h) * 2 + d; const gfloat* Uu = UGb + (size_t)un * 8192 + dv0 + r;
#pragma unroll
        for (int tt = 0; tt < 2; ++tt)
#pragma unroll
            for (int i = 0; i < 16; ++i) Un[tt][i] = Uu[(tt * 32 + crow(i, hh)) * 128]; }
    __syncthreads();
    if (!comp) {
        for (int step = 0; step < 68; ++step) {
            const int buf = step & 1;
            if (VAR != 2) { if (step + 2 < 68) GB_LOAD(step + 2, 0, sreg2, rsc2);
            if (step + 1 < 68) GB_STORE(buf ^ 1, 0, sreg, rsc); }
#pragma unroll
            for (int i_ = 0; i_ < NIT; ++i_) sreg[i_] = sreg2[i_];
            rsc = rsc2;
            asm volatile("s_waitcnt lgkmcnt(0)\n\ts_barrier" ::: "memory");
        }
    } else {
        for (int step = 0; step < 68; ++step) {
            const int buf = step & 1;
            if (VAR != 1) {
            int ln_ = lane; asm volatile("" : "+v"(ln_)); const int r = ln_ & 31, hh = ln_ >> 5;
            const int cidx = chunk_of(step), un = (cidx * 8 + h) * 2 + d, row0 = chunk_row0(cidx);
            const LAS unsigned char* Bp = ldsb + buf * GB_BUF; const LAS bf16* Wl = (const LAS bf16*)(Bp + GB_W); const LAS bf16* Ql = (const LAS bf16*)(Bp + GB_Q);
            const LAS bf16* KTl = (const LAS bf16*)(Bp + GB_KT); const LAS bf16* QKl = (const LAS bf16*)(Bp + GB_QK); const LAS float* scl = (const LAS float*)(Bp + GB_SC);
            bf16x8 sp[4][2];
#pragma unroll
            for (int kb = 0; kb < 4; ++kb) { sp[kb][0] = pack_step(S[kb], 0); sp[kb][1] = pack_step(S[kb], 1); }
            f32x16 aw0 = zero16(), aw1 = zero16();
#pragma unroll
            for (int kb = 0; kb < 4; ++kb)
#pragma unroll
                for (int s = 0; s < 2; ++s) { aw0 = MFMA32(ld_perm_frag(Wl + r * 136, kb * 32, s, hh), sp[kb][s], aw0); aw1 = MFMA32(ld_perm_frag(Wl + (32 + r) * 136, kb * 32, s, hh), sp[kb][s], aw1); }
#pragma unroll
            for (int i = 0; i < 16; ++i) { Un[0][i] -= aw0[i]; Un[1][i] -= aw1[i]; }
            f32x16 aq0 = zero16(), aq1 = zero16();
#pragma unroll
            for (int kb = 0; kb < 4; ++kb)
#pragma unroll
                for (int s = 0; s < 2; ++s) { aq0 = MFMA32(ld_perm_frag(Ql + r * 136, kb * 32, s, hh), sp[kb][s], aq0); aq1 = MFMA32(ld_perm_frag(Ql + (32 + r) * 136, kb * 32, s, hh), sp[kb][s], aq1); }
            bf16x8 vp[2][2];
#pragma unroll
            for (int jt = 0; jt < 2; ++jt) { vp[jt][0] = pack_step(Un[jt], 0); vp[jt][1] = pack_step(Un[jt], 1); }
#pragma unroll
            for (int i = 0; i < 16; ++i) { aq0[i] *= scl[crow(i, hh)]; aq1[i] *= scl[32 + crow(i, hh)]; }
#pragma unroll
            for (int jt = 0; jt < 2; ++jt)
#pragma unroll
                for (int s = 0; s < 2; ++s) { aq0 = MFMA32(ld_perm_frag(QKl + r * 72, jt * 32, s, hh), vp[jt][s], aq0); aq1 = MFMA32(ld_perm_frag(QKl + (32 + r) * 72, jt * 32, s, hh), vp[jt][s], aq1); }
#pragma unroll
            for (int jt = 0; jt < 2; ++jt) {
#pragma unroll
                for (int i = 0; i < 16; ++i) Un[jt][i] *= scl[64 + jt * 32 + crow(i, hh)];
                vp[jt][0] = pack_step(Un[jt], 0); vp[jt][1] = pack_step(Un[jt], 1); }
            if (step + 1 < 68) { const int cn = chunk_of(step + 1), unn = (cn * 8 + h) * 2 + d; const gfloat* Uu = UGb + (size_t)unn * 8192 + dv0 + r;
#pragma unroll
                for (int tt = 0; tt < 2; ++tt)
#pragma unroll
                    for (int i = 0; i < 16; ++i) Un[tt][i] = Uu[(tt * 32 + crow(i, hh)) * 128]; }
            const float gtot = scl[128];
#pragma unroll
            for (int kb = 0; kb < 4; ++kb) S[kb] = S[kb] * gtot;
#pragma unroll
            for (int jt = 0; jt < 2; ++jt)
#pragma unroll
                for (int s = 0; s < 2; ++s)
#pragma unroll
                    for (int kb = 0; kb < 4; ++kb) S[kb] = MFMA32(ld_perm_frag(KTl + (kb * 32 + r) * 72, jt * 32, s, hh), vp[jt][s], S[kb]);
#pragma unroll
            for (int i = 0; i < 16; ++i) { const int pos = crow(i, hh), row = row0 + (d ? 63 - pos : pos); OG[(size_t)row * D + h * 128 + dv0 + r] = aq0[i]; }
#pragma unroll
            for (int i = 0; i < 16; ++i) { const int pos = 32 + crow(i, hh), row = row0 + (d ? 63 - pos : pos); OG[(size_t)row * D + h * 128 + dv0 + r] = aq1[i]; }
            }
            asm volatile("s_waitcnt lgkmcnt(0)\n\ts_barrier" ::: "memory");
        }
    }
#undef GB_LOAD
#undef GB_STORE
}
DI void ph_gdn_gb(const Ctx& C, const Params& p, int lp, int rep) {
    constexpr int NU = 64 * (4 / GB_NSL);
#ifndef GB_PROBE_VAR
    for (int u = C.blk; u < NU; u += C.nblk) gdn_gb_unit<0>(C, u);
#else
    if (rep) { for (int u = C.blk; u < NU; u += C.nblk) gdn_gb_unit<GB_PROBE_VAR>(C, u); return; }
    for (int u = C.blk; u < NU; u += C.nblk) gdn_gb_unit<0>(C, u);
#endif
#if CONV_DEFER
    if (C.nblk > NU) { if (C.blk >= NU) convert_weights(C, p, 1 + lp, (C.blk - NU) * 8 + C.wave, (C.nblk - NU) * 8); }
    else convert_weights(C, p, 1 + lp, C.blk * 8 + C.wave, C.nblk * 8);
#endif
}
constexpr int NPH_PAIR = 20, NPHASE = 1 + 2 * NPH_PAIR;
DI void fresh(Ctx& C) { int t; asm volatile("v_mbcnt_lo_u32_b32 %0, -1, 0\n\tv_mbcnt_hi_u32_b32 %0, -1, %0" : "=v"(t)); t += C.wave0 * 64; asm volatile("" : "+v"(t));     int b = blockIdx.x; asm volatile("" : "+s"(b)); guchar* w_ = C.ws0; asm volatile("" : "+s"(w_)); C.ws = w_; C.tid = t; C.lane = t & 63; C.wave = __builtin_amdgcn_readfirstlane(t >> 6); C.blk = b; }
__global__ void __launch_bounds__(512, 2) fused_fwd(Params p) {
    extern __shared__ __attribute__((aligned(16))) unsigned char lds_raw[];
    Ctx C; C.lds = (LAS unsigned char*)lds_raw; C.ws = (guchar*)p.ws; C.ws0 = (guchar*)p.ws; C.tid = threadIdx.x; C.lane = C.tid & 63; C.wave = __builtin_amdgcn_readfirstlane(C.tid >> 6); C.wave0 = C.wave; C.nblk = gridDim.x; C.blk = blockIdx.x;
    volatile LAS unsigned* misc = (volatile LAS unsigned*)(C.lds + LDS_MISC);
    if (C.tid < 16) misc[C.tid] = 0u;
    __syncthreads();
    unsigned* ctl = (unsigned*)(p.ws + WS_CTL);
    const bool single = (p.ph_lo == 0 && p.ph_hi == NPHASE);
    XcdBarrier bar; bar.bar = ctl + CW_BAR; bar.x = 0; bar.st = misc;
    if (single) bar = xcd_barrier_post(ctl + CW_BAR, misc);
    const int lo = p.ph_lo, hi = p.ph_hi;
#ifndef PH_MASK
#define PH_MASK 0x1FFFFFu
#endif
#define PHEN(k) (((PH_MASK) >> (k)) & 1u)
#ifndef XTRA_BAR
#define XTRA_BAR 0
#endif
#ifndef REP_MASK
#define REP_MASK 0u
#endif
#define NREP(k) (1 + (int)(((REP_MASK) >> (k)) & 1u))
#define IN(k) (fresh(C), lo <= (k) && (k) < hi)
#define SEAM(k) do { if (single) { unsigned* bp_ = ctl + CW_BAR; asm volatile("" : "+s"(bp_)); bar.bar = bp_; xcd_barrier(bar); for (int xb_ = 0; xb_ < XTRA_BAR; ++xb_) xcd_barrier(bar); } } while (0)
#define H ((gbf16*)(C.ws + WS_H))
#define MIX ((gbf16*)(C.ws + WS_MIX))
#define P ((gbf16*)(C.ws + WS_P))
#define X ((gfloat*)(C.ws + WS_X))
#define MOD ((const gfloat*)(C.ws + WS_MOD))
    for (int rep_ = 0; rep_ < NREP(0); ++rep_) { if (rep_) { SEAM(0); } if (PHEN(0) && IN(0)) ph_prologue(C, p); }
    SEAM(0);
    for (int lp = 0; lp < 2; ++lp) {
        const int pb = 1 + lp * NPH_PAIR, le = 2 * lp, lod = 2 * lp + 1;
        for (int rep_ = 0; rep_ < NREP(1); ++rep_) { if (rep_) { SEAM(0); } if (PHEN(1) && IN(pb + 0)) { if (lp == 0) ph_normmod(C, p, 0, false, true, 0, 0); } }
        SEAM(pb + 0);
        for (int rep_ = 0; rep_ < NREP(2); ++rep_) { if (rep_) { SEAM(0); } if (PHEN(2) && IN(pb + 1)) { pg8::Gemm g{H, (const gbf16*)(C.ws + WS_WEIN) + (size_t)lp * 2560 * 1024, NTOK, EVEN_IN, D, 0}; pg8::StaticOrder S; S.init(NTOK, EVEN_IN, C.nblk, C.blk);
            EpiEvenIn E{P, (const gfloat*)(C.ws + WS_COS), (const gfloat*)(C.ws + WS_SIN)}; pg8::gemm_phase<EpiEvenIn, pg8::StaticOrder>(C.lds, g, S, E, C.tid); } }
        SEAM(pb + 1);
        for (int rep_ = 0; rep_ < NREP(20); ++rep_) { if (rep_) { SEAM(0); } if (PHEN(20) && IN(pb + 2)) ph_rg_gates(C, p, lp); }
        SEAM(pb + 2);
        for (int rep_ = 0; rep_ < NREP(3); ++rep_) { if (rep_) { SEAM(0); } if (PHEN(3) && IN(pb + 3)) ph_even_mix(C, p, le, rep_); }
        SEAM(pb + 3);
        for (int rep_ = NREP(4) - 1; rep_ >= 0; --rep_) { if (PHEN(4) && IN(pb + 4)) {
            { pg8::Gemm g{MIX, (const gbf16*)(C.ws + WS_WEOUT) + (size_t)lp * 1024 * 1024, NLAT, D, D, 0}; pg8::StaticOrder S; S.init(NLAT, D, C.nblk, C.blk);
              EpiResid E{rep_ ? (gfloat*)(C.ws + WS_U + (size_t)200 * 1024 * 1024) : X, MOD + (size_t)le * 5 * MODW + 2 * D}; pg8::gemm_phase<EpiResid, pg8::StaticOrder>(C.lds, g, S, E, C.tid); }
            { fresh(C); pg8::Gemm g{MIX + (size_t)NLAT * D, (const gbf16*)(C.ws + WS_WEOUT) + (size_t)lp * 1024 * 1024, NCTX, D, D, D / 4}; pg8::StaticOrder S; S.init(NCTX, D, C.nblk, C.blk); S.lim = S.nwg * 4; S.s = 4;
              EpiPart E{(gfloat*)(C.ws + WS_PART)}; pg8::gemm_phase<EpiPart, pg8::StaticOrder>(C.lds, g, S, E, C.tid); } } if (rep_) { SEAM(0); } }
        SEAM(pb + 4);
        for (int rep_ = 0; rep_ < NREP(5); ++rep_) { if (rep_) { SEAM(0); } if (PHEN(5) && IN(pb + 5)) ph_normmod(C, p, le, true, false, 4, le * 5 * MODW + 2 * D); }
        SEAM(pb + 5);
        for (int rep_ = 0; rep_ < NREP(6); ++rep_) { if (rep_) { SEAM(0); } if (PHEN(6) && IN(pb + 6)) { pg8::Gemm g{H, (const gbf16*)(C.ws + WS_WEF1) + (size_t)lp * 5632 * 1024, NTOK, 2 * FFN, D, 0}; pg8::StaticOrder S; S.init(NTOK, 2 * FFN, C.nblk, C.blk);
            EpiSwiglu E{P, FFN, 2 * FFN / 256}; pg8::gemm_phase<EpiSwiglu, pg8::StaticOrder>(C.lds, g, S, E, C.tid); } }
        SEAM(pb + 6);
        for (int rep_ = NREP(7) - 1; rep_ >= 0; --rep_) { if (PHEN(7) && IN(pb + 7)) {
            { pg8::Gemm g{P, (const gbf16*)(C.ws + WS_WEF2) + (size_t)lp * 1024 * 2816, NLAT, D, FFN, 0}; pg8::StaticOrder S; S.init(NLAT, D, C.nblk, C.blk);
              EpiResid E{rep_ ? (gfloat*)(C.ws + WS_U + (size_t)200 * 1024 * 1024) : X, MOD + (size_t)le * 5 * MODW + 5 * D}; pg8::gemm_phase<EpiResid, pg8::StaticOrder>(C.lds, g, S, E, C.tid); }
            { fresh(C); pg8::Gemm g{P + (size_t)NLAT * FFN, (const gbf16*)(C.ws + WS_WEF2) + (size_t)lp * 1024 * 2816, NCTX, D, FFN, FFN / 11}; pg8::StaticOrder S; S.init(NCTX, D, C.nblk, C.blk); S.lim = S.nwg * 11; S.s = 11;
              EpiPart E{(gfloat*)(C.ws + WS_PART)}; pg8::gemm_phase<EpiPart, pg8::StaticOrder>(C.lds, g, S, E, C.tid); } } if (rep_) { SEAM(0); } }
        SEAM(pb + 7);
        const int ntok = (lod < DEPTH - 1) ? NTOK : NLAT;
        for (int rep_ = 0; rep_ < NREP(8); ++rep_) { if (rep_) { SEAM(0); } if (PHEN(8) && IN(pb + 8)) ph_normmod(C, p, lod, false, false, 11, le * 5 * MODW + 5 * D); }
        SEAM(pb + 8);
        for (int rep_ = 0; rep_ < NREP(9); ++rep_) { if (rep_) { SEAM(0); } if (PHEN(9) && IN(pb + 9)) { pg8::Gemm g{H, (const gbf16*)(C.ws + WS_WOIN) + (size_t)lp * 4352 * 1024, NTOK, 4352, D, 0}; pg8::StaticOrder S; S.init(NTOK, 4352, C.nblk, C.blk);
            EpiBf16Ab E{P, 4352, (gfloat*)(C.ws + WS_AB), 16}; pg8::gemm_phase<EpiBf16Ab, pg8::StaticOrder>(C.lds, g, S, E, C.tid); } }
        SEAM(pb + 9);
        for (int rep_ = 0; rep_ < NREP(10); ++rep_) { if (rep_) { SEAM(0); } if (PHEN(10) && IN(pb + 10)) ph_odd_conv(C, p, lp); }
        SEAM(pb + 10);
        for (int rep_ = 0; rep_ < NREP(11); ++rep_) { if (rep_) { SEAM(0); } if (PHEN(11) && IN(pb + 11)) ph_gdn_ga(C); }
        SEAM(pb + 11);
        for (int rep_ = 0; rep_ < NREP(12); ++rep_) { if (rep_) { SEAM(0); } if (PHEN(12) && IN(pb + 12)) ph_gdn_gb(C, p, lp, rep_); }
        SEAM(pb + 12);
        for (int rep_ = 0; rep_ < NREP(13); ++rep_) { if (rep_) { SEAM(0); } if (PHEN(13) && IN(pb + 13)) ph_gdn_out(C, p, lp); }
        SEAM(pb + 13);
        for (int rep_ = NREP(14) - 1; rep_ >= 0; --rep_) { if (PHEN(14) && IN(pb + 14)) {
            { pg8::Gemm g{MIX, (const gbf16*)(C.ws + WS_WOOUT) + (size_t)lp * 1024 * 1024, NLAT, D, D, 0}; pg8::StaticOrder S; S.init(NLAT, D, C.nblk, C.blk);
              EpiResid E{rep_ ? (gfloat*)(C.ws + WS_U + (size_t)200 * 1024 * 1024) : X, MOD + (size_t)lod * 5 * MODW + 2 * D}; pg8::gemm_phase<EpiResid, pg8::StaticOrder>(C.lds, g, S, E, C.tid); }
            if (lod < DEPTH - 1) { fresh(C); pg8::Gemm g{MIX + (size_t)NLAT * D, (const gbf16*)(C.ws + WS_WOOUT) + (size_t)lp * 1024 * 1024, NCTX, D, D, D / 4}; pg8::StaticOrder S; S.init(NCTX, D, C.nblk, C.blk); S.lim = S.nwg * 4; S.s = 4;
              EpiPart E{(gfloat*)(C.ws + WS_PART)}; pg8::gemm_phase<EpiPart, pg8::StaticOrder>(C.lds, g, S, E, C.tid); } } if (rep_) { SEAM(0); } }
        SEAM(pb + 14);
        if (PHEN(15) && IN(pb + 15)) ph_router(C, p, lod, ntok, (lod < DEPTH - 1) ? 4 : 0);
        SEAM(pb + 15);
        for (int rep_ = 0; rep_ < NREP(16); ++rep_) { if (rep_) { SEAM(0); } if (PHEN(16) && IN(pb + 16)) ph_gather(C, lod, ntok); }
        SEAM(pb + 16);
        for (int rep_ = 0; rep_ < NREP(17); ++rep_) { if (rep_) { SEAM(0); } if (PHEN(17) && IN(pb + 17)) { pg8::Gemm g{(const gbf16*)(C.ws + WS_XS), (const gbf16*)(C.ws + WS_WXIN) + (size_t)lp * 8 * 7168 * 1024, RMAX, 8 * 7168, D, 0}; MoeOrder S; S.initm((const guint*)(ctl + CW_CNT + lp * 64), 28, C.nblk, C.blk);
            EpiSwiglu E{(gbf16*)(C.ws + WS_HIDM), FFE, 28}; pg8::gemm_phase<EpiSwiglu, MoeOrder>(C.lds, g, S, E, C.tid); } }
        SEAM(pb + 17);
        for (int rep_ = 0; rep_ < NREP(18); ++rep_) { if (rep_) { SEAM(0); } if (PHEN(18) && IN(pb + 18)) {
            { pg8::Gemm g{(const gbf16*)(C.ws + WS_HIDM), (const gbf16*)(C.ws + WS_WXOUT) + (size_t)lp * 8 * 1024 * 3584, RMAX, 8 * 1024, FFE, 0}; MoeOrder2 S; S.initm((const guint*)(ctl + CW_CNT + lp * 64), C.nblk, C.blk, 0);
              EpiF32 E{(gfloat*)(C.ws + WS_Y), D, 4}; pg8::gemm_phase<EpiF32, MoeOrder2>(C.lds, g, S, E, C.tid); }
            { fresh(C); MoeOrder2 S; S.initm((const guint*)(ctl + CW_CNT + lp * 64), C.nblk, C.blk, 1);
              pg8::Gemm g{(const gbf16*)(C.ws + WS_HIDM), (const gbf16*)(C.ws + WS_WXOUT) + (size_t)lp * 8 * 1024 * 3584, RMAX, 8 * 1024, FFE, FFE / S.s};
              EpiPartY E{(gfloat*)(C.ws + WS_YP), S.Lmain >> 2, (S.r >> 2) * 256}; pg8::gemm_phase<EpiPartY, MoeOrder2>(C.lds, g, S, E, C.tid); } } }
        SEAM(pb + 18);
        if (PHEN(19) && IN(pb + 19)) ph_combine(C, p, lod, ntok, (const guint*)(ctl + CW_CNT + lp * 64));
        SEAM(pb + 19);
    }
#undef IN
#undef SEAM
#undef H
#undef MIX
#undef P
#undef X
#undef MOD
}

static int fused_setup() {
    static int grid = 0;
    if (grid == 0) {
        int dev = 0, cus = 0, per_cu = 0;
        if (hipGetDevice(&dev) != hipSuccess || hipDeviceGetAttribute(&cus, hipDeviceAttributeMultiprocessorCount, dev) != hipSuccess) { fprintf(stderr, "fused_setup: device query failed\n"); grid = -1; return grid; }
        if (hipFuncSetAttribute((const void*)fused_fwd, hipFuncAttributeMaxDynamicSharedMemorySize, LDS_BYTES) != hipSuccess) { fprintf(stderr, "fused_setup: hipFuncSetAttribute failed\n"); grid = -1; return grid; }
        if (hipOccupancyMaxActiveBlocksPerMultiprocessor(&per_cu, (const void*)fused_fwd, 512, LDS_BYTES) != hipSuccess || per_cu < 1) { fprintf(stderr, "fused_setup: occupancy query says %d blocks per CU\n", per_cu); (void)hipGetLastError(); }
        grid = cus;
    }
    return grid;
}
static void launch_fused(const Params& p0, int lo, int hi, hipStream_t s) {
    const int grid = fused_setup(); if (grid <= 0) return;
    Params p = p0; p.ph_lo = lo; p.ph_hi = hi;
    hipLaunchKernelGGL(fused_fwd, dim3(grid), dim3(512), LDS_BYTES, s, p);
}
}
#ifdef DEBUG_MODE
namespace dbg {
using namespace cfg;
__global__ void k_cmp_f32_bf16(const float* __restrict__ A, const unsigned short* __restrict__ R, size_t n, float* __restrict__ res) {
    float d2 = 0.f, r2 = 0.f;
    for (size_t i = (size_t)blockIdx.x * 256 + threadIdx.x; i < n; i += (size_t)gridDim.x * 256) { const float r = __uint_as_float((unsigned)R[i] << 16), a = A[i]; d2 += (a - r) * (a - r); r2 += r * r; }
    for (int o = 32; o >= 1; o >>= 1) { d2 += __shfl_xor(d2, o); r2 += __shfl_xor(r2, o); }
    if ((threadIdx.x & 63) == 0) { atomicAdd(res, d2); atomicAdd(res + 1, r2); }
}
__global__ void k_cmp_bf16_f32(const unsigned short* __restrict__ A, int fp, int fo, const float* __restrict__ R, int rp, int ro, int nrows, int ncols, float rscale, float* __restrict__ res) {
    float d2 = 0.f, r2 = 0.f;
    for (size_t i = (size_t)blockIdx.x * 256 + threadIdx.x; i < (size_t)nrows * ncols; i += (size_t)gridDim.x * 256) { const int row = (int)(i / ncols), c = (int)(i % ncols);
        const float a = __uint_as_float((unsigned)A[(size_t)row * fp + fo + c] << 16), r = R[(size_t)row * rp + ro + c] * rscale; d2 += (a - r) * (a - r); r2 += r * r; }
    for (int o = 32; o >= 1; o >>= 1) { d2 += __shfl_xor(d2, o); r2 += __shfl_xor(r2, o); }
    if ((threadIdx.x & 63) == 0) { atomicAdd(res, d2); atomicAdd(res + 1, r2); }
}
__global__ void k_cmp_f32_f32(const float* __restrict__ A, int fp, int fo, const float* __restrict__ R, int rp, int ro, int nrows, int ncols, float* __restrict__ res) {
    float d2 = 0.f, r2 = 0.f;
    for (size_t i = (size_t)blockIdx.x * 256 + threadIdx.x; i < (size_t)nrows * ncols; i += (size_t)gridDim.x * 256) { const int row = (int)(i / ncols), c = (int)(i % ncols);
        const float a = A[(size_t)row * fp + fo + c], r = R[(size_t)row * rp + ro + c]; d2 += (a - r) * (a - r); r2 += r * r; }
    for (int o = 32; o >= 1; o >>= 1) { d2 += __shfl_xor(d2, o); r2 += __shfl_xor(r2, o); }
    if ((threadIdx.x & 63) == 0) { atomicAdd(res, d2); atomicAdd(res + 1, r2); }
}
__global__ void k_decide(const float* __restrict__ res, int nchk, float tol, float* __restrict__ out, size_t nout) {
    int code = 0; float frac = 0.f;
    for (int k = 0; k < nchk; ++k) { const float err = res[2 * k] / res[2 * k + 1]; if (!(err <= tol)) { code = k + 1; float l = (err == err && err > 0.f) ? log10f(err) : 0.f; frac = fminf(fmaxf((l + 4.f) / 4.f * 0.9f, 0.f), 0.9f); break; } }
    if (code == 0) return;
    const float c = sqrtf((float)code + frac);
    for (size_t i = (size_t)blockIdx.x * 256 + threadIdx.x; i < nout; i += (size_t)gridDim.x * 256) out[i] = c;
}
}
#endif

static nv::NaiveWs carve_naive(char* base, size_t& off) {
    using namespace cfg;
    nv::NaiveWs w{};
    auto take = [&](size_t nfloats) { float* p = (float*)(base + off); off += ((nfloats * 4 + 255) / 256) * 256; return p; };
    w.MOD = take((size_t)DEPTH * 5 * MODW);
    w.X = take((size_t)NTOK * D); w.H = take((size_t)NTOK * D); w.P = take((size_t)NTOK * ODD_IN); w.MIX = take((size_t)NTOK * D);
    w.T0 = take((size_t)NTOK * 512); w.T1 = take((size_t)NTOK * 3072); w.T2 = take((size_t)NTOK * 2048);
    w.FOUT = take((size_t)NTOK * D); w.HID = take((size_t)NTOK * FFE);
    w.lam = take(64); w.cnt = (int*)take(64); w.list_tok = (int*)take((size_t)NEXP * NTOK); w.list_w = take((size_t)NEXP * NTOK);
    return w;
}
extern "C" void kernel_launch(void* const* d_in, const int* in_sizes, int n_in, void* d_out, int out_size, void* d_ws, size_t ws_size, hipStream_t stream) {
    using namespace cfg;
    if (n_in != 31 || out_size != NLAT * D) { fprintf(stderr, "kernel_launch: unexpected n_in %d / out_size %d\n", n_in, out_size); return; }
    fk::Params p{}; for (int i = 0; i < 31; ++i) p.in[i] = (const float*)d_in[i];
    p.out = (float*)d_out; p.ws = (unsigned char*)d_ws;
#ifdef DEBUG_MODE
    const size_t snap_bytes = (size_t)NTOK * D * 2, CK_BYTES = 8 * snap_bytes + (size_t)NLAT * D * 4 + 4096;
    if (ws_size < fk::WS_END + CK_BYTES) { fprintf(stderr, "kernel_launch(debug): workspace too small\n"); return; }
    char* ckb = (char*)d_ws + ws_size - CK_BYTES; ckb -= ((size_t)ckb & 255);
    unsigned short* snaps = (unsigned short*)ckb; float* nout = (float*)(ckb + 8 * snap_bytes); float* res = (float*)(ckb + 8 * snap_bytes + (size_t)NLAT * D * 4);
    {
        nv::Inputs in{}; for (int i = 0; i < 31; ++i) in.p[i] = (const float*)d_in[i];
        size_t off = 0; nv::NaiveWs w = carve_naive((char*)d_ws, off);
        if ((char*)d_ws + off > ckb) { fprintf(stderr, "kernel_launch(debug): oracle scratch overlaps snapshots\n"); return; }
        nv::run_naive(in, w, nout, snaps, stream);
    }
    (void)hipMemsetAsync(res, 0, 4096, stream);
    (void)hipMemsetAsync((char*)d_ws + fk::WS_CTL, 0, fk::CTL_BYTES, stream);
    int chk = 0;
    for (int ph = 0; ph < fk::NPHASE; ++ph) {
        fk::launch_fused(p, ph, ph + 1, stream);
        if (ph == 0) continue;
        const int lp = (ph - 1) / fk::NPH_PAIR, k = (ph - 1) % fk::NPH_PAIR;
        int snap = -1;
        if (k == 5) snap = 4 * lp + 0; else if (k == 8) snap = 4 * lp + 1; else if (k == 15) snap = 4 * lp + 2; else if (k == 19 && lp == 0) snap = 3;
        if (snap >= 0) { hipLaunchKernelGGL(dbg::k_cmp_f32_bf16, dim3(2048), dim3(256), 0, stream, (const float*)((char*)d_ws + fk::WS_X), snaps + (size_t)snap * NTOK * D, (size_t)(snap == 6 ? NLAT : NTOK) * D, res + 2 * chk); ++chk; }
    }
    hipLaunchKernelGGL(dbg::k_cmp_f32_f32, dim3(2048), dim3(256), 0, stream, (const float*)d_out, D, 0, (const float*)nout, D, 0, NLAT, D, res + 2 * chk); ++chk;
    hipLaunchKernelGGL(dbg::k_decide, dim3(1024), dim3(256), 0, stream, (const float*)res, chk, DEBUG_TOL, (float*)d_out, (size_t)NLAT * D);
#else
    if (ws_size < fk::WS_END) { fprintf(stderr, "kernel_launch: workspace too small: need %zu have %zu\n", (size_t)fk::WS_END, ws_size); return; }
    (void)hipMemsetAsync((char*)d_ws + fk::WS_CTL, 0, fk::CTL_BYTES, stream);
    fk::launch_fused(p, 0, fk::NPHASE, stream);
#endif
}
```

```cpp
#include <hip/hip_runtime.h>
#include <cstdio>
#include <cstdint>
#include <cmath>
namespace cfg {
constexpr int D = 1024, B = 4, SEQ = 4096, CTX = 256, DEPTH = 4;
constexpr int NLAT = B * SEQ, NCTX = B * CTX, NTOK = NLAT + NCTX;
constexpr int NMOD = 6, MODW = NMOD * D;
constexpr int EVEN_IN = 2560, ODD_IN = 4128, FFN = 2816, FFE = 3584, NEXP = 8;
}
namespace nv {
using namespace cfg;
struct NaiveWs { float *MOD, *X, *H, *P, *MIX, *T0, *T1, *T2, *FOUT, *HID, *lam; int* cnt; int* list_tok; float* list_w; };
}
namespace pg8 {
#define PG8_LAS __attribute__((address_space(3)))
#define PG8_GAS __attribute__((address_space(1)))
typedef unsigned short bf16_t;
typedef short bf16x8 __attribute__((ext_vector_type(8)));
typedef float f32x4 __attribute__((ext_vector_type(4)));
typedef unsigned u32x4 __attribute__((ext_vector_type(4)));
constexpr int BM = 256, BK = 64, HALF = 128, HTB = HALF * BK * 2  , STAGE_BYTES = 8 * HTB, NXCD = 8, WGM = 8;

__host__ __device__ __forceinline__ int lds_byte(int r_, int c_) { const unsigned r = (unsigned)r_, c = (unsigned)c_; const unsigned st = (r >> 4) * 2u + (c >> 5), rr = r & 15u, cc = c & 31u, ob = rr * 64u + cc * 2u; return (int)(st * 1024u + (ob ^ (((ob >> 9) & 1u) << 5))); }
__host__ __device__ __forceinline__ void stage_rc(int b_, int& R, int& C) { const unsigned b = (unsigned)b_; const unsigned st = b >> 10, sb = b & 1023u, swz = sb ^ (((sb >> 9) & 1u) << 5); R = (int)((st >> 1) * 16u + (swz >> 6)); C = (int)((st & 1u) * 32u + ((swz & 63u) >> 1)); }
__host__ __device__ __forceinline__ int perm32(int rho_) { const unsigned rho = (unsigned)rho_; const unsigned n = rho >> 4, i = rho & 15u; return (int)(8u * (i >> 2) + 4u * n + (i & 3u)); }

struct Unit { int pm, pn, pk; };
struct Gemm { const PG8_GAS bf16_t* A; const PG8_GAS bf16_t* Bt; int M, N, K, Kh; };

struct StaticOrder {
    int nM, nN, nwg, G, c;
    int lim, L0, s;
    __host__ __device__ void init(int M, int N, int G_, int c_) { nM = M / BM; nN = N / BM; nwg = nM * nN; G = G_; c = c_; lim = nwg; L0 = 0; s = 1; }
    __host__ __device__ void decode(int wgid, Unit& u) const {
        { const int q = nwg / NXCD, r = nwg % NXCD, xcd = wgid % NXCD, off = wgid / NXCD; wgid = (xcd < r ? xcd * (q + 1) : r * (q + 1) + (xcd - r) * q) + off; }
        const int nig = WGM * nN, gid = wgid / nig, fm = gid * WGM, gsz = (nM - fm) < WGM ? (nM - fm) : WGM;
        u.pm = fm + ((wgid % nig) % gsz); u.pn = (wgid % nig) / gsz;
    }
    __host__ __device__ bool next(int i, Unit& u) const {
        const long j = (long)i * G + c; if (j >= lim) return false;
        u.pk = (int)(j % s); decode(L0 + (int)(j / s), u); return true;
    }
    __host__ __device__ void main_part() { lim = (nwg / G) * G; L0 = 0; s = 1; }
    __host__ __device__ void tail_part(int s_) { L0 = (nwg / G) * G; s = s_; lim = (nwg - L0) * s_; }
    __host__ __device__ int tail_tiles() const { return nwg - (nwg / G) * G; }
    __device__ __forceinline__ void a_ready(const Unit&) const {}
    __device__ __forceinline__ void done(const Unit&) const {}
};
template <class Epi, class Sched, bool ALIGN_EPI = true, bool SP2 = true>
__device__ __forceinline__ void gemm_phase(PG8_LAS unsigned char* lds, const Gemm g, const Sched& S, const Epi& E, const int tid) {
    const int wid = __builtin_amdgcn_readfirstlane(tid >> 6), lane = tid & 63, wr = wid >> 2, wc = wid & 3, fr = lane & 15, fq = lane >> 4;
    const int K = g.K, Kh = g.Kh ? g.Kh : g.K, nt = Kh / BK;
    unsigned voffA[2], voffB[2];
#pragma unroll
    for (int i = 0; i < 2; ++i) { int R, C; stage_rc(tid * 16 + i * 8192, R, C); const int Rb = Epi::PERM ? ((R & ~31) + perm32(R & 31)) : R;
        voffA[i] = (unsigned)(R * K + C) * 2u; voffB[i] = (unsigned)(Rb * K + C) * 2u; }
    const size_t kstep = (size_t)(BK * 2);
    const size_t hstep = (size_t)HALF * K * 2;
    const size_t tstep = 2 * hstep;
    const unsigned ldsw = (unsigned)wid * 1024u;
    const int aoff = lds_byte(wr * 64 + fr, fq * 8), boff = lds_byte(wc * 32 + fr, fq * 8);
#define PG8_SA(b, h) (((b) * 2 + (h)) * HTB)
#define PG8_SB(b, h) ((4 + (b) * 2 + (h)) * HTB)
#define PG8_STAGE(bufoff, gbase, voff) do { _Pragma("unroll") for (int _i = 0; _i < 2; ++_i) \
        __builtin_amdgcn_global_load_lds((const PG8_GAS unsigned*)((const PG8_GAS char*)(gbase) + (voff)[_i]), (PG8_LAS unsigned*)(lds + (bufoff) + ldsw + _i * 8192), 16, 0, 0); } while (0)
#define PG8_LDA(dst, b, h) do { _Pragma("unroll") for (int m = 0; m < 4; ++m) _Pragma("unroll") for (int k = 0; k < 2; ++k) dst[m][k] = *(const PG8_LAS bf16x8*)(lds + PG8_SA(b, h) + aoff + m * 2048 + k * 1024); } while (0)
#define PG8_LDB(dst, b, h) do { _Pragma("unroll") for (int n = 0; n < 2; ++n) _Pragma("unroll") for (int k = 0; k < 2; ++k) dst[n][k] = *(const PG8_LAS bf16x8*)(lds + PG8_SB(b, h) + boff + n * 2048 + k * 1024); } while (0)
#define PG8_MMA(ai, bj, At, Bt) do { __builtin_amdgcn_s_setprio(1); _Pragma("unroll") for (int m = 0; m < 4; ++m) _Pragma("unroll") for (int n = 0; n < 2; ++n) _Pragma("unroll") for (int k = 0; k < 2; ++k) \
        acc[ai][bj][m][n] = __builtin_amdgcn_mfma_f32_16x16x32_bf16(Bt[n][k], At[m][k], acc[ai][bj][m][n], 0, 0, 0); __builtin_amdgcn_s_setprio(0); } while (0)
#define PG8_WAIT_V(n) asm volatile("s_waitcnt vmcnt(" #n ")" ::: "memory")
#define PG8_WAIT_L(n) asm volatile("s_waitcnt lgkmcnt(" #n ")" ::: "memory")
#define PG8_BAR __builtin_amdgcn_s_barrier()
#define PG8_SCHED __builtin_amdgcn_sched_barrier(0)
    Unit cur, nxt; int ui = 0;
    if (!S.next(0, cur)) return;
    f32x4 acc[2][2][4][2];
#pragma unroll
    for (int a = 0; a < 2; ++a)
#pragma unroll
        for (int b = 0; b < 2; ++b)
#pragma unroll
            for (int m = 0; m < 4; ++m)
#pragma unroll
                for (int n = 0; n < 2; ++n) acc[a][b][m][n] = (f32x4){0.f, 0.f, 0.f, 0.f};
    bf16x8 At[4][2], B0[2][2], B1[2][2];
    const PG8_GAS char* cA = (const PG8_GAS char*)g.A + (size_t)cur.pm * tstep + (size_t)cur.pk * Kh * 2; const PG8_GAS char* cB = (const PG8_GAS char*)g.Bt + (size_t)cur.pn * tstep + (size_t)cur.pk * Kh * 2;
    S.a_ready(cur);
    if constexpr (SP2) {
        PG8_STAGE(PG8_SB(0, 0), cB, voffB); PG8_STAGE(PG8_SB(0, 1), cB + hstep, voffB); PG8_STAGE(PG8_SA(0, 0), cA, voffA); PG8_STAGE(PG8_SA(0, 1), cA + hstep, voffA);
        if (wr == 1) PG8_BAR;
        PG8_WAIT_V(2); PG8_BAR;
        PG8_STAGE(PG8_SB(1, 0), cB + kstep, voffB); PG8_STAGE(PG8_SA(1, 0), cA + kstep, voffA); PG8_STAGE(PG8_SB(1, 1), cB + hstep + kstep, voffB);
        PG8_WAIT_V(6); PG8_BAR;
    } else {
    PG8_STAGE(PG8_SB(0, 0), cB, voffB); PG8_STAGE(PG8_SA(0, 0), cA, voffA); PG8_STAGE(PG8_SB(0, 1), cB + hstep, voffB); PG8_STAGE(PG8_SA(0, 1), cA + hstep, voffA);
    if (wr == 1) PG8_BAR;
    PG8_WAIT_V(4); PG8_BAR;
    PG8_STAGE(PG8_SB(1, 0), cB + kstep, voffB); PG8_STAGE(PG8_SA(1, 0), cA + kstep, voffA); PG8_STAGE(PG8_SB(1, 1), cB + hstep + kstep, voffB);
    PG8_WAIT_V(6); PG8_BAR;
    }
    for (;;) {
        const bool has_next = S.next(ui + 1, nxt);
        const PG8_GAS char* nA = has_next ? (const PG8_GAS char*)g.A + (size_t)nxt.pm * tstep + (size_t)nxt.pk * Kh * 2 : cA; const PG8_GAS char* nB = has_next ? (const PG8_GAS char*)g.Bt + (size_t)nxt.pn * tstep + (size_t)nxt.pk * Kh * 2 : cB;
        for (int t = 0; t < nt; t += 2) {
            const bool last = (t == nt - 2);
            const PG8_GAS char* a1 = cA + (size_t)(t + 1) * kstep;
            const PG8_GAS char* a2 = last ? nA : cA + (size_t)(t + 2) * kstep; const PG8_GAS char* b2 = last ? nB : cB + (size_t)(t + 2) * kstep;
            const PG8_GAS char* a3 = a2 + kstep; const PG8_GAS char* b3 = b2 + kstep;
            if (last && has_next) S.a_ready(nxt);
            if constexpr (SP2) {
            PG8_LDB(B0, 0, 0); PG8_LDB(B1, 0, 1); PG8_SCHED; PG8_LDA(At, 0, 0); PG8_STAGE(PG8_SA(1, 1), a1 + hstep, voffA);
            PG8_WAIT_V(8); PG8_WAIT_L(0); PG8_BAR; PG8_MMA(0, 0, At, B0); PG8_MMA(0, 1, At, B1); PG8_BAR; PG8_SCHED;
            PG8_LDA(At, 0, 1); PG8_STAGE(PG8_SB(0, 0), b2, voffB); PG8_STAGE(PG8_SB(0, 1), b2 + hstep, voffB); PG8_STAGE(PG8_SA(0, 0), a2, voffA);
            PG8_WAIT_V(8); PG8_WAIT_L(0); PG8_BAR; PG8_MMA(1, 0, At, B0); PG8_MMA(1, 1, At, B1); PG8_BAR; PG8_SCHED;
            PG8_LDB(B0, 1, 0); PG8_LDB(B1, 1, 1); PG8_SCHED; PG8_LDA(At, 1, 0); PG8_STAGE(PG8_SA(0, 1), a2 + hstep, voffA);
            PG8_WAIT_V(8); PG8_WAIT_L(0); PG8_BAR; PG8_MMA(0, 0, At, B0); PG8_MMA(0, 1, At, B1); PG8_BAR; PG8_SCHED;
            PG8_LDA(At, 1, 1); PG8_STAGE(PG8_SB(1, 0), b3, voffB); PG8_STAGE(PG8_SB(1, 1), b3 + hstep, voffB); PG8_STAGE(PG8_SA(1, 0), a3, voffA);
            PG8_WAIT_V(8); PG8_WAIT_L(0); PG8_BAR; PG8_MMA(1, 0, At, B0); PG8_MMA(1, 1, At, B1); PG8_BAR; PG8_SCHED;
            } else {
            PG8_LDB(B0, 0, 0); PG8_SCHED; PG8_LDA(At, 0, 0); PG8_STAGE(PG8_SA(1, 1), a1 + hstep, voffA);
            PG8_WAIT_L(8); PG8_BAR; PG8_WAIT_L(0); PG8_MMA(0, 0, At, B0); PG8_BAR; PG8_SCHED;
            PG8_LDB(B1, 0, 1); PG8_STAGE(PG8_SB(0, 0), b2, voffB);
            PG8_BAR; PG8_WAIT_L(0); PG8_MMA(0, 1, At, B1); PG8_BAR;
            PG8_LDA(At, 0, 1); PG8_STAGE(PG8_SA(0, 0), a2, voffA);
            PG8_BAR; PG8_WAIT_L(0); PG8_MMA(1, 0, At, B0); PG8_BAR; PG8_SCHED;
            PG8_STAGE(PG8_SB(0, 1), b2 + hstep, voffB);
            PG8_WAIT_V(6); PG8_BAR; PG8_MMA(1, 1, At, B1); PG8_BAR;
            PG8_LDB(B0, 1, 0); PG8_SCHED; PG8_LDA(At, 1, 0); PG8_STAGE(PG8_SA(0, 1), a2 + hstep, voffA);
            PG8_WAIT_L(8); PG8_BAR; PG8_WAIT_L(0); PG8_MMA(0, 0, At, B0); PG8_BAR; PG8_SCHED;
            PG8_LDB(B1, 1, 1); PG8_STAGE(PG8_SB(1, 0), b3, voffB);
            PG8_BAR; PG8_WAIT_L(0); PG8_MMA(0, 1, At, B1); PG8_BAR;
            PG8_LDA(At, 1, 1); PG8_STAGE(PG8_SA(1, 0), a3, voffA);
            PG8_BAR; PG8_WAIT_L(0); PG8_MMA(1, 0, At, B0); PG8_BAR; PG8_SCHED;
            PG8_STAGE(PG8_SB(1, 1), b3 + hstep, voffB);
            PG8_WAIT_V(6); PG8_BAR; PG8_MMA(1, 1, At, B1); PG8_BAR;
            }
        }
        if constexpr (ALIGN_EPI) { if (wr == 0) PG8_BAR; }
        if constexpr (!Epi::AFTER_DRAIN) { E(acc, cur, wr, wc, fr, fq); S.done(cur); }
        if (!has_next) break;
#pragma unroll
        for (int a = 0; a < 2; ++a)
#pragma unroll
            for (int b = 0; b < 2; ++b)
#pragma unroll
                for (int m = 0; m < 4; ++m)
#pragma unroll
                    for (int n = 0; n < 2; ++n) acc[a][b][m][n] = (f32x4){0.f, 0.f, 0.f, 0.f};
        cur = nxt; cA = nA; cB = nB; ++ui;
        if constexpr (ALIGN_EPI) { if (wr == 1) PG8_BAR; }
    }
    PG8_WAIT_V(0);
    if constexpr (!ALIGN_EPI) { if (wr == 0) PG8_BAR; }
    PG8_BAR;
    if constexpr (Epi::AFTER_DRAIN) { E.fused(acc, cur, wr, wc, fr, fq, lds, wid, lane); S.done(cur); }
#undef PG8_SA
#undef PG8_SB
#undef PG8_STAGE
#undef PG8_LDA
#undef PG8_LDB
#undef PG8_MMA
#undef PG8_WAIT_V
#undef PG8_WAIT_L
#undef PG8_BAR
#undef PG8_SCHED
}
}
namespace fk {
using namespace cfg;
#define LAS __attribute__((address_space(3)))
typedef unsigned short bf16;
typedef short bf16x8 __attribute__((ext_vector_type(8)));
typedef short s16x4 __attribute__((ext_vector_type(4)));
typedef float f32x4 __attribute__((ext_vector_type(4)));
typedef float f32x2 __attribute__((ext_vector_type(2)));
typedef float f32x16 __attribute__((ext_vector_type(16)));
typedef unsigned u32x4 __attribute__((ext_vector_type(4)));
typedef unsigned u32x2 __attribute__((ext_vector_type(2)));
typedef __bf16 bf16x2_t __attribute__((ext_vector_type(2)));
#define DI __device__ __forceinline__
#define GAS __attribute__((address_space(1)))
typedef GAS float gfloat; typedef GAS unsigned short gbf16; typedef GAS unsigned guint; typedef GAS int gint; typedef GAS unsigned char guchar;
#define MFMA32(a, b, c) __builtin_amdgcn_mfma_f32_32x32x16_bf16((a), (b), (c), 0, 0, 0)

DI unsigned pk2(float a, float b) { f32x2 f = {a, b}; bf16x2_t r = __builtin_convertvector(f, bf16x2_t); return __builtin_bit_cast(unsigned, r); }
DI bf16 f2bf(float a) { return (bf16)(pk2(a, 0.f) & 0xffffu); }
DI float bf2f(bf16 v) { return __builtin_bit_cast(float, (unsigned)v << 16); }
DI float bflo(unsigned w) { return __builtin_bit_cast(float, w << 16); }
DI float bfhi(unsigned w) { return __builtin_bit_cast(float, w & 0xffff0000u); }
DI float sigmoid_(float x) { return __builtin_amdgcn_rcpf(1.f + __expf(-x)); }
DI float silu_(float x) { return x * __builtin_amdgcn_rcpf(1.f + __expf(-x)); }
DI float softplus_(float x) { return fmaxf(x, 0.f) + log1pf(expf(-fabsf(x))); }
DI float gelu_tanh_(float x) { const float u = 0.7978845608028654f * (x + 0.044715f * x * x * x); const float e = __expf(2.f * u); return x * (1.f - __builtin_amdgcn_rcpf(e + 1.f)); }
DI int crow(int reg, int h) { return (reg & 3) + 8 * (reg >> 2) + 4 * h; }
DI f32x16 zero16() { f32x16 z; for (int i = 0; i < 16; ++i) z[i] = 0.f; return z; }
DI bf16x8 pack_step(const f32x16& x, int s) {
    u32x4 p; p[0] = pk2(x[8 * s], x[8 * s + 1]); p[1] = pk2(x[8 * s + 2], x[8 * s + 3]); p[2] = pk2(x[8 * s + 4], x[8 * s + 5]); p[3] = pk2(x[8 * s + 6], x[8 * s + 7]);
    return __builtin_bit_cast(bf16x8, p);
}
DI bf16x8 ld_perm_frag(const LAS bf16* rowp, int kbase, int s, int h) {
    const s16x4 lo = *(const LAS s16x4*)(rowp + kbase + 16 * s + 4 * h);
    const s16x4 hi = *(const LAS s16x4*)(rowp + kbase + 16 * s + 8 + 4 * h);
    return __builtin_shufflevector(lo, hi, 0, 1, 2, 3, 4, 5, 6, 7);
}
DI float shx(float v, int o, int lane) { return __builtin_bit_cast(float, __builtin_amdgcn_ds_bpermute((lane ^ o) << 2, __builtin_bit_cast(int, v))); }
DI float half_max(float v) { auto rr = __builtin_amdgcn_permlane32_swap(__float_as_uint(v), __float_as_uint(v), false, false); return __builtin_fmaxf(__uint_as_float(rr[0]), __uint_as_float(rr[1])); }
DI float half_sum(float v) { auto rr = __builtin_amdgcn_permlane32_swap(__float_as_uint(v), __float_as_uint(v), false, false); return __uint_as_float(rr[0]) + __uint_as_float(rr[1]); }
#define LDS_SYNC() asm volatile("s_waitcnt lgkmcnt(0)\n\ts_barrier" ::: "memory")
template <int CTRL> DI float dpp_mov(float v) { return __builtin_bit_cast(float, __builtin_amdgcn_update_dpp(0, __builtin_bit_cast(int, v), CTRL, 0xF, 0xF, true)); }
DI float row16_sum(float v) { v += dpp_mov<0xB1>(v); v += dpp_mov<0x4E>(v); v += dpp_mov<0x141>(v); v += dpp_mov<0x140>(v); return v; }
DI float half32_sum(float v, int lane) {
    v = row16_sum(v); const int iv = __builtin_bit_cast(int, v);
    const float lo = __builtin_bit_cast(float, __builtin_amdgcn_readlane(iv, 0)) + __builtin_bit_cast(float, __builtin_amdgcn_readlane(iv, 16)), hi = __builtin_bit_cast(float, __builtin_amdgcn_readlane(iv, 32)) + __builtin_bit_cast(float, __builtin_amdgcn_readlane(iv, 48));
    return (lane & 32) ? hi : lo;
}
DI float wave_sum(float v, int lane) {
    (void)lane;
    v += dpp_mov<0xB1>(v); v += dpp_mov<0x4E>(v); v += dpp_mov<0x141>(v); v += dpp_mov<0x140>(v);
    const int iv = __builtin_bit_cast(int, v);
    return (__builtin_bit_cast(float, __builtin_amdgcn_readlane(iv, 0)) + __builtin_bit_cast(float, __builtin_amdgcn_readlane(iv, 16))) + (__builtin_bit_cast(float, __builtin_amdgcn_readlane(iv, 32)) + __builtin_bit_cast(float, __builtin_amdgcn_readlane(iv, 48)));
}

constexpr size_t al256(size_t x) { return (x + 255) / 256 * 256; }
constexpr int RMAX = 36864;
constexpr int NCH = NTOK / 64;
constexpr int NCHD = NCH * 8 * 2;
constexpr size_t WS_CTL = 0, CTL_BYTES = 1u << 20;
constexpr size_t WS_MOD = CTL_BYTES;
constexpr size_t WS_COS = WS_MOD + al256((size_t)DEPTH * 5 * MODW * 4);
constexpr size_t WS_SIN = WS_COS + (size_t)SEQ * 32 * 4;
constexpr size_t WS_WEIN = WS_SIN + (size_t)SEQ * 32 * 4;
constexpr size_t WS_WEOUT = WS_WEIN + (size_t)2 * 2560 * 1024 * 2;
constexpr size_t WS_WEF1 = WS_WEOUT + (size_t)2 * 1024 * 1024 * 2;
constexpr size_t WS_WEF2 = WS_WEF1 + (size_t)2 * 5632 * 1024 * 2;
constexpr size_t WS_WOIN = WS_WEF2 + (size_t)2 * 1024 * 2816 * 2;
constexpr size_t WS_WOOUT = WS_WOIN + (size_t)2 * 4352 * 1024 * 2;
constexpr size_t WS_WXIN = WS_WOOUT + (size_t)2 * 1024 * 1024 * 2;
constexpr size_t WS_WXOUT = WS_WXIN + (size_t)2 * 8 * 7168 * 1024 * 2;
constexpr size_t WS_X = WS_WXOUT + (size_t)2 * 8 * 1024 * 3584 * 2;
constexpr size_t WS_H = WS_X + (size_t)NTOK * D * 4;
constexpr size_t WS_MIX = WS_H + (size_t)NTOK * D * 2;
constexpr size_t WS_P = WS_MIX + (size_t)NTOK * D * 2;
constexpr size_t WS_HS1 = WS_P + (size_t)NTOK * 4352 * 2;
constexpr size_t WS_U = WS_HS1 + (size_t)NTOK * 512 * 4;
constexpr size_t WS_PART = WS_U + (size_t)400 * 1024 * 1024;
constexpr size_t WS_RGA = WS_U;
constexpr size_t WS_RGU = WS_RGA + (size_t)2 * NTOK * 512 * 4;
constexpr size_t WS_QKVN = WS_U;
constexpr size_t WS_WG = WS_QKVN + (size_t)NTOK * 3072 * 2;
constexpr size_t WS_UG = WS_WG + (size_t)NCHD * 64 * 128 * 2;
constexpr size_t WS_QG = WS_UG + (size_t)NCHD * 64 * 128 * 2;
constexpr size_t WS_QKD = WS_UG + (size_t)NCHD * 64 * 128 * 4;
constexpr size_t WS_SC = WS_QKD + (size_t)NCHD * 64 * 64 * 2;
constexpr size_t WS_KTG = WS_SC + (size_t)NCHD * 192 * 4;
constexpr size_t WS_OG = WS_KTG + (size_t)NCHD * 128 * 64 * 2;
constexpr size_t WS_U_END1 = WS_OG + (size_t)2 * NTOK * D * 4;
constexpr size_t WS_XS = WS_U;
constexpr size_t WS_HIDM = WS_XS + (size_t)RMAX * D * 2;
constexpr size_t WS_Y = WS_HIDM + (size_t)RMAX * FFE * 2;
constexpr size_t WS_YP = WS_Y + (size_t)RMAX * D * 4;
constexpr size_t WS_U_END2 = WS_YP + (size_t)64 * 256 * D * 4;
constexpr size_t WS_TOK = (WS_U_END1 > WS_U_END2 ? WS_U_END1 : WS_U_END2);
constexpr size_t WS_END = WS_TOK + (size_t)NTOK * 32;
constexpr size_t WS_AB = WS_HS1;
constexpr size_t WS_GB = WS_AB + (size_t)NTOK * 32 * 4;

constexpr int CW_BAR = 4096;
constexpr int CW_CNT = 8192;
constexpr int CW_Q = 8448;
constexpr int CW_BC = 16384;

#ifndef LDS_KIB
#define LDS_KIB 152
#endif
constexpr int LDS_BYTES = LDS_KIB * 1024;
constexpr int LDS_MISC = LDS_BYTES - 256;

struct Params { const float* in[31]; float* out; unsigned char* ws; int ph_lo, ph_hi; int dbg0, dbg1; };

DI const gfloat* gin(const Params& p, int k) { return (const gfloat*)p.in[k]; }
struct Ctx {
    LAS unsigned char* lds;
    guchar* ws; guchar* ws0;
    int tid, lane, wave, nblk, blk, wave0;
};
DI int fresh_tid(const Ctx& C) { int t; asm volatile("v_mbcnt_lo_u32_b32 %0, -1, 0\n\tv_mbcnt_hi_u32_b32 %0, -1, %0" : "=v"(t)); return t + C.wave0 * 64; }
#define XB_TMO      128
#define XB_XCNT(j)  (256  + 64 * (j))
#define XB_XSUB(j)  (1280 + 64 * (j))
#define XB_XGEN(j)  (2304 + 64 * (j))
#define XB_TOP      3328
#define XB_TOPGEN   3392
#define XCD_BAR_WORDS 3456
#define XB_SPIN_CAP (1u << 27)

__device__ __forceinline__ unsigned xb_ld(unsigned* p)              { return __hip_atomic_load(p, __ATOMIC_RELAXED, __HIP_MEMORY_SCOPE_AGENT); }
__device__ __forceinline__ unsigned xb_add(unsigned* p, unsigned v) { (void)v; unsigned one; asm volatile("v_mov_b32 %0, 1" : "=v"(one)); return __hip_atomic_fetch_add(p, one, __ATOMIC_RELAXED, __HIP_MEMORY_SCOPE_AGENT); }
__device__ __forceinline__ unsigned xb_xcc_id() { return (unsigned)__builtin_amdgcn_s_getreg((3 << 11) | 20) & 0xFu; }
#define XB_SPIN(cond, bar) do { unsigned _sp = 0; while (cond) { __builtin_amdgcn_s_sleep(1); \
    if ((++_sp & 255u) == 0u) { if (xb_ld(&(bar)[XB_TMO])) break; if (_sp > XB_SPIN_CAP) { (void)xb_add(&(bar)[XB_TMO], 1u); break; } } } } while (0)

struct XcdBarrier {
    unsigned* bar; unsigned x;
    volatile LAS unsigned* st;
};

__device__ __forceinline__ XcdBarrier xcd_barrier_post(unsigned* bar, volatile LAS unsigned* st) {
    XcdBarrier b; b.bar = bar; b.x = xb_xcc_id(); b.st = st;
    if (threadIdx.x == 0) (void)xb_add(&bar[XB_XCNT(b.x)], 1u);
    return b;
}
__device__ __forceinline__ void xcd_barrier_complete(unsigned* bar, unsigned x, unsigned& nloc, unsigned& nx) {
    const unsigned G = gridDim.x * gridDim.y * gridDim.z;
    unsigned sum, cnt, mine, sp = 0u;
    for (;;) {
        sum = 0u; cnt = 0u; mine = 0u;
#pragma unroll
        for (unsigned j = 0; j < 16; ++j) { const unsigned c = xb_ld(&bar[XB_XCNT(j)]); sum += c; cnt += (c > 0u) ? 1u : 0u; mine = (j == x) ? c : mine; }
        if (sum == G) break;
        __builtin_amdgcn_s_sleep(1);
        if ((++sp & 255u) == 0u) { if (xb_ld(&bar[XB_TMO])) break; if (sp > XB_SPIN_CAP) { (void)xb_add(&bar[XB_TMO], 1u); break; } }
    }
    nloc = mine > 0u ? mine : 1u; nx = cnt > 0u ? cnt : 1u;
}

__device__ __forceinline__ void xcd_barrier(const XcdBarrier& b) {
    asm volatile("s_waitcnt vmcnt(0)" ::: "memory");
    __syncthreads();
    if (threadIdx.x == 0) {
        unsigned* bar = b.bar;
        __builtin_amdgcn_s_waitcnt(0);
        unsigned nloc = b.st[0], nx = b.st[1];
        if (nloc == 0u) { xcd_barrier_complete(bar, b.x, nloc, nx); b.st[0] = nloc; b.st[1] = nx; }
        const unsigned old = xb_add(&bar[XB_XSUB(b.x)], 1u);
        const unsigned gen = old / nloc;
        if (old + 1u == (gen + 1u) * nloc) {
            __builtin_amdgcn_fence(__ATOMIC_RELEASE, "agent");
            asm volatile("s_waitcnt vmcnt(0)" ::: "memory");
            const unsigned og = xb_add(&bar[XB_TOP], 1u);
            const unsigned tg = og / nx;
            if (og + 1u == (tg + 1u) * nx) xb_add(&bar[XB_TOPGEN], 1u);
            else XB_SPIN(xb_ld(&bar[XB_TOPGEN]) == tg, bar);
            __builtin_amdgcn_fence(__ATOMIC_ACQUIRE, "agent");
            xb_add(&bar[XB_XGEN(b.x)], 1u);
            asm volatile("s_waitcnt vmcnt(0)" ::: "memory");
        } else {
            XB_SPIN(xb_ld(&bar[XB_XGEN(b.x)]) == gen, bar);
            __builtin_amdgcn_fence(__ATOMIC_ACQUIRE, "agent");
            asm volatile("s_waitcnt vmcnt(0)" ::: "memory");
        }
    }
    __syncthreads();
}

using pg8::Unit;
typedef pg8::f32x4 af4;

struct EpiEvenIn {
    static constexpr bool PERM = true, AFTER_DRAIN = false;
    gbf16* P; const gfloat* cosT; const gfloat* sinT;
    DI void operator()(const af4 (&acc)[2][2][4][2], const Unit& u, int wr, int wc, int fr, int fq) const {
        const int row0 = u.pm * 256 + wr * 64 + fr, col0 = u.pn * 256 + wc * 32 + 8 * fq;
        const bool rope = (u.pn < 4) && (u.pm < 64);
        const float qs = (u.pn < 2) ? 0.18033688011112042f : 1.f;
        gbf16* base = P + (size_t)row0 * EVEN_IN + col0;
        if (rope) {
            const int i0 = (wc & 1) * 16 + 4 * fq;
            af4 cs[8], sn[8];
#pragma unroll
            for (int gi = 0; gi < 8; ++gi) { const int t = (row0 + (gi >> 2) * 128 + (gi & 3) * 16) & 4095; cs[gi] = *(const GAS af4*)(cosT + t * 32 + i0); sn[gi] = *(const GAS af4*)(sinT + t * 32 + i0); }
#pragma unroll
            for (int gi = 0; gi < 8; ++gi) {
                const int ai = gi >> 2, m = gi & 3;
                gbf16* rowp = base + (size_t)(ai * 128 + m * 16) * EVEN_IN;
#pragma unroll
                for (int bj = 0; bj < 2; ++bj) {
                    const af4 v0 = acc[ai][bj][m][0], v1 = acc[ai][bj][m][1], c = cs[gi], sv = sn[gi];
                    af4 o0, o1;
                    o0[0] = v0[0] * c[0] - v0[1] * sv[0]; o0[1] = v0[0] * sv[0] + v0[1] * c[0];
                    o0[2] = v0[2] * c[1] - v0[3] * sv[1]; o0[3] = v0[2] * sv[1] + v0[3] * c[1];
                    o1[0] = v1[0] * c[2] - v1[1] * sv[2]; o1[1] = v1[0] * sv[2] + v1[1] * c[2];
                    o1[2] = v1[2] * c[3] - v1[3] * sv[3]; o1[3] = v1[2] * sv[3] + v1[3] * c[3];
                    o0 = o0 * qs; o1 = o1 * qs;
                    u32x4 w; w[0] = pk2(o0[0], o0[1]); w[1] = pk2(o0[2], o0[3]); w[2] = pk2(o1[0], o1[1]); w[3] = pk2(o1[2], o1[3]);
                    *(GAS u32x4*)(rowp + bj * 128) = w;
                }
            }
        } else {
#pragma unroll
            for (int gi = 0; gi < 8; ++gi) {
                const int ai = gi >> 2, m = gi & 3;
                gbf16* rowp = base + (size_t)(ai * 128 + m * 16) * EVEN_IN;
#pragma unroll
                for (int bj = 0; bj < 2; ++bj) {
                    const af4 v0 = acc[ai][bj][m][0] * qs, v1 = acc[ai][bj][m][1] * qs;
                    u32x4 w; w[0] = pk2(v0[0], v0[1]); w[1] = pk2(v0[2], v0[3]); w[2] = pk2(v1[0], v1[1]); w[3] = pk2(v1[2], v1[3]);
                    *(GAS u32x4*)(rowp + bj * 128) = w;
                }
            }
        }
    }
};
struct EpiBf16Ab {
    static constexpr bool PERM = true, AFTER_DRAIN = false;
    gbf16* O; int ldc; gfloat* AB; int ab_pn;
    DI void operator()(const af4 (&acc)[2][2][4][2], const Unit& u, int wr, int wc, int fr, int fq) const {
        const int row0 = u.pm * 256 + wr * 64 + fr, col0 = u.pn * 256 + wc * 32 + 8 * fq;
        if (u.pn == ab_pn) {
            if (wc == 0) {
#pragma unroll
                for (int ai = 0; ai < 2; ++ai)
#pragma unroll
                    for (int m = 0; m < 4; ++m) { gfloat* ap = AB + (size_t)(row0 + ai * 128 + m * 16) * 32 + 8 * fq; *(GAS af4*)ap = acc[ai][0][m][0]; *(GAS af4*)(ap + 4) = acc[ai][0][m][1]; }
            }
            return;
        }
#pragma unroll
        for (int ai = 0; ai < 2; ++ai)
#pragma unroll
            for (int m = 0; m < 4; ++m) {
                gbf16* rowp = O + (size_t)(row0 + ai * 128 + m * 16) * ldc + col0;
#pragma unroll
                for (int bj = 0; bj < 2; ++bj) { const af4 v0 = acc[ai][bj][m][0], v1 = acc[ai][bj][m][1];
                    u32x4 w; w[0] = pk2(v0[0], v0[1]); w[1] = pk2(v0[2], v0[3]); w[2] = pk2(v1[0], v1[1]); w[3] = pk2(v1[2], v1[3]);
                    *(GAS u32x4*)(rowp + bj * 128) = w; }
            }
    }
};
struct EpiSwiglu {
    static constexpr bool PERM = true, AFTER_DRAIN = false;
    gbf16* O; int ldc; int nN;
    DI void operator()(const af4 (&acc)[2][2][4][2], const Unit& u, int wr, int wc, int fr, int fq) const {
        const int row0 = u.pm * 256 + wr * 64 + fr, col0 = (u.pn % nN) * 128 + wc * 32 + 8 * fq;
#pragma unroll
        for (int ai = 0; ai < 2; ++ai)
#pragma unroll
            for (int m = 0; m < 4; ++m) {
                const af4 g0 = acc[ai][0][m][0], g1 = acc[ai][0][m][1], u0 = acc[ai][1][m][0], u1 = acc[ai][1][m][1];
                float r[8];
#pragma unroll
                for (int j = 0; j < 4; ++j) { r[j] = silu_(g0[j]) * u0[j]; r[4 + j] = silu_(g1[j]) * u1[j]; }
                u32x4 w; w[0] = pk2(r[0], r[1]); w[1] = pk2(r[2], r[3]); w[2] = pk2(r[4], r[5]); w[3] = pk2(r[6], r[7]);
                *(GAS u32x4*)(O + (size_t)(row0 + ai * 128 + m * 16) * ldc + col0) = w;
            }
    }
};
struct EpiResid {
    static constexpr bool PERM = true, AFTER_DRAIN = false;
    gbf16* X; const gfloat* gate;
    DI void operator()(const af4 (&acc)[2][2][4][2], const Unit& u, int wr, int wc, int fr, int fq) const {
        const int row0 = u.pm * 256 + wr * 64 + fr, col0 = u.pn * 256 + wc * 32 + 8 * fq;
        const gfloat* gv = gate + (size_t)(u.pm < 64 ? (u.pm >> 4) : 4) * MODW + col0;
        af4 g[2][2];
#pragma unroll
        for (int bj = 0; bj < 2; ++bj)
#pragma unroll
            for (int n = 0; n < 2; ++n) g[bj][n] = *(const GAS af4*)(gv + bj * 128 + n * 4);
        gbf16* base = X + (size_t)row0 * D + col0;
        u32x4 x[3][2];
#define ER_LD(slot, grp) do { const gbf16* rp_ = base + (size_t)(((grp) >> 2) * 128 + ((grp) & 3) * 16) * D; x[slot][0] = *(const GAS u32x4*)rp_; x[slot][1] = *(const GAS u32x4*)(rp_ + 128); } while (0)
        ER_LD(0, 0); ER_LD(1, 1); ER_LD(2, 2);
#pragma unroll
        for (int gi = 0; gi < 8; ++gi) {
            const int ai = gi >> 2, m = gi & 3;
            gbf16* rowp = base + (size_t)(ai * 128 + m * 16) * D;
#pragma unroll
            for (int bj = 0; bj < 2; ++bj) { const u32x4 xv = x[gi % 3][bj]; const af4 a0 = acc[ai][bj][m][0], a1 = acc[ai][bj][m][1], g0 = g[bj][0], g1 = g[bj][1]; u32x4 w;
                w[0] = pk2(bflo(xv[0]) + g0[0] * a0[0], bfhi(xv[0]) + g0[1] * a0[1]); w[1] = pk2(bflo(xv[1]) + g0[2] * a0[2], bfhi(xv[1]) + g0[3] * a0[3]);
                w[2] = pk2(bflo(xv[2]) + g1[0] * a1[0], bfhi(xv[2]) + g1[1] * a1[1]); w[3] = pk2(bflo(xv[3]) + g1[2] * a1[2], bfhi(xv[3]) + g1[3] * a1[3]);
                *(GAS u32x4*)(rowp + bj * 128) = w; }
            if (gi + 3 < 8) ER_LD(gi % 3, gi + 3);
        }
#undef ER_LD
    }
};
struct EpiPart {
    static constexpr bool PERM = false, AFTER_DRAIN = false;
    gfloat* PART;
    DI void operator()(const af4 (&acc)[2][2][4][2], const Unit& u, int wr, int wc, int fr, int fq) const {
        const int row0 = u.pm * 256 + wr * 64 + fr, col0 = u.pn * 256 + wc * 32 + 4 * fq;
        gfloat* base = PART + (size_t)u.pk * NCTX * D;
#pragma unroll
        for (int ai = 0; ai < 2; ++ai)
#pragma unroll
            for (int m = 0; m < 4; ++m) { gfloat* rowp = base + (size_t)(row0 + ai * 128 + m * 16) * D + col0;
#pragma unroll
                for (int bj = 0; bj < 2; ++bj)
#pragma unroll
                    for (int n = 0; n < 2; ++n) *(GAS af4*)(rowp + bj * 128 + n * 16) = acc[ai][bj][m][n]; }
    }
};
struct EpiF32 {
    static constexpr bool PERM = true, AFTER_DRAIN = false;
    gbf16* C; int ldc; int nN;
    DI void operator()(const af4 (&acc)[2][2][4][2], const Unit& u, int wr, int wc, int fr, int fq) const {
        const int row0 = u.pm * 256 + wr * 64 + fr, col0 = (u.pn % nN) * 256 + wc * 32 + 8 * fq;
#pragma unroll
        for (int ai = 0; ai < 2; ++ai)
#pragma unroll
            for (int m = 0; m < 4; ++m) { gbf16* rowp = C + (size_t)(row0 + ai * 128 + m * 16) * ldc + col0;
#pragma unroll
                for (int bj = 0; bj < 2; ++bj) { const af4 v0 = acc[ai][bj][m][0], v1 = acc[ai][bj][m][1];
                    u32x4 w; w[0] = pk2(v0[0], v0[1]); w[1] = pk2(v0[2], v0[3]); w[2] = pk2(v1[0], v1[1]); w[3] = pk2(v1[2], v1[3]);
                    *(GAS u32x4*)(rowp + bj * 128) = w; } }
    }
};
struct MoeOrder : pg8::StaticOrder {
    int tend[8];
    __device__ void initm(const guint* cnt, int nN_, int G_, int c_) {
        int acc = 0;
#pragma unroll
        for (int e = 0; e < 8; ++e) { acc += ((int)cnt[e] + 255) >> 8; tend[e] = acc; }
        nM = acc; nN = nN_; nwg = nM * nN; G = G_; c = c_; lim = nwg; L0 = 0; s = 1;
    }
    __device__ bool next(int i, Unit& u) const {
        if (!pg8::StaticOrder::next(i, u)) return false;
        int e = 0;
#pragma unroll
        for (int k = 0; k < 7; ++k) e += (u.pm >= tend[k]) ? 1 : 0;
        u.pn += e * nN; return true;
    }
};

struct MoeOrder2 {
    int tend[8]; int nM, nwg, G, c, Lmain, r, s, tail;
    __device__ __forceinline__ void initm(const guint* cnt, int G_, int c_, int tail_) {
        int acc = 0;
#pragma unroll
        for (int e = 0; e < 8; ++e) { acc += ((int)cnt[e] + 255) >> 8; tend[e] = acc; }
        nM = acc; nwg = nM * 4; G = G_; c = c_; tail = tail_; Lmain = (nwg / G) * G; r = nwg - Lmain;
        s = 1; if (r > 0) { const int q = G / r; s = q >= 14 ? 14 : (q >= 7 ? 7 : (q >= 4 ? 4 : (q >= 2 ? 2 : 1))); }
    }
    __device__ __forceinline__ int tail_row0() const { return (Lmain >> 2) * 256; }
    __device__ __forceinline__ bool next(int i, Unit& u) const {
        const int j = i * G + c; int Lp;
        if (!tail) { if (j >= Lmain) return false; Lp = (j & 7) * (Lmain >> 3) + (j >> 3); u.pk = 0; }
        else { if (j >= r * s) return false; Lp = Lmain + j / s; u.pk = j % s; }
        u.pm = Lp >> 2; int e = 0;
#pragma unroll
        for (int k = 0; k < 7; ++k) e += (u.pm >= tend[k]) ? 1 : 0;
        u.pn = e * 4 + (Lp & 3); return true;
    }
    __device__ __forceinline__ void a_ready(const Unit&) const {}
    __device__ __forceinline__ void done(const Unit&) const {}
};
struct EpiPartY {
    static constexpr bool PERM = false, AFTER_DRAIN = false;
    gfloat* YP; int pm0, tail_rows;
    DI void operator()(const af4 (&acc)[2][2][4][2], const Unit& u, int wr, int wc, int fr, int fq) const {
        const int row0 = (u.pm - pm0) * 256 + wr * 64 + fr, col0 = (u.pn & 3) * 256 + wc * 32 + 4 * fq;
        gfloat* base = YP + (size_t)u.pk * tail_rows * D;
#pragma unroll
        for (int ai = 0; ai < 2; ++ai)
#pragma unroll
            for (int m = 0; m < 4; ++m) { gfloat* rowp = base + (size_t)(row0 + ai * 128 + m * 16) * D + col0;
#pragma unroll
                for (int bj = 0; bj < 2; ++bj)
#pragma unroll
                    for (int n = 0; n < 2; ++n) *(GAS af4*)(rowp + bj * 128 + n * 16) = acc[ai][bj][m][n]; }
    }
};
DI void transpose_load(f32x4 (&v)[8], const gfloat* W, int ldw, int k0, int n0, int lane) {
#pragma unroll
    for (int i = 0; i < 8; ++i) v[i] = *(const GAS f32x4*)(W + (size_t)(k0 + 8 * i + (lane >> 3)) * ldw + n0 + 4 * (lane & 7));
}
DI void transpose_store(const f32x4 (&v)[8], int K, gbf16* WT, int k0, int drow0, LAS float* scr, int lane) {
#pragma unroll
    for (int i = 0; i < 8; ++i) { LAS float* d = scr + (8 * i + (lane >> 3)) * 33 + 4 * (lane & 7); d[0] = v[i][0]; d[1] = v[i][1]; d[2] = v[i][2]; d[3] = v[i][3]; }
    asm volatile("s_waitcnt lgkmcnt(0)" ::: "memory");
    const int c = lane & 7;
#pragma unroll
    for (int j = 0; j < 4; ++j) { const int n = (lane >> 3) + 8 * j; const LAS float* s = scr + (8 * c) * 33 + n;
        u32x4 o; o[0] = pk2(s[0 * 33], s[1 * 33]); o[1] = pk2(s[2 * 33], s[3 * 33]); o[2] = pk2(s[4 * 33], s[5 * 33]); o[3] = pk2(s[6 * 33], s[7 * 33]);
        *(GAS u32x4*)(WT + (size_t)(drow0 + n) * K + k0 + 8 * c) = o; }
    asm volatile("s_waitcnt lgkmcnt(0)" ::: "memory");
}
struct TJob { const gfloat* W; gbf16* WT; int ldw, K, N, F; };
DI int tjob_items(const TJob& j) { return (j.K / 64) * (j.N / 32); }
DI TJob get_tjob(const Params& p, int j) {
    const int i = j / 22, r = j % 22; unsigned char* ws = p.ws; TJob t;
    if (r == 0) t = TJob{gin(p, 9) + (size_t)i * D * EVEN_IN, (gbf16*)(ws + WS_WEIN) + (size_t)i * 2560 * 1024, EVEN_IN, D, EVEN_IN, 0};
    else if (r == 1) t = TJob{gin(p, 10) + (size_t)i * D * D, (gbf16*)(ws + WS_WEOUT) + (size_t)i * 1024 * 1024, D, D, D, 0};
    else if (r == 2) t = TJob{gin(p, 20) + (size_t)i * D * 2 * FFN, (gbf16*)(ws + WS_WEF1) + (size_t)i * 5632 * 1024, 2 * FFN, D, 2 * FFN, FFN};
    else if (r == 3) t = TJob{gin(p, 21) + (size_t)i * FFN * D, (gbf16*)(ws + WS_WEF2) + (size_t)i * 1024 * 2816, D, FFN, D, 0};
    else if (r == 4) t = TJob{gin(p, 22) + (size_t)i * D * ODD_IN, (gbf16*)(ws + WS_WOIN) + (size_t)i * 4352 * 1024, ODD_IN, D, ODD_IN, 0};
    else if (r == 5) t = TJob{gin(p, 27) + (size_t)i * D * D, (gbf16*)(ws + WS_WOOUT) + (size_t)i * 1024 * 1024, D, D, D, 0};
    else if (r < 14) { const int e = r - 6; t = TJob{gin(p, 29) + ((size_t)i * 8 + e) * D * 2 * FFE, (gbf16*)(ws + WS_WXIN) + ((size_t)i * 8 + e) * 7168 * 1024, 2 * FFE, D, 2 * FFE, FFE}; }
    else { const int e = r - 14; t = TJob{gin(p, 30) + ((size_t)i * 8 + e) * FFE * D, (gbf16*)(ws + WS_WXOUT) + ((size_t)i * 8 + e) * 1024 * 3584, D, FFE, D, 0}; }
    return t;
}
#ifndef CONV_JX
#define CONV_JX 18
#endif
#ifndef CONV_J0
#define CONV_J0 22
#endif
#ifndef CONV_J1
#define CONV_J1 33
#endif
#ifndef CONV_DEFER
#define CONV_DEFER 1
#endif
DI void convert_weights(const Ctx& C, const Params& p, int group, int gw, int NGW) {
    LAS float* scr = (LAS float*)(C.lds + 32768 + C.wave * 8704);
    int jstart = 0;
    for (int j = 0; j < 44; ++j) {
        const int gj = j < CONV_JX ? 0 : (j < CONV_J0 ? 3 : (j < CONV_J1 ? 1 : 2));
        if (gj != group) continue;
        const TJob t = get_tjob(p, j); const int ni = tjob_items(t), nblkN = t.N / 32;
        const int first = (gw - jstart % NGW + NGW) % NGW;
        auto item_geom = [&](int it, int& k0, int& n0, int& drow0) { const int kb = it / nblkN, nb = it % nblkN; k0 = kb * 64; n0 = nb * 32; drow0 = n0;
            if (t.F > 0) drow0 = (n0 < t.F) ? ((n0 / 128) * 256 + (n0 % 128)) : (((n0 - t.F) / 128) * 256 + 128 + ((n0 - t.F) % 128)); };
        f32x4 va[8], vb[8], vc[8]; int k0 = 0, n0 = 0, d0 = 0, k1 = 0, n1 = 0, d1 = 0;
        if (first < ni) { item_geom(first, k0, n0, d0); transpose_load(va, t.W, t.ldw, k0, n0, C.lane); }
        if (first + NGW < ni) { item_geom(first + NGW, k1, n1, d1); transpose_load(vb, t.W, t.ldw, k1, n1, C.lane); }
        for (int it = first; it < ni; it += NGW) {
            const int nx = it + 2 * NGW; int k2 = 0, n2 = 0, d2 = 0;
            if (nx < ni) { item_geom(nx, k2, n2, d2); transpose_load(vc, t.W, t.ldw, k2, n2, C.lane); }
            transpose_store(va, t.K, t.WT, k0, d0, scr, C.lane);
#pragma unroll
            for (int q = 0; q < 8; ++q) { va[q] = vb[q]; vb[q] = vc[q]; }
            k0 = k1; n0 = n1; d0 = d1; k1 = k2; n1 = n2; d1 = d2;
        }
        jstart += ni;
    }
}
DI void ph_prologue(const Ctx& C, const Params& p) {
    LAS float* sil = (LAS float*)(C.lds);
    { float xs[10];
#pragma unroll
      for (int q = 0; q < 10; ++q) { const int i = C.tid + 512 * q, v = i >> 10, k = i & 1023; xs[q] = v < 4 ? gin(p, 1)[v * 1024 + k] : gin(p, 3)[k]; }
#pragma unroll
      for (int q = 0; q < 10; ++q) { const float x = xs[q]; sil[C.tid + 512 * q] = x / (1.f + expf(-x)); } }
    __syncthreads();
    const int gw = C.blk * 8 + C.wave, NGW = C.nblk * 8;
    gfloat* MOD = (gfloat*)(C.ws + WS_MOD);
    { LAS float* red = (LAS float*)(C.lds + 32768);
      for (int it = C.blk; it < DEPTH * (MODW / 256); it += C.nblk) {
        const int l = it / (MODW / 256), nb = (it % (MODW / 256)) * 256, k0 = C.wave * 128;
        const gfloat* w = gin(p, 4) + (size_t)l * 1024 * MODW + (size_t)k0 * MODW + nb + 4 * C.lane;
        f32x4 a0 = (f32x4){0.f, 0.f, 0.f, 0.f}, a1 = a0, a2 = a0, a3 = a0, a4 = a0;
#pragma unroll 8
        for (int k = 0; k < 128; ++k) { const f32x4 wv = *(const GAS f32x4*)(w + (size_t)k * MODW); a0 = a0 + wv * sil[k0 + k]; a1 = a1 + wv * sil[1024 + k0 + k]; a2 = a2 + wv * sil[2048 + k0 + k]; a3 = a3 + wv * sil[3072 + k0 + k]; a4 = a4 + wv * sil[4096 + k0 + k]; }
        *(LAS f32x4*)(red + (C.wave * 5 + 0) * 256 + 4 * C.lane) = a0; *(LAS f32x4*)(red + (C.wave * 5 + 1) * 256 + 4 * C.lane) = a1; *(LAS f32x4*)(red + (C.wave * 5 + 2) * 256 + 4 * C.lane) = a2;
        *(LAS f32x4*)(red + (C.wave * 5 + 3) * 256 + 4 * C.lane) = a3; *(LAS f32x4*)(red + (C.wave * 5 + 4) * 256 + 4 * C.lane) = a4;
        __syncthreads();
        for (int o = C.tid; o < 5 * 256; o += 512) { const int v = o >> 8, c = o & 255; float sm = 0.f;
#pragma unroll
            for (int q = 0; q < 8; ++q) sm += red[(q * 5 + v) * 256 + c];
            MOD[(size_t)(l * 5 + v) * MODW + nb + c] = sm + gin(p, 5)[l * MODW + nb + c]; }
        __syncthreads();
      } }
    { gfloat* cosT = (gfloat*)(C.ws + WS_COS); gfloat* sinT = (gfloat*)(C.ws + WS_SIN);
      for (int idx = C.blk * 512 + C.tid; idx < SEQ * 32; idx += C.nblk * 512) { const int t = idx >> 5, i = idx & 31;
          const float invf = powf(10000.f, -(float)(i & 15) / 16.f); const float ang = (i < 16 ? (float)(t >> 6) : (float)(t & 63)) * invf;
          cosT[idx] = cosf(ang); sinT[idx] = sinf(ang); } }
    { for (int i = 0; i < 2; ++i) { GAS u32x4* z = (GAS u32x4*)((gbf16*)(C.ws + WS_WOIN) + (size_t)i * 4352 * 1024 + (size_t)4128 * 1024);
          for (int idx = C.blk * 512 + C.tid; idx < 224 * 1024 / 8; idx += C.nblk * 512) z[idx] = (u32x4){0u, 0u, 0u, 0u}; } }
    convert_weights(C, p, 0, gw, NGW);
    { const int nmod = DEPTH * (MODW / 256);
      if (C.nblk > nmod + 32) { if (C.blk >= nmod) convert_weights(C, p, 3, (C.blk - nmod) * 8 + C.wave, (C.nblk - nmod) * 8); }
      else convert_weights(C, p, 3, gw, NGW); }
#if CONV_DEFER == 0
    convert_weights(C, p, 1, gw, NGW); convert_weights(C, p, 2, gw, NGW);
#endif
}

DI void xrow_raw(u32x2 (&w)[4], const gbf16* xrow, int lane) {
#pragma unroll
    for (int j = 0; j < 4; ++j) w[j] = ((const GAS u32x2*)xrow)[lane + 64 * j];
}
DI void xrow_unpack(f32x4 (&v)[4], const u32x2 (&w)[4]) {
#pragma unroll
    for (int j = 0; j < 4; ++j) { v[j][0] = bflo(w[j][0]); v[j][1] = bfhi(w[j][0]); v[j][2] = bflo(w[j][1]); v[j][3] = bfhi(w[j][1]); }
}
DI void xrow_store(gbf16* xrow, f32x4 (&v)[4], int lane) {
#pragma unroll
    for (int j = 0; j < 4; ++j) { u32x2 w; w[0] = pk2(v[j][0], v[j][1]); w[1] = pk2(v[j][2], v[j][3]); ((GAS u32x2*)xrow)[lane + 64 * j] = w;
        v[j][0] = bflo(w[0]); v[j][1] = bfhi(w[0]); v[j][2] = bflo(w[1]); v[j][3] = bfhi(w[1]); }
}
constexpr int RB_K = 5;
struct ModVec { f32x4 g[4], sh[4], sc[4]; };
DI void modvec_load(ModVec& m, const gfloat* g, const gfloat* shift, const gfloat* scale, int lane) {
#pragma unroll
    for (int j = 0; j < 4; ++j) { m.g[j] = ((const GAS f32x4*)g)[lane + 64 * j]; m.sh[j] = ((const GAS f32x4*)shift)[lane + 64 * j]; m.sc[j] = ((const GAS f32x4*)scale)[lane + 64 * j]; }
}
constexpr int MV_LDS = 40960;
DI void modvec_stage(const Ctx& C, const gfloat* g, const gfloat* mod0) {
    LAS f32x4* mg = (LAS f32x4*)(C.lds + MV_LDS);
    f32x4 mq[6];
#pragma unroll
    for (int i6 = 0; i6 < 6; ++i6) { const int i = C.tid + 512 * i6, vec = (i >> 8) < 11 ? (i >> 8) : 10, c = i & 255;
        const gfloat* src = vec == 0 ? g : (vec <= 5 ? mod0 + (size_t)(vec - 1) * MODW : mod0 + (size_t)(vec - 6) * MODW + D);
        mq[i6] = ((const GAS f32x4*)src)[c]; }
#pragma unroll
    for (int i6 = 0; i6 < 6; ++i6) { const int i = C.tid + 512 * i6; if (i < 256 * 11) mg[i] = mq[i6]; }
    __syncthreads();
}
DI void modvec_lds(ModVec& m, const Ctx& C, int slot, int lane) {
    const LAS f32x4* mg = (const LAS f32x4*)(C.lds + MV_LDS);
#pragma unroll
    for (int j = 0; j < 4; ++j) { m.g[j] = mg[lane + 64 * j]; m.sh[j] = mg[(1 + slot) * 256 + lane + 64 * j]; m.sc[j] = mg[(6 + slot) * 256 + lane + 64 * j]; }
}
DI void normmod_regs(f32x4 (&v)[4], const ModVec& m, int lane) {
    float ss = 0.f;
#pragma unroll
    for (int j = 0; j < 4; ++j) ss += (v[j][0] * v[j][0] + v[j][1] * v[j][1]) + (v[j][2] * v[j][2] + v[j][3] * v[j][3]);
    const float rs = rsqrtf(wave_sum(ss, lane) * (1.f / D) + 1e-6f);
#pragma unroll
    for (int j = 0; j < 4; ++j) v[j] = v[j] * rs * m.g[j] * (m.sc[j] + 1.f) + m.sh[j];
}
DI void store_row_bf16(gbf16* orow, const f32x4 (&v)[4], int lane) {
#pragma unroll
    for (int j = 0; j < 4; ++j) { u32x2 w; w[0] = pk2(v[j][0], v[j][1]); w[1] = pk2(v[j][2], v[j][3]); ((GAS u32x2*)orow)[lane + 64 * j] = w; }
}
DI void add_ctx_partials(const Ctx& C, f32x4 (&v)[4], int r, int npart, const gfloat* gate_ctx, gbf16* Xrow) {
    const gfloat* PART = (const gfloat*)(C.ws + WS_PART) + (size_t)(r - NLAT) * D;
#pragma unroll
    for (int j = 0; j < 4; ++j) { f32x4 a = (f32x4){0.f, 0.f, 0.f, 0.f}; const f32x4 z4 = a;
        if (npart <= 4) { f32x4 q[4];
#pragma unroll
            for (int pk = 0; pk < 4; ++pk) q[pk] = ((const GAS f32x4*)(PART + (size_t)(pk < npart ? pk : npart - 1) * NCTX * D))[C.lane + 64 * j];
#pragma unroll
            for (int pk = 0; pk < 4; ++pk) a = a + ((pk < npart) ? q[pk] : z4); }
        else { f32x4 q[11];
#pragma unroll
            for (int pk = 0; pk < 11; ++pk) q[pk] = ((const GAS f32x4*)(PART + (size_t)(pk < npart ? pk : npart - 1) * NCTX * D))[C.lane + 64 * j];
#pragma unroll
            for (int pk = 0; pk < 11; ++pk) a = a + ((pk < npart) ? q[pk] : z4); }
        v[j] = v[j] + ((const GAS f32x4*)gate_ctx)[C.lane + 64 * j] * a; }
    xrow_store(Xrow, v, C.lane);
}
DI void ph_normmod(const Ctx& C, const Params& p, int layer, bool second, bool from_input, int npart, int gate_off) {
    const int gw = C.blk * 8 + C.wave, NGW = C.nblk * 8;
    gbf16* X = (gbf16*)(C.ws + WS_X); gbf16* H = (gbf16*)(C.ws + WS_H);
    const gfloat* MODl = (const gfloat*)(C.ws + WS_MOD) + (size_t)layer * 5 * MODW;
    const gfloat* g = (second ? gin(p, 7) : gin(p, 6)) + layer * D;
    modvec_stage(C, g, MODl + (second ? 3 * D : 0));
    if (from_input) {
        auto inrow = [&](int r) { return r < NLAT ? gin(p, 0) + (size_t)r * D : gin(p, 2) + (size_t)(r - NLAT) * D; };
        for (int r0 = gw; r0 < NTOK; r0 += RB_K * NGW) {
            f32x4 vr[RB_K][4];
#pragma unroll
            for (int k = 0; k < RB_K; ++k) { const int rq = r0 + k * NGW; const gfloat* src = inrow(rq < NTOK ? rq : r0);
#pragma unroll
                for (int j = 0; j < 4; ++j) vr[k][j] = ((const GAS f32x4*)src)[C.lane + 64 * j]; }
#pragma unroll
            for (int k = 0; k < RB_K; ++k) { const int r = r0 + k * NGW;
                if (r < NTOK) {
                    ModVec mvec; modvec_lds(mvec, C, r < NLAT ? (r >> 12) : 4, C.lane);
                    f32x4 v[4];
#pragma unroll
                    for (int j = 0; j < 4; ++j) v[j] = vr[k][j];
                    xrow_store(X + (size_t)r * D, v, C.lane);
                    normmod_regs(v, mvec, C.lane);
                    store_row_bf16(H + (size_t)r * D, v, C.lane);
                } }
        }
        return;
    }
    for (int r0 = gw; r0 < NTOK; r0 += RB_K * NGW) {
        u32x2 wr9[RB_K][4];
#pragma unroll
        for (int k = 0; k < RB_K; ++k) { const int r = r0 + k * NGW; xrow_raw(wr9[k], X + (size_t)(r < NTOK ? r : r0) * D, C.lane); }
#pragma unroll
        for (int k = 0; k < RB_K; ++k) { const int r = r0 + k * NGW;
            if (r < NTOK) {
                ModVec mvec; modvec_lds(mvec, C, r < NLAT ? (r >> 12) : 4, C.lane);
                f32x4 v[4]; xrow_unpack(v, wr9[k]);
                if (npart > 0 && r >= NLAT) add_ctx_partials(C, v, r, npart, (const gfloat*)(C.ws + WS_MOD) + gate_off + 4 * MODW, X + (size_t)r * D);
                normmod_regs(v, mvec, C.lane);
                store_row_bf16(H + (size_t)r * D, v, C.lane);
            } }
    }
}

DI void seq_bounds(int r, int& s0, int& s1) { if (r < NLAT) { s0 = r & ~4095; s1 = s0 + 4096; } else { s0 = NLAT + ((r - NLAT) & ~255); s1 = s0 + 256; } }

DI void ph_odd_conv(const Ctx& C, const Params& p, int i) {
    const int gw = C.blk * 8 + C.wave, NGW = C.nblk * 8;
    const gbf16* PO = (const gbf16*)(C.ws + WS_P); gbf16* QKVN = (gbf16*)(C.ws + WS_QKVN);
    const gfloat* AB = (const gfloat*)(C.ws + WS_AB); gfloat* Gd = (gfloat*)(C.ws + WS_GB); gfloat* Bd = Gd + (size_t)2 * NTOK * 8;
    const gfloat* cw = gin(p, 23) + (size_t)i * 4 * 3072;
    for (int u = gw; u < NCH * 6; u += NGW) {
        const int strip = u / 6, cgp = u % 6, r0 = strip * 64, c = cgp * 512 + 8 * C.lane;
        int s0, s1; seq_bounds(r0, s0, s1);
        float w[4][8];
#pragma unroll
        for (int tp = 0; tp < 4; ++tp) { const f32x4 w0 = *(const GAS f32x4*)(cw + tp * 3072 + c), w1 = *(const GAS f32x4*)(cw + tp * 3072 + c + 4);
#pragma unroll
            for (int e = 0; e < 4; ++e) { w[tp][e] = w0[e]; w[tp][4 + e] = w1[e]; } }
        u32x4 win[4];
        const u32x4 zz = (u32x4){0u, 0u, 0u, 0u};
        win[1] = (r0 - 2 >= s0) ? *(const GAS u32x4*)(PO + (size_t)(r0 - 2) * 4352 + c) : zz;
        win[2] = (r0 - 1 >= s0) ? *(const GAS u32x4*)(PO + (size_t)(r0 - 1) * 4352 + c) : zz;
        win[3] = *(const GAS u32x4*)(PO + (size_t)r0 * 4352 + c);
        u32x4 cur[4], nx[4];
#pragma unroll
        for (int k = 0; k < 4; ++k) { const int rq = r0 + 1 + k; const u32x4 t4 = *(const GAS u32x4*)(PO + (size_t)(rq < s1 ? rq : s1 - 1) * 4352 + c); cur[k] = (rq < s1) ? t4 : zz; nx[k] = zz; }
        for (int g4 = 0; g4 < 16; ++g4) {
            const int rb = r0 + 4 * g4;
            {
#pragma unroll
                for (int k = 0; k < 4; ++k) { const int rq = rb + 5 + k; const u32x4 t4 = *(const GAS u32x4*)(PO + (size_t)(rq < s1 ? rq : s1 - 1) * 4352 + c); nx[k] = (rq < s1) ? t4 : zz; } }
#pragma unroll
          for (int k4 = 0; k4 < 4; ++k4) {
            const int r = rb + k4;
            win[0] = win[1]; win[1] = win[2]; win[2] = win[3]; win[3] = cur[k4];
            float a[8] = {0.f, 0.f, 0.f, 0.f, 0.f, 0.f, 0.f, 0.f};
#pragma unroll
            for (int tp = 0; tp < 4; ++tp) { const u32x4 x = win[tp];
                a[0] += w[tp][0] * bflo(x[0]); a[1] += w[tp][1] * bfhi(x[0]); a[2] += w[tp][2] * bflo(x[1]); a[3] += w[tp][3] * bfhi(x[1]);
                a[4] += w[tp][4] * bflo(x[2]); a[5] += w[tp][5] * bfhi(x[2]); a[6] += w[tp][6] * bflo(x[3]); a[7] += w[tp][7] * bfhi(x[3]); }
            float ss = 0.f;
#pragma unroll
            for (int e = 0; e < 8; ++e) { a[e] = silu_(a[e]); ss += a[e] * a[e]; }
            if (cgp < 4) {
                ss = row16_sum(ss);
                const float rn = rsqrtf(ss + 1e-6f);
#pragma unroll
                for (int e = 0; e < 8; ++e) a[e] *= rn;
            }
            u32x4 o; o[0] = pk2(a[0], a[1]); o[1] = pk2(a[2], a[3]); o[2] = pk2(a[4], a[5]); o[3] = pk2(a[6], a[7]);
            *(GAS u32x4*)(QKVN + (size_t)r * 3072 + c) = o;
          }
#pragma unroll
            for (int k = 0; k < 4; ++k) cur[k] = nx[k];
        }
    }
    for (int r = gw * 4 + (C.lane >> 4); r < NTOK; r += NGW * 4) { const int l16 = C.lane & 15, d = l16 >> 3, h = l16 & 7;
        const float x0 = AB[(size_t)r * 32 + d * 16 + h], x1 = AB[(size_t)r * 32 + d * 16 + 8 + h];
        Gd[((size_t)d * NTOK + r) * 8 + h] = -expf(gin(p, 24)[i * 16 + d * 8 + h]) * softplus_(x0 + gin(p, 25)[i * 16 + d * 8 + h]);
        Bd[((size_t)d * NTOK + r) * 8 + h] = 1.f / (1.f + expf(-x1)); }
}
DI void ph_gdn_out(const Ctx& C, const Params& p, int i, int nrows) {
    const int gw = C.blk * 8 + C.wave, NGW = C.nblk * 8;
    const gbf16* OG = (const gbf16*)(C.ws + WS_OG); const gbf16* PO = (const gbf16*)(C.ws + WS_P); gbf16* MIX = (gbf16*)(C.ws + WS_MIX);
    const f32x4 go = ((const GAS f32x4*)(gin(p, 26) + i * 128))[C.lane & 31];
    struct GoRow { u32x2 a[4], b[4]; u32x2 z[4]; };
#define GO_LOAD(r_, R_) do { const int ci_ = (r_) >> 6, t_ = (r_) & 63; _Pragma("unroll") for (int j = 0; j < 4; ++j) { const gbf16* ob_ = OG + (size_t)((ci_ * 8 + 2 * j + (C.lane >> 5)) * 2) * 8192 + 4 * (C.lane & 31); \
        R_.a[j] = *(const GAS u32x2*)(ob_ + t_ * 128); R_.b[j] = *(const GAS u32x2*)(ob_ + 8192 + (63 - t_) * 128); \
        R_.z[j] = *(const GAS u32x2*)(PO + (size_t)(r_) * 4352 + 3072 + 4 * C.lane + 256 * j); } } while (0)
    auto body = [&](int r, const GoRow& cur) {
#pragma unroll
        for (int j = 0; j < 4; ++j) {
            f32x4 o; o[0] = bflo(cur.a[j][0]) + bflo(cur.b[j][0]); o[1] = bfhi(cur.a[j][0]) + bfhi(cur.b[j][0]); o[2] = bflo(cur.a[j][1]) + bflo(cur.b[j][1]); o[3] = bfhi(cur.a[j][1]) + bfhi(cur.b[j][1]);
            float ss = (o[0] * o[0] + o[1] * o[1]) + (o[2] * o[2] + o[3] * o[3]);
            ss = half32_sum(ss, C.lane);
            const float rs = rsqrtf(ss * (1.f / 128.f) + 1e-6f);
            const u32x2 z = cur.z[j];
            o[0] *= rs * go[0] * silu_(bflo(z[0])); o[1] *= rs * go[1] * silu_(bfhi(z[0])); o[2] *= rs * go[2] * silu_(bflo(z[1])); o[3] *= rs * go[3] * silu_(bfhi(z[1]));
            u32x2 w; w[0] = pk2(o[0], o[1]); w[1] = pk2(o[2], o[3]);
            ((GAS u32x2*)(MIX + (size_t)r * D))[C.lane + 64 * j] = w;
        }
    };
    for (int r0 = gw; r0 < nrows; r0 += RB_K * NGW) {
        GoRow R5[RB_K];
#pragma unroll
        for (int k = 0; k < RB_K; ++k) { const int rq = r0 + k * NGW, rc = rq < nrows ? rq : r0; GO_LOAD(rc, R5[k]); }
#pragma unroll
        for (int k = 0; k < RB_K; ++k) { const int r = r0 + k * NGW; if (r < nrows) body(r, R5[k]); }
    }
#undef GO_LOAD
}
struct TokInfo { int e0, p0, e1, p1; float w0, w1; int r0, r1; };
DI void ti_store(GAS TokInfo* q, const TokInfo& t) { u32x4 a, b; a[0] = (unsigned)t.e0; a[1] = (unsigned)t.p0; a[2] = (unsigned)t.e1; a[3] = (unsigned)t.p1; b[0] = __float_as_uint(t.w0); b[1] = __float_as_uint(t.w1); b[2] = (unsigned)t.r0; b[3] = (unsigned)t.r1;
    ((GAS u32x4*)q)[0] = a; ((GAS u32x4*)q)[1] = b; }
DI TokInfo ti_from(const u32x4 a, const u32x4 b) { TokInfo t; t.e0 = (int)a[0]; t.p0 = (int)a[1]; t.e1 = (int)a[2]; t.p1 = (int)a[3]; t.w0 = __uint_as_float(b[0]); t.w1 = __uint_as_float(b[1]); t.r0 = (int)b[2]; t.r1 = (int)b[3]; return t; }
DI TokInfo ti_load(const GAS TokInfo* q) { const u32x4 a = ((const GAS u32x4*)q)[0], b = ((const GAS u32x4*)q)[1]; TokInfo t; t.e0 = (int)a[0]; t.p0 = (int)a[1]; t.e1 = (int)a[2]; t.p1 = (int)a[3]; t.w0 = __uint_as_float(b[0]); t.w1 = __uint_as_float(b[1]); t.r0 = (int)b[2]; t.r1 = (int)b[3]; return t; }
DI void ph_router(const Ctx& C, const Params& p, int layer, int ntok, int npart) {
    const int gw = C.blk * 8 + C.wave, NGW = C.nblk * 8, i = layer >> 1;
    gbf16* X = (gbf16*)(C.ws + WS_X); gbf16* H = (gbf16*)(C.ws + WS_H);
    const gfloat* MODl = (const gfloat*)(C.ws + WS_MOD) + (size_t)layer * 5 * MODW;
    const gfloat* g = gin(p, 7) + layer * D; const gfloat* wr = gin(p, 28) + (size_t)i * D * 8;
    guint* bc = (guint*)(C.ws + WS_CTL) + CW_BC + (i * 1024 + C.blk) * 8; GAS TokInfo* TI = (GAS TokInfo*)(C.ws + WS_TOK);
    LAS int* sl = (LAS int*)(C.lds + 64);
    for (int q = C.tid; q < 96 * 6; q += 512) sl[q] = -1;
    LAS float* wrT = (LAS float*)(C.lds + 8192);
    { float wq[16];
#pragma unroll
      for (int i2 = 0; i2 < 16; ++i2) wq[i2] = wr[C.tid + 512 * i2];
#pragma unroll
      for (int i2 = 0; i2 < 16; ++i2) { const int q = C.tid + 512 * i2; wrT[(q & 7) * 1024 + (q >> 3)] = wq[i2]; } }
    modvec_stage(C, g, MODl + 3 * D);
    int k = 0;
    const int nrw = (npart == 0 && ntok < NTOK) ? ntok : NTOK;
    for (int r0 = gw; r0 < nrw; r0 += RB_K * NGW) {
      u32x2 wr9[RB_K][4];
#pragma unroll
      for (int k9 = 0; k9 < RB_K; ++k9) { const int rq = r0 + k9 * NGW; xrow_raw(wr9[k9], X + (size_t)(rq < nrw ? rq : r0) * D, C.lane); }
#pragma unroll
      for (int k9 = 0; k9 < RB_K; ++k9) { const int r = r0 + k9 * NGW;
       if (r < nrw) {
        ModVec mvec; modvec_lds(mvec, C, r < NLAT ? (r >> 12) : 4, C.lane);
        f32x4 v[4]; xrow_unpack(v, wr9[k9]);
        if (npart > 0 && r >= NLAT) add_ctx_partials(C, v, r, npart, MODl + 4 * MODW + 2 * D, X + (size_t)r * D);
        normmod_regs(v, mvec, C.lane);
        store_row_bf16(H + (size_t)r * D, v, C.lane);
        if (r < ntok) {
        float lg[8] = {0.f, 0.f, 0.f, 0.f, 0.f, 0.f, 0.f, 0.f};
#pragma unroll
        for (int j = 0; j < 4; ++j)
#pragma unroll
            for (int e = 0; e < 8; ++e) { const f32x4 w4 = *(const LAS f32x4*)(wrT + e * 1024 + 4 * C.lane + 256 * j); lg[e] += (v[j][0] * w4[0] + v[j][1] * w4[1]) + (v[j][2] * w4[2] + v[j][3] * w4[3]); }
#pragma unroll
        for (int e = 0; e < 8; ++e) lg[e] = wave_sum(lg[e], C.lane);
        if (C.lane == 0) {
            int e0 = 0; float b0 = lg[0];
#pragma unroll
            for (int e = 1; e < 8; ++e) if (lg[e] > b0) { e0 = e; b0 = lg[e]; }
            int e1 = -1; float b1 = -INFINITY;
#pragma unroll
            for (int e = 0; e < 8; ++e) if (e != e0 && lg[e] > b1) { e1 = e; b1 = lg[e]; }
            const float w1 = 1.f / (1.f + expf(b0 - b1)), w0 = 1.f - w1;
            LAS int* s = sl + (k * 8 + C.wave) * 6;
            s[0] = e0; s[1] = e1; s[2] = __float_as_int(w0); s[3] = __float_as_int(w1);
        }
        }
        ++k;
       } }
    }
    __syncthreads();
    if (C.tid < 192) { const int q = C.tid, sq = q >> 1, wq = q & 1, e = sl[sq * 6 + wq]; int rk = 0;
        if (e >= 0) {
#pragma clang loop vectorize(disable) unroll(disable)
            for (int q2 = 0; q2 < q; ++q2) rk += (sl[(q2 >> 1) * 6 + (q2 & 1)] == e) ? 1 : 0; sl[sq * 6 + 4 + wq] = rk; } }
    if (C.tid < 8) { int c8 = 0;
#pragma clang loop vectorize(disable) unroll(disable)
        for (int q2 = 0; q2 < 192; ++q2) c8 += (sl[(q2 >> 1) * 6 + (q2 & 1)] == C.tid) ? 1 : 0; bc[C.tid] = (unsigned)c8; }
    __syncthreads();
    if (C.lane == 0) { int k2 = 0;
        for (int r = gw; r < ntok; r += NGW, ++k2) { const LAS int* s = sl + (k2 * 8 + C.wave) * 6;
            TokInfo t; t.e0 = s[0]; t.e1 = s[1]; t.p0 = s[4]; t.p1 = s[5]; t.w0 = __int_as_float(s[2]); t.w1 = __int_as_float(s[3]); t.r0 = 0; t.r1 = 0;
            ti_store(TI + r, t); } }
    __syncthreads();
}
DI void ph_gather(const Ctx& C, int layer, int ntok) {
    const int gw = C.blk * 8 + C.wave, NGW = C.nblk * 8, i = layer >> 1;
    GAS TokInfo* TI = (GAS TokInfo*)(C.ws + WS_TOK);
    const gbf16* H = (const gbf16*)(C.ws + WS_H); gbf16* XS = (gbf16*)(C.ws + WS_XS);
    LAS int* red = (LAS int*)C.lds;
    if (C.tid < 16) red[C.tid] = 0;
    __syncthreads();
    { const guint* bcb = (const guint*)(C.ws + WS_CTL) + CW_BC + (size_t)i * 1024 * 8; int tot[8] = {0, 0, 0, 0, 0, 0, 0, 0}, pre[8] = {0, 0, 0, 0, 0, 0, 0, 0};
#pragma clang loop vectorize(disable) unroll(disable)
      for (int t = C.tid; t < C.nblk; t += 512) { const u32x4 a = *(const GAS u32x4*)(bcb + t * 8), b2 = *(const GAS u32x4*)(bcb + t * 8 + 4);
#pragma unroll
          for (int e = 0; e < 4; ++e) { tot[e] += (int)a[e]; tot[4 + e] += (int)b2[e]; if (t < C.blk) { pre[e] += (int)a[e]; pre[4 + e] += (int)b2[e]; } } }
#pragma unroll
      for (int e = 0; e < 8; ++e) { const int ts = (int)wave_sum((float)tot[e], C.lane), ps = (int)wave_sum((float)pre[e], C.lane);
          if (C.lane == 0) { (void)__hip_atomic_fetch_add(red + e, ts, __ATOMIC_RELAXED, __HIP_MEMORY_SCOPE_WORKGROUP); (void)__hip_atomic_fetch_add(red + 8 + e, ps, __ATOMIC_RELAXED, __HIP_MEMORY_SCOPE_WORKGROUP); } } }
    __syncthreads();
    int base[8], cn[8], pref[8]; { int acc = 0;
#pragma unroll
        for (int e = 0; e < 8; ++e) { cn[e] = red[e]; pref[e] = red[8 + e]; base[e] = acc * 256 + pref[e]; acc += (cn[e] + 255) >> 8; } }
    if (C.blk == 0 && C.tid < 8) ((guint*)(C.ws + WS_CTL) + CW_CNT + i * 64)[C.tid] = (unsigned)red[C.tid];
    for (int rg0 = gw; rg0 < ntok; rg0 += RB_K * NGW) {
        u32x4 ta[RB_K], tb[RB_K], ha[RB_K], hb[RB_K];
#pragma unroll
        for (int k = 0; k < RB_K; ++k) { const int rq = rg0 + k * NGW, rc = rq < ntok ? rq : rg0; const GAS u32x4* tq = (const GAS u32x4*)(TI + rc); ta[k] = tq[0]; tb[k] = tq[1];
            ha[k] = ((const GAS u32x4*)(H + (size_t)rc * D))[C.lane]; hb[k] = ((const GAS u32x4*)(H + (size_t)rc * D))[C.lane + 64]; }
#pragma unroll
        for (int k = 0; k < RB_K; ++k) { const int r = rg0 + k * NGW;
            if (r < ntok) {
                const TokInfo t = ti_from(ta[k], tb[k]);
                int b0 = 0, b1 = 0;
#pragma unroll
                for (int e = 0; e < 8; ++e) { b0 = (t.e0 == e) ? base[e] : b0; b1 = (t.e1 == e) ? base[e] : b1; }
                const int r0 = b0 + t.p0, r1 = b1 + t.p1;
                ((GAS u32x4*)(XS + (size_t)r0 * D))[C.lane] = ha[k]; ((GAS u32x4*)(XS + (size_t)r0 * D))[C.lane + 64] = hb[k];
                ((GAS u32x4*)(XS + (size_t)r1 * D))[C.lane] = ha[k]; ((GAS u32x4*)(XS + (size_t)r1 * D))[C.lane + 64] = hb[k];
                if (C.lane == 0) { ((GAS int*)(TI + r))[6] = r0; ((GAS int*)(TI + r))[7] = r1; }
            } }
    }
    for (int pr = gw; pr < 8 * 256; pr += NGW) {
        const int e = pr >> 8, j = pr & 255; int be = 0, ce = 0;
#pragma unroll
        for (int k = 0; k < 8; ++k) { be = (e == k) ? base[k] - pref[k] : be; ce = (e == k) ? cn[k] : ce; }
        const int lim = ((ce + 255) >> 8) << 8;
        if (ce + j < lim) { GAS u32x4* z = (GAS u32x4*)(XS + (size_t)(be + ce + j) * D); z[C.lane] = (u32x4){0u, 0u, 0u, 0u}; z[C.lane + 64] = (u32x4){0u, 0u, 0u, 0u}; }
    }
}
DI void ph_combine(const Ctx& C, const Params& p, int layer, int ntok, const guint* cnt) {
    int nM_ = 0;
#pragma unroll
    for (int e = 0; e < 8; ++e) nM_ += ((int)cnt[e] + 255) >> 8;
    const int nwg_ = nM_ * 4, Lm_ = (nwg_ / C.nblk) * C.nblk, r_ = nwg_ - Lm_; int ts = 1;
    if (r_ > 0) { const int q = C.nblk / r_; ts = q >= 14 ? 14 : (q >= 7 ? 7 : (q >= 4 ? 4 : (q >= 2 ? 2 : 1))); }
    const int trow0 = (Lm_ >> 2) * 256, trows = (r_ >> 2) * 256; const gfloat* YP = (const gfloat*)(C.ws + WS_YP);
    const int gw = C.blk * 8 + C.wave, NGW = C.nblk * 8;
    gbf16* X = (gbf16*)(C.ws + WS_X); gbf16* H = (gbf16*)(C.ws + WS_H); const gbf16* Y = (const gbf16*)(C.ws + WS_Y); const GAS TokInfo* TI = (const GAS TokInfo*)(C.ws + WS_TOK);
    const gfloat* MODl = (const gfloat*)(C.ws + WS_MOD) + (size_t)layer * 5 * MODW;
    const bool last = (layer == DEPTH - 1);
    if (!last) modvec_stage(C, gin(p, 6) + (layer + 1) * D, (const gfloat*)(C.ws + WS_MOD) + (size_t)(layer + 1) * 5 * MODW);
    const int nrows = last ? NLAT : NTOK;
    auto tail_sum = [&](int rr, int j) -> f32x4 {
        const gfloat* base = YP + (size_t)(rr - trow0) * D; f32x4 acc = (f32x4){0.f, 0.f, 0.f, 0.f}; const f32x4 z4 = acc;
        if (ts <= 4) { f32x4 q[4];
#pragma unroll
            for (int pk = 0; pk < 4; ++pk) q[pk] = ((const GAS f32x4*)(base + (size_t)(pk < ts ? pk : ts - 1) * trows * D))[C.lane + 64 * j];
#pragma unroll
            for (int pk = 0; pk < 4; ++pk) acc = acc + ((pk < ts) ? q[pk] : z4); }
        else { f32x4 q[14];
#pragma unroll
            for (int pk = 0; pk < 14; ++pk) q[pk] = ((const GAS f32x4*)(base + (size_t)(pk < ts ? pk : ts - 1) * trows * D))[C.lane + 64 * j];
#pragma unroll
            for (int pk = 0; pk < 14; ++pk) acc = acc + ((pk < ts) ? q[pk] : z4); }
        return acc; };
    u32x2 xw[4], xn[4]; u32x4 ta = (u32x4){0u, 0u, 0u, 0u}, tb = ta, tna = ta, tnb = ta;
    if (gw < nrows) { xrow_raw(xw, X + (size_t)gw * D, C.lane); if (gw < ntok) { const GAS u32x4* tq = (const GAS u32x4*)(TI + gw); ta = tq[0]; tb = tq[1]; } }
    for (int r = gw; r < nrows; r += NGW) {
        const int rn = r + NGW;
        ModVec mvec;
        if (!last) modvec_lds(mvec, C, r < NLAT ? (r >> 12) : 4, C.lane);
        f32x4 v[4]; xrow_unpack(v, xw);
        TokInfo t = ti_from(ta, tb); f32x4 ggr[4]; u32x2 y0r[4], y1r[4]; const bool m0 = t.r0 < trow0, m1 = t.r1 < trow0;
        if (r < ntok) {
            const gfloat* ga = MODl + (size_t)(r < NLAT ? (r >> 12) : 4) * MODW + 5 * D;
#pragma unroll
            for (int j = 0; j < 4; ++j) { ggr[j] = ((const GAS f32x4*)ga)[C.lane + 64 * j];
                if (m0) y0r[j] = ((const GAS u32x2*)(Y + (size_t)t.r0 * D))[C.lane + 64 * j];
                if (m1) y1r[j] = ((const GAS u32x2*)(Y + (size_t)t.r1 * D))[C.lane + 64 * j]; }
        }
        if (rn < nrows) { xrow_raw(xn, X + (size_t)rn * D, C.lane); if (rn < ntok) { const GAS u32x4* tq = (const GAS u32x4*)(TI + rn); tna = tq[0]; tnb = tq[1]; } }
        if (r < ntok) {
#pragma unroll
            for (int j = 0; j < 4; ++j) { f32x4 y0, y1;
                if (m0) y0 = (f32x4){bflo(y0r[j][0]), bfhi(y0r[j][0]), bflo(y0r[j][1]), bfhi(y0r[j][1])};
                else y0 = tail_sum(t.r0, j);
                if (m1) y1 = (f32x4){bflo(y1r[j][0]), bfhi(y1r[j][0]), bflo(y1r[j][1]), bfhi(y1r[j][1])};
                else y1 = tail_sum(t.r1, j);
                v[j] = v[j] + ggr[j] * (y0 * t.w0 + y1 * t.w1); }
        }
        if (!last) {
            xrow_store(X + (size_t)r * D, v, C.lane);
            normmod_regs(v, mvec, C.lane);
            store_row_bf16(H + (size_t)r * D, v, C.lane);
        } else {
            float ss = 0.f;
#pragma unroll
            for (int j = 0; j < 4; ++j) ss += (v[j][0] * v[j][0] + v[j][1] * v[j][1]) + (v[j][2] * v[j][2] + v[j][3] * v[j][3]);
            const float rs = rsqrtf(wave_sum(ss, C.lane) * (1.f / D) + 1e-6f);
#pragma unroll
            for (int j = 0; j < 4; ++j) { const f32x4 gg = ((const GAS f32x4*)gin(p, 8))[C.lane + 64 * j]; ((GAS f32x4*)(((gfloat*)p.out) + (size_t)r * D))[C.lane + 64 * j] = v[j] * rs * gg; }
        }
#pragma unroll
        for (int j = 0; j < 4; ++j) xw[j] = xn[j];
        ta = tna; tb = tnb;
    }
}
constexpr int AT_KB = 0, AT_KB_SZ = 64 * 136 * 2, AT_VT = 2 * AT_KB_SZ, AT_VT_SZ = 128 * 72 * 2, AT_QL = AT_VT + 2 * AT_VT_SZ, AT_END = AT_QL + 256 * 136 * 2;
static_assert(AT_END <= LDS_MISC, "attention LDS");
DI void attn_unit(const Ctx& C, const gbf16* PE, gbf16* MIX, const gfloat* gsub, int layer, int b, int h, int qb, bool ctxq) {
    LAS unsigned char* ldsb = C.lds; asm volatile("" : "+v"(ldsb));
    int tid = fresh_tid(C); asm volatile("" : "+v"(tid));
    const int lane = tid & 63, wave = __builtin_amdgcn_readfirstlane(tid >> 6), r = lane & 31, hh = lane >> 5;
    const int qrow0 = (ctxq ? NLAT + b * CTX : b * SEQ) + qb * 256;
    const int ntile = ctxq ? CTX / 64 : (CTX + SEQ) / 64;
    LAS bf16* QL = (LAS bf16*)(ldsb + AT_QL);
#pragma unroll
    for (int i = 0; i < 8; ++i) { const int c = tid + 512 * i, row = c >> 4, part = c & 15; *(LAS u32x4*)(QL + row * 136 + part * 8) = *(const GAS u32x4*)(PE + (size_t)(qrow0 + row) * EVEN_IN + h * 128 + part * 8); }
    f32x16 O[2][4];
#pragma unroll
    for (int mp = 0; mp < 2; ++mp)
#pragma unroll
        for (int k = 0; k < 4; ++k) O[mp][k] = zero16();
    float m[2] = {-1e30f, -1e30f}, l[2] = {0.f, 0.f};
    u32x4 vA[2];
    const int skey = tid & 63, spart = tid >> 6;
#define AT_LOAD(t, kr, vr) do { \
        { const int kidx_ = (t) * 64 + skey; const int krow_ = kidx_ < CTX ? NLAT + b * CTX + kidx_ : b * SEQ + kidx_ - CTX; \
          _Pragma("unroll") for (int i_ = 0; i_ < 2; ++i_) { const gbf16* src_ = PE + (size_t)krow_ * EVEN_IN + h * 128 + (spart + 8 * i_) * 8; vr[i_] = *(const GAS u32x4*)(src_ + 1024); } } \
        { LAS unsigned char* kd_ = ldsb + AT_KB + (((t) & 1)) * AT_KB_SZ; \
          _Pragma("unroll") for (int i_ = 0; i_ < 8; ++i_) { const int key_ = wave * 8 + i_, kidx_ = (t) * 64 + key_; const int krow_ = kidx_ < CTX ? NLAT + b * CTX + kidx_ : b * SEQ + kidx_ - CTX; \
              __builtin_amdgcn_global_load_lds((const GAS unsigned*)(PE + (size_t)krow_ * EVEN_IN + 512 + h * 128) + lane, (LAS unsigned*)(kd_ + key_ * 272), 4, 0, 0); } } } while (0)
#define AT_STORE(buf, kr, vr) do { LAS bf16* vt_ = (LAS bf16*)(ldsb + AT_VT + (buf) * AT_VT_SZ); const int j16_ = skey & 15, pkey_ = (skey & ~15) | ((j16_ & 3) | (((j16_ >> 2) == 1) ? 8 : (((j16_ >> 2) == 2) ? 4 : (j16_ & 12))));   \
        _Pragma("unroll") for (int i_ = 0; i_ < 2; ++i_) { const int part_ = spart + 8 * i_; \
            _Pragma("unroll") for (int e_ = 0; e_ < 4; ++e_) { vt_[(part_ * 8 + 2 * e_) * 72 + pkey_] = (bf16)(vr[i_][e_] & 0xffffu); vt_[(part_ * 8 + 2 * e_ + 1) * 72 + pkey_] = (bf16)(vr[i_][e_] >> 16); } } } while (0)
#if defined(AT_PROBE) && AT_PROBE == 1
#define AT_PROBE_EXP(S) { _Pragma("unroll") for (int i = 0; i < 16; ++i) { float x_ = S[i]; asm volatile("" : "+v"(x_)); x_ = __builtin_amdgcn_exp2f(x_ - mu); asm volatile("" :: "v"(x_)); } }
#else
#define AT_PROBE_EXP(S)
#endif
#if defined(AT_PROBE) && AT_PROBE == 2
#define AT_PROBE_MM(F) { f32x16 Sd_ = zero16(); _Pragma("unroll") for (int ks = 0; ks < 4; ++ks) Sd_ = MFMA32(F[ks], F[4 + ks], Sd_); asm volatile("" :: "v"(Sd_)); }
#else
#define AT_PROBE_MM(F)
#endif
#define AT_SB __builtin_amdgcn_sched_barrier(0)
#define AT_LDKQ(F, mp) do { _Pragma("unroll") for (int ks = 0; ks < 4; ++ks) { F[ks] = *(const LAS bf16x8*)(kb + (ks2 * 32 + r) * 136 + (mp) * 64 + 16 * ks + 8 * hh); F[4 + ks] = *(const LAS bf16x8*)(QL + (wave * 32 + r) * 136 + (mp) * 64 + 16 * ks + 8 * hh); } } while (0)
#define AT_SOFTMAX(S, mp) do { float mx; { const float m0_ = fmaxf(fmaxf(S[0], S[1]), fmaxf(S[2], S[3])), m1_ = fmaxf(fmaxf(S[4], S[5]), fmaxf(S[6], S[7])), m2_ = fmaxf(fmaxf(S[8], S[9]), fmaxf(S[10], S[11])), m3_ = fmaxf(fmaxf(S[12], S[13]), fmaxf(S[14], S[15])); mx = fmaxf(fmaxf(m0_, m1_), fmaxf(m2_, m3_)); } \
        mx = half_max(mx); \
        if (__any(mx > m[mp] + 8.f)) { const float mnew = fmaxf(m[mp], mx), corr = __builtin_amdgcn_exp2f(m[mp] - mnew); m[mp] = mnew; l[mp] *= corr; \
            _Pragma("unroll") for (int k = 0; k < 4; ++k) O[mp][k] = O[mp][k] * corr; } \
        const float mu = m[mp]; \
        _Pragma("unroll") for (int i = 0; i < 16; ++i) S[i] = __builtin_amdgcn_exp2f(S[i] - mu); \
        { const float s0_ = (S[0] + S[1]) + (S[2] + S[3]), s1_ = (S[4] + S[5]) + (S[6] + S[7]), s2_ = (S[8] + S[9]) + (S[10] + S[11]), s3_ = (S[12] + S[13]) + (S[14] + S[15]); l[mp] += (s0_ + s1_) + (s2_ + s3_); } \
        const float ls = 0.f; (void)ls; \
        AT_PROBE_EXP(S) \
        pf[mp][0] = pack_step(S, 0); pf[mp][1] = pack_step(S, 1); } while (0)
#define AT_TILE(t) do { const int buf = (t) & 1; \
        int tl_ = tid; asm volatile("" : "+v"(tl_)); const int lane = tl_ & 63, r = lane & 31, hh = lane >> 5, skey = lane, spart = tl_ >> 6;     \
        if ((t) + 1 < ntile) AT_LOAD((t) + 1, vA, vA); \
        const LAS bf16* kb = (const LAS bf16*)(ldsb + AT_KB + buf * AT_KB_SZ); const LAS bf16* vt = (const LAS bf16*)(ldsb + AT_VT + buf * AT_VT_SZ); \
        _Pragma("unroll") for (int ks2 = 0; ks2 < 2; ++ks2) {             \
            bf16x8 f[8], pf[2][2]; \
            AT_LDKQ(f, 0); AT_SB; \
            f32x16 S0 = zero16(); \
            _Pragma("unroll") for (int ks = 0; ks < 4; ++ks) S0 = MFMA32(f[ks], f[4 + ks], S0); \
            AT_PROBE_MM(f) \
            AT_SB; AT_LDKQ(f, 1); AT_SB; \
            AT_SOFTMAX(S0, 0); AT_SB; \
            f32x16 S1 = zero16(); \
            _Pragma("unroll") for (int ks = 0; ks < 4; ++ks) S1 = MFMA32(f[ks], f[4 + ks], S1); \
            AT_PROBE_MM(f) \
            AT_SB; \
            _Pragma("unroll") for (int q = 0; q < 8; ++q) f[q] = *(const LAS bf16x8*)(vt + ((q & 3) * 32 + r) * 72 + ks2 * 32 + 16 * (q >> 2) + 8 * hh); \
            AT_SB; \
            AT_SOFTMAX(S1, 1); AT_SB; \
            _Pragma("unroll") for (int q = 0; q < 8; ++q) { O[0][q & 3] = MFMA32(f[q], pf[0][q >> 2], O[0][q & 3]); O[1][q & 3] = MFMA32(f[q], pf[1][q >> 2], O[1][q & 3]); } \
            } \
        if ((t) + 1 < ntile) AT_STORE(buf ^ 1, vA, vA); \
        __syncthreads(); } while (0)
    AT_LOAD(0, vA, vA); AT_STORE(0, vA, vA);
    __syncthreads();
    for (int t = 0; t < ntile; ++t) AT_TILE(t);
#undef AT_TILE
#undef AT_SB
#undef AT_LDKQ
#undef AT_SOFTMAX
#undef AT_LOAD
#undef AT_STORE
    {
        int ly_ = layer; asm volatile("" : "+s"(ly_));
        const float lam_init_ = 0.8f - 0.6f * expf(-0.3f * (float)ly_), mul = 1.f - lam_init_, lam = ((volatile LAS float*)(C.lds + LDS_MISC))[4];
        const float i0 = 1.f / half_sum(l[0]), i1 = lam / half_sum(l[1]);
        float ss = 0.f;
#pragma unroll
        for (int k = 0; k < 4; ++k)
#pragma unroll
            for (int i = 0; i < 16; ++i) { const float o = O[0][k][i] * i0 - O[1][k][i] * i1; O[0][k][i] = o; ss += o * o; }
        ss = half_sum(ss);
        const float rs = rsqrtf(ss * (1.f / 128.f) + 1e-6f) * mul;
        const int qrow = qrow0 + wave * 32 + r;
#pragma unroll
        for (int k = 0; k < 4; ++k)
#pragma unroll
            for (int g4 = 0; g4 < 4; ++g4) { const int dv0 = k * 32 + 8 * g4 + 4 * hh; const f32x4 gg = *(const GAS f32x4*)(gsub + dv0);
                u32x2 w; w[0] = pk2(O[0][k][4 * g4] * rs * gg[0], O[0][k][4 * g4 + 1] * rs * gg[1]); w[1] = pk2(O[0][k][4 * g4 + 2] * rs * gg[2], O[0][k][4 * g4 + 3] * rs * gg[3]);
                *(GAS u32x2*)(MIX + (size_t)qrow * D + h * 128 + dv0) = w; }
    }
    __syncthreads();
}

constexpr int RGG_WT = 0, RGG_XR = 36864, RGG_XB = RGG_XR + 17408, RGG_XF = RGG_XB + 18432, RGG_END = RGG_XF + 128 * 65 * 4;
static_assert(RGG_END <= LDS_MISC && 131 * 66 * 2 <= 17408, "rg gates LDS");
DI void ph_rg_gates(const Ctx& C, const Params& p, int i) {
    const gbf16* PE = (const gbf16*)(C.ws + WS_P); gfloat* RGA = (gfloat*)(C.ws + WS_RGA); gbf16* RGU = (gbf16*)(C.ws + WS_RGU);
    const gfloat* w_a = gin(p, 15) + (size_t)i * 2 * 8 * 64 * 64; const gfloat* w_x = gin(p, 17) + (size_t)i * 2 * 8 * 64 * 64;
    const gfloat* b_a = gin(p, 16) + i * 1024; const gfloat* b_x = gin(p, 18) + i * 1024; const gfloat* lamv = gin(p, 19) + i * 1024;
    const gfloat* cw = gin(p, 13) + i * 4 * 512; const gfloat* cb = gin(p, 14) + i * 512;
    int ncur = -1;
    u32x4 pre[3];
#define RGG_XLOAD(unit_) do { int t_ = C.tid; asm volatile("" : "+v"(t_)); const int n_ = (unit_) & 7, r0_ = ((unit_) >> 3) * 128; int s0_, s1_; seq_bounds(r0_, s0_, s1_); \
        _Pragma("unroll") for (int i_ = 0; i_ < 3; ++i_) { const int idx_ = t_ + 512 * i_, ri_ = idx_ >> 3, part_ = idx_ & 7, row_ = r0_ - 2 + ri_; pre[i_] = (u32x4){0u, 0u, 0u, 0u}; \
            if (idx_ < 131 * 8 && row_ >= s0_ && row_ < s1_) pre[i_] = *(const GAS u32x4*)(PE + (size_t)row_ * EVEN_IN + 1536 + n_ * 64 + part_ * 8); } } while (0)
    if (C.blk < (NTOK / 128) * 8) RGG_XLOAD(C.blk);
    for (int unit = C.blk; unit < (NTOK / 128) * 8; unit += C.nblk) {
        LAS unsigned char* ldsb = C.lds; asm volatile("" : "+v"(ldsb));
        int tid = C.tid; asm volatile("" : "+v"(tid));
        const int lane = tid & 63, wave = __builtin_amdgcn_readfirstlane(tid >> 6), r = lane & 31, hh = lane >> 5;
        const int n = unit & 7, tile = unit >> 3, r0 = tile * 128;
        LAS bf16* WT = (LAS bf16*)(ldsb + RGG_WT); LAS bf16* xraw = (LAS bf16*)(ldsb + RGG_XR); LAS bf16* XB = (LAS bf16*)(ldsb + RGG_XB); LAS float* XF = (LAS float*)(ldsb + RGG_XF);
        if (n != ncur) {
            LDS_SYNC();
            { float wv[32];
#pragma unroll
              for (int q = 0; q < 32; ++q) { const int idx = tid + 512 * q, ch = idx & 63, ci = (idx >> 6) & 63, g = (idx >> 12) & 1, d = idx >> 13; wv[q] = (g ? w_x : w_a)[((size_t)(d * 8 + n) * 64 + ci) * 64 + ch]; }
#pragma unroll
              for (int q = 0; q < 32; ++q) { const int idx = tid + 512 * q, ch = idx & 63, ci = (idx >> 6) & 63, g = (idx >> 12) & 1, d = idx >> 13; WT[(((d * 2 + g) * 2 + (ch >> 5)) * 32 + (ch & 31)) * 72 + ci] = f2bf(wv[q]); } }
            ncur = n;
        }
#pragma unroll
        for (int i3 = 0; i3 < 3; ++i3) { const int idx = tid + 512 * i3, ri = idx >> 3, part = idx & 7; const u32x4 v = pre[i3];
            if (idx < 131 * 8) { LAS unsigned* dst = (LAS unsigned*)(xraw + ri * 66 + part * 8); dst[0] = v[0]; dst[1] = v[1]; dst[2] = v[2]; dst[3] = v[3]; } }
        LDS_SYNC();
        if (unit + C.nblk < (NTOK / 128) * 8) RGG_XLOAD(unit + C.nblk);
        { const int cc = tid & 63; float tap[4];
#pragma unroll
          for (int tp = 0; tp < 4; ++tp) tap[tp] = cw[tp * 512 + n * 64 + cc];
          const float cbias = cb[n * 64 + cc];
#pragma unroll 4
          for (int it = 0; it < 16; ++it) { const int tok = (tid >> 6) + 8 * it; float a = cbias;
#pragma unroll
              for (int tp = 0; tp < 4; ++tp) a += tap[tp] * bf2f(xraw[(tok + tp) * 66 + cc]);
              XF[tok * 65 + cc] = a; XB[tok * 72 + cc] = f2bf(a); } }
        LDS_SYNC();
        { const int ti = wave & 3, d = wave >> 2;
#pragma unroll
          for (int chblk = 0; chblk < 2; ++chblk) {
              f32x16 aa = zero16(), ax = zero16();
#pragma unroll
              for (int ks = 0; ks < 4; ++ks) { const bf16x8 xa = *(const LAS bf16x8*)(XB + (ti * 32 + r) * 72 + 16 * ks + 8 * hh);
                  const bf16x8 ba = *(const LAS bf16x8*)(WT + (((d * 2 + 0) * 2 + chblk) * 32 + r) * 72 + 16 * ks + 8 * hh), bx = *(const LAS bf16x8*)(WT + (((d * 2 + 1) * 2 + chblk) * 32 + r) * 72 + 16 * ks + 8 * hh);
                  aa = MFMA32(xa, ba, aa); ax = MFMA32(xa, bx, ax); }
              const int ch = n * 64 + chblk * 32 + r;
              const float ba_ = b_a[d * 512 + ch], bx_ = b_x[d * 512 + ch], sp = softplus_(-lamv[d * 512 + ch]);
#pragma unroll
              for (int q = 0; q < 16; ++q) { const int tok = ti * 32 + crow(q, hh);
                  const float rr = sigmoid_(aa[q] + ba_), ii = sigmoid_(ax[q] + bx_);
                  const float log_a = -8.f * rr * sp; const float a = __expf(log_a), u = sqrtf(fmaxf(1.f - a * a, 0.f)) * (ii * XF[tok * 65 + chblk * 32 + r]);
                  const size_t o = ((size_t)d * NTOK + r0 + tok) * 512 + ch; RGA[o] = a; RGU[o] = f2bf(u); }
          } }
        LDS_SYNC();
    }
}
DI int rg_row(int b, int d, int pp) { return pp < CTX ? NLAT + b * CTX + (d ? CTX - 1 - pp : pp) : b * SEQ + (d ? SEQ - 1 - (pp - CTX) : (pp - CTX)); }
DI void rgscan_unit(const Ctx& C, int b, int cg) {
    const gfloat* RGA = (const gfloat*)(C.ws + WS_RGA); const gbf16* RGU = (const gbf16*)(C.ws + WS_RGU); gfloat* HS1 = (gfloat*)(C.ws + WS_HS1);
    const gbf16* PE = (const gbf16*)(C.ws + WS_P); gbf16* MIX = (gbf16*)(C.ws + WS_MIX);
    for (int pass = 0; pass < 2; ++pass) {
        const int tid = fresh_tid(C), ch = cg * 8 + (tid & 7), chunk = tid >> 3, p0 = chunk * 68;
        LAS float* sb = (LAS float*)C.lds;
        const int d = 1 - pass;
        const gfloat* Ab = RGA + (size_t)d * NTOK * 512; const gbf16* Ub = RGU + (size_t)d * NTOK * 512;
        float av[68], uv[68];
#pragma unroll
        for (int k = 0; k < 68; ++k) { const unsigned o = (unsigned)rg_row(b, d, p0 + k) * 512u + (unsigned)ch; av[k] = Ab[o]; uv[k] = bf2f(Ub[o]); }
        float A = 1.f, H = 0.f;
#pragma unroll
        for (int k = 0; k < 68; ++k) { H = av[k] * H + uv[k]; A *= av[k]; }
        sb[(chunk * 8 + (tid & 7)) * 2] = A; sb[(chunk * 8 + (tid & 7)) * 2 + 1] = H;
        __syncthreads();
        float h = 0.f;
        for (int k = 0; k < chunk; ++k) h = sb[(k * 8 + (tid & 7)) * 2] * h + sb[(k * 8 + (tid & 7)) * 2 + 1];
        if (pass == 0) {
#pragma unroll
            for (int k = 0; k < 68; ++k) { h = av[k] * h + uv[k]; HS1[(unsigned)rg_row(b, d, p0 + k) * 512u + (unsigned)ch] = h; }
        } else {
#pragma unroll
            for (int hf = 0; hf < 4; ++hf) {
                float hv[17]; bf16 gv[17];
#pragma unroll
                for (int k = 0; k < 17; ++k) { const unsigned row = (unsigned)rg_row(b, d, p0 + hf * 17 + k); hv[k] = HS1[row * 512u + (unsigned)ch]; gv[k] = PE[row * (unsigned)EVEN_IN + 2048u + (unsigned)ch]; }
#pragma unroll
                for (int k = 0; k < 17; ++k) { h = av[hf * 17 + k] * h + uv[hf * 17 + k]; const unsigned row = (unsigned)rg_row(b, d, p0 + hf * 17 + k);
                    const float y = h + hv[k]; MIX[row * (unsigned)D + 512u + (unsigned)ch] = f2bf(y * gelu_tanh_(bf2f(gv[k]))); }
            }
        }
        __syncthreads();
    }
}
DI void ph_even_mix(const Ctx& C, const Params& p, int layer, int rep) {
    const int i = layer >> 1;
    volatile LAS unsigned* misc = (volatile LAS unsigned*)(C.lds + LDS_MISC);
    guint* q = (guint*)(C.ws + WS_CTL) + CW_Q + (i + 2 * rep) * 64;
    const float lam_init = 0.8f - 0.6f * expf(-0.3f * (float)layer);
    if (C.wave == 0) { const gfloat* lq = gin(p, 11) + i * 256; const float a = wave_sum(lq[C.lane] * lq[64 + C.lane], C.lane), b2 = wave_sum(lq[128 + C.lane] * lq[192 + C.lane], C.lane);
        if (C.lane == 0) ((volatile LAS float*)misc)[4] = expf(a) - expf(b2) + lam_init; }
    __syncthreads();
    const gbf16* PE = (const gbf16*)(C.ws + WS_P); gbf16* MIX = (gbf16*)(C.ws + WS_MIX);
#ifndef MIX_STATIC
#define MIX_STATIC 1
#endif
#if MIX_STATIC
    for (int y = C.blk; y < 256; y += C.nblk) { const int bh = 2 * (y & 7) + ((y >> 3) >> 4), qb = (y >> 3) & 15; attn_unit(C, PE, MIX, gin(p, 12) + i * 128, layer, bh >> 2, bh & 3, qb, false); }
#endif
    for (;;) {
        if (fresh_tid(C) == 0) misc[8] = __hip_atomic_fetch_add(q, 1u, __ATOMIC_RELAXED, __HIP_MEMORY_SCOPE_AGENT);
        __syncthreads();
        const int u = (int)misc[8];
        __syncthreads();
#ifndef MIX_RG_REP
#define MIX_RG_REP 1
#endif
#ifndef MIX_AT_REP
#define MIX_AT_REP 1
#endif
#if MIX_STATIC
        if (u >= 256 + 16) break;
        if (u < 16) attn_unit(C, PE, MIX, gin(p, 12) + i * 128, layer, u >> 2, u & 3, 0, true);
        else { const int x = u - 16; rgscan_unit(C, x >> 6, x & 63); }
        continue;
#endif
        if (u >= 128 * MIX_RG_REP + 272 * MIX_AT_REP) break;
        if (u < 128 * MIX_RG_REP) { const int x = u & 127; rgscan_unit(C, x >> 5, 2 * (x & 31)); rgscan_unit(C, x >> 5, 2 * (x & 31) + 1); }
        else { const int y = (u - 128 * MIX_RG_REP) % 272;
            if (y < 256) attn_unit(C, PE, MIX, gin(p, 12) + i * 128, layer, y >> 6, (y >> 4) & 3, y & 15, false);
            else { const int x = y - 256; attn_unit(C, PE, MIX, gin(p, 12) + i * 128, layer, x >> 2, x & 3, 0, true); } }
    }
}
DI int chunk_row0(int cidx) { return cidx < 256 ? (cidx >> 6) * SEQ + (cidx & 63) * 64 : NLAT + (cidx - 256) * 64; }
constexpr int GA_RA = 0, GA_RB = 18432, GA_KT0 = 2 * 18432, GA_KT1 = 3 * 18432, GA_VT0 = 4 * 18432, GA_VT1 = 5 * 18432, GA_KK = 6 * 18432, GA_QK = GA_KK + 16640, GA_GC = GA_QK + 16640, GA_END = GA_GC + 2048;
static_assert(GA_END <= LDS_MISC, "GA LDS");
struct GaRegs { u32x4 q[2], k[2], v[2]; float g, be; };
DI void ga_load(const Ctx& C, int unit, GaRegs& R, int tid) {
    const int h = unit & 7, cidx = unit >> 3, row0 = chunk_row0(cidx), lane = tid & 63, wave = tid >> 6;
    const gbf16* QKVN = (const gbf16*)(C.ws + WS_QKVN); const gfloat* Gd = (const gfloat*)(C.ws + WS_GB); const gfloat* Bd = Gd + (size_t)2 * NTOK * 8;
#pragma unroll
    for (int i2 = 0; i2 < 2; ++i2) { const int c = tid + 512 * i2, pos = c & 63, part = c >> 6; const gbf16* src = QKVN + (size_t)(row0 + pos) * 3072 + h * 128 + part * 8;
        R.q[i2] = *(const GAS u32x4*)src; R.k[i2] = *(const GAS u32x4*)(src + 1024); R.v[i2] = *(const GAS u32x4*)(src + 2048); }
    R.g = 0.f; R.be = 0.f;
    if (wave < 2) { const int d = wave, row = row0 + (d ? 63 - lane : lane); R.g = Gd[((size_t)d * NTOK + row) * 8 + h]; R.be = Bd[((size_t)d * NTOK + row) * 8 + h]; }
}
DI void gdn_ga_unit(const Ctx& C, int unit, int next_unit, GaRegs& R) {
    LAS unsigned char* ldsb = C.lds; asm volatile("" : "+v"(ldsb));
    const int h = unit & 7, cidx = unit >> 3;
    const int row0 = chunk_row0(cidx);
    const gbf16* QKVN = (const gbf16*)(C.ws + WS_QKVN); const gfloat* Gd = (const gfloat*)(C.ws + WS_GB); const gfloat* Bd = Gd + (size_t)2 * NTOK * 8;
    const size_t ud0 = (size_t)(cidx * 8 + h) * 2;
    gbf16* WG = (gbf16*)(C.ws + WS_WG) + ud0 * 8192; gbf16* UG = (gbf16*)(C.ws + WS_UG) + ud0 * 8192; gbf16* QKD = (gbf16*)(C.ws + WS_QKD) + ud0 * 4096; gfloat* SC = (gfloat*)(C.ws + WS_SC) + ud0 * 192;
    gbf16* KTG = (gbf16*)(C.ws + WS_KTG) + ud0 * 8192; gbf16* QG = (gbf16*)(C.ws + WS_QG) + ud0 * 8192;
    LAS bf16* Kc = (LAS bf16*)(ldsb + GA_RA); LAS bf16* Qc = (LAS bf16*)(ldsb + GA_RB);
    LAS float* KKm = (LAS float*)(ldsb + GA_KK); LAS float* QKm = (LAS float*)(ldsb + GA_QK);
    LAS float* gc = (LAS float*)(ldsb + GA_GC); LAS float* be = gc + 128; LAS float* ekL = gc + 256;
    int tid = C.tid; asm volatile("" : "+v"(tid));
    const int lane = tid & 63, wave = __builtin_amdgcn_readfirstlane(tid >> 6), r = lane & 31, hh = lane >> 5;
#pragma unroll
    for (int i2 = 0; i2 < 2; ++i2) { const int c = tid + 512 * i2, pos = c & 63, part = c >> 6;
        const u32x4 q = R.q[i2], k = R.k[i2], v = R.v[i2];
        *(LAS u32x4*)(Qc + pos * 136 + part * 8) = q; *(LAS u32x4*)(Kc + pos * 136 + part * 8) = k;
        LAS bf16* kt0 = (LAS bf16*)(ldsb + GA_KT0) + (part * 8) * 72; LAS bf16* kt1 = (LAS bf16*)(ldsb + GA_KT1) + (part * 8) * 72;
        LAS bf16* vt0 = (LAS bf16*)(ldsb + GA_VT0) + (part * 8) * 72; LAS bf16* vt1 = (LAS bf16*)(ldsb + GA_VT1) + (part * 8) * 72;
#pragma unroll
        for (int e = 0; e < 4; ++e) { const bf16 k0 = (bf16)(k[e] & 0xffffu), k1 = (bf16)(k[e] >> 16), v0 = (bf16)(v[e] & 0xffffu), v1 = (bf16)(v[e] >> 16);
            kt0[(2 * e) * 72 + pos] = k0; kt0[(2 * e + 1) * 72 + pos] = k1; kt1[(2 * e) * 72 + 63 - pos] = k0; kt1[(2 * e + 1) * 72 + 63 - pos] = k1;
            vt0[(2 * e) * 72 + pos] = v0; vt0[(2 * e + 1) * 72 + pos] = v1; vt1[(2 * e) * 72 + 63 - pos] = v0; vt1[(2 * e + 1) * 72 + 63 - pos] = v1; } }
    if (wave < 2) {
        const int d = wave;
        float g = R.g;
#pragma unroll
        for (int o = 1; o < 64; o <<= 1) { const float t = __builtin_bit_cast(float, __builtin_amdgcn_ds_bpermute((lane - o) << 2, __builtin_bit_cast(int, g))); if (lane >= o) g += t; }
        gc[d * 64 + lane] = g; be[d * 64 + lane] = R.be;
    }
    if (next_unit >= 0) ga_load(C, next_unit, R, tid);
    LDS_SYNC();
    { const float qscale_ = 0.08838834764831845f;
#pragma unroll
      for (int d = 0; d < 2; ++d)
#pragma unroll
          for (int i2 = 0; i2 < 2; ++i2) { const int c = tid + 512 * i2, pn = c >> 4, part = c & 15, pd = d ? 63 - pn : pn; const float e = qscale_ * __expf(gc[d * 64 + pd]);
              const u32x4 q = *(const LAS u32x4*)(Qc + pn * 136 + part * 8); u32x4 o;
#pragma unroll
              for (int k = 0; k < 4; ++k) o[k] = pk2(bflo(q[k]) * e, bfhi(q[k]) * e);
              *(GAS u32x4*)(QG + d * 8192 + pd * 128 + part * 8) = o; }
      if (tid < 128) { const int d = tid >> 6, i = tid & 63; ekL[tid] = __expf(gc[d * 64 + 63] - gc[d * 64 + i]); } }
    { const int ti = (wave & 3) >> 1, tj = wave & 1; const LAS bf16* Arows = (wave < 4 ? Kc : Qc);
      f32x16 acc = zero16();
#pragma unroll
      for (int ks = 0; ks < 8; ++ks) { const bf16x8 a = *(const LAS bf16x8*)(Arows + (ti * 32 + r) * 136 + 16 * ks + 8 * hh), bb = *(const LAS bf16x8*)(Kc + (tj * 32 + r) * 136 + 16 * ks + 8 * hh); acc = MFMA32(a, bb, acc); }
      LAS float* dst = (wave < 4 ? KKm : QKm);
#pragma unroll
      for (int i = 0; i < 16; ++i) dst[(ti * 32 + crow(i, hh)) * 65 + tj * 32 + r] = acc[i]; }
    LDS_SYNC();
    const float qscale = 0.08838834764831845f;
#pragma unroll
    for (int e = 0; e < 16; ++e) { const int idx = tid + 512 * e, d = idx >> 12, i = (idx >> 6) & 63, j = idx & 63, ti = d ? 63 - i : i, tj = d ? 63 - j : j;
        const float dec = (j <= i) ? __expf(gc[d * 64 + i] - gc[d * 64 + j]) : 0.f;
        ((LAS float*)(ldsb + (d ? GA_RB : GA_RA)))[i * 68 + j] = (j < i) ? KKm[ti * 65 + tj] * be[d * 64 + i] * dec : 0.f;
        QKD[idx] = f2bf(QKm[ti * 65 + tj] * qscale * dec); }
    if (tid < 128) { const int d = tid >> 6, i = tid & 63; SC[d * 192 + i] = qscale * __expf(gc[d * 64 + i]); SC[d * 192 + 64 + i] = __expf(gc[d * 64 + 63] - gc[d * 64 + i]); if (i == 0) SC[d * 192 + 128] = __expf(gc[d * 64 + 63]); }
    LDS_SYNC();
    if (wave < 2) {
        const int d = wave, c = lane; LAS float* Lm = (LAS float*)(ldsb + (d ? GA_RB : GA_RA)); float T[64];
        f32x4 rb[2][16];
        T[0] = (c == 0) ? 1.f : 0.f;
        rb[1][0] = *(const LAS f32x4*)(Lm + 68);
#pragma unroll
        for (int i = 1; i < 64; ++i) {
            if (i + 1 < 64) {
#pragma unroll
                for (int j4 = 0; j4 < (i + 4) / 4; ++j4) rb[(i + 1) & 1][j4] = *(const LAS f32x4*)(Lm + (i + 1) * 68 + 4 * j4); }
            __builtin_amdgcn_sched_barrier(0);
            float a0 = (i == c) ? 1.f : 0.f, a1 = 0.f, a2 = 0.f, a3 = 0.f;
#pragma unroll
            for (int j4 = 0; j4 < (i + 3) / 4; ++j4) { const f32x4 l4 = rb[i & 1][j4];
                a0 -= l4[0] * T[4 * j4]; if (4 * j4 + 1 < i) a1 -= l4[1] * T[4 * j4 + 1]; if (4 * j4 + 2 < i) a2 -= l4[2] * T[4 * j4 + 2]; if (4 * j4 + 3 < i) a3 -= l4[3] * T[4 * j4 + 3]; }
            T[i] = (a0 + a1) + (a2 + a3);
            __builtin_amdgcn_sched_barrier(0);
        }
        const float s2 = be[d * 64 + c], s1 = s2 * __expf(gc[d * 64 + c]);
        LAS bf16* T1 = (LAS bf16*)Lm; LAS bf16* T2 = T1 + 64 * 72;
#pragma unroll
        for (int i = 0; i < 64; ++i) { T1[i * 72 + c] = f2bf(T[i] * s1); T2[i * 72 + c] = f2bf(T[i] * s2); }
    }
    LDS_SYNC();
#pragma unroll
    for (int d = 0; d < 2; ++d) {
        const LAS bf16* T1 = (const LAS bf16*)(ldsb + (d ? GA_RB : GA_RA)); const LAS bf16* T2 = T1 + 64 * 72;
        const LAS bf16* Kt = (const LAS bf16*)(ldsb + (d ? GA_KT1 : GA_KT0)); const LAS bf16* Vt = (const LAS bf16*)(ldsb + (d ? GA_VT1 : GA_VT0));
        const int ti = wave >> 2, tn = wave & 3; f32x16 aw = zero16(), au = zero16();
#pragma unroll
        for (int ks = 0; ks < 4; ++ks) { const bf16x8 a1 = *(const LAS bf16x8*)(T1 + (ti * 32 + r) * 72 + 16 * ks + 8 * hh), a2 = *(const LAS bf16x8*)(T2 + (ti * 32 + r) * 72 + 16 * ks + 8 * hh);
            const bf16x8 bk = *(const LAS bf16x8*)(Kt + (tn * 32 + r) * 72 + 16 * ks + 8 * hh), bv = *(const LAS bf16x8*)(Vt + (tn * 32 + r) * 72 + 16 * ks + 8 * hh);
            aw = MFMA32(a1, bk, aw); au = MFMA32(a2, bv, au); }
#pragma unroll
        for (int i = 0; i < 16; ++i) { const int pos = ti * 32 + crow(i, hh); WG[d * 8192 + pos * 128 + tn * 32 + r] = f2bf(-aw[i]); UG[d * 8192 + pos * 128 + tn * 32 + r] = f2bf(au[i]); }
#pragma unroll
        for (int i2 = 0; i2 < 2; ++i2) { const int c = tid + 512 * i2, row = c >> 3, part = c & 7; const u32x4 kk = *(const LAS u32x4*)(Kt + row * 72 + part * 8);
            const f32x4 e0 = *(const LAS f32x4*)(ekL + d * 64 + part * 8), e1 = *(const LAS f32x4*)(ekL + d * 64 + part * 8 + 4); u32x4 o;
            o[0] = pk2(bflo(kk[0]) * e0[0], bfhi(kk[0]) * e0[1]); o[1] = pk2(bflo(kk[1]) * e0[2], bfhi(kk[1]) * e0[3]); o[2] = pk2(bflo(kk[2]) * e1[0], bfhi(kk[2]) * e1[1]); o[3] = pk2(bflo(kk[3]) * e1[2], bfhi(kk[3]) * e1[3]);
            *(GAS u32x4*)(KTG + d * 8192 + row * 64 + part * 8) = o; }
    }
    LDS_SYNC();
}
DI void ph_gdn_ga(const Ctx& C) {
    GaRegs R; if (C.blk < NCH * 8) ga_load(C, C.blk, R, C.tid);
    for (int u = C.blk; u < NCH * 8; u += C.nblk) gdn_ga_unit(C, u, (u + C.nblk < NCH * 8) ? u + C.nblk : -1, R);
}

#ifndef GB_NSL_V
#define GB_NSL_V 2
#endif
#ifndef GB_XCD_MAP
#define GB_XCD_MAP 1
#endif
constexpr int GB_NSL = GB_NSL_V;
constexpr int GB_W = 0, GB_Q = GB_W + 64 * 136 * 2, GB_KT = GB_Q + 64 * 136 * 2, GB_QK = GB_KT + 128 * 72 * 2, GB_SC = GB_QK + 64 * 72 * 2, GB_U = GB_SC + 1024, GB_UP = GB_NSL * 32 + 8  , GB_UC = GB_NSL * 4  , GB_BUF = GB_U + 64 * GB_UP * 2;
static_assert(2 * GB_BUF <= LDS_MISC, "GB LDS");
template <int VAR> DI void gdn_gb_unit(const Ctx& C, int unit) {
    LAS unsigned char* ldsb = C.lds; asm volatile("" : "+v"(ldsb));
    constexpr int NGRP = 4 / GB_NSL;
#if GB_XCD_MAP
    const int bhd = (unit & 7) * 8 + ((unit >> 3) & 7), grp = unit >> 6, d = bhd & 1, h = (bhd >> 1) & 7, b = bhd >> 4;
#else
    const int grp = unit % NGRP, bhd = unit / NGRP, d = bhd & 1, h = (bhd >> 1) & 7, b = bhd >> 4;
#endif
    const gbf16* QGb = (const gbf16*)(C.ws + WS_QG);
    const gbf16* WGb = (const gbf16*)(C.ws + WS_WG); const gbf16* UGb = (const gbf16*)(C.ws + WS_UG); const gbf16* QKDb = (const gbf16*)(C.ws + WS_QKD); const gbf16* KTGb = (const gbf16*)(C.ws + WS_KTG); const gfloat* SCb = (const gfloat*)(C.ws + WS_SC);
    gbf16* OG = (gbf16*)(C.ws + (VAR ? WS_XS : WS_OG));
    int tid = C.tid; asm volatile("" : "+v"(tid));
    const int lane = tid & 63, wave = __builtin_amdgcn_readfirstlane(tid >> 6), r = lane & 31, hh = lane >> 5;
    const bool comp = wave < GB_NSL; const int dv0 = (grp * GB_NSL + wave) * 32;
    static_assert(GB_NSL == 2 || GB_NSL == 4, "the staging split is written for two or four computing waves");
    constexpr int NUI = GB_NSL;
    const int wv = wave - GB_NSL; const bool stg = (wv >= 0 && wv < 4);
    auto chunk_of = [&](int step) { return step < 4 ? 256 + b * 4 + (d ? 3 - step : step) : b * 64 + (d ? 63 - (step - 4) : (step - 4)); };
#define GB_LOAD(step, SR, RS) do { int ln2_ = lane; asm volatile("" : "+v"(ln2_)); const int sc_ = (step) < 67 ? (step) : 67, cidx_ = chunk_of(sc_), un_ = (cidx_ * 8 + h) * 2 + d; \
        _Pragma("unroll") for (int i_ = 0; i_ < 4; ++i_) { const int c_ = (wv * 4 + i_) * 64 + ln2_; \
            SR[i_] = *(const GAS u32x4*)(WGb + (size_t)un_ * 8192 + c_ * 8); SR[4 + i_] = *(const GAS u32x4*)(QGb + (size_t)un_ * 8192 + c_ * 8); SR[8 + i_] = *(const GAS u32x4*)(KTGb + (size_t)un_ * 8192 + c_ * 8); } \
        _Pragma("unroll") for (int i_ = 0; i_ < 2; ++i_) { const int c_ = (wv * 2 + i_) * 64 + ln2_; \
            SR[12 + i_] = *(const GAS u32x4*)(QKDb + (size_t)un_ * 4096 + c_ * 8); } \
        _Pragma("unroll") for (int i_ = 0; i_ < NUI; ++i_) { const int c_ = (wv * NUI + i_) * 64 + ln2_; \
            SR[14 + i_] = *(const GAS u32x4*)(UGb + (size_t)un_ * 8192 + (c_ / GB_UC) * 128 + grp * (GB_NSL * 32) + (c_ % GB_UC) * 8); } \
        { const int si_ = wv * 64 + ln2_; RS = SCb[(size_t)un_ * 192 + (si_ < 191 ? si_ : 191)]; } } while (0)
#define GB_STORE(buf, SR, RS) do { int ln2_ = lane; asm volatile("" : "+v"(ln2_)); LAS unsigned char* B_ = ldsb + (buf) * GB_BUF; \
        _Pragma("unroll") for (int i_ = 0; i_ < 4; ++i_) { const int c_ = (wv * 4 + i_) * 64 + ln2_; \
            *(LAS u32x4*)((LAS bf16*)(B_ + GB_W) + (c_ >> 4) * 136 + (c_ & 15) * 8) = SR[i_]; *(LAS u32x4*)((LAS bf16*)(B_ + GB_Q) + (c_ >> 4) * 136 + (c_ & 15) * 8) = SR[4 + i_]; \
            *(LAS u32x4*)((LAS bf16*)(B_ + GB_KT) + (c_ >> 3) * 72 + (c_ & 7) * 8) = SR[8 + i_]; } \
        _Pragma("unroll") for (int i_ = 0; i_ < 2; ++i_) { const int c_ = (wv * 2 + i_) * 64 + ln2_; \
            *(LAS u32x4*)((LAS bf16*)(B_ + GB_QK) + (c_ >> 3) * 72 + (c_ & 7) * 8) = SR[12 + i_]; } \
        _Pragma("unroll") for (int i_ = 0; i_ < NUI; ++i_) { const int c_ = (wv * NUI + i_) * 64 + ln2_; \
            *(LAS u32x4*)((LAS bf16*)(B_ + GB_U) + (c_ / GB_UC) * GB_UP + (c_ % GB_UC) * 8) = SR[14 + i_]; } \
        { const int si_ = wv * 64 + ln2_; ((LAS float*)(B_ + GB_SC))[si_ < 191 ? si_ : 191] = RS; } } while (0)
    if (stg) {
        u32x4 sreg[14 + NUI], sreg2[14 + NUI]; float rsc = 0.f, rsc2 = 0.f;
        GB_LOAD(0, sreg, rsc); GB_STORE(0, sreg, rsc); GB_LOAD(1, sreg, rsc);
        asm volatile("s_waitcnt lgkmcnt(0)\n\ts_barrier" ::: "memory");
        for (int step = 0; step < 68; step += 2) {
            if (VAR != 2) { GB_LOAD(step + 2, sreg2, rsc2); GB_STORE(1, sreg, rsc); }
            asm volatile("s_waitcnt lgkmcnt(0)\n\ts_barrier" ::: "memory");
            if (VAR != 2) { GB_LOAD(step + 3, sreg, rsc); GB_STORE(0, sreg2, rsc2); }
            asm volatile("s_waitcnt lgkmcnt(0)\n\ts_barrier" ::: "memory");
        }
    } else if (!comp) {
        for (int step = 0; step < 69; ++step) asm volatile("s_barrier" ::: "memory");
    } else {
        f32x16 S[4];
#pragma unroll
        for (int k = 0; k < 4; ++k) S[k] = zero16();
        bf16x8 idf[2];
#pragma unroll
        for (int s = 0; s < 2; ++s) { const int js = r - 16 * s - 8 * hh; u32x4 iw;
#pragma unroll
            for (int q = 0; q < 4; ++q) iw[q] = (js == 2 * q) ? 0x00003F80u : ((js == 2 * q + 1) ? 0x3F800000u : 0u);
            idf[s] = __builtin_bit_cast(bf16x8, iw); }
        asm volatile("s_barrier" ::: "memory");
        for (int step = 0; step < 68; ++step) {
            const int buf = step & 1;
            if (VAR != 1) {
            int ln_ = lane; asm volatile("" : "+v"(ln_)); const int r = ln_ & 31, hh = ln_ >> 5;
            const int cidx = chunk_of(step), un = (cidx * 8 + h) * 2 + d, row0 = chunk_row0(cidx);
            const LAS unsigned char* Bp = ldsb + buf * GB_BUF; const LAS bf16* Wl = (const LAS bf16*)(Bp + GB_W); const LAS bf16* Ql = (const LAS bf16*)(Bp + GB_Q);
            const LAS bf16* KTl = (const LAS bf16*)(Bp + GB_KT); const LAS bf16* QKl = (const LAS bf16*)(Bp + GB_QK); const LAS float* scl = (const LAS float*)(Bp + GB_SC);
            bf16x8 fa[8], fb[8];
#define GB_SB __builtin_amdgcn_sched_barrier(0)
#define GB_LDWQ(F, Ml, kb0) do { _Pragma("unroll") for (int q_ = 0; q_ < 8; ++q_) F[q_] = ld_perm_frag(Ml + ((q_ & 1) * 32 + r) * 136, ((kb0) + (q_ >> 2)) * 32, (q_ >> 1) & 1, hh); } while (0)
#define GB_MMWQ(F, A0, A1, kb0) do { _Pragma("unroll") for (int q_ = 0; q_ < 8; q_ += 2) { A0 = MFMA32(F[q_], sp[(kb0) + (q_ >> 2)][(q_ >> 1) & 1], A0); A1 = MFMA32(F[q_ + 1], sp[(kb0) + (q_ >> 2)][(q_ >> 1) & 1], A1); } } while (0)
            bf16x8 sp[4][2];
            GB_LDWQ(fa, Wl, 0); GB_SB;
#pragma unroll
            for (int kb = 0; kb < 4; ++kb) { sp[kb][0] = pack_step(S[kb], 0); sp[kb][1] = pack_step(S[kb], 1); }
            f32x16 aw0 = zero16(), aw1 = zero16(), aq0 = zero16(), aq1 = zero16();
            GB_LDWQ(fb, Wl, 2); GB_SB; GB_MMWQ(fa, aw0, aw1, 0); GB_SB;
            GB_LDWQ(fa, Ql, 0); GB_SB; GB_MMWQ(fb, aw0, aw1, 2); GB_SB;
            GB_LDWQ(fb, Ql, 2); GB_SB; GB_MMWQ(fa, aq0, aq1, 0); GB_SB;
            { const LAS bf16* Ul = (const LAS bf16*)(Bp + GB_U) + wave * 32 + 8 * hh;
#pragma unroll
              for (int q = 0; q < 4; ++q) fa[q] = *(const LAS bf16x8*)(Ul + ((q & 1) * 32 + r) * GB_UP + 16 * (q >> 1)); }
            GB_SB; GB_MMWQ(fb, aq0, aq1, 2); GB_SB;
#pragma unroll
            for (int q = 0; q < 8; ++q) fb[q] = ld_perm_frag(QKl + ((q & 1) * 32 + r) * 72, (q >> 2) * 32, (q >> 1) & 1, hh);
            GB_SB;
#pragma unroll
            for (int s = 0; s < 2; ++s) { aw0 = MFMA32(fa[2 * s], idf[s], aw0); aw1 = MFMA32(fa[2 * s + 1], idf[s], aw1); }
            bf16x8 vp[2][2];
            vp[0][0] = pack_step(aw0, 0); vp[0][1] = pack_step(aw0, 1); vp[1][0] = pack_step(aw1, 0); vp[1][1] = pack_step(aw1, 1);
            GB_SB;
#pragma unroll
            for (int q = 0; q < 8; ++q) fa[q] = ld_perm_frag(KTl + ((q & 3) * 32 + r) * 72, 0, q >> 2, hh);
            GB_SB;
#pragma unroll
            for (int q = 0; q < 8; q += 2) { aq0 = MFMA32(fb[q], vp[q >> 2][(q >> 1) & 1], aq0); aq1 = MFMA32(fb[q + 1], vp[q >> 2][(q >> 1) & 1], aq1); }
            const float gtot = scl[128];
#pragma unroll
            for (int kb = 0; kb < 4; ++kb) S[kb] = S[kb] * gtot;
            GB_SB;
#pragma unroll
            for (int q = 0; q < 8; ++q) fb[q] = ld_perm_frag(KTl + ((q & 3) * 32 + r) * 72, 32, q >> 2, hh);
            GB_SB;
#pragma unroll
            for (int q = 0; q < 8; ++q) S[q & 3] = MFMA32(fa[q], vp[0][q >> 2], S[q & 3]);
            GB_SB;
#pragma unroll
            for (int q = 0; q < 8; ++q) S[q & 3] = MFMA32(fb[q], vp[1][q >> 2], S[q & 3]);
#undef GB_SB
#undef GB_LDWQ
#undef GB_MMWQ
            { gbf16* ob = OG + (size_t)un * 8192 + hh * 512 + dv0 + r;
#pragma unroll
              for (int i = 0; i < 16; ++i) { ob[((i & 3) + 8 * (i >> 2)) * 128] = f2bf(aq0[i]); ob[(32 + (i & 3) + 8 * (i >> 2)) * 128] = f2bf(aq1[i]); } }
            }
            asm volatile("s_waitcnt lgkmcnt(0)\n\ts_barrier" ::: "memory");
        }
    }
#undef GB_LOAD
#undef GB_STORE
}
DI void ph_gdn_gb(const Ctx& C, const Params& p, int lp, int rep) {
    constexpr int NU = 64 * (4 / GB_NSL);
#ifndef GB_PROBE_VAR
    for (int u = C.blk; u < NU; u += C.nblk) gdn_gb_unit<0>(C, u);
#else
    if (rep) { for (int u = C.blk; u < NU; u += C.nblk) gdn_gb_unit<GB_PROBE_VAR>(C, u); return; }
    for (int u = C.blk; u < NU; u += C.nblk) gdn_gb_unit<0>(C, u);
#endif
#if CONV_DEFER
    if (C.nblk > NU) { if (C.blk >= NU) convert_weights(C, p, 1 + lp, (C.blk - NU) * 8 + C.wave, (C.nblk - NU) * 8); }
    else convert_weights(C, p, 1 + lp, C.blk * 8 + C.wave, C.nblk * 8);
#endif
}
constexpr int NPH_PAIR = 20, NPHASE = 1 + 2 * NPH_PAIR;
DI void fresh(Ctx& C) { int t; asm volatile("v_mbcnt_lo_u32_b32 %0, -1, 0\n\tv_mbcnt_hi_u32_b32 %0, -1, %0" : "=v"(t)); t += C.wave0 * 64; asm volatile("" : "+v"(t));     int b = blockIdx.x; asm volatile("" : "+s"(b)); guchar* w_ = C.ws0; asm volatile("" : "+s"(w_)); C.ws = w_; C.tid = t; C.lane = t & 63; C.wave = __builtin_amdgcn_readfirstlane(t >> 6); C.blk = b; }
__global__ void __launch_bounds__(512, 2) fused_fwd(Params p) {
    extern __shared__ __attribute__((aligned(16))) unsigned char lds_raw[];
    Ctx C; C.lds = (LAS unsigned char*)lds_raw; C.ws = (guchar*)p.ws; C.ws0 = (guchar*)p.ws; C.tid = threadIdx.x; C.lane = C.tid & 63; C.wave = __builtin_amdgcn_readfirstlane(C.tid >> 6); C.wave0 = C.wave; C.nblk = gridDim.x; C.blk = blockIdx.x;
    volatile LAS unsigned* misc = (volatile LAS unsigned*)(C.lds + LDS_MISC);
    if (C.tid < 16) misc[C.tid] = 0u;
    __syncthreads();
    unsigned* ctl = (unsigned*)(p.ws + WS_CTL);
    const bool single = (p.ph_lo == 0 && p.ph_hi == NPHASE);
    XcdBarrier bar; bar.bar = ctl + CW_BAR; bar.x = 0; bar.st = misc;
    if (single) bar = xcd_barrier_post(ctl + CW_BAR, misc);
    const int lo = p.ph_lo, hi = p.ph_hi;
#ifndef PH_MASK
#define PH_MASK 0x1FFFFFu
#endif
#define PHEN(k) (((PH_MASK) >> (k)) & 1u)
#ifndef XTRA_BAR
#define XTRA_BAR 0
#endif
#ifndef REP_MASK
#define REP_MASK 0u
#endif
#define NREP(k) (1 + (int)(((REP_MASK) >> (k)) & 1u))
#define IN(k) (fresh(C), lo <= (k) && (k) < hi)
#define SEAM(k) do { if (single) { unsigned* bp_ = ctl + CW_BAR; asm volatile("" : "+s"(bp_)); bar.bar = bp_; xcd_barrier(bar); for (int xb_ = 0; xb_ < XTRA_BAR; ++xb_) xcd_barrier(bar); } } while (0)
#define H ((gbf16*)(C.ws + WS_H))
#define MIX ((gbf16*)(C.ws + WS_MIX))
#define P ((gbf16*)(C.ws + WS_P))
#define X ((gbf16*)(C.ws + WS_X))
#define MOD ((const gfloat*)(C.ws + WS_MOD))
    for (int rep_ = 0; rep_ < NREP(0); ++rep_) { if (rep_) { SEAM(0); } if (PHEN(0) && IN(0)) ph_prologue(C, p); }
    SEAM(0);
    for (int lp = 0; lp < 2; ++lp) {
        const int pb = 1 + lp * NPH_PAIR, le = 2 * lp, lod = 2 * lp + 1;
        for (int rep_ = 0; rep_ < NREP(1); ++rep_) { if (rep_) { SEAM(0); } if (PHEN(1) && IN(pb + 0)) { if (lp == 0) ph_normmod(C, p, 0, false, true, 0, 0); } }
        if (lp == 0) SEAM(pb + 0);
        for (int rep_ = 0; rep_ < NREP(2); ++rep_) { if (rep_) { SEAM(0); } if (PHEN(2) && IN(pb + 1)) { pg8::Gemm g{H, (const gbf16*)(C.ws + WS_WEIN) + (size_t)lp * 2560 * 1024, NTOK, EVEN_IN, D, 0}; pg8::StaticOrder S; S.init(NTOK, EVEN_IN, C.nblk, C.blk);
            EpiEvenIn E{P, (const gfloat*)(C.ws + WS_COS), (const gfloat*)(C.ws + WS_SIN)}; pg8::gemm_phase<EpiEvenIn, pg8::StaticOrder>(C.lds, g, S, E, C.tid); } }
        SEAM(pb + 1);
        for (int rep_ = 0; rep_ < NREP(20); ++rep_) { if (rep_) { SEAM(0); } if (PHEN(20) && IN(pb + 2)) ph_rg_gates(C, p, lp); }
        SEAM(pb + 2);
        for (int rep_ = 0; rep_ < NREP(3); ++rep_) { if (rep_) { SEAM(0); } if (PHEN(3) && IN(pb + 3)) ph_even_mix(C, p, le, rep_); }
        SEAM(pb + 3);
        for (int rep_ = NREP(4) - 1; rep_ >= 0; --rep_) { if (PHEN(4) && IN(pb + 4)) {
            { pg8::Gemm g{MIX, (const gbf16*)(C.ws + WS_WEOUT) + (size_t)lp * 1024 * 1024, NLAT, D, D, 0}; pg8::StaticOrder S; S.init(NLAT, D, C.nblk, C.blk);
              EpiResid E{rep_ ? (gbf16*)(C.ws + WS_U + (size_t)200 * 1024 * 1024) : X, MOD + (size_t)le * 5 * MODW + 2 * D}; pg8::gemm_phase<EpiResid, pg8::StaticOrder>(C.lds, g, S, E, C.tid); }
            { fresh(C); pg8::Gemm g{MIX + (size_t)NLAT * D, (const gbf16*)(C.ws + WS_WEOUT) + (size_t)lp * 1024 * 1024, NCTX, D, D, D / 4}; pg8::StaticOrder S; S.init(NCTX, D, C.nblk, C.blk); S.lim = S.nwg * 4; S.s = 4;
              EpiPart E{(gfloat*)(C.ws + WS_PART)}; pg8::gemm_phase<EpiPart, pg8::StaticOrder>(C.lds, g, S, E, C.tid); } } if (rep_) { SEAM(0); } }
        SEAM(pb + 4);
        for (int rep_ = 0; rep_ < NREP(5); ++rep_) { if (rep_) { SEAM(0); } if (PHEN(5) && IN(pb + 5)) ph_normmod(C, p, le, true, false, 4, le * 5 * MODW + 2 * D); }
        SEAM(pb + 5);
        for (int rep_ = 0; rep_ < NREP(6); ++rep_) { if (rep_) { SEAM(0); } if (PHEN(6) && IN(pb + 6)) { pg8::Gemm g{H, (const gbf16*)(C.ws + WS_WEF1) + (size_t)lp * 5632 * 1024, NTOK, 2 * FFN, D, 0}; pg8::StaticOrder S; S.init(NTOK, 2 * FFN, C.nblk, C.blk);
            EpiSwiglu E{P, FFN, 2 * FFN / 256}; pg8::gemm_phase<EpiSwiglu, pg8::StaticOrder>(C.lds, g, S, E, C.tid); } }
        SEAM(pb + 6);
        for (int rep_ = NREP(7) - 1; rep_ >= 0; --rep_) { if (PHEN(7) && IN(pb + 7)) {
            { pg8::Gemm g{P, (const gbf16*)(C.ws + WS_WEF2) + (size_t)lp * 1024 * 2816, NLAT, D, FFN, 0}; pg8::StaticOrder S; S.init(NLAT, D, C.nblk, C.blk);
              EpiResid E{rep_ ? (gbf16*)(C.ws + WS_U + (size_t)200 * 1024 * 1024) : X, MOD + (size_t)le * 5 * MODW + 5 * D}; pg8::gemm_phase<EpiResid, pg8::StaticOrder>(C.lds, g, S, E, C.tid); }
            { fresh(C); pg8::Gemm g{P + (size_t)NLAT * FFN, (const gbf16*)(C.ws + WS_WEF2) + (size_t)lp * 1024 * 2816, NCTX, D, FFN, FFN / 11}; pg8::StaticOrder S; S.init(NCTX, D, C.nblk, C.blk); S.lim = S.nwg * 11; S.s = 11;
              EpiPart E{(gfloat*)(C.ws + WS_PART)}; pg8::gemm_phase<EpiPart, pg8::StaticOrder>(C.lds, g, S, E, C.tid); } } if (rep_) { SEAM(0); } }
        SEAM(pb + 7);
        const int ntok = (lod < DEPTH - 1) ? NTOK : NLAT;
        for (int rep_ = 0; rep_ < NREP(8); ++rep_) { if (rep_) { SEAM(0); } if (PHEN(8) && IN(pb + 8)) ph_normmod(C, p, lod, false, false, 11, le * 5 * MODW + 5 * D); }
        SEAM(pb + 8);
        for (int rep_ = 0; rep_ < NREP(9); ++rep_) { if (rep_) { SEAM(0); } if (PHEN(9) && IN(pb + 9)) { pg8::Gemm g{H, (const gbf16*)(C.ws + WS_WOIN) + (size_t)lp * 4352 * 1024, NTOK, 4352, D, 0}; pg8::StaticOrder S; S.init(NTOK, 4352, C.nblk, C.blk);
            EpiBf16Ab E{P, 4352, (gfloat*)(C.ws + WS_AB), 16}; pg8::gemm_phase<EpiBf16Ab, pg8::StaticOrder>(C.lds, g, S, E, C.tid); } }
        SEAM(pb + 9);
        for (int rep_ = 0; rep_ < NREP(10); ++rep_) { if (rep_) { SEAM(0); } if (PHEN(10) && IN(pb + 10)) ph_odd_conv(C, p, lp); }
        SEAM(pb + 10);
        for (int rep_ = 0; rep_ < NREP(11); ++rep_) { if (rep_) { SEAM(0); } if (PHEN(11) && IN(pb + 11)) ph_gdn_ga(C); }
        SEAM(pb + 11);
        for (int rep_ = 0; rep_ < NREP(12); ++rep_) { if (rep_) { SEAM(0); } if (PHEN(12) && IN(pb + 12)) ph_gdn_gb(C, p, lp, rep_); }
        SEAM(pb + 12);
        for (int rep_ = 0; rep_ < NREP(13); ++rep_) { if (rep_) { SEAM(0); } if (PHEN(13) && IN(pb + 13)) ph_gdn_out(C, p, lp, ntok); }
        SEAM(pb + 13);
        for (int rep_ = NREP(14) - 1; rep_ >= 0; --rep_) { if (PHEN(14) && IN(pb + 14)) {
            { pg8::Gemm g{MIX, (const gbf16*)(C.ws + WS_WOOUT) + (size_t)lp * 1024 * 1024, NLAT, D, D, 0}; pg8::StaticOrder S; S.init(NLAT, D, C.nblk, C.blk);
              EpiResid E{rep_ ? (gbf16*)(C.ws + WS_U + (size_t)200 * 1024 * 1024) : X, MOD + (size_t)lod * 5 * MODW + 2 * D}; pg8::gemm_phase<EpiResid, pg8::StaticOrder>(C.lds, g, S, E, C.tid); }
            if (lod < DEPTH - 1) { fresh(C); pg8::Gemm g{MIX + (size_t)NLAT * D, (const gbf16*)(C.ws + WS_WOOUT) + (size_t)lp * 1024 * 1024, NCTX, D, D, D / 4}; pg8::StaticOrder S; S.init(NCTX, D, C.nblk, C.blk); S.lim = S.nwg * 4; S.s = 4;
              EpiPart E{(gfloat*)(C.ws + WS_PART)}; pg8::gemm_phase<EpiPart, pg8::StaticOrder>(C.lds, g, S, E, C.tid); } } if (rep_) { SEAM(0); } }
        SEAM(pb + 14);
        if (PHEN(15) && IN(pb + 15)) ph_router(C, p, lod, ntok, (lod < DEPTH - 1) ? 4 : 0);
        SEAM(pb + 15);
        for (int rep_ = 0; rep_ < NREP(16); ++rep_) { if (rep_) { SEAM(0); } if (PHEN(16) && IN(pb + 16)) ph_gather(C, lod, ntok); }
        SEAM(pb + 16);
        for (int rep_ = 0; rep_ < NREP(17); ++rep_) { if (rep_) { SEAM(0); } if (PHEN(17) && IN(pb + 17)) { pg8::Gemm g{(const gbf16*)(C.ws + WS_XS), (const gbf16*)(C.ws + WS_WXIN) + (size_t)lp * 8 * 7168 * 1024, RMAX, 8 * 7168, D, 0}; MoeOrder S; S.initm((const guint*)(ctl + CW_CNT + lp * 64), 28, C.nblk, C.blk);
            EpiSwiglu E{(gbf16*)(C.ws + WS_HIDM), FFE, 28}; pg8::gemm_phase<EpiSwiglu, MoeOrder>(C.lds, g, S, E, C.tid); } }
        SEAM(pb + 17);
        for (int rep_ = 0; rep_ < NREP(18); ++rep_) { if (rep_) { SEAM(0); } if (PHEN(18) && IN(pb + 18)) {
            { pg8::Gemm g{(const gbf16*)(C.ws + WS_HIDM), (const gbf16*)(C.ws + WS_WXOUT) + (size_t)lp * 8 * 1024 * 3584, RMAX, 8 * 1024, FFE, 0}; MoeOrder2 S; S.initm((const guint*)(ctl + CW_CNT + lp * 64), C.nblk, C.blk, 0);
              EpiF32 E{(gbf16*)(C.ws + WS_Y), D, 4}; pg8::gemm_phase<EpiF32, MoeOrder2>(C.lds, g, S, E, C.tid); }
            { fresh(C); MoeOrder2 S; S.initm((const guint*)(ctl + CW_CNT + lp * 64), C.nblk, C.blk, 1);
              pg8::Gemm g{(const gbf16*)(C.ws + WS_HIDM), (const gbf16*)(C.ws + WS_WXOUT) + (size_t)lp * 8 * 1024 * 3584, RMAX, 8 * 1024, FFE, FFE / S.s};
              EpiPartY E{(gfloat*)(C.ws + WS_YP), S.Lmain >> 2, (S.r >> 2) * 256}; pg8::gemm_phase<EpiPartY, MoeOrder2>(C.lds, g, S, E, C.tid); } } }
        SEAM(pb + 18);
        if (PHEN(19) && IN(pb + 19)) ph_combine(C, p, lod, ntok, (const guint*)(ctl + CW_CNT + lp * 64));
        SEAM(pb + 19);
    }
#undef IN
#undef SEAM
#undef H
#undef MIX
#undef P
#undef X
#undef MOD
}

static int fused_setup() {
    static int grid = 0;
    if (grid == 0) {
        int dev = 0, cus = 0, per_cu = 0;
        if (hipGetDevice(&dev) != hipSuccess || hipDeviceGetAttribute(&cus, hipDeviceAttributeMultiprocessorCount, dev) != hipSuccess) { fprintf(stderr, "fused_setup: device query failed\n"); grid = -1; return grid; }
        if (hipFuncSetAttribute((const void*)fused_fwd, hipFuncAttributeMaxDynamicSharedMemorySize, LDS_BYTES) != hipSuccess) { fprintf(stderr, "fused_setup: hipFuncSetAttribute failed\n"); grid = -1; return grid; }
        if (hipOccupancyMaxActiveBlocksPerMultiprocessor(&per_cu, (const void*)fused_fwd, 512, LDS_BYTES) != hipSuccess || per_cu < 1) { fprintf(stderr, "fused_setup: occupancy query says %d blocks per CU\n", per_cu); (void)hipGetLastError(); }
        grid = cus;
    }
    return grid;
}
static void launch_fused(const Params& p0, int lo, int hi, hipStream_t s) {
    const int grid = fused_setup(); if (grid <= 0) return;
    Params p = p0; p.ph_lo = lo; p.ph_hi = hi;
    hipLaunchKernelGGL(fused_fwd, dim3(grid), dim3(512), LDS_BYTES, s, p);
}
}
#ifdef DEBUG_MODE
namespace dbg {
using namespace cfg;
__global__ void k_cmp_f32_bf16(const float* __restrict__ A, const unsigned short* __restrict__ R, size_t n, float* __restrict__ res) {
    float d2 = 0.f, r2 = 0.f;
    for (size_t i = (size_t)blockIdx.x * 256 + threadIdx.x; i < n; i += (size_t)gridDim.x * 256) { const float r = __uint_as_float((unsigned)R[i] << 16), a = A[i]; d2 += (a - r) * (a - r); r2 += r * r; }
    for (int o = 32; o >= 1; o >>= 1) { d2 += __shfl_xor(d2, o); r2 += __shfl_xor(r2, o); }
    if ((threadIdx.x & 63) == 0) { atomicAdd(res, d2); atomicAdd(res + 1, r2); }
}
__global__ void k_cmp_bf16_f32(const unsigned short* __restrict__ A, int fp, int fo, const float* __restrict__ R, int rp, int ro, int nrows, int ncols, float rscale, float* __restrict__ res) {
    float d2 = 0.f, r2 = 0.f;
    for (size_t i = (size_t)blockIdx.x * 256 + threadIdx.x; i < (size_t)nrows * ncols; i += (size_t)gridDim.x * 256) { const int row = (int)(i / ncols), c = (int)(i % ncols);
        const float a = __uint_as_float((unsigned)A[(size_t)row * fp + fo + c] << 16), r = R[(size_t)row * rp + ro + c] * rscale; d2 += (a - r) * (a - r); r2 += r * r; }
    for (int o = 32; o >= 1; o >>= 1) { d2 += __shfl_xor(d2, o); r2 += __shfl_xor(r2, o); }
    if ((threadIdx.x & 63) == 0) { atomicAdd(res, d2); atomicAdd(res + 1, r2); }
}
__global__ void k_cmp_f32_f32(const float* __restrict__ A, int fp, int fo, const float* __restrict__ R, int rp, int ro, int nrows, int ncols, float* __restrict__ res) {
    float d2 = 0.f, r2 = 0.f;
    for (size_t i = (size_t)blockIdx.x * 256 + threadIdx.x; i < (size_t)nrows * ncols; i += (size_t)gridDim.x * 256) { const int row = (int)(i / ncols), c = (int)(i % ncols);
        const float a = A[(size_t)row * fp + fo + c], r = R[(size_t)row * rp + ro + c]; d2 += (a - r) * (a - r); r2 += r * r; }
    for (int o = 32; o >= 1; o >>= 1) { d2 += __shfl_xor(d2, o); r2 += __shfl_xor(r2, o); }
    if ((threadIdx.x & 63) == 0) { atomicAdd(res, d2); atomicAdd(res + 1, r2); }
}
__global__ void k_decide(const float* __restrict__ res, int nchk, float tol, float* __restrict__ out, size_t nout) {
    int code = 0; float frac = 0.f;
    for (int k = 0; k < nchk; ++k) { const float err = res[2 * k] / res[2 * k + 1]; if (!(err <= tol)) { code = k + 1; float l = (err == err && err > 0.f) ? log10f(err) : 0.f; frac = fminf(fmaxf((l + 4.f) / 4.f * 0.9f, 0.f), 0.9f); break; } }
    if (code == 0) return;
    const float c = sqrtf((float)code + frac);
    for (size_t i = (size_t)blockIdx.x * 256 + threadIdx.x; i < nout; i += (size_t)gridDim.x * 256) out[i] = c;
}
}
#endif

static nv::NaiveWs carve_naive(char* base, size_t& off) {
    using namespace cfg;
    nv::NaiveWs w{};
    auto take = [&](size_t nfloats) { float* p = (float*)(base + off); off += ((nfloats * 4 + 255) / 256) * 256; return p; };
    w.MOD = take((size_t)DEPTH * 5 * MODW);
    w.X = take((size_t)NTOK * D); w.H = take((size_t)NTOK * D); w.P = take((size_t)NTOK * ODD_IN); w.MIX = take((size_t)NTOK * D);
    w.T0 = take((size_t)NTOK * 512); w.T1 = take((size_t)NTOK * 3072); w.T2 = take((size_t)NTOK * 2048);
    w.FOUT = take((size_t)NTOK * D); w.HID = take((size_t)NTOK * FFE);
    w.lam = take(64); w.cnt = (int*)take(64); w.list_tok = (int*)take((size_t)NEXP * NTOK); w.list_w = take((size_t)NEXP * NTOK);
    return w;
}
extern "C" void kernel_launch(void* const* d_in, const int* in_sizes, int n_in, void* d_out, int out_size, void* d_ws, size_t ws_size, hipStream_t stream) {
    using namespace cfg;
    if (n_in != 31 || out_size != NLAT * D) { fprintf(stderr, "kernel_launch: unexpected n_in %d / out_size %d\n", n_in, out_size); return; }
    fk::Params p{}; for (int i = 0; i < 31; ++i) p.in[i] = (const float*)d_in[i];
    p.out = (float*)d_out; p.ws = (unsigned char*)d_ws;
#ifdef DEBUG_MODE
    const size_t snap_bytes = (size_t)NTOK * D * 2, CK_BYTES = 8 * snap_bytes + (size_t)NLAT * D * 4 + 4096;
    if (ws_size < fk::WS_END + CK_BYTES) { fprintf(stderr, "kernel_launch(debug): workspace too small\n"); return; }
    char* ckb = (char*)d_ws + ws_size - CK_BYTES; ckb -= ((size_t)ckb & 255);
    unsigned short* snaps = (unsigned short*)ckb; float* nout = (float*)(ckb + 8 * snap_bytes); float* res = (float*)(ckb + 8 * snap_bytes + (size_t)NLAT * D * 4);
    {
        nv::Inputs in{}; for (int i = 0; i < 31; ++i) in.p[i] = (const float*)d_in[i];
        size_t off = 0; nv::NaiveWs w = carve_naive((char*)d_ws, off);
        if ((char*)d_ws + off > ckb) { fprintf(stderr, "kernel_launch(debug): oracle scratch overlaps snapshots\n"); return; }
        nv::run_naive(in, w, nout, snaps, stream);
    }
    (void)hipMemsetAsync(res, 0, 4096, stream);
    (void)hipMemsetAsync((char*)d_ws + fk::WS_CTL, 0, fk::CTL_BYTES, stream);
    int chk = 0;
    for (int ph = 0; ph < fk::NPHASE; ++ph) {
        fk::launch_fused(p, ph, ph + 1, stream);
        if (ph == 0) continue;
        const int lp = (ph - 1) / fk::NPH_PAIR, k = (ph - 1) % fk::NPH_PAIR;
        int snap = -1;
        if (k == 5) snap = 4 * lp + 0; else if (k == 8) snap = 4 * lp + 1; else if (k == 15) snap = 4 * lp + 2; else if (k == 19 && lp == 0) snap = 3;
        if (snap >= 0) { hipLaunchKernelGGL(dbg::k_cmp_f32_bf16, dim3(2048), dim3(256), 0, stream, (const float*)((char*)d_ws + fk::WS_X), snaps + (size_t)snap * NTOK * D, (size_t)(snap == 6 ? NLAT : NTOK) * D, res + 2 * chk); ++chk; }
    }
    hipLaunchKernelGGL(dbg::k_cmp_f32_f32, dim3(2048), dim3(256), 0, stream, (const float*)d_out, D, 0, (const float*)nout, D, 0, NLAT, D, res + 2 * chk); ++chk;
    hipLaunchKernelGGL(dbg::k_decide, dim3(1024), dim3(256), 0, stream, (const float*)res, chk, DEBUG_TOL, (float*)d_out, (size_t)NLAT * D);
#else
    if (ws_size < fk::WS_END) { fprintf(stderr, "kernel_launch: workspace too small: need %zu have %zu\n", (size_t)fk::WS_END, ws_size); return; }
    (void)hipMemsetAsync((char*)d_ws + fk::WS_CTL, 0, fk::CTL_BYTES, stream);
    fk::launch_fused(p, 0, fk::NPHASE, stream);
#endif
}
```
